# Optimizing an MI355X kernel written in HIP

```python
import math
import jax, jax.numpy as jnp
from jax import lax
import numpy as np

D_MODEL = 2048
BATCH = 4
SEQ = 2048
DEPTH = 1
DEC_BATCH = 32
DEC_SEQ = 1
PAST_LEN = 16384
PAGE_SIZE = 128

HEAD_DIM = 64
ATT_WIDTH = D_MODEL // 2
N_Q_HEADS = ATT_WIDTH // HEAD_DIM
N_KV_HEADS = 4
GQA_GROUP = N_Q_HEADS // N_KV_HEADS
KV_WIDTH = N_KV_HEADS * HEAD_DIM
RWKV_WIDTH = D_MODEL - ATT_WIDTH
RWKV_HEADS = RWKV_WIDTH // HEAD_DIM
WINDOW = 128
BLOCK = 128
N_BUCKETS = 32
MAX_DISTANCE = 128
DECAY_LORA = 64
AAA_LORA = 64
GATE_LORA = 128
D_FF = 5504
ATT_COLS = ATT_WIDTH + 2 * KV_WIDTH
SHIFT_COLS = 3 * RWKV_WIDTH + DECAY_LORA + AAA_LORA + GATE_LORA
IN_COLS = ATT_COLS + SHIFT_COLS
RMS_EPS = 1e-5
GN_EPS = 64e-5
FFN_RES = 0.5

kernel_name = "hymba_swa_sink_rwkv7_macaron_step"


def rmsnorm(x, g):
    xf = x.astype(jnp.float32)
    y = xf * lax.rsqrt(jnp.mean(xf * xf, axis=-1, keepdims=True) + RMS_EPS)
    return (y * g.astype(jnp.float32)).astype(x.dtype)


def swiglu(x, wg, wu, wd):
    return (jax.nn.silu(x @ wg) * (x @ wu)) @ wd


def t5_bucket(dist):
    n = jnp.maximum(dist, 0)
    max_exact = N_BUCKETS // 2
    nf = jnp.maximum(n, 1).astype(jnp.float32)
    large = max_exact + (jnp.log(nf / max_exact) / math.log(MAX_DISTANCE / max_exact)
                         * (N_BUCKETS - max_exact)).astype(jnp.int32)
    large = jnp.minimum(large, N_BUCKETS - 1)
    return jnp.where(n < max_exact, n, large)


def sink_attention(q, k, v, dist, valid, rel_bias, sinks):
    bias = rel_bias.astype(jnp.float32)[t5_bucket(dist)]
    bias = jnp.transpose(bias, (2, 0, 1)).reshape(N_KV_HEADS, GQA_GROUP, *dist.shape)
    s = jnp.einsum('...qhgd,...khd->...hgqk', q, k).astype(jnp.float32) * (HEAD_DIM ** -0.5) + bias
    s = jnp.where(valid[..., None, None, :, :], s, -jnp.inf)
    sink = sinks.astype(jnp.float32).reshape(N_KV_HEADS, GQA_GROUP)[:, :, None, None]
    m = jnp.maximum(jnp.max(s, axis=-1, keepdims=True), sink)
    p = jnp.exp(s - m)
    denom = jnp.sum(p, axis=-1, keepdims=True) + jnp.exp(sink - m)
    return jnp.einsum('...hgqk,...khd->...qhgd', (p / denom).astype(v.dtype), v)


def swa_prompt(q, k, v, rel_bias, sinks):
    B, S = q.shape[:2]
    nb = S // BLOCK
    qb = q.reshape(B, nb, BLOCK, N_KV_HEADS, GQA_GROUP, HEAD_DIM)
    pad = ((0, 0), (BLOCK, 0), (0, 0), (0, 0))
    kp = jnp.pad(k, pad).reshape(B, nb + 1, BLOCK, N_KV_HEADS, HEAD_DIM)
    vp = jnp.pad(v, pad).reshape(B, nb + 1, BLOCK, N_KV_HEADS, HEAD_DIM)
    kc = jnp.concatenate([kp[:, :-1], kp[:, 1:]], axis=2)
    vc = jnp.concatenate([vp[:, :-1], vp[:, 1:]], axis=2)
    qi = jnp.arange(BLOCK)[:, None]
    kj = jnp.arange(2 * BLOCK)[None, :]
    dist = BLOCK + qi - kj
    blk = jnp.arange(nb)[:, None, None]
    valid = (dist >= 0) & (dist <= WINDOW) & ((blk > 0) | (kj >= BLOCK))
    o = sink_attention(qb, kc, vc, dist, valid, rel_bias, sinks)
    L = min(WINDOW, S)
    return o.reshape(B, S, ATT_WIDTH), k[:, S - L:], v[:, S - L:]


def swa_decode(q, k, v, k_buf, v_buf, rel_bias, sinks):
    B, T = q.shape[:2]
    L = k_buf.shape[1]
    kc = jnp.concatenate([k_buf.astype(k.dtype), k], axis=1)
    vc = jnp.concatenate([v_buf.astype(v.dtype), v], axis=1)
    qi = jnp.arange(T)[:, None]
    kj = jnp.arange(L + T)[None, :]
    dist = L + qi - kj
    valid = (dist >= 0) & (dist <= WINDOW)
    o = sink_attention(q.reshape(B, T, N_KV_HEADS, GQA_GROUP, HEAD_DIM), kc, vc, dist, valid, rel_bias, sinks)
    return o.reshape(B, T, ATT_WIDTH), kc[:, -L:], vc[:, -L:]


def wkv_scan(S0, r, logw, k, v, kk, a):
    xs = tuple(jnp.swapaxes(t, 0, 1) for t in (r, logw, k, v, kk, a))

    def step(S, inp):
        r_t, lw_t, k_t, v_t, kk_t, a_t = inp
        sa = jnp.einsum('bhij,bhj->bhi', S, -kk_t)
        S = (S * jnp.exp(lw_t)[:, :, None, :] + sa[..., None] * (kk_t * a_t)[:, :, None, :]
             + v_t[..., None] * k_t[:, :, None, :])
        return S, jnp.einsum('bhij,bhj->bhi', S, r_t)

    S, ys = lax.scan(step, S0.astype(jnp.float32), xs)
    return S, jnp.swapaxes(ys, 0, 1)


def rwkv_time_mix(proj, shift0, wkv0, mu, w0, w2, a0, a2, g2, k_k, k_a, r_k, ln_w, ln_b):
    f32 = jnp.float32
    B, T = proj.shape[:2]
    prev = jnp.concatenate([shift0[:, None].astype(proj.dtype), proj[:, :-1]], axis=1)
    xm = (proj + mu * (prev - proj)).astype(f32)
    o1, o2, o3 = RWKV_WIDTH, 2 * RWKV_WIDTH, 3 * RWKV_WIDTH
    o4, o5 = o3 + DECAY_LORA, o3 + DECAY_LORA + AAA_LORA
    r, k, v = xm[..., :o1], xm[..., o1:o2], xm[..., o2:o3]
    wl, al, gl = xm[..., o3:o4], xm[..., o4:o5], xm[..., o5:]
    w = -jax.nn.softplus(-(w0.astype(f32) + jnp.tanh(wl) @ w2.astype(f32))) - 0.5
    logw = -jnp.exp(w)
    a = jax.nn.sigmoid(a0.astype(f32) + al @ a2.astype(f32))
    g = jax.nn.sigmoid(gl) @ g2.astype(f32)
    kk = k * k_k.astype(f32)
    k = k * (1.0 + (a - 1.0) * k_a.astype(f32))
    hs = lambda t: t.reshape(B, T, RWKV_HEADS, HEAD_DIM)
    r, logw, k, v, kk, a = hs(r), hs(logw), hs(k), hs(v), hs(kk), hs(a)
    kk = kk / jnp.maximum(jnp.sqrt(jnp.sum(kk * kk, axis=-1, keepdims=True)), 1e-12)
    S, y = wkv_scan(wkv0, r, logw, k, v, kk, a)
    mean = jnp.mean(y, axis=-1, keepdims=True)
    var = jnp.mean((y - mean) ** 2, axis=-1, keepdims=True)
    yn = ((y - mean) * lax.rsqrt(var + GN_EPS)).reshape(B, T, RWKV_WIDTH) * ln_w.astype(f32) + ln_b.astype(f32)
    bonus = jnp.sum(r * k * r_k.astype(f32), axis=-1, keepdims=True) * v
    out = (yn + bonus.reshape(B, T, RWKV_WIDTH)) * g
    return out, proj[:, -1], S


def trunk_layer(x, attend, shift0, wkv0, lp):
    (n1, f1g, f1u, f1d, nm, w_in, sinks, mu, w0, w2, a0, a2, g2,
     k_k, k_a, r_k, ln_w, ln_b, w_out, n2, f2g, f2u, f2d) = lp
    B, T = x.shape[:2]
    x = x + FFN_RES * swiglu(rmsnorm(x, n1), f1g, f1u, f1d)
    h = rmsnorm(x, nm)
    proj = h @ w_in
    q = proj[..., :ATT_WIDTH].reshape(B, T, N_Q_HEADS, HEAD_DIM)
    k = proj[..., ATT_WIDTH:ATT_WIDTH + KV_WIDTH].reshape(B, T, N_KV_HEADS, HEAD_DIM)
    v = proj[..., ATT_WIDTH + KV_WIDTH:ATT_COLS].reshape(B, T, N_KV_HEADS, HEAD_DIM)
    o_att, k_buf, v_buf = attend(q, k, v, sinks)
    o_rwkv, shift, S = rwkv_time_mix(proj[..., ATT_COLS:], shift0, wkv0, mu, w0, w2, a0, a2, g2,
                                     k_k, k_a, r_k, ln_w, ln_b)
    mixed = jnp.concatenate([o_att, o_rwkv.astype(o_att.dtype)], axis=-1)
    x = x + mixed @ w_out
    x = x + FFN_RES * swiglu(rmsnorm(x, n2), f2g, f2u, f2d)
    return x, k_buf, v_buf, S, shift


def setup_inputs(seed: int = 0) -> dict:
    key = jax.random.key(seed)
    ks = jax.random.split(key, 32)
    f32 = jnp.float32
    nrm = lambda k, shape, s: s * jax.random.normal(k, shape, f32)
    L_win = min(WINDOW, PAST_LEN)
    ramp = (jnp.arange(RWKV_WIDTH, dtype=f32) / (RWKV_WIDTH - 1)) ** 0.85
    return {
        "x_prompt": nrm(ks[0], (BATCH, SEQ, D_MODEL), 1.0),
        "x_sample": nrm(ks[1], (DEC_BATCH, DEC_SEQ, D_MODEL), 1.0),
        "cache_k": nrm(ks[2], (DEPTH, DEC_BATCH, L_win, N_KV_HEADS, HEAD_DIM), 1.0),
        "cache_v": nrm(ks[3], (DEPTH, DEC_BATCH, L_win, N_KV_HEADS, HEAD_DIM), 1.0),
        "state_wkv": nrm(ks[4], (DEPTH, DEC_BATCH, RWKV_HEADS, HEAD_DIM, HEAD_DIM), 0.5),
        "state_shift": nrm(ks[5], (DEPTH, DEC_BATCH, SHIFT_COLS), 1.0),
        "rel_bias": nrm(ks[6], (N_BUCKETS, N_Q_HEADS), 0.5),
        "ffn1_norm": 1.0 + nrm(ks[7], (DEPTH, D_MODEL), 0.02),
        "ffn1_w_gate": nrm(ks[8], (DEPTH, D_MODEL, D_FF), D_MODEL ** -0.5),
        "ffn1_w_up": nrm(ks[9], (DEPTH, D_MODEL, D_FF), D_MODEL ** -0.5),
        "ffn1_w_down": nrm(ks[10], (DEPTH, D_FF, D_MODEL), D_FF ** -0.5),
        "mix_norm": 1.0 + nrm(ks[11], (DEPTH, D_MODEL), 0.02),
        "w_in": nrm(ks[12], (DEPTH, D_MODEL, IN_COLS), D_MODEL ** -0.5),
        "attn_sinks": nrm(ks[13], (DEPTH, N_Q_HEADS), 0.5),
        "shift_mu": jax.random.uniform(ks[14], (DEPTH, SHIFT_COLS), f32),
        "decay_w0": -6.0 + 5.0 * ramp[None, :] + nrm(ks[15], (DEPTH, RWKV_WIDTH), 0.05),
        "decay_w2": nrm(ks[16], (DEPTH, DECAY_LORA, RWKV_WIDTH), 0.1 * DECAY_LORA ** -0.5),
        "aaa_a0": nrm(ks[17], (DEPTH, RWKV_WIDTH), 0.1),
        "aaa_a2": nrm(ks[18], (DEPTH, AAA_LORA, RWKV_WIDTH), AAA_LORA ** -0.5),
        "gate_g2": nrm(ks[19], (DEPTH, GATE_LORA, RWKV_WIDTH), GATE_LORA ** -0.5),
        "key_k": 0.85 + nrm(ks[20], (DEPTH, RWKV_WIDTH), 0.02),
        "key_a": 1.0 + nrm(ks[21], (DEPTH, RWKV_WIDTH), 0.02),
        "bonus_r_k": nrm(ks[22], (DEPTH, RWKV_HEADS, HEAD_DIM), 0.1),
        "ln_x_w": 1.0 + nrm(ks[23], (DEPTH, RWKV_WIDTH), 0.02),
        "ln_x_b": nrm(ks[24], (DEPTH, RWKV_WIDTH), 0.02),
        "w_out": nrm(ks[25], (DEPTH, D_MODEL, D_MODEL), D_MODEL ** -0.5),
        "ffn2_norm": 1.0 + nrm(ks[26], (DEPTH, D_MODEL), 0.02),
        "ffn2_w_gate": nrm(ks[27], (DEPTH, D_MODEL, D_FF), D_MODEL ** -0.5),
        "ffn2_w_up": nrm(ks[28], (DEPTH, D_MODEL, D_FF), D_MODEL ** -0.5),
        "ffn2_w_down": nrm(ks[29], (DEPTH, D_FF, D_MODEL), D_FF ** -0.5),
        "final_norm": 1.0 + nrm(ks[30], (D_MODEL,), 0.02),
    }


def reference(x_prompt, x_sample, cache_k, cache_v, state_wkv, state_shift, rel_bias,
              ffn1_norm, ffn1_w_gate, ffn1_w_up, ffn1_w_down, mix_norm, w_in, attn_sinks,
              shift_mu, decay_w0, decay_w2, aaa_a0, aaa_a2, gate_g2, key_k, key_a, bonus_r_k,
              ln_x_w, ln_x_b, w_out, ffn2_norm, ffn2_w_gate, ffn2_w_up, ffn2_w_down, final_norm):
    xp, xs = x_prompt, x_sample
    B = x_prompt.shape[0]
    kp_l, vp_l, sp_l, shp_l = [], [], [], []
    ks_l, vs_l, ss_l, shs_l = [], [], [], []
    for l in range(DEPTH):
        lp = (ffn1_norm[l], ffn1_w_gate[l], ffn1_w_up[l], ffn1_w_down[l], mix_norm[l], w_in[l],
              attn_sinks[l], shift_mu[l], decay_w0[l], decay_w2[l], aaa_a0[l], aaa_a2[l], gate_g2[l],
              key_k[l], key_a[l], bonus_r_k[l], ln_x_w[l], ln_x_b[l], w_out[l],
              ffn2_norm[l], ffn2_w_gate[l], ffn2_w_up[l], ffn2_w_down[l])
        shift0 = jnp.zeros((B, SHIFT_COLS), x_prompt.dtype)
        wkv0 = jnp.zeros((B, RWKV_HEADS, HEAD_DIM, HEAD_DIM), jnp.float32)
        xp, kp, vp, sp, shp = trunk_layer(
            xp, lambda q, k, v, s: swa_prompt(q, k, v, rel_bias, s), shift0, wkv0, lp)
        xs, kd, vd, sd, shd = trunk_layer(
            xs, lambda q, k, v, s, l=l: swa_decode(q, k, v, cache_k[l], cache_v[l], rel_bias, s),
            state_shift[l], state_wkv[l], lp)
        kp_l.append(kp); vp_l.append(vp); sp_l.append(sp); shp_l.append(shp)
        ks_l.append(kd); vs_l.append(vd); ss_l.append(sd); shs_l.append(shd)
    y_prompt = rmsnorm(xp, final_norm)
    y_sample = rmsnorm(xs, final_norm)
    new_k_prompt = jnp.stack(kp_l, 0)
    new_v_prompt = jnp.stack(vp_l, 0)
    new_wkv_prompt = jnp.stack(sp_l, 0)
    new_shift_prompt = jnp.stack(shp_l, 0)
    new_k_sample = jnp.stack(ks_l, 0)
    new_v_sample = jnp.stack(vs_l, 0)
    new_wkv_sample = jnp.stack(ss_l, 0)
    new_shift_sample = jnp.stack(shs_l, 0)
    return (y_prompt, y_sample, new_k_prompt, new_v_prompt, new_wkv_prompt, new_shift_prompt,
            new_k_sample, new_v_sample, new_wkv_sample, new_shift_sample)
```

```cpp
#include <hip/hip_runtime.h>
#include <cstdio>
#include <cstdint>
#define MK_N_LAUNCHES 1
constexpr int DM = 2048, SEQ = 2048, NB = 4, MP = NB * SEQ  , NDEC = 32, MV = MP + NDEC  , MPAD = 8448  ;
constexpr int DFF = 5504, ATTW = 1024, KVW = 256, RWW = 1024, NQH = 16, NKVH = 4, HD = 64, RWH = 16, WIN = 128;
constexpr int ATT_COLS = ATTW + 2 * KVW  , SHC = 3 * RWW + 64 + 64 + 128  , INC = ATT_COLS + SHC  ;
constexpr float RMS_EPS = 1e-5f, GN_EPS = 64e-5f, LOG2E = 1.4426950408889634f;
constexpr float QSCALE = 0.125f * LOG2E;
constexpr size_t O_YP = 0, O_YS = O_YP + (size_t)MP * DM, O_KP = O_YS + (size_t)NDEC * DM, O_VP = O_KP + (size_t)NB * WIN * KVW, O_WP = O_VP + (size_t)NB * WIN * KVW,
                 O_SP = O_WP + (size_t)NB * RWH * HD * HD, O_KS = O_SP + (size_t)NB * SHC, O_VS = O_KS + (size_t)NDEC * WIN * KVW, O_WS = O_VS + (size_t)NDEC * WIN * KVW,
                 O_SS = O_WS + (size_t)NDEC * RWH * HD * HD, O_END = O_SS + (size_t)NDEC * SHC;
namespace pg8 {
#define PG8_LAS __attribute__((address_space(3)))
typedef unsigned short bf16_t;
typedef short bf16x8 __attribute__((ext_vector_type(8)));
typedef float f32x4 __attribute__((ext_vector_type(4)));
typedef unsigned u32x4 __attribute__((ext_vector_type(4)));
constexpr int BM = 256, BK = 64, HALF = 128, HTB = HALF * BK * 2  , STAGE_BYTES = 8 * HTB, NXCD = 8, WGM = 8;

__host__ __device__ __forceinline__ int lds_byte(int r, int c) { const int st = (r >> 4) * 2 + (c >> 5), rr = r & 15, cc = c & 31, ob = rr * 64 + cc * 2; return st * 1024 + (ob ^ (((ob >> 9) & 1) << 5)); }
__host__ __device__ __forceinline__ void stage_rc(int b, int& R, int& C) { const int st = b / 1024, sb = b % 1024, swz = sb ^ (((sb >> 9) & 1) << 5); R = (st >> 1) * 16 + swz / 64; C = (st & 1) * 32 + (swz % 64) / 2; }
__host__ __device__ __forceinline__ int perm32(int rho) { const int n = rho >> 4, i = rho & 15; return 8 * (i >> 2) + 4 * n + (i & 3); }

struct Unit { int pm, pn; };
struct Gemm { const bf16_t* A; const bf16_t* Bt; int M, N, K; };

struct StaticOrder {
    int nM, nN, nwg, G, c;
    __host__ __device__ void init(int M, int N, int G_, int c_) { nM = M / BM; nN = N / BM; nwg = nM * nN; G = G_; c = c_; }
    __host__ __device__ bool next(int i, Unit& u) const {
        const long L = (long)i * G + c; if (L >= nwg) return false;
        int wgid = (int)L; { const int q = nwg / NXCD, r = nwg % NXCD, xcd = wgid % NXCD, off = wgid / NXCD; wgid = (xcd < r ? xcd * (q + 1) : r * (q + 1) + (xcd - r) * q) + off; }
        const int nig = WGM * nN, gid = wgid / nig, fm = gid * WGM, gsz = (nM - fm) < WGM ? (nM - fm) : WGM;
        u.pm = fm + ((wgid % nig) % gsz); u.pn = (wgid % nig) / gsz; return true;
    }
    __device__ __forceinline__ void a_ready(const Unit&) const {}
    __device__ __forceinline__ void done(const Unit&) const {}
};

__device__ __forceinline__ unsigned cvt_pk_bf16(float lo, float hi) { unsigned r; asm volatile("v_cvt_pk_bf16_f32 %0, %1, %2" : "=v"(r) : "v"(lo), "v"(hi)); return r; }
__device__ __forceinline__ float silu_mul(float g, float u) { return g * u * __builtin_amdgcn_rcpf(1.0f + __builtin_amdgcn_exp2f(-g * LOG2E)); }

struct EpiSwiglu {
    static constexpr bool PERM = true, AFTER_DRAIN = false;
    bf16_t* O; const float* ssq;
    __device__ __forceinline__ void operator()(const f32x4 (&acc)[2][2][4][2], const Unit& u, int wr, int wc, int fr, int fq) const {
        const int row0 = u.pm * BM + wr * 64 + fr, col0 = u.pn * HALF + wc * 32 + 8 * fq;
#pragma unroll
        for (int ai = 0; ai < 2; ++ai)
#pragma unroll
            for (int m = 0; m < 4; ++m) { const int row = row0 + ai * HALF + m * 16;
                const float s = __builtin_amdgcn_rsqf(ssq[row] * (1.0f / DM) + RMS_EPS);
                const f32x4 g0 = acc[ai][0][m][0] * s, g1 = acc[ai][0][m][1] * s, u0 = acc[ai][1][m][0] * s, u1 = acc[ai][1][m][1] * s;
                u32x4 w; w.x = cvt_pk_bf16(silu_mul(g0[0], u0[0]), silu_mul(g0[1], u0[1])); w.y = cvt_pk_bf16(silu_mul(g0[2], u0[2]), silu_mul(g0[3], u0[3]));
                w.z = cvt_pk_bf16(silu_mul(g1[0], u1[0]), silu_mul(g1[1], u1[1])); w.w = cvt_pk_bf16(silu_mul(g1[2], u1[2]), silu_mul(g1[3], u1[3]));
                *(u32x4*)(O + (size_t)row * DFF + col0) = w; }
    }
};

struct EpiResid {
    static constexpr bool PERM = true, AFTER_DRAIN = false;
    const float* xi_p; const float* xi_s; float* xo_p; float* xo_s; bf16_t* XB; float* ssq; float alpha;
    __device__ __forceinline__ void operator()(const f32x4 (&acc)[2][2][4][2], const Unit& u, int wr, int wc, int fr, int fq) const {
        const int row0 = u.pm * BM + wr * 64 + fr, col0 = u.pn * BM + wc * 32 + 8 * fq;
#pragma unroll
        for (int ai = 0; ai < 2; ++ai)
#pragma unroll
            for (int m = 0; m < 4; ++m) { const int row = row0 + ai * HALF + m * 16; const bool valid = row < MV;
                const size_t ro = row < MP ? (size_t)row * DM : (size_t)(row - MP) * DM;
                const float* src = (row < MP ? xi_p : xi_s) + ro; float* dst = (row < MP ? xo_p : xo_s) + ro;
                float sq = 0.f;
#pragma unroll
                for (int bj = 0; bj < 2; ++bj) { const int col = col0 + bj * HALF;
                    f32x4 x0 = (f32x4){0.f, 0.f, 0.f, 0.f}, x1 = x0;
                    if (valid) { x0 = *(const f32x4*)(src + col); x1 = *(const f32x4*)(src + col + 4); }
                    const f32x4 y0 = x0 + acc[ai][bj][m][0] * alpha, y1 = x1 + acc[ai][bj][m][1] * alpha;
                    if (valid) { *(f32x4*)(dst + col) = y0; *(f32x4*)(dst + col + 4) = y1; }
                    sq += (y0[0] * y0[0] + y0[1] * y0[1]) + (y0[2] * y0[2] + y0[3] * y0[3]) + (y1[0] * y1[0] + y1[1] * y1[1]) + (y1[2] * y1[2] + y1[3] * y1[3]);
                    if (XB) { u32x4 w; w.x = cvt_pk_bf16(y0[0], y0[1]); w.y = cvt_pk_bf16(y0[2], y0[3]); w.z = cvt_pk_bf16(y1[0], y1[1]); w.w = cvt_pk_bf16(y1[2], y1[3]);
                        *(u32x4*)(XB + (size_t)row * DM + col) = w; } }
                sq += __shfl_xor(sq, 16); sq += __shfl_xor(sq, 32);
                if (fq == 0 && valid) atomicAdd(ssq + row, sq); }
    }
};

struct EpiWin {
    static constexpr bool PERM = true, AFTER_DRAIN = false;
    const float* ssq; bf16_t* QB; bf16_t* KB; bf16_t* VB; float* PR; float* out;
    __device__ __forceinline__ void operator()(const f32x4 (&acc)[2][2][4][2], const Unit& u, int wr, int wc, int fr, int fq) const {
        const int row0 = u.pm * BM + wr * 64 + fr, cl0 = wc * 32 + 8 * fq;
        const int pn = u.pn;
#pragma unroll
        for (int ai = 0; ai < 2; ++ai)
#pragma unroll
            for (int m = 0; m < 4; ++m) { const int row = row0 + ai * HALF + m * 16; const bool valid = row < MV;
                float s = __builtin_amdgcn_rsqf(ssq[row] * (1.0f / DM) + RMS_EPS);
                if (pn < 4) s *= QSCALE;
#pragma unroll
                for (int bj = 0; bj < 2; ++bj) { const int cl = cl0 + bj * HALF;
                    const f32x4 y0 = acc[ai][bj][m][0] * s, y1 = acc[ai][bj][m][1] * s;
                    if (pn < 6) { u32x4 w; w.x = cvt_pk_bf16(y0[0], y0[1]); w.y = cvt_pk_bf16(y0[2], y0[3]); w.z = cvt_pk_bf16(y1[0], y1[1]); w.w = cvt_pk_bf16(y1[2], y1[3]);
                        if (pn < 4) *(u32x4*)(QB + (size_t)row * ATTW + pn * BM + cl) = w;
                        else { *(u32x4*)((pn == 4 ? KB : VB) + (size_t)row * KVW + cl) = w;
                            if (valid) { float* o = nullptr;
                                if (row >= MP) o = out + (pn == 4 ? O_KS : O_VS) + ((size_t)(row - MP) * WIN + (WIN - 1)) * KVW + cl;
                                else if ((row & (SEQ - 1)) >= SEQ - WIN) o = out + (pn == 4 ? O_KP : O_VP) + ((size_t)(row >> 11) * WIN + ((row & (SEQ - 1)) - (SEQ - WIN))) * KVW + cl;
                                if (o) { *(f32x4*)o = y0; *(f32x4*)(o + 4) = y1; } } }
                    } else { const int cs = (pn - 6) * BM + cl;
                        *(f32x4*)(PR + (size_t)row * SHC + cs) = y0; *(f32x4*)(PR + (size_t)row * SHC + cs + 4) = y1;
                        if (valid) { float* o = nullptr;
                            if (row >= MP) o = out + O_SS + (size_t)(row - MP) * SHC + cs;
                            else if ((row & (SEQ - 1)) == SEQ - 1) o = out + O_SP + (size_t)(row >> 11) * SHC + cs;
                            if (o) { *(f32x4*)o = y0; *(f32x4*)(o + 4) = y1; } } } }
            }
    }
};
template <class Epi, class Sched, bool ALIGN_EPI = false, bool SP2 = false>
__device__ __forceinline__ void gemm_phase(PG8_LAS unsigned char* lds, const Gemm g, const Sched& S, const Epi& E) {
    int tid_ = threadIdx.x; asm volatile("" : "+v"(tid_)); const int tid = tid_, wid = __builtin_amdgcn_readfirstlane(tid >> 6), lane = tid & 63, wr = wid >> 2, wc = wid & 3, fr = lane & 15, fq = lane >> 4;
    const int K = g.K, nt = K / BK;
    unsigned voffA[2], voffB[2];
#pragma unroll
    for (int i = 0; i < 2; ++i) { int R, C; stage_rc(tid * 16 + i * 8192, R, C); const int Rb = Epi::PERM ? ((R & ~31) + perm32(R & 31)) : R;
        voffA[i] = (unsigned)(R * K + C) * 2u; voffB[i] = (unsigned)(Rb * K + C) * 2u; }
    const size_t kstep = (size_t)(BK * 2);
    const size_t hstep = (size_t)HALF * K * 2;
    const size_t tstep = 2 * hstep;
    const unsigned ldsw = (unsigned)wid * 1024u;
    const int aoff = lds_byte(wr * 64 + fr, fq * 8), boff = lds_byte(wc * 32 + fr, fq * 8);
#define PG8_SA(b, h) (((b) * 2 + (h)) * HTB)
#define PG8_SB(b, h) ((4 + (b) * 2 + (h)) * HTB)
#define PG8_STAGE(bufoff, gbase, voff) do { _Pragma("unroll") for (int _i = 0; _i < 2; ++_i) \
        __builtin_amdgcn_global_load_lds((const unsigned*)((const char*)(gbase) + (voff)[_i]), (PG8_LAS unsigned*)(lds + (bufoff) + ldsw + _i * 8192), 16, 0, 0); } while (0)
#define PG8_LDA(dst, b, h) do { _Pragma("unroll") for (int m = 0; m < 4; ++m) _Pragma("unroll") for (int k = 0; k < 2; ++k) dst[m][k] = *(const PG8_LAS bf16x8*)(lds + PG8_SA(b, h) + aoff + m * 2048 + k * 1024); } while (0)
#define PG8_LDB(dst, b, h) do { _Pragma("unroll") for (int n = 0; n < 2; ++n) _Pragma("unroll") for (int k = 0; k < 2; ++k) dst[n][k] = *(const PG8_LAS bf16x8*)(lds + PG8_SB(b, h) + boff + n * 2048 + k * 1024); } while (0)
#define PG8_MMA(ai, bj, At, Bt) do { __builtin_amdgcn_s_setprio(1); _Pragma("unroll") for (int m = 0; m < 4; ++m) _Pragma("unroll") for (int n = 0; n < 2; ++n) _Pragma("unroll") for (int k = 0; k < 2; ++k) \
        acc[ai][bj][m][n] = __builtin_amdgcn_mfma_f32_16x16x32_bf16(Bt[n][k], At[m][k], acc[ai][bj][m][n], 0, 0, 0); __builtin_amdgcn_s_setprio(0); } while (0)
#define PG8_WAIT_V(n) asm volatile("s_waitcnt vmcnt(" #n ")" ::: "memory")
#define PG8_WAIT_L(n) asm volatile("s_waitcnt lgkmcnt(" #n ")" ::: "memory")
#define PG8_BAR __builtin_amdgcn_s_barrier()
#define PG8_SCHED __builtin_amdgcn_sched_barrier(0)
    Unit cur, nxt; int ui = 0;
    if (!S.next(0, cur)) return;
    f32x4 acc[2][2][4][2];
#pragma unroll
    for (int a = 0; a < 2; ++a)
#pragma unroll
        for (int b = 0; b < 2; ++b)
#pragma unroll
            for (int m = 0; m < 4; ++m)
#pragma unroll
                for (int n = 0; n < 2; ++n) acc[a][b][m][n] = (f32x4){0.f, 0.f, 0.f, 0.f};
    bf16x8 At[4][2], B0[2][2], B1[2][2];
    const char* cA = (const char*)g.A + (size_t)cur.pm * tstep; const char* cB = (const char*)g.Bt + (size_t)cur.pn * tstep;
    S.a_ready(cur);
    if constexpr (SP2) {
        PG8_STAGE(PG8_SB(0, 0), cB, voffB); PG8_STAGE(PG8_SB(0, 1), cB + hstep, voffB); PG8_STAGE(PG8_SA(0, 0), cA, voffA); PG8_STAGE(PG8_SA(0, 1), cA + hstep, voffA);
        if (wr == 1) PG8_BAR;
        PG8_WAIT_V(2); PG8_BAR;
        PG8_STAGE(PG8_SB(1, 0), cB + kstep, voffB); PG8_STAGE(PG8_SA(1, 0), cA + kstep, voffA); PG8_STAGE(PG8_SB(1, 1), cB + hstep + kstep, voffB);
        PG8_WAIT_V(6); PG8_BAR;
    } else {
        PG8_STAGE(PG8_SB(0, 0), cB, voffB); PG8_STAGE(PG8_SA(0, 0), cA, voffA); PG8_STAGE(PG8_SB(0, 1), cB + hstep, voffB); PG8_STAGE(PG8_SA(0, 1), cA + hstep, voffA);
        if (wr == 1) PG8_BAR;
        PG8_WAIT_V(4); PG8_BAR;
        PG8_STAGE(PG8_SB(1, 0), cB + kstep, voffB); PG8_STAGE(PG8_SA(1, 0), cA + kstep, voffA); PG8_STAGE(PG8_SB(1, 1), cB + hstep + kstep, voffB);
        PG8_WAIT_V(6); PG8_BAR;
    }
    for (;;) {
        const bool has_next = S.next(ui + 1, nxt);
        const char* nA = has_next ? (const char*)g.A + (size_t)nxt.pm * tstep : cA; const char* nB = has_next ? (const char*)g.Bt + (size_t)nxt.pn * tstep : cB;
        for (int t = 0; t < nt; t += 2) {
            const bool last = (t == nt - 2);
            const char* a1 = cA + (size_t)(t + 1) * kstep;
            const char* a2 = last ? nA : cA + (size_t)(t + 2) * kstep; const char* b2 = last ? nB : cB + (size_t)(t + 2) * kstep;
            const char* a3 = a2 + kstep; const char* b3 = b2 + kstep;
            if (last && has_next) S.a_ready(nxt);
            if constexpr (SP2) {
            PG8_LDB(B0, 0, 0); PG8_LDB(B1, 0, 1); PG8_SCHED; PG8_LDA(At, 0, 0); PG8_STAGE(PG8_SA(1, 1), a1 + hstep, voffA);
            PG8_WAIT_V(8); PG8_WAIT_L(0); PG8_BAR; PG8_MMA(0, 0, At, B0); PG8_MMA(0, 1, At, B1); PG8_BAR; PG8_SCHED;
            PG8_LDA(At, 0, 1); PG8_STAGE(PG8_SB(0, 0), b2, voffB); PG8_STAGE(PG8_SB(0, 1), b2 + hstep, voffB); PG8_STAGE(PG8_SA(0, 0), a2, voffA);
            PG8_WAIT_V(8); PG8_WAIT_L(0); PG8_BAR; PG8_MMA(1, 0, At, B0); PG8_MMA(1, 1, At, B1); PG8_BAR; PG8_SCHED;
            PG8_LDB(B0, 1, 0); PG8_LDB(B1, 1, 1); PG8_SCHED; PG8_LDA(At, 1, 0); PG8_STAGE(PG8_SA(0, 1), a2 + hstep, voffA);
            PG8_WAIT_V(8); PG8_WAIT_L(0); PG8_BAR; PG8_MMA(0, 0, At, B0); PG8_MMA(0, 1, At, B1); PG8_BAR; PG8_SCHED;
            PG8_LDA(At, 1, 1); PG8_STAGE(PG8_SB(1, 0), b3, voffB); PG8_STAGE(PG8_SB(1, 1), b3 + hstep, voffB); PG8_STAGE(PG8_SA(1, 0), a3, voffA);
            PG8_WAIT_V(8); PG8_WAIT_L(0); PG8_BAR; PG8_MMA(1, 0, At, B0); PG8_MMA(1, 1, At, B1); PG8_BAR; PG8_SCHED;
            } else {
            PG8_LDB(B0, 0, 0); PG8_SCHED; PG8_LDA(At, 0, 0); PG8_STAGE(PG8_SA(1, 1), a1 + hstep, voffA);
            PG8_WAIT_L(8); PG8_BAR; PG8_WAIT_L(0); PG8_MMA(0, 0, At, B0); PG8_BAR; PG8_SCHED;
            PG8_LDB(B1, 0, 1); PG8_STAGE(PG8_SB(0, 0), b2, voffB);
            PG8_BAR; PG8_WAIT_L(0); PG8_MMA(0, 1, At, B1); PG8_BAR;
            PG8_LDA(At, 0, 1); PG8_STAGE(PG8_SA(0, 0), a2, voffA);
            PG8_BAR; PG8_WAIT_L(0); PG8_MMA(1, 0, At, B0); PG8_BAR; PG8_SCHED;
            PG8_STAGE(PG8_SB(0, 1), b2 + hstep, voffB);
            PG8_WAIT_V(6); PG8_BAR; PG8_MMA(1, 1, At, B1); PG8_BAR;
            PG8_LDB(B0, 1, 0); PG8_SCHED; PG8_LDA(At, 1, 0); PG8_STAGE(PG8_SA(0, 1), a2 + hstep, voffA);
            PG8_WAIT_L(8); PG8_BAR; PG8_WAIT_L(0); PG8_MMA(0, 0, At, B0); PG8_BAR; PG8_SCHED;
            PG8_LDB(B1, 1, 1); PG8_STAGE(PG8_SB(1, 0), b3, voffB);
            PG8_BAR; PG8_WAIT_L(0); PG8_MMA(0, 1, At, B1); PG8_BAR;
            PG8_LDA(At, 1, 1); PG8_STAGE(PG8_SA(1, 0), a3, voffA);
            PG8_BAR; PG8_WAIT_L(0); PG8_MMA(1, 0, At, B0); PG8_BAR; PG8_SCHED;
            PG8_STAGE(PG8_SB(1, 1), b3 + hstep, voffB);
            PG8_WAIT_V(6); PG8_BAR; PG8_MMA(1, 1, At, B1); PG8_BAR;
            }
        }
        if constexpr (ALIGN_EPI) { if (wr == 0) PG8_BAR; }
        if constexpr (!Epi::AFTER_DRAIN) { E(acc, cur, wr, wc, fr, fq); S.done(cur); }
        if (!has_next) break;
#pragma unroll
        for (int a = 0; a < 2; ++a)
#pragma unroll
            for (int b = 0; b < 2; ++b)
#pragma unroll
                for (int m = 0; m < 4; ++m)
#pragma unroll
                    for (int n = 0; n < 2; ++n) acc[a][b][m][n] = (f32x4){0.f, 0.f, 0.f, 0.f};
        cur = nxt; cA = nA; cB = nB; ++ui;
        if constexpr (ALIGN_EPI) { if (wr == 1) PG8_BAR; }
    }
    PG8_WAIT_V(0);
    if constexpr (!ALIGN_EPI) { if (wr == 0) PG8_BAR; }
    PG8_BAR;
    if constexpr (Epi::AFTER_DRAIN) { E.fused(acc, cur, wr, wc, fr, fq, lds, wid, lane); S.done(cur); }
#undef PG8_SA
#undef PG8_SB
#undef PG8_STAGE
#undef PG8_LDA
#undef PG8_LDB
#undef PG8_MMA
#undef PG8_WAIT_V
#undef PG8_WAIT_L
#undef PG8_BAR
#undef PG8_SCHED
}
}
#define GAS __attribute__((address_space(1)))
#define LAS __attribute__((address_space(3)))
typedef unsigned short bf16;
typedef unsigned v4u __attribute__((ext_vector_type(4)));
typedef float f32x4 __attribute__((ext_vector_type(4)));
typedef short bf16x8 __attribute__((ext_vector_type(8)));
typedef GAS unsigned gu32;
typedef GAS unsigned long long gu64;
#define RLX_AGENT __ATOMIC_RELAXED, __HIP_MEMORY_SCOPE_AGENT
#define LDS_WAIT() asm volatile("s_waitcnt lgkmcnt(0)" ::: "memory")
#define VM_WAIT() asm volatile("s_waitcnt vmcnt(0)" ::: "memory")
__device__ __forceinline__ unsigned long long rt() { return __builtin_amdgcn_s_memrealtime(); }
__device__ __forceinline__ unsigned f2bf(float f) { unsigned u = __builtin_bit_cast(unsigned, f); return (u + 0x7fffu + ((u >> 16) & 1u)) >> 16; }
__device__ __forceinline__ unsigned pk2(float lo, float hi) { return f2bf(lo) | (f2bf(hi) << 16); }

#define XB_TMO      128
#define XB_XCNT(j)  (256  + 64 * (j))
#define XB_XSUB(j)  (1280 + 64 * (j))
#define XB_XGEN(j)  (2304 + 64 * (j))
#define XB_TOP      3328
#define XB_TOPGEN   3392
#define XCD_BAR_WORDS 3456
#define XB_SPIN_CAP (1u << 18)

__device__ __forceinline__ unsigned xb_ld(unsigned* p)              { return __hip_atomic_load(p, __ATOMIC_RELAXED, __HIP_MEMORY_SCOPE_AGENT); }
__device__ __forceinline__ unsigned xb_add(unsigned* p, unsigned v) { return __hip_atomic_fetch_add(p, v, __ATOMIC_RELAXED, __HIP_MEMORY_SCOPE_AGENT); }
__device__ __forceinline__ unsigned xb_xcc_id() { return (unsigned)__builtin_amdgcn_s_getreg((3 << 11) | 20) & 0xFu; }
#define XB_SPIN(cond, bar) do { unsigned _sp = 0; while (cond) { __builtin_amdgcn_s_sleep(1); \
    if ((++_sp & 255u) == 0u) { if (xb_ld(&(bar)[XB_TMO])) break; if (_sp > XB_SPIN_CAP) { atomicAdd(&(bar)[XB_TMO], 1u); break; } } } } while (0)

struct XcdBarrier {
    unsigned* bar; unsigned x;
    volatile LAS unsigned* st;
};

__device__ __forceinline__ XcdBarrier xcd_barrier_post(unsigned* bar, volatile LAS unsigned* st) {
    XcdBarrier b; b.bar = bar; b.x = xb_xcc_id(); b.st = st;
    if (threadIdx.x == 0) (void)xb_add(&bar[XB_XCNT(b.x)], 1u);
    return b;
}
__device__ __forceinline__ void xcd_barrier_complete(unsigned* bar, unsigned x, unsigned& nloc, unsigned& nx) {
    const unsigned G = gridDim.x * gridDim.y * gridDim.z;
    unsigned sum, cnt, mine, sp = 0u;
    for (;;) {
        sum = 0u; cnt = 0u; mine = 0u;
#pragma unroll
        for (unsigned j = 0; j < 16; ++j) { const unsigned c = xb_ld(&bar[XB_XCNT(j)]); sum += c; cnt += (c > 0u) ? 1u : 0u; mine = (j == x) ? c : mine; }
        if (sum == G) break;
        __builtin_amdgcn_s_sleep(1);
        if ((++sp & 255u) == 0u) { if (xb_ld(&bar[XB_TMO])) break; if (sp > XB_SPIN_CAP) { atomicAdd(&bar[XB_TMO], 1u); break; } }
    }
    nloc = mine > 0u ? mine : 1u; nx = cnt > 0u ? cnt : 1u;
}

__device__ __forceinline__ void xcd_barrier(const XcdBarrier& b) {
    asm volatile("s_waitcnt vmcnt(0)" ::: "memory");
    __syncthreads();
    if (threadIdx.x == 0) {
        unsigned* bar = b.bar;
        __builtin_amdgcn_s_waitcnt(0);
        unsigned nloc = b.st[0], nx = b.st[1];
        if (nloc == 0u) { xcd_barrier_complete(bar, b.x, nloc, nx); b.st[0] = nloc; b.st[1] = nx; }
        const unsigned old = xb_add(&bar[XB_XSUB(b.x)], 1u);
        const unsigned gen = old / nloc;
        if (old + 1u == (gen + 1u) * nloc) {
            __builtin_amdgcn_fence(__ATOMIC_RELEASE, "agent");
            asm volatile("s_waitcnt vmcnt(0)" ::: "memory");
            const unsigned og = xb_add(&bar[XB_TOP], 1u);
            const unsigned tg = og / nx;
            if (og + 1u == (tg + 1u) * nx) xb_add(&bar[XB_TOPGEN], 1u);
            else XB_SPIN(xb_ld(&bar[XB_TOPGEN]) == tg, bar);
            __builtin_amdgcn_fence(__ATOMIC_ACQUIRE, "agent");
            xb_add(&bar[XB_XGEN(b.x)], 1u);
            asm volatile("s_waitcnt vmcnt(0)" ::: "memory");
        } else {
            XB_SPIN(xb_ld(&bar[XB_XGEN(b.x)]) == gen, bar);
            __builtin_amdgcn_fence(__ATOMIC_ACQUIRE, "agent");
            asm volatile("s_waitcnt vmcnt(0)" ::: "memory");
        }
    }
    __syncthreads();
}
constexpr size_t MiB = 1u << 20;
constexpr size_t WS_CTL = 0, CTL_ZERO_BYTES = 1 * MiB;
constexpr size_t WS_BIAS = 1 * MiB, WS_W2T = WS_BIAS + 16384, WS_A2T = WS_W2T + 131072, WS_G2T = WS_A2T + 131072;
constexpr size_t WS_WGU1 = 2 * MiB, WS_WD1 = WS_WGU1 + 43 * MiB, WS_WINB = WS_WD1 + 21 * MiB + MiB / 2;
constexpr size_t WS_WOUT = 86 * MiB, WS_WGU2 = 94 * MiB, WS_WD2 = 137 * MiB;
constexpr size_t WS_XB = 159 * MiB;
constexpr size_t WS_ACT = 192 * MiB;
constexpr size_t WS_QB = 300 * MiB, WS_KB = WS_QB + 16 * MiB + MiB / 2, WS_VB = WS_KB + 4 * MiB + MiB / 8;
constexpr size_t WS_DD = 325 * MiB, WS_LG = 358 * MiB, WS_EE = WS_LG + 16 * MiB + MiB / 2, WS_END = WS_EE + 16 * MiB + MiB / 2;
constexpr size_t VEC16 = 16 * MiB + MiB / 2;
constexpr size_t WS_KK = WS_WGU1, WS_BB = WS_KK + VEC16, WS_KP = WS_BB + VEC16, WS_RR = WS_KP + VEC16, WS_VV = WS_RR + VEC16;
constexpr size_t WS_X2B = WS_WGU1;
static_assert(WS_VV + VEC16 <= WS_WOUT && WS_WINB + 19 * MiB <= WS_WOUT && WS_WD2 + 22 * MiB <= WS_XB && WS_XB + 33 * MiB <= WS_ACT && WS_VB + 4 * MiB + MiB / 8 <= WS_DD && WS_DD + 33 * MiB <= WS_LG, "d_ws map");
constexpr int CW_BAR = 4096;
constexpr int CW_SSQ0 = 16384, CW_SSQ1 = CW_SSQ0 + MPAD, CW_SSQ2 = CW_SSQ1 + MPAD, CW_SSQ3 = CW_SSQ2 + MPAD;
static_assert((CW_SSQ3 + MPAD) * 4 <= (int)CTL_ZERO_BYTES, "CTL");
constexpr int RING_OFF = 0, RING_BYTES = 131072;
constexpr int LDSCTL_OFF = RING_BYTES, MISC_OFF = LDSCTL_OFF + 320;
constexpr int LDS_BYTES = 147456;
constexpr int NWAVES = 8;
constexpr int NPHASES = 11;
#ifndef MK_N_LAUNCHES
#define MK_N_LAUNCHES 1
#endif

__constant__ unsigned char T5B[129] = {0, 1, 2, 3, 4, 5, 6, 7, 8, 9, 10, 11, 12, 13, 14, 15, 16, 16, 16, 17, 17, 18, 18, 18, 19, 19, 19, 20, 20, 20, 20, 21, 21, 21, 21, 22, 22, 22, 22, 22, 23, 23, 23, 23, 23, 23, 24, 24, 24, 24, 24, 24, 25, 25, 25, 25, 25, 25, 25, 26, 26, 26, 26, 26, 26, 26, 26, 27, 27, 27, 27, 27, 27, 27, 27, 27, 27, 28, 28, 28, 28, 28, 28, 28, 28, 28, 28, 29, 29, 29, 29, 29, 29, 29, 29, 29, 29, 29, 29, 30, 30, 30, 30, 30, 30, 30, 30, 30, 30, 30, 30, 30, 30, 31, 31, 31, 31, 31, 31, 31, 31, 31, 31, 31, 31, 31, 31, 31, 31};

struct Args { const float* in[31]; float* out; unsigned char* ws; int ph_lo, ph_hi, li, pad; };

struct Frame {
    LAS unsigned char* lds;
    volatile LAS unsigned* MISC;
    gu32* ctl;
    int tid, lane, wave, G;
    float* out; unsigned char* ws;
};
typedef float f32x2 __attribute__((ext_vector_type(2)));
__device__ __forceinline__ float bf2f(unsigned short u) { return __builtin_bit_cast(float, (unsigned)u << 16); }
__device__ __forceinline__ unsigned short f2bfs(float f) { return (unsigned short)f2bf(f); }
__device__ __forceinline__ float wave_sum(float v) {
#pragma unroll
    for (int o = 1; o < 64; o <<= 1) v += __shfl_xor(v, o);
    return v;
}
__device__ __forceinline__ float wave_max(float v) {
#pragma unroll
    for (int o = 1; o < 64; o <<= 1) v = fmaxf(v, __shfl_xor(v, o));
    return v;
}
template <int CTRL> __device__ __forceinline__ float dpp_f(float x) { return __builtin_bit_cast(float, __builtin_amdgcn_update_dpp(0, __builtin_bit_cast(int, x), CTRL, 0xf, 0xf, true)); }
__device__ __forceinline__ float allsum16(float x) { x += dpp_f<0x128>(x); x += dpp_f<0x124>(x); x += dpp_f<0x122>(x); x += dpp_f<0x121>(x); return x; }
__device__ __forceinline__ float sigmoidf_(float x) { return __builtin_amdgcn_rcpf(1.0f + __builtin_amdgcn_exp2f(-x * LOG2E)); }
__device__ __forceinline__ float tanhf_(float x) { return 1.0f - 2.0f * __builtin_amdgcn_rcpf(1.0f + __builtin_amdgcn_exp2f(2.0f * LOG2E * x)); }

__device__ __forceinline__ void p0_transpose_item(const float* W, int K, int N, bf16* WT, int kb, int nb, int drow, const float* kscale, LAS float* scr, int lane) {
    const int k0 = 64 * kb, n0 = 32 * nb;
#pragma unroll 8
    for (int i = 0; i < 32; ++i) { const int kk = 2 * i + (lane >> 5); float v = W[(size_t)(k0 + kk) * N + n0 + (lane & 31)]; if (kscale) v *= kscale[k0 + kk]; scr[kk * 33 + (lane & 31)] = v; }
    LDS_WAIT(); asm volatile("" ::: "memory");
    const int c = lane & 7;
#pragma unroll
    for (int j = 0; j < 4; ++j) { const int n = (lane >> 3) + 8 * j; const LAS float* s = scr + (8 * c) * 33 + n;
        v4u o; o.x = pk2(s[0 * 33], s[1 * 33]); o.y = pk2(s[2 * 33], s[3 * 33]); o.z = pk2(s[4 * 33], s[5 * 33]); o.w = pk2(s[6 * 33], s[7 * 33]);
        *(GAS v4u*)(WT + (size_t)(drow + n) * K + k0 + 8 * c) = o; }
    LDS_WAIT(); asm volatile("" ::: "memory");
}
__device__ __forceinline__ int gu_row(int n0, int up) { return 256 * (n0 >> 7) + (n0 & 127) + 128 * up; }

__device__ __forceinline__ void p0_prologue(Frame& F, const Args& A) {
    LAS float* scr = (LAS float*)(F.lds + RING_OFF + F.wave * 16384);
    const int gw = blockIdx.x * NWAVES + F.wave, NGW = F.G * NWAVES, lane = F.lane;
    unsigned char* ws = F.ws;
    constexpr int I_GU = (DM / 64) * (DFF / 32), I_D = (DFF / 64) * (DM / 32), I_IN = (DM / 64) * (INC / 32), I_OUT = (DM / 64) * (DM / 32), I_L64 = RWW / 32, I_L128 = 2 * (RWW / 32);
    constexpr int NITEMS = 4 * I_GU + 2 * I_D + I_IN + I_OUT + 2 * I_L64 + I_L128;
    for (int it = gw; it < NITEMS; it += NGW) {
        int r = it;
        if (r < I_GU) { const int kb = r / (DFF / 32), nb = r % (DFF / 32); p0_transpose_item(A.in[8], DM, DFF, (bf16*)(ws + WS_WGU1), kb, nb, gu_row(32 * nb, 0), A.in[7], scr, lane); continue; } r -= I_GU;
        if (r < I_GU) { const int kb = r / (DFF / 32), nb = r % (DFF / 32); p0_transpose_item(A.in[9], DM, DFF, (bf16*)(ws + WS_WGU1), kb, nb, gu_row(32 * nb, 1), A.in[7], scr, lane); continue; } r -= I_GU;
        if (r < I_D)  { const int kb = r / (DM / 32), nb = r % (DM / 32); p0_transpose_item(A.in[10], DFF, DM, (bf16*)(ws + WS_WD1), kb, nb, 32 * nb, nullptr, scr, lane); continue; } r -= I_D;
        if (r < I_IN) { const int kb = r / (INC / 32), nb = r % (INC / 32); p0_transpose_item(A.in[12], DM, INC, (bf16*)(ws + WS_WINB), kb, nb, 32 * nb, A.in[11], scr, lane); continue; } r -= I_IN;
        if (r < I_OUT) { const int kb = r / (DM / 32), nb = r % (DM / 32); p0_transpose_item(A.in[25], DM, DM, (bf16*)(ws + WS_WOUT), kb, nb, 32 * nb, nullptr, scr, lane); continue; } r -= I_OUT;
        if (r < I_GU) { const int kb = r / (DFF / 32), nb = r % (DFF / 32); p0_transpose_item(A.in[27], DM, DFF, (bf16*)(ws + WS_WGU2), kb, nb, gu_row(32 * nb, 0), A.in[26], scr, lane); continue; } r -= I_GU;
        if (r < I_GU) { const int kb = r / (DFF / 32), nb = r % (DFF / 32); p0_transpose_item(A.in[28], DM, DFF, (bf16*)(ws + WS_WGU2), kb, nb, gu_row(32 * nb, 1), A.in[26], scr, lane); continue; } r -= I_GU;
        if (r < I_D)  { const int kb = r / (DM / 32), nb = r % (DM / 32); p0_transpose_item(A.in[29], DFF, DM, (bf16*)(ws + WS_WD2), kb, nb, 32 * nb, nullptr, scr, lane); continue; } r -= I_D;
        if (r < I_L64) { p0_transpose_item(A.in[16], 64, RWW, (bf16*)(ws + WS_W2T), 0, r, 32 * r, nullptr, scr, lane); continue; } r -= I_L64;
        if (r < I_L64) { p0_transpose_item(A.in[18], 64, RWW, (bf16*)(ws + WS_A2T), 0, r, 32 * r, nullptr, scr, lane); continue; } r -= I_L64;
        { const int kb = r / (RWW / 32), nb = r % (RWW / 32); p0_transpose_item(A.in[19], 128, RWW, (bf16*)(ws + WS_G2T), kb, nb, 32 * nb, nullptr, scr, lane); }
    }
    bf16* XB = (bf16*)(ws + WS_XB); float* ssq0 = (float*)(F.ctl + CW_SSQ0);
    for (int m = gw; m < MPAD; m += NGW) {
        GAS unsigned long long* o8 = (GAS unsigned long long*)(XB + (size_t)m * DM) + lane;
        if (m < MV) {
            const float* xrow = m < MP ? A.in[0] + (size_t)m * DM : A.in[1] + (size_t)(m - MP) * DM;
            const GAS f32x4* xr = (const GAS f32x4*)xrow + lane; f32x4 v[8]; float s = 0.f;
#pragma unroll
            for (int j = 0; j < 8; ++j) { v[j] = xr[64 * j]; s += (v[j].x * v[j].x + v[j].y * v[j].y) + (v[j].z * v[j].z + v[j].w * v[j].w); }
            s = wave_sum(s);
#pragma unroll
            for (int j = 0; j < 8; ++j) o8[64 * j] = (unsigned long long)pk2(v[j].x, v[j].y) | ((unsigned long long)pk2(v[j].z, v[j].w) << 32);
            if (lane == 0) ssq0[m] = s;
        } else {
#pragma unroll
            for (int j = 0; j < 8; ++j) o8[64 * j] = 0ull;
        }
    }
    float* bt = (float*)(ws + WS_BIAS);
    for (int i = blockIdx.x * (NWAVES * 64) + F.tid; i < 129 * NQH; i += F.G * NWAVES * 64) bt[i] = A.in[6][(int)T5B[i >> 4] * NQH + (i & 15)] * LOG2E;
}
constexpr int PREP_TILES = (MV + 63) / 64  , PREP_UNITS = PREP_TILES * RWH;
constexpr int PA_PITCH = 528;
constexpr int PA_OFF = 0, PW_OFF = 64 * PA_PITCH  , PMAT = 64 * 65 * 4  ;
__device__ __forceinline__ void prep_unit(Frame& F, const Args& A, int mt, int h) {
    const int tid = F.tid, lane = F.lane, wave = F.wave, m0 = mt * 64;
    unsigned char* ws = F.ws;
    const float* PR = (const float*)(ws + WS_ACT);
    const float* mu = A.in[14];
    LAS unsigned char* lds = F.lds;
    { const int row = tid >> 3, cc = tid & 7, m = m0 + row; const int c0 = 3 * RWW + 32 * cc;
      const bool valid = m < MV;
      const float* p = PR + (size_t)m * SHC + c0;
      const float* pv = nullptr;
      if (valid) { if (m >= MP) pv = A.in[5] + (size_t)(m - MP) * SHC + c0; else if ((m & (SEQ - 1)) != 0) pv = PR + (size_t)(m - 1) * SHC + c0; }
#pragma unroll
      for (int q = 0; q < 8; ++q) {
          f32x4 a = (f32x4){0.f, 0.f, 0.f, 0.f}, b = a;
          if (valid) a = *(const f32x4*)(p + 4 * q);
          if (pv) b = *(const f32x4*)(pv + 4 * q);
          const f32x4 m4 = *(const f32x4*)(mu + c0 + 4 * q);
          f32x4 x = a + m4 * (b - a);
          if (cc < 2) { x.x = tanhf_(x.x); x.y = tanhf_(x.y); x.z = tanhf_(x.z); x.w = tanhf_(x.w); }
          else if (cc >= 4) { x.x = sigmoidf_(x.x); x.y = sigmoidf_(x.y); x.z = sigmoidf_(x.z); x.w = sigmoidf_(x.w); }
          if (!valid) x = (f32x4){0.f, 0.f, 0.f, 0.f};
          *(LAS unsigned long long*)(lds + PA_OFF + row * PA_PITCH + (32 * cc + 4 * q) * 2) = (unsigned long long)pk2(x.x, x.y) | ((unsigned long long)pk2(x.z, x.w) << 32);
      } }
    __syncthreads();
    { const int mtile = wave & 3, nh = wave >> 2, ln = lane & 15, q4 = lane >> 4;
#pragma unroll
      for (int mat = 0; mat < 3; ++mat) {
          const int kbase = mat == 0 ? 0 : (mat == 1 ? 64 : 128), KM = mat == 2 ? 128 : 64;
          const bf16* Bt = (const bf16*)(ws + (mat == 0 ? WS_W2T : (mat == 1 ? WS_A2T : WS_G2T)));
#pragma unroll
          for (int n2 = 0; n2 < 2; ++n2) { const int nt = 2 * nh + n2; f32x4 acc = (f32x4){0.f, 0.f, 0.f, 0.f};
#pragma unroll
              for (int ks = 0; ks < KM / 32; ++ks) {
                  const bf16x8 a = *(const LAS bf16x8*)(lds + PA_OFF + (16 * mtile + ln) * PA_PITCH + (kbase + 32 * ks + 8 * q4) * 2);
                  const bf16x8 b = *(const GAS bf16x8*)(Bt + (size_t)(64 * h + 16 * nt + ln) * KM + 32 * ks + 8 * q4);
                  acc = __builtin_amdgcn_mfma_f32_16x16x32_bf16(a, b, acc, 0, 0, 0); }
              LAS float* o = (LAS float*)(lds + PW_OFF + mat * PMAT);
#pragma unroll
              for (int r = 0; r < 4; ++r) o[(16 * mtile + 4 * q4 + r) * 65 + 16 * nt + ln] = acc[r]; } } }
    __syncthreads();
    { const int hc = 64 * h + lane;
      const float mu_r = mu[hc], mu_k = mu[RWW + hc], mu_v = mu[2 * RWW + hc];
      const float w0 = A.in[15][hc], a0 = A.in[17][hc], k_k = A.in[20][hc], k_a = A.in[21][hc], r_k = A.in[22][hc], ln_w = A.in[23][hc], ln_b = A.in[24][hc];
      bf16* KK = (bf16*)(ws + WS_KK); bf16* BB = (bf16*)(ws + WS_BB); bf16* KP = (bf16*)(ws + WS_KP); bf16* RR = (bf16*)(ws + WS_RR); bf16* VV = (bf16*)(ws + WS_VV);
      float* DD = (float*)(ws + WS_DD); bf16* LG = (bf16*)(ws + WS_LG); bf16* EE = (bf16*)(ws + WS_EE);
      const LAS float* Wp = (const LAS float*)(lds + PW_OFF); const LAS float* Ap = (const LAS float*)(lds + PW_OFF + PMAT); const LAS float* Gp = (const LAS float*)(lds + PW_OFF + 2 * PMAT);
      for (int tt = 0; tt < 8; ++tt) { const int tok = 8 * wave + tt, m = m0 + tok;
          if (m >= MV) break;
          const float* p = PR + (size_t)m * SHC + hc;
          float pr = p[0], pk = p[RWW], pvv = p[2 * RWW], qr = 0.f, qk = 0.f, qv = 0.f;
          if (m >= MP) { const float* s = A.in[5] + (size_t)(m - MP) * SHC + hc; qr = s[0]; qk = s[RWW]; qv = s[2 * RWW]; }
          else if ((m & (SEQ - 1)) != 0) { const float* s = p - SHC; qr = s[0]; qk = s[RWW]; qv = s[2 * RWW]; }
          const float xr = pr + mu_r * (qr - pr), xk = pk + mu_k * (qk - pk), xv = pvv + mu_v * (qv - pvv);
          const float wpre = w0 + Wp[tok * 65 + lane];
          const float dec = __builtin_amdgcn_exp2f(-0.6065306597126334f * LOG2E * sigmoidf_(wpre));
          const float aa = sigmoidf_(a0 + Ap[tok * 65 + lane]);
          const float gg = Gp[tok * 65 + lane];
          float kk = xk * k_k; const float n2 = wave_sum(kk * kk); kk = kk / fmaxf(sqrtf(n2), 1e-12f);
          const float kp = xk * (1.0f + (aa - 1.0f) * k_a);
          const float bonus = wave_sum(xr * kp * r_k);
          const size_t o = (size_t)m * RWW + hc;
          KK[o] = f2bfs(kk); BB[o] = f2bfs(kk * aa); KP[o] = f2bfs(kp); RR[o] = f2bfs(xr); VV[o] = f2bfs(xv); DD[o] = dec;
          LG[o] = f2bfs(ln_w * gg); EE[o] = f2bfs((ln_b + bonus * xv) * gg); }
    }
}

constexpr int AK_PITCH = 144, AV_PITCH = 592, AP_PITCH = 336;
constexpr int AK_OFF = 0, AV_OFF = 272 * AK_PITCH  , AP_OFF = AV_OFF + 64 * AV_PITCH  , AB_OFF = AP_OFF + 8 * 16 * AP_PITCH  ;
static_assert(AB_OFF + 129 * 4 * 4 <= RING_BYTES, "attention LDS");
__device__ __forceinline__ void attn_unit(Frame& F, const Args& A, int b, int blk, int hk) {
    const int tid = F.tid, lane = F.lane, wave = F.wave;
    unsigned char* ws = F.ws; LAS unsigned char* lds = F.lds;
    const bf16* QB = (const bf16*)(ws + WS_QB); const bf16* KB = (const bf16*)(ws + WS_KB); const bf16* VB = (const bf16*)(ws + WS_VB); bf16* MX = (bf16*)(ws + WS_XB);
    const int mq0 = b * SEQ + blk * 128, mk0 = mq0 - 128;
    for (int i = tid; i < 16 * AK_PITCH / 4; i += NWAVES * 64) ((LAS unsigned*)(lds + AK_OFF + 256 * AK_PITCH))[i] = 0u;
    for (int i = tid; i < 64 * 16; i += NWAVES * 64) ((LAS unsigned*)(lds + AV_OFF + (i >> 4) * AV_PITCH + 512))[i & 15] = 0u;
#pragma unroll
    for (int it = 0; it < 4; ++it) { const int idx = it * 512 + tid, row = idx >> 3, ch = idx & 7;
        v4u kv = (v4u){0u, 0u, 0u, 0u}, vv = kv;
        if (blk > 0 || row >= 128) { kv = *(const GAS v4u*)(KB + (size_t)(mk0 + row) * KVW + hk * 64 + ch * 8); vv = *(const GAS v4u*)(VB + (size_t)(mk0 + row) * KVW + hk * 64 + ch * 8); }
        *(LAS v4u*)(lds + AK_OFF + row * AK_PITCH + ch * 16) = kv;
        LAS unsigned short* vt = (LAS unsigned short*)(lds + AV_OFF + (8 * ch) * AV_PITCH + row * 2);
        vt[0 * (AV_PITCH / 2)] = (unsigned short)(vv.x & 0xffffu); vt[1 * (AV_PITCH / 2)] = (unsigned short)(vv.x >> 16);
        vt[2 * (AV_PITCH / 2)] = (unsigned short)(vv.y & 0xffffu); vt[3 * (AV_PITCH / 2)] = (unsigned short)(vv.y >> 16);
        vt[4 * (AV_PITCH / 2)] = (unsigned short)(vv.z & 0xffffu); vt[5 * (AV_PITCH / 2)] = (unsigned short)(vv.z >> 16);
        vt[6 * (AV_PITCH / 2)] = (unsigned short)(vv.w & 0xffffu); vt[7 * (AV_PITCH / 2)] = (unsigned short)(vv.w >> 16); }
    { const float* bt = (const float*)(ws + WS_BIAS); LAS float* bl = (LAS float*)(lds + AB_OFF);
      for (int i = tid; i < 129 * 4; i += NWAVES * 64) bl[i] = bt[(i >> 2) * NQH + 4 * hk + (i & 3)]; }
    __syncthreads();
    const int g = wave >> 1, half = wave & 1, head = 4 * hk + g, ln = lane & 15, q4 = lane >> 4;
    const float sink2 = A.in[13][head] * LOG2E;
    const LAS float* bl = (const LAS float*)(lds + AB_OFF);
    LAS unsigned char* Pw = lds + AP_OFF + wave * (16 * AP_PITCH);
    for (int rb = 0; rb < 4; ++rb) {
        const int i0 = 64 * half + 16 * rb, kt0 = i0 >> 4;
        bf16x8 qf[2];
#pragma unroll
        for (int ks = 0; ks < 2; ++ks) qf[ks] = *(const GAS bf16x8*)(QB + (size_t)(mq0 + i0 + ln) * ATTW + head * 64 + 32 * ks + 8 * q4);
        f32x4 s[10];
#pragma unroll
        for (int j = 0; j < 10; ++j) { f32x4 acc = (f32x4){0.f, 0.f, 0.f, 0.f};
#pragma unroll
            for (int ks = 0; ks < 2; ++ks) { const bf16x8 kf = *(const LAS bf16x8*)(lds + AK_OFF + (16 * (kt0 + j) + ln) * AK_PITCH + (32 * ks + 8 * q4) * 2);
                acc = __builtin_amdgcn_mfma_f32_16x16x32_bf16(qf[ks], kf, acc, 0, 0, 0); }
            s[j] = acc; }
        float mx[4] = {-INFINITY, -INFINITY, -INFINITY, -INFINITY};
#pragma unroll
        for (int j = 0; j < 10; ++j) { const int kj = 16 * (kt0 + j) + ln;
#pragma unroll
            for (int r = 0; r < 4; ++r) { const int dist = 128 + i0 + 4 * q4 + r - kj; const bool ok = dist >= 0 && dist <= 128 && (blk > 0 || kj >= 128);
                const int dc = dist < 0 ? 0 : (dist > 128 ? 128 : dist);
                const float v = ok ? s[j][r] + bl[dc * 4 + g] : -INFINITY; s[j][r] = v; mx[r] = fmaxf(mx[r], v); } }
        float l[4];
#pragma unroll
        for (int r = 0; r < 4; ++r) { float m_ = mx[r]; m_ = fmaxf(m_, __shfl_xor(m_, 1)); m_ = fmaxf(m_, __shfl_xor(m_, 2)); m_ = fmaxf(m_, __shfl_xor(m_, 4)); m_ = fmaxf(m_, __shfl_xor(m_, 8));
            mx[r] = fmaxf(m_, sink2); l[r] = 0.f; }
#pragma unroll
        for (int j = 0; j < 10; ++j)
#pragma unroll
            for (int r = 0; r < 4; ++r) { const float p = __builtin_amdgcn_exp2f(s[j][r] - mx[r]); l[r] += p;
                *(LAS unsigned short*)(Pw + (4 * q4 + r) * AP_PITCH + (16 * j + ln) * 2) = f2bfs(p); }
#pragma unroll
        for (int r = 0; r < 4; ++r) { float t = l[r]; t += __shfl_xor(t, 1); t += __shfl_xor(t, 2); t += __shfl_xor(t, 4); t += __shfl_xor(t, 8);
            l[r] = __builtin_amdgcn_rcpf(t + __builtin_amdgcn_exp2f(sink2 - mx[r])); }
        f32x4 o[4];
#pragma unroll
        for (int dt = 0; dt < 4; ++dt) o[dt] = (f32x4){0.f, 0.f, 0.f, 0.f};
#pragma unroll
        for (int st = 0; st < 5; ++st) { const bf16x8 pf = *(const LAS bf16x8*)(Pw + ln * AP_PITCH + (32 * st + 8 * q4) * 2);
#pragma unroll
            for (int dt = 0; dt < 4; ++dt) { const bf16x8 vf = *(const LAS bf16x8*)(lds + AV_OFF + (16 * dt + ln) * AV_PITCH + (16 * kt0 + 32 * st + 8 * q4) * 2);
                o[dt] = __builtin_amdgcn_mfma_f32_16x16x32_bf16(pf, vf, o[dt], 0, 0, 0); } }
#pragma unroll
        for (int dt = 0; dt < 4; ++dt)
#pragma unroll
            for (int r = 0; r < 4; ++r) MX[(size_t)(mq0 + i0 + 4 * q4 + r) * DM + head * 64 + 16 * dt + ln] = f2bfs(o[dt][r] * l[r]);
    }
    __syncthreads();
}

__device__ __forceinline__ void dec_attn_unit(Frame& F, const Args& A, int du) {
    const int lane = F.lane, wave = F.wave; unsigned char* ws = F.ws;
    const int idx = du * 8 + wave, b = idx >> 4, head = idx & 15, hk = head >> 2, m = MP + b;
    LAS float* qs = (LAS float*)(F.lds + wave * 1024); LAS float* ps = qs + 64;
    const bf16* QB = (const bf16*)(ws + WS_QB); bf16* MX = (bf16*)(ws + WS_XB);
    const float* bt = (const float*)(ws + WS_BIAS);
    const float sink2 = A.in[13][head] * LOG2E;
    const float qv = bf2f(QB[(size_t)m * ATTW + head * 64 + lane]);
    qs[lane] = qv;
    LDS_WAIT(); asm volatile("" ::: "memory");
    float sc[2];
#pragma unroll
    for (int pi = 0; pi < 2; ++pi) { const int pos = lane + 64 * pi; const float* kr = A.in[2] + ((size_t)(b * WIN + pos) * NKVH + hk) * HD; float d = 0.f;
#pragma unroll
        for (int j = 0; j < 16; ++j) { const f32x4 k4 = *(const f32x4*)(kr + 4 * j); const f32x4 q4v = *(const LAS f32x4*)(qs + 4 * j); d += (k4.x * q4v.x + k4.y * q4v.y) + (k4.z * q4v.z + k4.w * q4v.w); }
        sc[pi] = d + bt[(WIN - pos) * NQH + head]; }
    const float* kn = F.out + O_KS + ((size_t)b * WIN + (WIN - 1)) * KVW + hk * HD; const float* vn = F.out + O_VS + ((size_t)b * WIN + (WIN - 1)) * KVW + hk * HD;
    const float snew = wave_sum(qv * kn[lane]) + bt[head];
    const float mx = fmaxf(fmaxf(wave_max(fmaxf(sc[0], sc[1])), snew), sink2);
    const float p0 = __builtin_amdgcn_exp2f(sc[0] - mx), p1 = __builtin_amdgcn_exp2f(sc[1] - mx), pn = __builtin_amdgcn_exp2f(snew - mx);
    const float linv = __builtin_amdgcn_rcpf(wave_sum(p0 + p1) + pn + __builtin_amdgcn_exp2f(sink2 - mx));
    ps[lane] = p0; ps[lane + 64] = p1;
    LDS_WAIT(); asm volatile("" ::: "memory");
    const float* vr = A.in[3] + ((size_t)(b * WIN) * NKVH + hk) * HD + lane; float o = pn * vn[lane];
#pragma unroll 8
    for (int pos = 0; pos < WIN; ++pos) o += ps[pos] * vr[(size_t)pos * NKVH * HD];
    MX[(size_t)m * DM + head * 64 + lane] = f2bfs(o * linv);
    LDS_WAIT(); asm volatile("" ::: "memory");
}

constexpr int SC_T = 32, SC_REC = 1344  , SC_BUF = SC_T * SC_REC  ;
static_assert(2 * SC_BUF <= RING_BYTES, "scan LDS");
struct ScanRegs { v4u kk, bb, kp, rr, vv; f32x4 d0, d1; };
__device__ __forceinline__ void scan_load(ScanRegs& R, const unsigned char* ws, int m, int h, int rq, int part) {
    const size_t o = (size_t)m * RWW + 64 * h + 8 * part;
    R.kk = *(const GAS v4u*)((const bf16*)(ws + WS_KK) + o); R.bb = *(const GAS v4u*)((const bf16*)(ws + WS_BB) + o);
    R.kp = *(const GAS v4u*)((const bf16*)(ws + WS_KP) + o); R.rr = *(const GAS v4u*)((const bf16*)(ws + WS_RR) + o);
    R.d0 = *(const GAS f32x4*)((const float*)(ws + WS_DD) + o); R.d1 = *(const GAS f32x4*)((const float*)(ws + WS_DD) + o + 4);
    R.vv = (v4u){0u, 0u, 0u, 0u};
    if (part < 2) R.vv = *(const GAS v4u*)((const bf16*)(ws + WS_VV) + (size_t)m * RWW + 64 * h + 16 * rq + 8 * part);
}
__device__ __forceinline__ void st8(LAS unsigned char* p, v4u u) {
    *(LAS f32x4*)p = (f32x4){__builtin_bit_cast(float, u.x << 16), __builtin_bit_cast(float, u.x & 0xffff0000u), __builtin_bit_cast(float, u.y << 16), __builtin_bit_cast(float, u.y & 0xffff0000u)};
    *(LAS f32x4*)(p + 16) = (f32x4){__builtin_bit_cast(float, u.z << 16), __builtin_bit_cast(float, u.z & 0xffff0000u), __builtin_bit_cast(float, u.w << 16), __builtin_bit_cast(float, u.w & 0xffff0000u)};
}
__device__ __forceinline__ void scan_store(const ScanRegs& R, LAS unsigned char* rec, int part) {
    st8(rec + 0 + 32 * part, R.kk); *(LAS f32x4*)(rec + 256 + 32 * part) = R.d0; *(LAS f32x4*)(rec + 256 + 32 * part + 16) = R.d1;
    st8(rec + 512 + 32 * part, R.bb); st8(rec + 768 + 32 * part, R.kp); st8(rec + 1024 + 32 * part, R.rr);
    if (part < 2) st8(rec + 1280 + 32 * part, R.vv);
}
__device__ __forceinline__ void scan_unit(Frame& F, int c) {
    const int b = c >> 6, h = (c >> 2) & 15, rq = c & 3, lane = F.lane, wave = F.wave;
    unsigned char* ws = F.ws; LAS unsigned char* lds = F.lds;
    const int mb = b * SEQ; constexpr int NCH = SEQ / SC_T;
    if (wave >= 4) {
        const int ptid = F.tid - 256, tok = ptid >> 3, part = ptid & 7;
        ScanRegs cur, nxt;
        scan_load(cur, ws, mb + tok, h, rq, part);
        scan_load(nxt, ws, mb + SC_T + tok, h, rq, part);
        scan_store(cur, lds + tok * SC_REC, part);
        __syncthreads();
        for (int ch = 0; ch < NCH; ++ch) {
            cur = nxt;
            if (ch + 2 < NCH) scan_load(nxt, ws, mb + (ch + 2) * SC_T + tok, h, rq, part);
            if (ch + 1 < NCH) scan_store(cur, lds + ((ch + 1) & 1) * SC_BUF + tok * SC_REC, part);
            __syncthreads();
        }
    } else {
        const int rl = 4 * wave + (lane >> 4), p = lane & 15, row = 16 * rq + rl;
        float* YS = (float*)(ws + WS_ACT) + (size_t)mb * RWW + 64 * h + row;
        f32x4 S = (f32x4){0.f, 0.f, 0.f, 0.f};
        __syncthreads();
        for (int ch = 0; ch < NCH; ++ch) {
            const LAS unsigned char* base = lds + (ch & 1) * SC_BUF + p * 16;
            const LAS unsigned char* vb = lds + (ch & 1) * SC_BUF + 1280 + rl * 4;
#pragma unroll 4
            for (int t = 0; t < SC_T; ++t) {
                const f32x4 kk = *(const LAS f32x4*)(base + t * SC_REC), dd = *(const LAS f32x4*)(base + t * SC_REC + 256), bb = *(const LAS f32x4*)(base + t * SC_REC + 512),
                            kp = *(const LAS f32x4*)(base + t * SC_REC + 768), rr = *(const LAS f32x4*)(base + t * SC_REC + 1024);
                const float v = *(const LAS float*)(vb + t * SC_REC);
                const float sa = -allsum16((S.x * kk.x + S.y * kk.y) + (S.z * kk.z + S.w * kk.w));
                S = S * dd + bb * sa + kp * v;
                const float y = allsum16((S.x * rr.x + S.y * rr.y) + (S.z * rr.z + S.w * rr.w));
                if (p == 0) YS[(size_t)(ch * SC_T + t) * RWW] = y;
            }
            __syncthreads();
        }
        *(f32x4*)(F.out + O_WP + ((size_t)(b * RWH + h) * HD + row) * HD + 4 * p) = S;
    }
}
__device__ __forceinline__ void dec_rwkv_unit(Frame& F, const Args& A, int du) {
    const int lane = F.lane, wave = F.wave; unsigned char* ws = F.ws;
    const int idx = du * 8 + wave, b = idx >> 4, h = idx & 15, m = MP + b;
    LAS float* vec = (LAS float*)(F.lds + wave * 1280);
    const size_t o = (size_t)m * RWW + 64 * h + lane;
    vec[lane] = bf2f(((const bf16*)(ws + WS_KK))[o]); vec[64 + lane] = ((const float*)(ws + WS_DD))[o]; vec[128 + lane] = bf2f(((const bf16*)(ws + WS_BB))[o]);
    vec[192 + lane] = bf2f(((const bf16*)(ws + WS_KP))[o]); vec[256 + lane] = bf2f(((const bf16*)(ws + WS_RR))[o]);
    const float vi = bf2f(((const bf16*)(ws + WS_VV))[o]);
    const size_t so = ((size_t)(b * RWH + h) * HD + lane) * HD;
    const float* Sp = A.in[4] + so; f32x4 S[16];
#pragma unroll
    for (int j = 0; j < 16; ++j) S[j] = *(const f32x4*)(Sp + 4 * j);
    LDS_WAIT(); asm volatile("" ::: "memory");
    float sa = 0.f;
#pragma unroll
    for (int j = 0; j < 16; ++j) { const f32x4 kk = *(const LAS f32x4*)(vec + 4 * j); sa += (S[j].x * kk.x + S[j].y * kk.y) + (S[j].z * kk.z + S[j].w * kk.w); asm volatile("" ::: "memory"); }
    sa = -sa; float y = 0.f; float* So = F.out + O_WS + so;
#pragma unroll
    for (int j = 0; j < 16; ++j) { const f32x4 dd = *(const LAS f32x4*)(vec + 64 + 4 * j), bb = *(const LAS f32x4*)(vec + 128 + 4 * j), kp = *(const LAS f32x4*)(vec + 192 + 4 * j), rr = *(const LAS f32x4*)(vec + 256 + 4 * j);
        S[j] = S[j] * dd + bb * sa + kp * vi; y += (S[j].x * rr.x + S[j].y * rr.y) + (S[j].z * rr.z + S[j].w * rr.w);
        *(f32x4*)(So + 4 * j) = S[j]; asm volatile("" ::: "memory"); }
    ((float*)(ws + WS_ACT))[o] = y;
    LDS_WAIT(); asm volatile("" ::: "memory");
}
__global__ void __launch_bounds__(NWAVES * 64, 2) hymba_fwd(Args args) {
    extern __shared__ __attribute__((aligned(16))) unsigned char lds_raw[];
    { const int t0_ = threadIdx.x;
      for (int u = t0_; u < (LDS_BYTES - LDSCTL_OFF) / 4; u += NWAVES * 64) ((LAS unsigned*)((LAS unsigned char*)lds_raw + LDSCTL_OFF))[u] = 0u; }
    __syncthreads();
    XcdBarrier bar; bar.bar = (unsigned*)((gu32*)(args.ws + WS_CTL) + CW_BAR); bar.x = 0; bar.st = nullptr;
    if (MK_N_LAUNCHES == 1) bar = xcd_barrier_post((unsigned*)((gu32*)(args.ws + WS_CTL) + CW_BAR), (volatile LAS unsigned*)((LAS unsigned char*)lds_raw + MISC_OFF) + 8);
    const int lo = args.ph_lo, hi = args.ph_hi;
#ifndef PH_MASK
#define PH_MASK 0x7ff
#endif
#define IN(k) (((PH_MASK >> (k)) & 1) && lo <= (k) && (k) < hi)
#define SEAM(k) do { if (IN(k) && IN((k) + 1)) xcd_barrier(bar); } while (0)
#define PHASE_FRAME() Frame F; { int t_ = threadIdx.x; asm volatile("" : "+v"(t_)); F.lds = (LAS unsigned char*)lds_raw; F.MISC = (volatile LAS unsigned*)(F.lds + MISC_OFF); F.tid = t_; F.lane = t_ & 63; \
        F.wave = __builtin_amdgcn_readfirstlane(t_ >> 6); F.G = gridDim.x; F.out = args.out; F.ws = args.ws; F.ctl = (gu32*)(args.ws + WS_CTL); } \
    unsigned char* ws = F.ws; const int gw = blockIdx.x * NWAVES + F.wave, NGW = F.G * NWAVES; (void)gw; (void)NGW; \
    bf16* XB = (bf16*)(ws + WS_XB); bf16* ACT = (bf16*)(ws + WS_ACT); bf16* X2B = (bf16*)(ws + WS_X2B); (void)XB; (void)ACT; (void)X2B; \
    float* ssq0 = (float*)(F.ctl + CW_SSQ0); float* ssq1 = (float*)(F.ctl + CW_SSQ1); float* ssq2 = (float*)(F.ctl + CW_SSQ2); float* ssq3 = (float*)(F.ctl + CW_SSQ3); (void)ssq0; (void)ssq1; (void)ssq2; (void)ssq3; \
    float* yp = args.out + O_YP; float* ys = args.out + O_YS; (void)yp; (void)ys;

    if (IN(0)) { PHASE_FRAME(); p0_prologue(F, args); SEAM(0); }
    if (IN(1)) { PHASE_FRAME(); pg8::Gemm g{XB, (const bf16*)(ws + WS_WGU1), MPAD, 2 * DFF, DM}; pg8::StaticOrder S; S.init(MPAD, 2 * DFF, F.G, (int)blockIdx.x);
        pg8::EpiSwiglu E{ACT, ssq0};
        pg8::gemm_phase<pg8::EpiSwiglu, pg8::StaticOrder, true, true>(F.lds + RING_OFF, g, S, E); SEAM(1); }
    if (IN(2)) { PHASE_FRAME(); pg8::Gemm g{ACT, (const bf16*)(ws + WS_WD1), MPAD, DM, DFF}; pg8::StaticOrder S; S.init(MPAD, DM, F.G, (int)blockIdx.x);
        pg8::EpiResid E{args.in[0], args.in[1], yp, ys, XB, ssq1, 0.5f};
        pg8::gemm_phase<pg8::EpiResid, pg8::StaticOrder, true, true>(F.lds + RING_OFF, g, S, E); SEAM(2); }
    if (IN(3)) { PHASE_FRAME(); pg8::Gemm g{XB, (const bf16*)(ws + WS_WINB), MPAD, INC, DM}; pg8::StaticOrder S; S.init(MPAD, INC, F.G, (int)blockIdx.x);
        pg8::EpiWin E{ssq1, (bf16*)(ws + WS_QB), (bf16*)(ws + WS_KB), (bf16*)(ws + WS_VB), (float*)(ws + WS_ACT), args.out};
        pg8::gemm_phase<pg8::EpiWin, pg8::StaticOrder, true, true>(F.lds + RING_OFF, g, S, E); SEAM(3); }
    if (IN(4)) { PHASE_FRAME();
        for (int u = blockIdx.x; u < NB * 16 * NKVH; u += F.G) attn_unit(F, args, u >> 6, (u >> 2) & 15, u & 3);
        for (int u = blockIdx.x; u < PREP_UNITS; u += F.G) prep_unit(F, args, u >> 4, u & 15);
        __syncthreads();
        for (int u = (int)F.G - 1 - (int)blockIdx.x; u < NDEC * NQH / 8; u += F.G) dec_attn_unit(F, args, u);
        __syncthreads();
        { const int n4 = NDEC * (WIN - 1) * KVW / 4;
          for (int i = blockIdx.x * (NWAVES * 64) + F.tid; i < 2 * n4; i += F.G * NWAVES * 64) { const int t = i >= n4, j = t ? i - n4 : i; const int bb = j / ((WIN - 1) * KVW / 4), r = j % ((WIN - 1) * KVW / 4);
              const f32x4 v = *((const f32x4*)(args.in[2 + t] + (size_t)bb * WIN * KVW + KVW) + r);
              *((f32x4*)(args.out + (t ? O_VS : O_KS) + (size_t)bb * WIN * KVW) + r) = v; } }
        SEAM(4); }
    if (IN(5)) { PHASE_FRAME();
        for (int u = blockIdx.x; u < NB * RWH * 4; u += F.G) scan_unit(F, u);
        __syncthreads();
        for (int u = blockIdx.x; u < NDEC * RWH / 8; u += F.G) dec_rwkv_unit(F, args, u);
        SEAM(5); }
    if (IN(6)) { PHASE_FRAME(); const float* YS = (const float*)(ws + WS_ACT); const bf16* LG = (const bf16*)(ws + WS_LG); const bf16* EE = (const bf16*)(ws + WS_EE);
        for (int u = gw; u < MV * RWH; u += NGW) { const size_t o = (size_t)(u >> 4) * RWW + 64 * (u & 15) + F.lane;
            const float y = YS[o], mean = wave_sum(y) * (1.0f / 64.0f), dl = y - mean, var = wave_sum(dl * dl) * (1.0f / 64.0f);
            const float r = dl * __builtin_amdgcn_rsqf(var + GN_EPS) * bf2f(LG[o]) + bf2f(EE[o]);
            XB[(size_t)(u >> 4) * DM + ATTW + 64 * (u & 15) + F.lane] = f2bfs(r); }
        SEAM(6); }
    if (IN(7)) { PHASE_FRAME(); pg8::Gemm g{XB, (const bf16*)(ws + WS_WOUT), MPAD, DM, DM}; pg8::StaticOrder S; S.init(MPAD, DM, F.G, (int)blockIdx.x);
        pg8::EpiResid E{yp, ys, yp, ys, X2B, ssq2, 1.0f};
        pg8::gemm_phase<pg8::EpiResid, pg8::StaticOrder, true, true>(F.lds + RING_OFF, g, S, E); SEAM(7); }
    if (IN(8)) { PHASE_FRAME(); pg8::Gemm g{X2B, (const bf16*)(ws + WS_WGU2), MPAD, 2 * DFF, DM}; pg8::StaticOrder S; S.init(MPAD, 2 * DFF, F.G, (int)blockIdx.x);
        pg8::EpiSwiglu E{ACT, ssq2};
        pg8::gemm_phase<pg8::EpiSwiglu, pg8::StaticOrder, true, true>(F.lds + RING_OFF, g, S, E); SEAM(8); }
    if (IN(9)) { PHASE_FRAME(); pg8::Gemm g{ACT, (const bf16*)(ws + WS_WD2), MPAD, DM, DFF}; pg8::StaticOrder S; S.init(MPAD, DM, F.G, (int)blockIdx.x);
        pg8::EpiResid E{yp, ys, yp, ys, nullptr, ssq3, 0.5f};
        pg8::gemm_phase<pg8::EpiResid, pg8::StaticOrder, true, true>(F.lds + RING_OFF, g, S, E); SEAM(9); }
    if (IN(10)) { PHASE_FRAME(); const float* fn = args.in[30];
        for (int m = gw; m < MV; m += NGW) { float* xr = m < MP ? yp + (size_t)m * DM : ys + (size_t)(m - MP) * DM;
            const float s = __builtin_amdgcn_rsqf(ssq3[m] * (1.0f / DM) + RMS_EPS);
            GAS f32x4* x4 = (GAS f32x4*)xr + F.lane; const GAS f32x4* f4 = (const GAS f32x4*)fn + F.lane;
#pragma unroll
            for (int j = 0; j < 8; ++j) x4[64 * j] = x4[64 * j] * s * f4[64 * j]; } }
#undef IN
#undef SEAM
}

extern "C" void kernel_launch(void* const* d_in, const int* in_sizes, int n_in, void* d_out, int out_size, void* d_ws, size_t ws_size, hipStream_t stream) {
    static int grid = 0;
    if (grid == 0) {
        if (n_in != 31 || in_sizes[0] != MP * DM || (size_t)out_size != O_END || ws_size < WS_END) {
            fprintf(stderr, "kernel_launch: unexpected shapes: n_in %d in0 %d out %d (want %zu) ws %zu (want >= %zu); nothing launched\n", n_in, n_in > 0 ? in_sizes[0] : -1, out_size, (size_t)O_END, ws_size, (size_t)WS_END);
            grid = -1; return; }
        int dev = 0, cus = 0, per_cu = 0;
        if (hipGetDevice(&dev) != hipSuccess || hipDeviceGetAttribute(&cus, hipDeviceAttributeMultiprocessorCount, dev) != hipSuccess) { fprintf(stderr, "kernel_launch: device query failed\n"); grid = -1; return; }
        if (hipFuncSetAttribute((const void*)hymba_fwd, hipFuncAttributeMaxDynamicSharedMemorySize, LDS_BYTES) != hipSuccess) { fprintf(stderr, "kernel_launch: hipFuncSetAttribute failed\n"); grid = -1; return; }
        if (hipOccupancyMaxActiveBlocksPerMultiprocessor(&per_cu, (const void*)hymba_fwd, NWAVES * 64, LDS_BYTES) != hipSuccess || per_cu < 1)
            fprintf(stderr, "kernel_launch: note: occupancy query reports %d workgroups per CU\n", per_cu);
        (void)hipGetLastError();
        grid = cus;
    }
    if (grid < 0) return;
    if (hipMemsetAsync((char*)d_ws + WS_CTL, 0, CTL_ZERO_BYTES, stream) != hipSuccess) { fprintf(stderr, "kernel_launch: hipMemsetAsync failed\n"); return; }
    Args a{};
    for (int i = 0; i < 31; ++i) a.in[i] = (const float*)d_in[i];
    a.out = (float*)d_out; a.ws = (unsigned char*)d_ws;
    for (int li = 0; li < MK_N_LAUNCHES; ++li) {
        a.ph_lo = (MK_N_LAUNCHES == 1) ? 0 : li; a.ph_hi = (MK_N_LAUNCHES == 1) ? NPHASES : li + 1; a.li = li;
        hipLaunchKernelGGL(hymba_fwd, dim3(grid), dim3(NWAVES * 64), LDS_BYTES, stream, a);
        const hipError_t le = hipPeekAtLastError();
        if (le != hipSuccess) { fprintf(stderr, "kernel_launch: launch %d failed: %s\n", li, hipGetErrorName(le)); break; }
    }
}
```

```cpp
#include <hip/hip_runtime.h>
#include <cstdio>
#include <cstdint>
#define MK_N_LAUNCHES 1
constexpr int DM = 2048, SEQ = 2048, NB = 4, MP = NB * SEQ  , NDEC = 32, MV = MP + NDEC  , MPAD = 8448  ;
constexpr int DFF = 5504, ATTW = 1024, KVW = 256, RWW = 1024, NQH = 16, NKVH = 4, HD = 64, RWH = 16, WIN = 128;
constexpr int ATT_COLS = ATTW + 2 * KVW  , SHC = 3 * RWW + 64 + 64 + 128  , INC = ATT_COLS + SHC  ;
constexpr float RMS_EPS = 1e-5f, GN_EPS = 64e-5f, LOG2E = 1.4426950408889634f;
constexpr float QSCALE = 0.125f * LOG2E;
constexpr size_t O_YP = 0, O_YS = O_YP + (size_t)MP * DM, O_KP = O_YS + (size_t)NDEC * DM, O_VP = O_KP + (size_t)NB * WIN * KVW, O_WP = O_VP + (size_t)NB * WIN * KVW,
                 O_SP = O_WP + (size_t)NB * RWH * HD * HD, O_KS = O_SP + (size_t)NB * SHC, O_VS = O_KS + (size_t)NDEC * WIN * KVW, O_WS = O_VS + (size_t)NDEC * WIN * KVW,
                 O_SS = O_WS + (size_t)NDEC * RWH * HD * HD, O_END = O_SS + (size_t)NDEC * SHC;
namespace pg8 {
#define PG8_LAS __attribute__((address_space(3)))
typedef unsigned short bf16_t;
typedef short bf16x8 __attribute__((ext_vector_type(8)));
typedef float f32x4 __attribute__((ext_vector_type(4)));
typedef unsigned u32x4 __attribute__((ext_vector_type(4)));
constexpr int BM = 256, BK = 64, HALF = 128, HTB = HALF * BK * 2  , STAGE_BYTES = 8 * HTB, NXCD = 8, WGM = 8;

__host__ __device__ __forceinline__ int lds_byte(int r, int c) { const int st = (r >> 4) * 2 + (c >> 5), rr = r & 15, cc = c & 31, ob = rr * 64 + cc * 2; return st * 1024 + (ob ^ (((ob >> 9) & 1) << 5)); }
__host__ __device__ __forceinline__ void stage_rc(int b, int& R, int& C) { const int st = b / 1024, sb = b % 1024, swz = sb ^ (((sb >> 9) & 1) << 5); R = (st >> 1) * 16 + swz / 64; C = (st & 1) * 32 + (swz % 64) / 2; }
__host__ __device__ __forceinline__ int perm32(int rho) { const int n = rho >> 4, i = rho & 15; return 8 * (i >> 2) + 4 * n + (i & 3); }

struct Unit { int pm, pn; };
struct Gemm { const bf16_t* A; const bf16_t* Bt; int M, N, K; };

struct StaticOrder {
    int nM, nN, nwg, G, c;
    __host__ __device__ void init(int M, int N, int G_, int c_) { nM = M / BM; nN = N / BM; nwg = nM * nN; G = G_; c = c_; }
    __host__ __device__ bool next(int i, Unit& u) const {
        const long L = (long)i * G + c; if (L >= nwg) return false;
        int wgid = (int)L; { const int q = nwg / NXCD, r = nwg % NXCD, xcd = wgid % NXCD, off = wgid / NXCD; wgid = (xcd < r ? xcd * (q + 1) : r * (q + 1) + (xcd - r) * q) + off; }
        const int nig = WGM * nN, gid = wgid / nig, fm = gid * WGM, gsz = (nM - fm) < WGM ? (nM - fm) : WGM;
        u.pm = fm + ((wgid % nig) % gsz); u.pn = (wgid % nig) / gsz; return true;
    }
    __device__ __forceinline__ void a_ready(const Unit&) const {}
    __device__ __forceinline__ void done(const Unit&) const {}
};

__device__ __forceinline__ unsigned cvt_pk_bf16(float lo, float hi) { unsigned r; asm volatile("v_cvt_pk_bf16_f32 %0, %1, %2" : "=v"(r) : "v"(lo), "v"(hi)); return r; }
__device__ __forceinline__ float silu_mul(float g, float u) { return g * u * __builtin_amdgcn_rcpf(1.0f + __builtin_amdgcn_exp2f(-g * LOG2E)); }

struct EpiSwiglu {
    static constexpr bool PERM = true, AFTER_DRAIN = false;
    bf16_t* O; const float* ssq;
    __device__ __forceinline__ void operator()(const f32x4 (&acc)[2][2][4][2], const Unit& u, int wr, int wc, int fr, int fq) const {
        const int row0 = u.pm * BM + wr * 64 + fr, col0 = u.pn * HALF + wc * 32 + 8 * fq;
#pragma unroll
        for (int ai = 0; ai < 2; ++ai)
#pragma unroll
            for (int m = 0; m < 4; ++m) { const int row = row0 + ai * HALF + m * 16;
                const float s = __builtin_amdgcn_rsqf(ssq[row] * (1.0f / DM) + RMS_EPS);
                const f32x4 g0 = acc[ai][0][m][0] * s, g1 = acc[ai][0][m][1] * s, u0 = acc[ai][1][m][0] * s, u1 = acc[ai][1][m][1] * s;
                u32x4 w; w.x = cvt_pk_bf16(silu_mul(g0[0], u0[0]), silu_mul(g0[1], u0[1])); w.y = cvt_pk_bf16(silu_mul(g0[2], u0[2]), silu_mul(g0[3], u0[3]));
                w.z = cvt_pk_bf16(silu_mul(g1[0], u1[0]), silu_mul(g1[1], u1[1])); w.w = cvt_pk_bf16(silu_mul(g1[2], u1[2]), silu_mul(g1[3], u1[3]));
                *(u32x4*)(O + (size_t)row * DFF + col0) = w; }
    }
};

struct EpiResid {
    static constexpr bool PERM = true, AFTER_DRAIN = false;
    const float* xi_p; const float* xi_s; float* xo_p; float* xo_s; bf16_t* XB; float* ssq; float alpha;
    __device__ __forceinline__ void operator()(const f32x4 (&acc)[2][2][4][2], const Unit& u, int wr, int wc, int fr, int fq) const {
        const int row0 = u.pm * BM + wr * 64 + fr, col0 = u.pn * BM + wc * 32 + 8 * fq;
#pragma unroll
        for (int ai = 0; ai < 2; ++ai)
#pragma unroll
            for (int m = 0; m < 4; ++m) { const int row = row0 + ai * HALF + m * 16; const bool valid = row < MV;
                const size_t ro = row < MP ? (size_t)row * DM : (size_t)(row - MP) * DM;
                const float* src = (row < MP ? xi_p : xi_s) + ro; float* dst = (row < MP ? xo_p : xo_s) + ro;
                float sq = 0.f;
#pragma unroll
                for (int bj = 0; bj < 2; ++bj) { const int col = col0 + bj * HALF;
                    f32x4 x0 = (f32x4){0.f, 0.f, 0.f, 0.f}, x1 = x0;
                    if (valid) { x0 = *(const f32x4*)(src + col); x1 = *(const f32x4*)(src + col + 4); }
                    const f32x4 y0 = x0 + acc[ai][bj][m][0] * alpha, y1 = x1 + acc[ai][bj][m][1] * alpha;
                    if (valid) { *(f32x4*)(dst + col) = y0; *(f32x4*)(dst + col + 4) = y1; }
                    sq += (y0[0] * y0[0] + y0[1] * y0[1]) + (y0[2] * y0[2] + y0[3] * y0[3]) + (y1[0] * y1[0] + y1[1] * y1[1]) + (y1[2] * y1[2] + y1[3] * y1[3]);
                    if (XB) { u32x4 w; w.x = cvt_pk_bf16(y0[0], y0[1]); w.y = cvt_pk_bf16(y0[2], y0[3]); w.z = cvt_pk_bf16(y1[0], y1[1]); w.w = cvt_pk_bf16(y1[2], y1[3]);
                        *(u32x4*)(XB + (size_t)row * DM + col) = w; } }
                sq += __shfl_xor(sq, 16); sq += __shfl_xor(sq, 32);
                if (fq == 0 && valid) atomicAdd(ssq + row, sq); }
    }
};

struct EpiWin {
    static constexpr bool PERM = true, AFTER_DRAIN = false;
    const float* ssq; bf16_t* QB; bf16_t* KB; bf16_t* VB; float* PR; float* out;
    __device__ __forceinline__ void operator()(const f32x4 (&acc)[2][2][4][2], const Unit& u, int wr, int wc, int fr, int fq) const {
        const int row0 = u.pm * BM + wr * 64 + fr, cl0 = wc * 32 + 8 * fq;
        const int pn = u.pn;
#pragma unroll
        for (int ai = 0; ai < 2; ++ai)
#pragma unroll
            for (int m = 0; m < 4; ++m) { const int row = row0 + ai * HALF + m * 16; const bool valid = row < MV;
                float s = __builtin_amdgcn_rsqf(ssq[row] * (1.0f / DM) + RMS_EPS);
                if (pn < 4) s *= QSCALE;
#pragma unroll
                for (int bj = 0; bj < 2; ++bj) { const int cl = cl0 + bj * HALF;
                    const f32x4 y0 = acc[ai][bj][m][0] * s, y1 = acc[ai][bj][m][1] * s;
                    if (pn < 6) { u32x4 w; w.x = cvt_pk_bf16(y0[0], y0[1]); w.y = cvt_pk_bf16(y0[2], y0[3]); w.z = cvt_pk_bf16(y1[0], y1[1]); w.w = cvt_pk_bf16(y1[2], y1[3]);
                        if (pn < 4) *(u32x4*)(QB + (size_t)row * ATTW + pn * BM + cl) = w;
                        else { *(u32x4*)((pn == 4 ? KB : VB) + (size_t)row * KVW + cl) = w;
                            if (valid) { float* o = nullptr;
                                if (row >= MP) o = out + (pn == 4 ? O_KS : O_VS) + ((size_t)(row - MP) * WIN + (WIN - 1)) * KVW + cl;
                                else if ((row & (SEQ - 1)) >= SEQ - WIN) o = out + (pn == 4 ? O_KP : O_VP) + ((size_t)(row >> 11) * WIN + ((row & (SEQ - 1)) - (SEQ - WIN))) * KVW + cl;
                                if (o) { *(f32x4*)o = y0; *(f32x4*)(o + 4) = y1; } } }
                    } else { const int cs = (pn - 6) * BM + cl;
                        *(f32x4*)(PR + (size_t)row * SHC + cs) = y0; *(f32x4*)(PR + (size_t)row * SHC + cs + 4) = y1;
                        if (valid) { float* o = nullptr;
                            if (row >= MP) o = out + O_SS + (size_t)(row - MP) * SHC + cs;
                            else if ((row & (SEQ - 1)) == SEQ - 1) o = out + O_SP + (size_t)(row >> 11) * SHC + cs;
                            if (o) { *(f32x4*)o = y0; *(f32x4*)(o + 4) = y1; } } } }
            }
    }
};
template <class Epi, class Sched, bool ALIGN_EPI = false, bool SP2 = false>
__device__ __forceinline__ void gemm_phase(PG8_LAS unsigned char* lds, const Gemm g, const Sched& S, const Epi& E) {
    int tid_ = threadIdx.x; asm volatile("" : "+v"(tid_)); const int tid = tid_, wid = __builtin_amdgcn_readfirstlane(tid >> 6), lane = tid & 63, wr = wid >> 2, wc = wid & 3, fr = lane & 15, fq = lane >> 4;
    const int K = g.K, nt = K / BK;
    unsigned voffA[2], voffB[2];
#pragma unroll
    for (int i = 0; i < 2; ++i) { int R, C; stage_rc(tid * 16 + i * 8192, R, C); const int Rb = Epi::PERM ? ((R & ~31) + perm32(R & 31)) : R;
        voffA[i] = (unsigned)(R * K + C) * 2u; voffB[i] = (unsigned)(Rb * K + C) * 2u; }
    const size_t kstep = (size_t)(BK * 2);
    const size_t hstep = (size_t)HALF * K * 2;
    const size_t tstep = 2 * hstep;
    const unsigned ldsw = (unsigned)wid * 1024u;
    const int aoff = lds_byte(wr * 64 + fr, fq * 8), boff = lds_byte(wc * 32 + fr, fq * 8);
#define PG8_SA(b, h) (((b) * 2 + (h)) * HTB)
#define PG8_SB(b, h) ((4 + (b) * 2 + (h)) * HTB)
#define PG8_STAGE(bufoff, gbase, voff) do { _Pragma("unroll") for (int _i = 0; _i < 2; ++_i) \
        __builtin_amdgcn_global_load_lds((const unsigned*)((const char*)(gbase) + (voff)[_i]), (PG8_LAS unsigned*)(lds + (bufoff) + ldsw + _i * 8192), 16, 0, 0); } while (0)
#define PG8_LDA(dst, b, h) do { _Pragma("unroll") for (int m = 0; m < 4; ++m) _Pragma("unroll") for (int k = 0; k < 2; ++k) dst[m][k] = *(const PG8_LAS bf16x8*)(lds + PG8_SA(b, h) + aoff + m * 2048 + k * 1024); } while (0)
#define PG8_LDB(dst, b, h) do { _Pragma("unroll") for (int n = 0; n < 2; ++n) _Pragma("unroll") for (int k = 0; k < 2; ++k) dst[n][k] = *(const PG8_LAS bf16x8*)(lds + PG8_SB(b, h) + boff + n * 2048 + k * 1024); } while (0)
#define PG8_MMA(ai, bj, At, Bt) do { __builtin_amdgcn_s_setprio(1); _Pragma("unroll") for (int m = 0; m < 4; ++m) _Pragma("unroll") for (int n = 0; n < 2; ++n) _Pragma("unroll") for (int k = 0; k < 2; ++k) \
        acc[ai][bj][m][n] = __builtin_amdgcn_mfma_f32_16x16x32_bf16(Bt[n][k], At[m][k], acc[ai][bj][m][n], 0, 0, 0); __builtin_amdgcn_s_setprio(0); } while (0)
#define PG8_WAIT_V(n) asm volatile("s_waitcnt vmcnt(" #n ")" ::: "memory")
#define PG8_WAIT_L(n) asm volatile("s_waitcnt lgkmcnt(" #n ")" ::: "memory")
#define PG8_BAR __builtin_amdgcn_s_barrier()
#define PG8_SCHED __builtin_amdgcn_sched_barrier(0)
    Unit cur, nxt; int ui = 0;
    if (!S.next(0, cur)) return;
    f32x4 acc[2][2][4][2];
#pragma unroll
    for (int a = 0; a < 2; ++a)
#pragma unroll
        for (int b = 0; b < 2; ++b)
#pragma unroll
            for (int m = 0; m < 4; ++m)
#pragma unroll
                for (int n = 0; n < 2; ++n) acc[a][b][m][n] = (f32x4){0.f, 0.f, 0.f, 0.f};
    bf16x8 At[4][2], B0[2][2], B1[2][2];
    const char* cA = (const char*)g.A + (size_t)cur.pm * tstep; const char* cB = (const char*)g.Bt + (size_t)cur.pn * tstep;
    S.a_ready(cur);
    if constexpr (SP2) {
        PG8_STAGE(PG8_SB(0, 0), cB, voffB); PG8_STAGE(PG8_SB(0, 1), cB + hstep, voffB); PG8_STAGE(PG8_SA(0, 0), cA, voffA); PG8_STAGE(PG8_SA(0, 1), cA + hstep, voffA);
        if (wr == 1) PG8_BAR;
        PG8_WAIT_V(2); PG8_BAR;
        PG8_STAGE(PG8_SB(1, 0), cB + kstep, voffB); PG8_STAGE(PG8_SA(1, 0), cA + kstep, voffA); PG8_STAGE(PG8_SB(1, 1), cB + hstep + kstep, voffB);
        PG8_WAIT_V(6); PG8_BAR;
    } else {
        PG8_STAGE(PG8_SB(0, 0), cB, voffB); PG8_STAGE(PG8_SA(0, 0), cA, voffA); PG8_STAGE(PG8_SB(0, 1), cB + hstep, voffB); PG8_STAGE(PG8_SA(0, 1), cA + hstep, voffA);
        if (wr == 1) PG8_BAR;
        PG8_WAIT_V(4); PG8_BAR;
        PG8_STAGE(PG8_SB(1, 0), cB + kstep, voffB); PG8_STAGE(PG8_SA(1, 0), cA + kstep, voffA); PG8_STAGE(PG8_SB(1, 1), cB + hstep + kstep, voffB);
        PG8_WAIT_V(6); PG8_BAR;
    }
    for (;;) {
        const bool has_next = S.next(ui + 1, nxt);
        const char* nA = has_next ? (const char*)g.A + (size_t)nxt.pm * tstep : cA; const char* nB = has_next ? (const char*)g.Bt + (size_t)nxt.pn * tstep : cB;
        for (int t = 0; t < nt; t += 2) {
            const bool last = (t == nt - 2);
            const char* a1 = cA + (size_t)(t + 1) * kstep;
            const char* a2 = last ? nA : cA + (size_t)(t + 2) * kstep; const char* b2 = last ? nB : cB + (size_t)(t + 2) * kstep;
            const char* a3 = a2 + kstep; const char* b3 = b2 + kstep;
            if (last && has_next) S.a_ready(nxt);
            if constexpr (SP2) {
            PG8_LDB(B0, 0, 0); PG8_LDB(B1, 0, 1); PG8_SCHED; PG8_LDA(At, 0, 0); PG8_STAGE(PG8_SA(1, 1), a1 + hstep, voffA);
            PG8_WAIT_V(8); PG8_WAIT_L(0); PG8_BAR; PG8_MMA(0, 0, At, B0); PG8_MMA(0, 1, At, B1); PG8_BAR; PG8_SCHED;
            PG8_LDA(At, 0, 1); PG8_STAGE(PG8_SB(0, 0), b2, voffB); PG8_STAGE(PG8_SB(0, 1), b2 + hstep, voffB); PG8_STAGE(PG8_SA(0, 0), a2, voffA);
            PG8_WAIT_V(8); PG8_WAIT_L(0); PG8_BAR; PG8_MMA(1, 0, At, B0); PG8_MMA(1, 1, At, B1); PG8_BAR; PG8_SCHED;
            PG8_LDB(B0, 1, 0); PG8_LDB(B1, 1, 1); PG8_SCHED; PG8_LDA(At, 1, 0); PG8_STAGE(PG8_SA(0, 1), a2 + hstep, voffA);
            PG8_WAIT_V(8); PG8_WAIT_L(0); PG8_BAR; PG8_MMA(0, 0, At, B0); PG8_MMA(0, 1, At, B1); PG8_BAR; PG8_SCHED;
            PG8_LDA(At, 1, 1); PG8_STAGE(PG8_SB(1, 0), b3, voffB); PG8_STAGE(PG8_SB(1, 1), b3 + hstep, voffB); PG8_STAGE(PG8_SA(1, 0), a3, voffA);
            PG8_WAIT_V(8); PG8_WAIT_L(0); PG8_BAR; PG8_MMA(1, 0, At, B0); PG8_MMA(1, 1, At, B1); PG8_BAR; PG8_SCHED;
            } else {
            PG8_LDB(B0, 0, 0); PG8_SCHED; PG8_LDA(At, 0, 0); PG8_STAGE(PG8_SA(1, 1), a1 + hstep, voffA);
            PG8_WAIT_L(8); PG8_BAR; PG8_WAIT_L(0); PG8_MMA(0, 0, At, B0); PG8_BAR; PG8_SCHED;
            PG8_LDB(B1, 0, 1); PG8_STAGE(PG8_SB(0, 0), b2, voffB);
            PG8_BAR; PG8_WAIT_L(0); PG8_MMA(0, 1, At, B1); PG8_BAR;
            PG8_LDA(At, 0, 1); PG8_STAGE(PG8_SA(0, 0), a2, voffA);
            PG8_BAR; PG8_WAIT_L(0); PG8_MMA(1, 0, At, B0); PG8_BAR; PG8_SCHED;
            PG8_STAGE(PG8_SB(0, 1), b2 + hstep, voffB);
            PG8_WAIT_V(6); PG8_BAR; PG8_MMA(1, 1, At, B1); PG8_BAR;
            PG8_LDB(B0, 1, 0); PG8_SCHED; PG8_LDA(At, 1, 0); PG8_STAGE(PG8_SA(0, 1), a2 + hstep, voffA);
            PG8_WAIT_L(8); PG8_BAR; PG8_WAIT_L(0); PG8_MMA(0, 0, At, B0); PG8_BAR; PG8_SCHED;
            PG8_LDB(B1, 1, 1); PG8_STAGE(PG8_SB(1, 0), b3, voffB);
            PG8_BAR; PG8_WAIT_L(0); PG8_MMA(0, 1, At, B1); PG8_BAR;
            PG8_LDA(At, 1, 1); PG8_STAGE(PG8_SA(1, 0), a3, voffA);
            PG8_BAR; PG8_WAIT_L(0); PG8_MMA(1, 0, At, B0); PG8_BAR; PG8_SCHED;
            PG8_STAGE(PG8_SB(1, 1), b3 + hstep, voffB);
            PG8_WAIT_V(6); PG8_BAR; PG8_MMA(1, 1, At, B1); PG8_BAR;
            }
        }
        if constexpr (ALIGN_EPI) { if (wr == 0) PG8_BAR; }
        if constexpr (!Epi::AFTER_DRAIN) { E(acc, cur, wr, wc, fr, fq); S.done(cur); }
        if (!has_next) break;
#pragma unroll
        for (int a = 0; a < 2; ++a)
#pragma unroll
            for (int b = 0; b < 2; ++b)
#pragma unroll
                for (int m = 0; m < 4; ++m)
#pragma unroll
                    for (int n = 0; n < 2; ++n) acc[a][b][m][n] = (f32x4){0.f, 0.f, 0.f, 0.f};
        cur = nxt; cA = nA; cB = nB; ++ui;
        if constexpr (ALIGN_EPI) { if (wr == 1) PG8_BAR; }
    }
    PG8_WAIT_V(0);
    if constexpr (!ALIGN_EPI) { if (wr == 0) PG8_BAR; }
    PG8_BAR;
    if constexpr (Epi::AFTER_DRAIN) { E.fused(acc, cur, wr, wc, fr, fq, lds, wid, lane); S.done(cur); }
#undef PG8_SA
#undef PG8_SB
#undef PG8_STAGE
#undef PG8_LDA
#undef PG8_LDB
#undef PG8_MMA
#undef PG8_WAIT_V
#undef PG8_WAIT_L
#undef PG8_BAR
#undef PG8_SCHED
}
}
#define GAS __attribute__((address_space(1)))
#define LAS __attribute__((address_space(3)))
typedef unsigned short bf16;
typedef unsigned v4u __attribute__((ext_vector_type(4)));
typedef float f32x4 __attribute__((ext_vector_type(4)));
typedef short bf16x8 __attribute__((ext_vector_type(8)));
typedef GAS unsigned gu32;
typedef GAS unsigned long long gu64;
#define RLX_AGENT __ATOMIC_RELAXED, __HIP_MEMORY_SCOPE_AGENT
#define LDS_WAIT() asm volatile("s_waitcnt lgkmcnt(0)" ::: "memory")
#define VM_WAIT() asm volatile("s_waitcnt vmcnt(0)" ::: "memory")
__device__ __forceinline__ unsigned long long rt() { return __builtin_amdgcn_s_memrealtime(); }
__device__ __forceinline__ unsigned f2bf(float f) { unsigned u = __builtin_bit_cast(unsigned, f); return (u + 0x7fffu + ((u >> 16) & 1u)) >> 16; }
__device__ __forceinline__ unsigned pk2(float lo, float hi) { return f2bf(lo) | (f2bf(hi) << 16); }

#define XB_TMO      128
#define XB_XCNT(j)  (256  + 64 * (j))
#define XB_XSUB(j)  (1280 + 64 * (j))
#define XB_XGEN(j)  (2304 + 64 * (j))
#define XB_TOP      3328
#define XB_TOPGEN   3392
#define XCD_BAR_WORDS 3456
#define XB_SPIN_CAP (1u << 18)

__device__ __forceinline__ unsigned xb_ld(unsigned* p)              { return __hip_atomic_load(p, __ATOMIC_RELAXED, __HIP_MEMORY_SCOPE_AGENT); }
__device__ __forceinline__ unsigned xb_add(unsigned* p, unsigned v) { return __hip_atomic_fetch_add(p, v, __ATOMIC_RELAXED, __HIP_MEMORY_SCOPE_AGENT); }
__device__ __forceinline__ unsigned xb_xcc_id() { return (unsigned)__builtin_amdgcn_s_getreg((3 << 11) | 20) & 0xFu; }
#define XB_SPIN(cond, bar) do { unsigned _sp = 0; while (cond) { __builtin_amdgcn_s_sleep(1); \
    if ((++_sp & 255u) == 0u) { if (xb_ld(&(bar)[XB_TMO])) break; if (_sp > XB_SPIN_CAP) { atomicAdd(&(bar)[XB_TMO], 1u); break; } } } } while (0)

struct XcdBarrier {
    unsigned* bar; unsigned x;
    volatile LAS unsigned* st;
};

__device__ __forceinline__ XcdBarrier xcd_barrier_post(unsigned* bar, volatile LAS unsigned* st) {
    XcdBarrier b; b.bar = bar; b.x = xb_xcc_id(); b.st = st;
    if (threadIdx.x == 0) (void)xb_add(&bar[XB_XCNT(b.x)], 1u);
    return b;
}
__device__ __forceinline__ void xcd_barrier_complete(unsigned* bar, unsigned x, unsigned& nloc, unsigned& nx) {
    const unsigned G = gridDim.x * gridDim.y * gridDim.z;
    unsigned sum, cnt, mine, sp = 0u;
    for (;;) {
        sum = 0u; cnt = 0u; mine = 0u;
#pragma unroll
        for (unsigned j = 0; j < 16; ++j) { const unsigned c = xb_ld(&bar[XB_XCNT(j)]); sum += c; cnt += (c > 0u) ? 1u : 0u; mine = (j == x) ? c : mine; }
        if (sum == G) break;
        __builtin_amdgcn_s_sleep(1);
        if ((++sp & 255u) == 0u) { if (xb_ld(&bar[XB_TMO])) break; if (sp > XB_SPIN_CAP) { atomicAdd(&bar[XB_TMO], 1u); break; } }
    }
    nloc = mine > 0u ? mine : 1u; nx = cnt > 0u ? cnt : 1u;
}

__device__ __forceinline__ void xcd_barrier(const XcdBarrier& b) {
    asm volatile("s_waitcnt vmcnt(0)" ::: "memory");
    __syncthreads();
    if (threadIdx.x == 0) {
        unsigned* bar = b.bar;
        __builtin_amdgcn_s_waitcnt(0);
        unsigned nloc = b.st[0], nx = b.st[1];
        if (nloc == 0u) { xcd_barrier_complete(bar, b.x, nloc, nx); b.st[0] = nloc; b.st[1] = nx; }
        const unsigned old = xb_add(&bar[XB_XSUB(b.x)], 1u);
        const unsigned gen = old / nloc;
        if (old + 1u == (gen + 1u) * nloc) {
            __builtin_amdgcn_fence(__ATOMIC_RELEASE, "agent");
            asm volatile("s_waitcnt vmcnt(0)" ::: "memory");
            const unsigned og = xb_add(&bar[XB_TOP], 1u);
            const unsigned tg = og / nx;
            if (og + 1u == (tg + 1u) * nx) xb_add(&bar[XB_TOPGEN], 1u);
            else XB_SPIN(xb_ld(&bar[XB_TOPGEN]) == tg, bar);
            __builtin_amdgcn_fence(__ATOMIC_ACQUIRE, "agent");
            xb_add(&bar[XB_XGEN(b.x)], 1u);
            asm volatile("s_waitcnt vmcnt(0)" ::: "memory");
        } else {
            XB_SPIN(xb_ld(&bar[XB_XGEN(b.x)]) == gen, bar);
            __builtin_amdgcn_fence(__ATOMIC_ACQUIRE, "agent");
            asm volatile("s_waitcnt vmcnt(0)" ::: "memory");
        }
    }
    __syncthreads();
}
constexpr size_t MiB = 1u << 20;
constexpr size_t WS_CTL = 0, CTL_ZERO_BYTES = 1 * MiB;
constexpr size_t WS_BIAS = 1 * MiB, WS_W2T = WS_BIAS + 16384, WS_A2T = WS_W2T + 131072, WS_G2T = WS_A2T + 131072;
constexpr size_t WS_WGU1 = 2 * MiB, WS_WD1 = WS_WGU1 + 43 * MiB, WS_WINB = WS_WD1 + 21 * MiB + MiB / 2;
constexpr size_t WS_WOUT = 86 * MiB, WS_WGU2 = 94 * MiB, WS_WD2 = 137 * MiB;
constexpr size_t WS_XB = 159 * MiB;
constexpr size_t WS_ACT = 192 * MiB;
constexpr size_t WS_QB = 300 * MiB, WS_KB = WS_QB + 16 * MiB + MiB / 2, WS_VB = WS_KB + 4 * MiB + MiB / 8;
constexpr size_t WS_DD = 325 * MiB, WS_LG = 358 * MiB, WS_EE = WS_LG + 16 * MiB + MiB / 2, WS_END = WS_EE + 16 * MiB + MiB / 2;
constexpr size_t VEC16 = 16 * MiB + MiB / 2;
constexpr size_t WS_KK = WS_WGU1, WS_BB = WS_KK + VEC16, WS_KP = WS_BB + VEC16, WS_RR = WS_KP + VEC16, WS_VV = WS_RR + VEC16;
constexpr size_t WS_X2B = WS_WGU1;
static_assert(WS_VV + VEC16 <= WS_WOUT && WS_WINB + 19 * MiB <= WS_WOUT && WS_WD2 + 22 * MiB <= WS_XB && WS_XB + 33 * MiB <= WS_ACT && WS_VB + 4 * MiB + MiB / 8 <= WS_DD && WS_DD + 33 * MiB <= WS_LG, "d_ws map");
constexpr int CW_BAR = 4096;
constexpr int CW_SSQ0 = 16384, CW_SSQ1 = CW_SSQ0 + MPAD, CW_SSQ2 = CW_SSQ1 + MPAD, CW_SSQ3 = CW_SSQ2 + MPAD;
constexpr int CW_SSQD = CW_SSQ3 + MPAD;
static_assert((CW_SSQD + MPAD) * 4 <= (int)CTL_ZERO_BYTES, "CTL");
constexpr int RING_OFF = 0, RING_BYTES = 131072;
constexpr int LDSCTL_OFF = RING_BYTES, MISC_OFF = LDSCTL_OFF + 320;
constexpr int LDS_BYTES = 147456;
constexpr int NWAVES = 8;
constexpr int NPHASES = 11;
#ifndef MK_N_LAUNCHES
#define MK_N_LAUNCHES 1
#endif

__constant__ unsigned char T5B[129] = {0, 1, 2, 3, 4, 5, 6, 7, 8, 9, 10, 11, 12, 13, 14, 15, 16, 16, 16, 17, 17, 18, 18, 18, 19, 19, 19, 20, 20, 20, 20, 21, 21, 21, 21, 22, 22, 22, 22, 22, 23, 23, 23, 23, 23, 23, 24, 24, 24, 24, 24, 24, 25, 25, 25, 25, 25, 25, 25, 26, 26, 26, 26, 26, 26, 26, 26, 27, 27, 27, 27, 27, 27, 27, 27, 27, 27, 28, 28, 28, 28, 28, 28, 28, 28, 28, 28, 29, 29, 29, 29, 29, 29, 29, 29, 29, 29, 29, 29, 30, 30, 30, 30, 30, 30, 30, 30, 30, 30, 30, 30, 30, 30, 31, 31, 31, 31, 31, 31, 31, 31, 31, 31, 31, 31, 31, 31, 31, 31};

struct Args { const float* in[31]; float* out; unsigned char* ws; int ph_lo, ph_hi, li, pad; };

struct Frame {
    LAS unsigned char* lds;
    volatile LAS unsigned* MISC;
    gu32* ctl;
    int tid, lane, wave, G;
    float* out; unsigned char* ws;
};
typedef float f32x2 __attribute__((ext_vector_type(2)));
__device__ __forceinline__ float bf2f(unsigned short u) { return __builtin_bit_cast(float, (unsigned)u << 16); }
__device__ __forceinline__ unsigned short f2bfs(float f) { return (unsigned short)f2bf(f); }
__device__ __forceinline__ float wave_sum(float v) {
#pragma unroll
    for (int o = 1; o < 64; o <<= 1) v += __shfl_xor(v, o);
    return v;
}
__device__ __forceinline__ float wave_max(float v) {
#pragma unroll
    for (int o = 1; o < 64; o <<= 1) v = fmaxf(v, __shfl_xor(v, o));
    return v;
}
template <int CTRL> __device__ __forceinline__ float dpp_f(float x) { return __builtin_bit_cast(float, __builtin_amdgcn_update_dpp(0, __builtin_bit_cast(int, x), CTRL, 0xf, 0xf, true)); }
__device__ __forceinline__ float allsum16(float x) { x += dpp_f<0x128>(x); x += dpp_f<0x124>(x); x += dpp_f<0x122>(x); x += dpp_f<0x121>(x); return x; }
__device__ __forceinline__ float sigmoidf_(float x) { return __builtin_amdgcn_rcpf(1.0f + __builtin_amdgcn_exp2f(-x * LOG2E)); }
__device__ __forceinline__ float tanhf_(float x) { return 1.0f - 2.0f * __builtin_amdgcn_rcpf(1.0f + __builtin_amdgcn_exp2f(2.0f * LOG2E * x)); }

__device__ __forceinline__ void p0_transpose_item(const float* W, int K, int N, bf16* WT, int kb, int nb, int drow, const float* kscale, LAS float* scr, int lane) {
    const int k0 = 64 * kb, n0 = 32 * nb;
#pragma unroll 8
    for (int i = 0; i < 32; ++i) { const int kk = 2 * i + (lane >> 5); float v = W[(size_t)(k0 + kk) * N + n0 + (lane & 31)]; if (kscale) v *= kscale[k0 + kk]; scr[kk * 33 + (lane & 31)] = v; }
    LDS_WAIT(); asm volatile("" ::: "memory");
    const int c = lane & 7;
#pragma unroll
    for (int j = 0; j < 4; ++j) { const int n = (lane >> 3) + 8 * j; const LAS float* s = scr + (8 * c) * 33 + n;
        v4u o; o.x = pk2(s[0 * 33], s[1 * 33]); o.y = pk2(s[2 * 33], s[3 * 33]); o.z = pk2(s[4 * 33], s[5 * 33]); o.w = pk2(s[6 * 33], s[7 * 33]);
        *(GAS v4u*)(WT + (size_t)(drow + n) * K + k0 + 8 * c) = o; }
    LDS_WAIT(); asm volatile("" ::: "memory");
}
__device__ __forceinline__ int gu_row(int n0, int up) { return 256 * (n0 >> 7) + (n0 & 127) + 128 * up; }

__device__ __forceinline__ void p0_prologue(Frame& F, const Args& A) {
    LAS float* scr = (LAS float*)(F.lds + RING_OFF + F.wave * 16384);
    const int gw = blockIdx.x * NWAVES + F.wave, NGW = F.G * NWAVES, lane = F.lane;
    unsigned char* ws = F.ws;
    constexpr int I_GU = (DM / 64) * (DFF / 32), I_D = (DFF / 64) * (DM / 32), I_IN = (DM / 64) * (INC / 32), I_OUT = (DM / 64) * (DM / 32), I_L64 = RWW / 32, I_L128 = 2 * (RWW / 32);
    constexpr int NITEMS = 4 * I_GU + 2 * I_D + I_IN + I_OUT + 2 * I_L64 + I_L128;
    for (int it = gw; it < NITEMS; it += NGW) {
        int r = it;
        if (r < I_GU) { const int kb = r / (DFF / 32), nb = r % (DFF / 32); p0_transpose_item(A.in[8], DM, DFF, (bf16*)(ws + WS_WGU1), kb, nb, gu_row(32 * nb, 0), A.in[7], scr, lane); continue; } r -= I_GU;
        if (r < I_GU) { const int kb = r / (DFF / 32), nb = r % (DFF / 32); p0_transpose_item(A.in[9], DM, DFF, (bf16*)(ws + WS_WGU1), kb, nb, gu_row(32 * nb, 1), A.in[7], scr, lane); continue; } r -= I_GU;
        if (r < I_D)  { const int kb = r / (DM / 32), nb = r % (DM / 32); p0_transpose_item(A.in[10], DFF, DM, (bf16*)(ws + WS_WD1), kb, nb, 32 * nb, nullptr, scr, lane); continue; } r -= I_D;
        if (r < I_IN) { const int kb = r / (INC / 32), nb = r % (INC / 32); p0_transpose_item(A.in[12], DM, INC, (bf16*)(ws + WS_WINB), kb, nb, 32 * nb, A.in[11], scr, lane); continue; } r -= I_IN;
        if (r < I_OUT) { const int kb = r / (DM / 32), nb = r % (DM / 32); p0_transpose_item(A.in[25], DM, DM, (bf16*)(ws + WS_WOUT), kb, nb, 32 * nb, nullptr, scr, lane); continue; } r -= I_OUT;
        if (r < I_GU) { const int kb = r / (DFF / 32), nb = r % (DFF / 32); p0_transpose_item(A.in[27], DM, DFF, (bf16*)(ws + WS_WGU2), kb, nb, gu_row(32 * nb, 0), A.in[26], scr, lane); continue; } r -= I_GU;
        if (r < I_GU) { const int kb = r / (DFF / 32), nb = r % (DFF / 32); p0_transpose_item(A.in[28], DM, DFF, (bf16*)(ws + WS_WGU2), kb, nb, gu_row(32 * nb, 1), A.in[26], scr, lane); continue; } r -= I_GU;
        if (r < I_D)  { const int kb = r / (DM / 32), nb = r % (DM / 32); p0_transpose_item(A.in[29], DFF, DM, (bf16*)(ws + WS_WD2), kb, nb, 32 * nb, nullptr, scr, lane); continue; } r -= I_D;
        if (r < I_L64) { p0_transpose_item(A.in[16], 64, RWW, (bf16*)(ws + WS_W2T), 0, r, 32 * r, nullptr, scr, lane); continue; } r -= I_L64;
        if (r < I_L64) { p0_transpose_item(A.in[18], 64, RWW, (bf16*)(ws + WS_A2T), 0, r, 32 * r, nullptr, scr, lane); continue; } r -= I_L64;
        { const int kb = r / (RWW / 32), nb = r % (RWW / 32); p0_transpose_item(A.in[19], 128, RWW, (bf16*)(ws + WS_G2T), kb, nb, 32 * nb, nullptr, scr, lane); }
    }
    bf16* XB = (bf16*)(ws + WS_XB); float* ssq0 = (float*)(F.ctl + CW_SSQ0);
    for (int m = gw; m < MPAD; m += NGW) {
        GAS unsigned long long* o8 = (GAS unsigned long long*)(XB + (size_t)m * DM) + lane;
        if (m < MV) {
            const float* xrow = m < MP ? A.in[0] + (size_t)m * DM : A.in[1] + (size_t)(m - MP) * DM;
            const GAS f32x4* xr = (const GAS f32x4*)xrow + lane; f32x4 v[8]; float s = 0.f;
#pragma unroll
            for (int j = 0; j < 8; ++j) { v[j] = xr[64 * j]; s += (v[j].x * v[j].x + v[j].y * v[j].y) + (v[j].z * v[j].z + v[j].w * v[j].w); }
            s = wave_sum(s);
#pragma unroll
            for (int j = 0; j < 8; ++j) o8[64 * j] = (unsigned long long)pk2(v[j].x, v[j].y) | ((unsigned long long)pk2(v[j].z, v[j].w) << 32);
            if (lane == 0) ssq0[m] = s;
        } else {
#pragma unroll
            for (int j = 0; j < 8; ++j) o8[64 * j] = 0ull;
        }
    }
    float* bt = (float*)(ws + WS_BIAS);
    for (int i = blockIdx.x * (NWAVES * 64) + F.tid; i < 129 * NQH; i += F.G * NWAVES * 64) bt[i] = A.in[6][(int)T5B[i >> 4] * NQH + (i & 15)] * LOG2E;
}
constexpr int PREP_TILES = (MV + 63) / 64  , PREP_UNITS = PREP_TILES * RWH;
constexpr int PA_PITCH = 528;
constexpr int PA_OFF = 0, PW_OFF = 64 * PA_PITCH  , PMAT = 64 * 65 * 4  ;
__device__ __forceinline__ void prep_unit(Frame& F, const Args& A, int mt, int h) {
    const int tid = F.tid, lane = F.lane, wave = F.wave, m0 = mt * 64;
    unsigned char* ws = F.ws;
    const float* PR = (const float*)(ws + WS_ACT);
    const float* mu = A.in[14];
    LAS unsigned char* lds = F.lds;
    { const int row = tid >> 3, cc = tid & 7, m = m0 + row; const int c0 = 3 * RWW + 32 * cc;
      const bool valid = m < MV;
      const float* p = PR + (size_t)m * SHC + c0;
      const float* pv = nullptr;
      if (valid) { if (m >= MP) pv = A.in[5] + (size_t)(m - MP) * SHC + c0; else if ((m & (SEQ - 1)) != 0) pv = PR + (size_t)(m - 1) * SHC + c0; }
#pragma unroll
      for (int q = 0; q < 8; ++q) {
          f32x4 a = (f32x4){0.f, 0.f, 0.f, 0.f}, b = a;
          if (valid) a = *(const f32x4*)(p + 4 * q);
          if (pv) b = *(const f32x4*)(pv + 4 * q);
          const f32x4 m4 = *(const f32x4*)(mu + c0 + 4 * q);
          f32x4 x = a + m4 * (b - a);
          if (cc < 2) { x.x = tanhf_(x.x); x.y = tanhf_(x.y); x.z = tanhf_(x.z); x.w = tanhf_(x.w); }
          else if (cc >= 4) { x.x = sigmoidf_(x.x); x.y = sigmoidf_(x.y); x.z = sigmoidf_(x.z); x.w = sigmoidf_(x.w); }
          if (!valid) x = (f32x4){0.f, 0.f, 0.f, 0.f};
          *(LAS unsigned long long*)(lds + PA_OFF + row * PA_PITCH + (32 * cc + 4 * q) * 2) = (unsigned long long)pk2(x.x, x.y) | ((unsigned long long)pk2(x.z, x.w) << 32);
      } }
    __syncthreads();
    { const int mtile = wave & 3, nh = wave >> 2, ln = lane & 15, q4 = lane >> 4;
#pragma unroll
      for (int mat = 0; mat < 3; ++mat) {
          const int kbase = mat == 0 ? 0 : (mat == 1 ? 64 : 128), KM = mat == 2 ? 128 : 64;
          const bf16* Bt = (const bf16*)(ws + (mat == 0 ? WS_W2T : (mat == 1 ? WS_A2T : WS_G2T)));
#pragma unroll
          for (int n2 = 0; n2 < 2; ++n2) { const int nt = 2 * nh + n2; f32x4 acc = (f32x4){0.f, 0.f, 0.f, 0.f};
#pragma unroll
              for (int ks = 0; ks < KM / 32; ++ks) {
                  const bf16x8 a = *(const LAS bf16x8*)(lds + PA_OFF + (16 * mtile + ln) * PA_PITCH + (kbase + 32 * ks + 8 * q4) * 2);
                  const bf16x8 b = *(const GAS bf16x8*)(Bt + (size_t)(64 * h + 16 * nt + ln) * KM + 32 * ks + 8 * q4);
                  acc = __builtin_amdgcn_mfma_f32_16x16x32_bf16(a, b, acc, 0, 0, 0); }
              LAS float* o = (LAS float*)(lds + PW_OFF + mat * PMAT);
#pragma unroll
              for (int r = 0; r < 4; ++r) o[(16 * mtile + 4 * q4 + r) * 65 + 16 * nt + ln] = acc[r]; } } }
    __syncthreads();
    { const int hc = 64 * h + lane;
      const float mu_r = mu[hc], mu_k = mu[RWW + hc], mu_v = mu[2 * RWW + hc];
      const float w0 = A.in[15][hc], a0 = A.in[17][hc], k_k = A.in[20][hc], k_a = A.in[21][hc], r_k = A.in[22][hc], ln_w = A.in[23][hc], ln_b = A.in[24][hc];
      bf16* KK = (bf16*)(ws + WS_KK); bf16* BB = (bf16*)(ws + WS_BB); bf16* KP = (bf16*)(ws + WS_KP); bf16* RR = (bf16*)(ws + WS_RR); bf16* VV = (bf16*)(ws + WS_VV);
      float* DD = (float*)(ws + WS_DD); bf16* LG = (bf16*)(ws + WS_LG); bf16* EE = (bf16*)(ws + WS_EE);
      const LAS float* Wp = (const LAS float*)(lds + PW_OFF); const LAS float* Ap = (const LAS float*)(lds + PW_OFF + PMAT); const LAS float* Gp = (const LAS float*)(lds + PW_OFF + 2 * PMAT);
      for (int tt = 0; tt < 8; ++tt) { const int tok = 8 * wave + tt, m = m0 + tok;
          if (m >= MV) break;
          const float* p = PR + (size_t)m * SHC + hc;
          float pr = p[0], pk = p[RWW], pvv = p[2 * RWW], qr = 0.f, qk = 0.f, qv = 0.f;
          if (m >= MP) { const float* s = A.in[5] + (size_t)(m - MP) * SHC + hc; qr = s[0]; qk = s[RWW]; qv = s[2 * RWW]; }
          else if ((m & (SEQ - 1)) != 0) { const float* s = p - SHC; qr = s[0]; qk = s[RWW]; qv = s[2 * RWW]; }
          const float xr = pr + mu_r * (qr - pr), xk = pk + mu_k * (qk - pk), xv = pvv + mu_v * (qv - pvv);
          const float wpre = w0 + Wp[tok * 65 + lane];
          const float dec = __builtin_amdgcn_exp2f(-0.6065306597126334f * LOG2E * sigmoidf_(wpre));
          const float aa = sigmoidf_(a0 + Ap[tok * 65 + lane]);
          const float gg = Gp[tok * 65 + lane];
          float kk = xk * k_k; const float n2 = wave_sum(kk * kk); kk = kk / fmaxf(sqrtf(n2), 1e-12f);
          const float kp = xk * (1.0f + (aa - 1.0f) * k_a);
          const float bonus = wave_sum(xr * kp * r_k);
          const size_t o = (size_t)m * RWW + hc;
          KK[o] = f2bfs(kk); BB[o] = f2bfs(kk * aa); KP[o] = f2bfs(kp); RR[o] = f2bfs(xr); VV[o] = f2bfs(xv); DD[o] = dec;
          LG[o] = f2bfs(ln_w * gg); EE[o] = f2bfs((ln_b + bonus * xv) * gg); }
    }
}

constexpr int AK_PITCH = 144, AV_PITCH = 592, AP_PITCH = 336;
constexpr int AK_OFF = 0, AV_OFF = 272 * AK_PITCH  , AP_OFF = AV_OFF + 64 * AV_PITCH  , AB_OFF = AP_OFF + 8 * 16 * AP_PITCH  ;
static_assert(AB_OFF + 129 * 4 * 4 <= RING_BYTES, "attention LDS");
__device__ __forceinline__ void attn_unit(Frame& F, const Args& A, int b, int blk, int hk) {
    const int tid = F.tid, lane = F.lane, wave = F.wave;
    unsigned char* ws = F.ws; LAS unsigned char* lds = F.lds;
    const bf16* QB = (const bf16*)(ws + WS_QB); const bf16* KB = (const bf16*)(ws + WS_KB); const bf16* VB = (const bf16*)(ws + WS_VB); bf16* MX = (bf16*)(ws + WS_XB);
    const int mq0 = b * SEQ + blk * 128, mk0 = mq0 - 128;
    for (int i = tid; i < 16 * AK_PITCH / 4; i += NWAVES * 64) ((LAS unsigned*)(lds + AK_OFF + 256 * AK_PITCH))[i] = 0u;
    for (int i = tid; i < 64 * 16; i += NWAVES * 64) ((LAS unsigned*)(lds + AV_OFF + (i >> 4) * AV_PITCH + 512))[i & 15] = 0u;
#pragma unroll
    for (int it = 0; it < 4; ++it) { const int idx = it * 512 + tid, row = idx >> 3, ch = idx & 7;
        v4u kv = (v4u){0u, 0u, 0u, 0u}, vv = kv;
        if (blk > 0 || row >= 128) { kv = *(const GAS v4u*)(KB + (size_t)(mk0 + row) * KVW + hk * 64 + ch * 8); vv = *(const GAS v4u*)(VB + (size_t)(mk0 + row) * KVW + hk * 64 + ch * 8); }
        *(LAS v4u*)(lds + AK_OFF + row * AK_PITCH + ch * 16) = kv;
        LAS unsigned short* vt = (LAS unsigned short*)(lds + AV_OFF + (8 * ch) * AV_PITCH + row * 2);
        vt[0 * (AV_PITCH / 2)] = (unsigned short)(vv.x & 0xffffu); vt[1 * (AV_PITCH / 2)] = (unsigned short)(vv.x >> 16);
        vt[2 * (AV_PITCH / 2)] = (unsigned short)(vv.y & 0xffffu); vt[3 * (AV_PITCH / 2)] = (unsigned short)(vv.y >> 16);
        vt[4 * (AV_PITCH / 2)] = (unsigned short)(vv.z & 0xffffu); vt[5 * (AV_PITCH / 2)] = (unsigned short)(vv.z >> 16);
        vt[6 * (AV_PITCH / 2)] = (unsigned short)(vv.w & 0xffffu); vt[7 * (AV_PITCH / 2)] = (unsigned short)(vv.w >> 16); }
    { const float* bt = (const float*)(ws + WS_BIAS); LAS float* bl = (LAS float*)(lds + AB_OFF);
      for (int i = tid; i < 129 * 4; i += NWAVES * 64) bl[i] = bt[(i >> 2) * NQH + 4 * hk + (i & 3)]; }
    __syncthreads();
    const int g = wave >> 1, half = wave & 1, head = 4 * hk + g, ln = lane & 15, q4 = lane >> 4;
    const float sink2 = A.in[13][head] * LOG2E;
    const LAS float* bl = (const LAS float*)(lds + AB_OFF);
    LAS unsigned char* Pw = lds + AP_OFF + wave * (16 * AP_PITCH);
    for (int rb = 0; rb < 4; ++rb) {
        const int i0 = 64 * half + 16 * rb, kt0 = i0 >> 4;
        bf16x8 qf[2];
#pragma unroll
        for (int ks = 0; ks < 2; ++ks) qf[ks] = *(const GAS bf16x8*)(QB + (size_t)(mq0 + i0 + ln) * ATTW + head * 64 + 32 * ks + 8 * q4);
        f32x4 s[10];
#pragma unroll
        for (int j = 0; j < 10; ++j) { f32x4 acc = (f32x4){0.f, 0.f, 0.f, 0.f};
#pragma unroll
            for (int ks = 0; ks < 2; ++ks) { const bf16x8 kf = *(const LAS bf16x8*)(lds + AK_OFF + (16 * (kt0 + j) + ln) * AK_PITCH + (32 * ks + 8 * q4) * 2);
                acc = __builtin_amdgcn_mfma_f32_16x16x32_bf16(qf[ks], kf, acc, 0, 0, 0); }
            s[j] = acc; }
        float mx[4] = {-INFINITY, -INFINITY, -INFINITY, -INFINITY};
#pragma unroll
        for (int j = 0; j < 10; ++j) { const int kj = 16 * (kt0 + j) + ln;
#pragma unroll
            for (int r = 0; r < 4; ++r) { const int dist = 128 + i0 + 4 * q4 + r - kj; const bool ok = dist >= 0 && dist <= 128 && (blk > 0 || kj >= 128);
                const int dc = dist < 0 ? 0 : (dist > 128 ? 128 : dist);
                const float v = ok ? s[j][r] + bl[dc * 4 + g] : -INFINITY; s[j][r] = v; mx[r] = fmaxf(mx[r], v); } }
        float l[4];
#pragma unroll
        for (int r = 0; r < 4; ++r) { float m_ = mx[r]; m_ = fmaxf(m_, __shfl_xor(m_, 1)); m_ = fmaxf(m_, __shfl_xor(m_, 2)); m_ = fmaxf(m_, __shfl_xor(m_, 4)); m_ = fmaxf(m_, __shfl_xor(m_, 8));
            mx[r] = fmaxf(m_, sink2); l[r] = 0.f; }
#pragma unroll
        for (int j = 0; j < 10; ++j)
#pragma unroll
            for (int r = 0; r < 4; ++r) { const float p = __builtin_amdgcn_exp2f(s[j][r] - mx[r]); l[r] += p;
                *(LAS unsigned short*)(Pw + (4 * q4 + r) * AP_PITCH + (16 * j + ln) * 2) = f2bfs(p); }
#pragma unroll
        for (int r = 0; r < 4; ++r) { float t = l[r]; t += __shfl_xor(t, 1); t += __shfl_xor(t, 2); t += __shfl_xor(t, 4); t += __shfl_xor(t, 8);
            l[r] = __builtin_amdgcn_rcpf(t + __builtin_amdgcn_exp2f(sink2 - mx[r])); }
        f32x4 o[4];
#pragma unroll
        for (int dt = 0; dt < 4; ++dt) o[dt] = (f32x4){0.f, 0.f, 0.f, 0.f};
#pragma unroll
        for (int st = 0; st < 5; ++st) { const bf16x8 pf = *(const LAS bf16x8*)(Pw + ln * AP_PITCH + (32 * st + 8 * q4) * 2);
#pragma unroll
            for (int dt = 0; dt < 4; ++dt) { const bf16x8 vf = *(const LAS bf16x8*)(lds + AV_OFF + (16 * dt + ln) * AV_PITCH + (16 * kt0 + 32 * st + 8 * q4) * 2);
                o[dt] = __builtin_amdgcn_mfma_f32_16x16x32_bf16(pf, vf, o[dt], 0, 0, 0); } }
#pragma unroll
        for (int dt = 0; dt < 4; ++dt)
#pragma unroll
            for (int r = 0; r < 4; ++r) MX[(size_t)(mq0 + i0 + 4 * q4 + r) * DM + head * 64 + 16 * dt + ln] = f2bfs(o[dt][r] * l[r]);
    }
    __syncthreads();
}

__device__ __forceinline__ void dec_attn_unit(Frame& F, const Args& A, int du) {
    const int lane = F.lane, wave = F.wave; unsigned char* ws = F.ws;
    const int idx = du * 8 + wave, b = idx >> 4, head = idx & 15, hk = head >> 2, m = MP + b;
    LAS float* qs = (LAS float*)(F.lds + wave * 1024); LAS float* ps = qs + 64;
    const bf16* QB = (const bf16*)(ws + WS_QB); bf16* MX = (bf16*)(ws + WS_XB);
    const float* bt = (const float*)(ws + WS_BIAS);
    const float sink2 = A.in[13][head] * LOG2E;
    const float qv = bf2f(QB[(size_t)m * ATTW + head * 64 + lane]);
    qs[lane] = qv;
    LDS_WAIT(); asm volatile("" ::: "memory");
    float sc[2];
#pragma unroll
    for (int pi = 0; pi < 2; ++pi) { const int pos = lane + 64 * pi; const float* kr = A.in[2] + ((size_t)(b * WIN + pos) * NKVH + hk) * HD; float d = 0.f;
#pragma unroll
        for (int j = 0; j < 16; ++j) { const f32x4 k4 = *(const f32x4*)(kr + 4 * j); const f32x4 q4v = *(const LAS f32x4*)(qs + 4 * j); d += (k4.x * q4v.x + k4.y * q4v.y) + (k4.z * q4v.z + k4.w * q4v.w); }
        sc[pi] = d + bt[(WIN - pos) * NQH + head]; }
    const float* kn = F.out + O_KS + ((size_t)b * WIN + (WIN - 1)) * KVW + hk * HD; const float* vn = F.out + O_VS + ((size_t)b * WIN + (WIN - 1)) * KVW + hk * HD;
    const float snew = wave_sum(qv * kn[lane]) + bt[head];
    const float mx = fmaxf(fmaxf(wave_max(fmaxf(sc[0], sc[1])), snew), sink2);
    const float p0 = __builtin_amdgcn_exp2f(sc[0] - mx), p1 = __builtin_amdgcn_exp2f(sc[1] - mx), pn = __builtin_amdgcn_exp2f(snew - mx);
    const float linv = __builtin_amdgcn_rcpf(wave_sum(p0 + p1) + pn + __builtin_amdgcn_exp2f(sink2 - mx));
    ps[lane] = p0; ps[lane + 64] = p1;
    LDS_WAIT(); asm volatile("" ::: "memory");
    const float* vr = A.in[3] + ((size_t)(b * WIN) * NKVH + hk) * HD + lane; float o = pn * vn[lane];
#pragma unroll 8
    for (int pos = 0; pos < WIN; ++pos) o += ps[pos] * vr[(size_t)pos * NKVH * HD];
    MX[(size_t)m * DM + head * 64 + lane] = f2bfs(o * linv);
    LDS_WAIT(); asm volatile("" ::: "memory");
}

constexpr int SC_T = 32, SC_REC = 1344  , SC_BUF = SC_T * SC_REC  ;
struct ScanRegs { v4u kk, bb, kp, rr, vv; f32x4 d0, d1; };
__device__ __forceinline__ void scan_load(ScanRegs& R, const unsigned char* ws, int m, int h, int rq, int part) {
    const size_t o = (size_t)m * RWW + 64 * h + 8 * part;
    R.kk = *(const GAS v4u*)((const bf16*)(ws + WS_KK) + o); R.bb = *(const GAS v4u*)((const bf16*)(ws + WS_BB) + o);
    R.kp = *(const GAS v4u*)((const bf16*)(ws + WS_KP) + o); R.rr = *(const GAS v4u*)((const bf16*)(ws + WS_RR) + o);
    R.d0 = *(const GAS f32x4*)((const float*)(ws + WS_DD) + o); R.d1 = *(const GAS f32x4*)((const float*)(ws + WS_DD) + o + 4);
    R.vv = (v4u){0u, 0u, 0u, 0u};
    if (part < 2) R.vv = *(const GAS v4u*)((const bf16*)(ws + WS_VV) + (size_t)m * RWW + 64 * h + 16 * rq + 8 * part);
}
__device__ __forceinline__ void st8(LAS unsigned char* p, v4u u) {
    *(LAS f32x4*)p = (f32x4){__builtin_bit_cast(float, u.x << 16), __builtin_bit_cast(float, u.x & 0xffff0000u), __builtin_bit_cast(float, u.y << 16), __builtin_bit_cast(float, u.y & 0xffff0000u)};
    *(LAS f32x4*)(p + 16) = (f32x4){__builtin_bit_cast(float, u.z << 16), __builtin_bit_cast(float, u.z & 0xffff0000u), __builtin_bit_cast(float, u.w << 16), __builtin_bit_cast(float, u.w & 0xffff0000u)};
}
__device__ __forceinline__ void scan_store(const ScanRegs& R, LAS unsigned char* rec, int part) {
    st8(rec + 0 + 32 * part, R.kk); *(LAS f32x4*)(rec + 256 + 32 * part) = R.d0; *(LAS f32x4*)(rec + 256 + 32 * part + 16) = R.d1;
    st8(rec + 512 + 32 * part, R.bb); st8(rec + 768 + 32 * part, R.kp); st8(rec + 1024 + 32 * part, R.rr);
    if (part < 2) st8(rec + 1280 + 32 * part, R.vv);
}
constexpr int SC_YOFF = 2 * SC_BUF, SC_YBUF = SC_T * 16 * 4 * 4  ;
static_assert(SC_YOFF + 2 * SC_YBUF <= RING_BYTES, "scan LDS");
struct ScanVec { f32x2 kk0, kk1, d0, d1, b0, b1, k0, k1, r0, r1; float v; };
__device__ __forceinline__ void scan_ld(ScanVec& x, const LAS unsigned char* base, const LAS unsigned char* vb, int t) {
    const f32x4 kk = *(const LAS f32x4*)(base + t * SC_REC), dd = *(const LAS f32x4*)(base + t * SC_REC + 256), bb = *(const LAS f32x4*)(base + t * SC_REC + 512),
                kp = *(const LAS f32x4*)(base + t * SC_REC + 768), rr = *(const LAS f32x4*)(base + t * SC_REC + 1024);
    x.kk0 = (f32x2){kk.x, kk.y}; x.kk1 = (f32x2){kk.z, kk.w}; x.d0 = (f32x2){dd.x, dd.y}; x.d1 = (f32x2){dd.z, dd.w}; x.b0 = (f32x2){bb.x, bb.y}; x.b1 = (f32x2){bb.z, bb.w};
    x.k0 = (f32x2){kp.x, kp.y}; x.k1 = (f32x2){kp.z, kp.w}; x.r0 = (f32x2){rr.x, rr.y}; x.r1 = (f32x2){rr.z, rr.w};
    x.v = *(const LAS float*)(vb + t * SC_REC);
}
__device__ __forceinline__ void scan_yflush(const LAS unsigned char* yb, float* YS, int ptid) {
#pragma unroll
    for (int i = 0; i < 2; ++i) { const int o = ptid + 256 * i, t = o >> 4, r = o & 15; const f32x4 q = *(const LAS f32x4*)(yb + o * 16);
        YS[(size_t)t * RWW + r] = (q.x + q.y) + (q.z + q.w); }
}
__device__ __forceinline__ void scan_unit(Frame& F, int c) {
    const int b = c >> 6, h = (c >> 2) & 15, rq = c & 3, lane = F.lane, wave = F.wave;
    unsigned char* ws = F.ws; LAS unsigned char* lds = F.lds;
    const int mb = b * SEQ; constexpr int NCH = SEQ / SC_T;
    if (wave >= 4) {
        const int ptid = F.tid - 256, tok = ptid >> 3, part = ptid & 7;
        float* YS = (float*)(ws + WS_ACT) + (size_t)mb * RWW + 64 * h + 16 * rq;
        ScanRegs cur, nxt;
        scan_load(cur, ws, mb + tok, h, rq, part);
        scan_load(nxt, ws, mb + SC_T + tok, h, rq, part);
        scan_store(cur, lds + tok * SC_REC, part);
        __syncthreads();
        for (int ch = 0; ch < NCH; ++ch) {
            cur = nxt;
            if (ch + 2 < NCH) scan_load(nxt, ws, mb + (ch + 2) * SC_T + tok, h, rq, part);
            if (ch + 1 < NCH) scan_store(cur, lds + ((ch + 1) & 1) * SC_BUF + tok * SC_REC, part);
            if (ch > 0) scan_yflush(lds + SC_YOFF + ((ch - 1) & 1) * SC_YBUF, YS + (size_t)(ch - 1) * SC_T * RWW, ptid);
            __syncthreads();
        }
        scan_yflush(lds + SC_YOFF + ((NCH - 1) & 1) * SC_YBUF, YS + (size_t)(NCH - 1) * SC_T * RWW, ptid);
    } else {
        const int rl = 4 * wave + (lane >> 4), p = lane & 15, row = 16 * rq + rl;
        f32x2 S0 = (f32x2){0.f, 0.f}, S1 = S0;
        __builtin_amdgcn_s_setprio(2);
        __syncthreads();
        for (int ch = 0; ch < NCH; ++ch) {
            const LAS unsigned char* base = lds + (ch & 1) * SC_BUF + p * 16;
            const LAS unsigned char* vb = lds + (ch & 1) * SC_BUF + 1280 + rl * 4;
            LAS unsigned char* yb = lds + SC_YOFF + (ch & 1) * SC_YBUF + (rl * 4 + (p & 3)) * 4;
            ScanVec cur; scan_ld(cur, base, vb, 0);
#pragma unroll
            for (int t = 0; t < SC_T; ++t) {
                ScanVec nxt; scan_ld(nxt, base, vb, t + 1 < SC_T ? t + 1 : t);
                f32x2 a = S0 * cur.kk0; a = S1 * cur.kk1 + a;
                const float sa = -allsum16(a.x + a.y);
                const f32x2 sa2 = (f32x2){sa, sa}, v2 = (f32x2){cur.v, cur.v};
                f32x2 u0 = cur.b0 * sa2, u1 = cur.b1 * sa2;
                u0 = S0 * cur.d0 + u0; u1 = S1 * cur.d1 + u1;
                S0 = cur.k0 * v2 + u0; S1 = cur.k1 * v2 + u1;
                f32x2 q = S0 * cur.r0; q = S1 * cur.r1 + q;
                float y = q.x + q.y; y += dpp_f<0x128>(y); y += dpp_f<0x124>(y);
                *(LAS float*)(yb + t * 256) = y;
                cur = nxt;
            }
            __syncthreads();
        }
        __builtin_amdgcn_s_setprio(0);
        *(f32x4*)(F.out + O_WP + ((size_t)(b * RWH + h) * HD + row) * HD + 4 * p) = (f32x4){S0.x, S0.y, S1.x, S1.y};
    }
}
__device__ __forceinline__ void dec_rwkv_unit(Frame& F, const Args& A, int du) {
    const int lane = F.lane, wave = F.wave; unsigned char* ws = F.ws;
    const int idx = du * 8 + wave, b = idx >> 4, h = idx & 15, m = MP + b;
    LAS float* vec = (LAS float*)(F.lds + wave * 1280);
    const size_t o = (size_t)m * RWW + 64 * h + lane;
    vec[lane] = bf2f(((const bf16*)(ws + WS_KK))[o]); vec[64 + lane] = ((const float*)(ws + WS_DD))[o]; vec[128 + lane] = bf2f(((const bf16*)(ws + WS_BB))[o]);
    vec[192 + lane] = bf2f(((const bf16*)(ws + WS_KP))[o]); vec[256 + lane] = bf2f(((const bf16*)(ws + WS_RR))[o]);
    const float vi = bf2f(((const bf16*)(ws + WS_VV))[o]);
    const size_t so = ((size_t)(b * RWH + h) * HD + lane) * HD;
    const float* Sp = A.in[4] + so; f32x4 S[16];
#pragma unroll
    for (int j = 0; j < 16; ++j) S[j] = *(const f32x4*)(Sp + 4 * j);
    LDS_WAIT(); asm volatile("" ::: "memory");
    float sa = 0.f;
#pragma unroll
    for (int j = 0; j < 16; ++j) { const f32x4 kk = *(const LAS f32x4*)(vec + 4 * j); sa += (S[j].x * kk.x + S[j].y * kk.y) + (S[j].z * kk.z + S[j].w * kk.w); asm volatile("" ::: "memory"); }
    sa = -sa; float y = 0.f; float* So = F.out + O_WS + so;
#pragma unroll
    for (int j = 0; j < 16; ++j) { const f32x4 dd = *(const LAS f32x4*)(vec + 64 + 4 * j), bb = *(const LAS f32x4*)(vec + 128 + 4 * j), kp = *(const LAS f32x4*)(vec + 192 + 4 * j), rr = *(const LAS f32x4*)(vec + 256 + 4 * j);
        S[j] = S[j] * dd + bb * sa + kp * vi; y += (S[j].x * rr.x + S[j].y * rr.y) + (S[j].z * rr.z + S[j].w * rr.w);
        *(f32x4*)(So + 4 * j) = S[j]; asm volatile("" ::: "memory"); }
    ((float*)(ws + WS_ACT))[o] = y;
    LDS_WAIT(); asm volatile("" ::: "memory");
}
__global__ void __launch_bounds__(NWAVES * 64, 2) hymba_fwd(Args args) {
    extern __shared__ __attribute__((aligned(16))) unsigned char lds_raw[];
    { const int t0_ = threadIdx.x;
      for (int u = t0_; u < (LDS_BYTES - LDSCTL_OFF) / 4; u += NWAVES * 64) ((LAS unsigned*)((LAS unsigned char*)lds_raw + LDSCTL_OFF))[u] = 0u; }
    __syncthreads();
    XcdBarrier bar; bar.bar = (unsigned*)((gu32*)(args.ws + WS_CTL) + CW_BAR); bar.x = 0; bar.st = nullptr;
    if (MK_N_LAUNCHES == 1) bar = xcd_barrier_post((unsigned*)((gu32*)(args.ws + WS_CTL) + CW_BAR), (volatile LAS unsigned*)((LAS unsigned char*)lds_raw + MISC_OFF) + 8);
    const int lo = args.ph_lo, hi = args.ph_hi;
#ifndef PH_MASK
#define PH_MASK 0x7ff
#endif
#define IN(k) (((PH_MASK >> (k)) & 1) && lo <= (k) && (k) < hi)
#define SEAM(k) do { if (IN(k) && IN((k) + 1)) xcd_barrier(bar); } while (0)
#ifndef PROBE_REP
#define PROBE_REP 0
#endif
#define NREP(k) (1 + ((PROBE_REP >> (k)) & 1))
#define PHASE_FRAME() Frame F; { int t_ = threadIdx.x; asm volatile("" : "+v"(t_)); F.lds = (LAS unsigned char*)lds_raw; F.MISC = (volatile LAS unsigned*)(F.lds + MISC_OFF); F.tid = t_; F.lane = t_ & 63; \
        F.wave = __builtin_amdgcn_readfirstlane(t_ >> 6); F.G = gridDim.x; F.out = args.out; F.ws = args.ws; F.ctl = (gu32*)(args.ws + WS_CTL); } \
    unsigned char* ws = F.ws; const int gw = blockIdx.x * NWAVES + F.wave, NGW = F.G * NWAVES; (void)gw; (void)NGW; \
    bf16* XB = (bf16*)(ws + WS_XB); bf16* ACT = (bf16*)(ws + WS_ACT); bf16* X2B = (bf16*)(ws + WS_X2B); (void)XB; (void)ACT; (void)X2B; \
    float* ssq0 = (float*)(F.ctl + CW_SSQ0); float* ssq1 = (float*)(F.ctl + CW_SSQ1); float* ssq2 = (float*)(F.ctl + CW_SSQ2); float* ssq3 = (float*)(F.ctl + CW_SSQ3); float* ssqd = (float*)(F.ctl + CW_SSQD); (void)ssqd; (void)ssq0; (void)ssq1; (void)ssq2; (void)ssq3; \
    float* yp = args.out + O_YP; float* ys = args.out + O_YS; (void)yp; (void)ys;

    if (IN(0)) for (int rep = 0; rep < NREP(0); ++rep) { PHASE_FRAME(); p0_prologue(F, args); if (rep + 1 < NREP(0)) xcd_barrier(bar); else SEAM(0); }
    if (IN(1)) for (int rep = 0; rep < NREP(1); ++rep) { PHASE_FRAME(); pg8::Gemm g{XB, (const bf16*)(ws + WS_WGU1), MPAD, 2 * DFF, DM}; pg8::StaticOrder S; S.init(MPAD, 2 * DFF, F.G, (int)blockIdx.x);
        pg8::EpiSwiglu E{ACT, ssq0};
        pg8::gemm_phase<pg8::EpiSwiglu, pg8::StaticOrder, true, true>(F.lds + RING_OFF, g, S, E); if (rep + 1 < NREP(1)) xcd_barrier(bar); else SEAM(1); }
    if (IN(2)) for (int rep = 0; rep < NREP(2); ++rep) { PHASE_FRAME(); pg8::Gemm g{ACT, (const bf16*)(ws + WS_WD1), MPAD, DM, DFF}; pg8::StaticOrder S; S.init(MPAD, DM, F.G, (int)blockIdx.x);
        pg8::EpiResid E{args.in[0], args.in[1], yp, ys, XB, rep ? ssqd : ssq1, 0.5f};
        pg8::gemm_phase<pg8::EpiResid, pg8::StaticOrder, true, true>(F.lds + RING_OFF, g, S, E); if (rep + 1 < NREP(2)) xcd_barrier(bar); else SEAM(2); }
    if (IN(3)) for (int rep = 0; rep < NREP(3); ++rep) { PHASE_FRAME(); pg8::Gemm g{XB, (const bf16*)(ws + WS_WINB), MPAD, INC, DM}; pg8::StaticOrder S; S.init(MPAD, INC, F.G, (int)blockIdx.x);
        pg8::EpiWin E{ssq1, (bf16*)(ws + WS_QB), (bf16*)(ws + WS_KB), (bf16*)(ws + WS_VB), (float*)(ws + WS_ACT), args.out};
        pg8::gemm_phase<pg8::EpiWin, pg8::StaticOrder, true, true>(F.lds + RING_OFF, g, S, E); if (rep + 1 < NREP(3)) xcd_barrier(bar); else SEAM(3); }
    if (IN(4)) for (int rep = 0; rep < NREP(4); ++rep) { PHASE_FRAME();
        for (int u = blockIdx.x; u < NB * 16 * NKVH; u += F.G) attn_unit(F, args, u >> 6, (u >> 2) & 15, u & 3);
        for (int u = blockIdx.x; u < PREP_UNITS; u += F.G) prep_unit(F, args, u >> 4, u & 15);
        __syncthreads();
        for (int u = (int)F.G - 1 - (int)blockIdx.x; u < NDEC * NQH / 8; u += F.G) dec_attn_unit(F, args, u);
        __syncthreads();
        { const int n4 = NDEC * (WIN - 1) * KVW / 4;
          for (int i = blockIdx.x * (NWAVES * 64) + F.tid; i < 2 * n4; i += F.G * NWAVES * 64) { const int t = i >= n4, j = t ? i - n4 : i; const int bb = j / ((WIN - 1) * KVW / 4), r = j % ((WIN - 1) * KVW / 4);
              const f32x4 v = *((const f32x4*)(args.in[2 + t] + (size_t)bb * WIN * KVW + KVW) + r);
              *((f32x4*)(args.out + (t ? O_VS : O_KS) + (size_t)bb * WIN * KVW) + r) = v; } }
        if (rep + 1 < NREP(4)) xcd_barrier(bar); else SEAM(4); }
    if (IN(5)) for (int rep = 0; rep < NREP(5); ++rep) { PHASE_FRAME();
        for (int u = blockIdx.x; u < NB * RWH * 4; u += F.G) scan_unit(F, u);
        __syncthreads();
        for (int u = blockIdx.x; u < NDEC * RWH / 8; u += F.G) dec_rwkv_unit(F, args, u);
        if (rep + 1 < NREP(5)) xcd_barrier(bar); else SEAM(5); }
    if (IN(6)) for (int rep = 0; rep < NREP(6); ++rep) { PHASE_FRAME(); const float* YS = (const float*)(ws + WS_ACT); const bf16* LG = (const bf16*)(ws + WS_LG); const bf16* EE = (const bf16*)(ws + WS_EE);
        for (int u = gw; u < MV * RWH; u += NGW) { const size_t o = (size_t)(u >> 4) * RWW + 64 * (u & 15) + F.lane;
            const float y = YS[o], mean = wave_sum(y) * (1.0f / 64.0f), dl = y - mean, var = wave_sum(dl * dl) * (1.0f / 64.0f);
            const float r = dl * __builtin_amdgcn_rsqf(var + GN_EPS) * bf2f(LG[o]) + bf2f(EE[o]);
            XB[(size_t)(u >> 4) * DM + ATTW + 64 * (u & 15) + F.lane] = f2bfs(r); }
        if (rep + 1 < NREP(6)) xcd_barrier(bar); else SEAM(6); }
    if (IN(7)) for (int rep = 0; rep < NREP(7); ++rep) { PHASE_FRAME(); pg8::Gemm g{XB, (const bf16*)(ws + WS_WOUT), MPAD, DM, DM}; pg8::StaticOrder S; S.init(MPAD, DM, F.G, (int)blockIdx.x);
        pg8::EpiResid E{yp, ys, yp, ys, rep ? nullptr : X2B, rep ? ssqd : ssq2, rep ? 0.0f : 1.0f};
        pg8::gemm_phase<pg8::EpiResid, pg8::StaticOrder, true, true>(F.lds + RING_OFF, g, S, E); if (rep + 1 < NREP(7)) xcd_barrier(bar); else SEAM(7); }
    if (IN(8)) for (int rep = 0; rep < NREP(8); ++rep) { PHASE_FRAME(); pg8::Gemm g{X2B, (const bf16*)(ws + WS_WGU2), MPAD, 2 * DFF, DM}; pg8::StaticOrder S; S.init(MPAD, 2 * DFF, F.G, (int)blockIdx.x);
        pg8::EpiSwiglu E{ACT, ssq2};
        pg8::gemm_phase<pg8::EpiSwiglu, pg8::StaticOrder, true, true>(F.lds + RING_OFF, g, S, E); if (rep + 1 < NREP(8)) xcd_barrier(bar); else SEAM(8); }
    if (IN(9)) for (int rep = 0; rep < NREP(9); ++rep) { PHASE_FRAME(); pg8::Gemm g{ACT, (const bf16*)(ws + WS_WD2), MPAD, DM, DFF}; pg8::StaticOrder S; S.init(MPAD, DM, F.G, (int)blockIdx.x);
        pg8::EpiResid E{yp, ys, yp, ys, nullptr, rep ? ssqd : ssq3, rep ? 0.0f : 0.5f};
        pg8::gemm_phase<pg8::EpiResid, pg8::StaticOrder, true, true>(F.lds + RING_OFF, g, S, E); if (rep + 1 < NREP(9)) xcd_barrier(bar); else SEAM(9); }
    if (IN(10)) for (int rep = 0; rep < NREP(10); ++rep) { PHASE_FRAME(); const float* fn = args.in[30];
        for (int m = gw; m < MV; m += NGW) { float* xr = m < MP ? yp + (size_t)m * DM : ys + (size_t)(m - MP) * DM;
            const float s = rep ? 1.0f : __builtin_amdgcn_rsqf(ssq3[m] * (1.0f / DM) + RMS_EPS);
            GAS f32x4* x4 = (GAS f32x4*)xr + F.lane; const GAS f32x4* f4 = (const GAS f32x4*)fn + F.lane;
#pragma unroll
            for (int j = 0; j < 8; ++j) x4[64 * j] = rep ? x4[64 * j] * s : x4[64 * j] * s * f4[64 * j]; } if (NREP(10) > 1 && rep == 0) xcd_barrier(bar); }
#undef IN
#undef SEAM
}

extern "C" void kernel_launch(void* const* d_in, const int* in_sizes, int n_in, void* d_out, int out_size, void* d_ws, size_t ws_size, hipStream_t stream) {
    static int grid = 0;
    if (grid == 0) {
        if (n_in != 31 || in_sizes[0] != MP * DM || (size_t)out_size != O_END || ws_size < WS_END) {
            fprintf(stderr, "kernel_launch: unexpected shapes: n_in %d in0 %d out %d (want %zu) ws %zu (want >= %zu); nothing launched\n", n_in, n_in > 0 ? in_sizes[0] : -1, out_size, (size_t)O_END, ws_size, (size_t)WS_END);
            grid = -1; return; }
        int dev = 0, cus = 0, per_cu = 0;
        if (hipGetDevice(&dev) != hipSuccess || hipDeviceGetAttribute(&cus, hipDeviceAttributeMultiprocessorCount, dev) != hipSuccess) { fprintf(stderr, "kernel_launch: device query failed\n"); grid = -1; return; }
        if (hipFuncSetAttribute((const void*)hymba_fwd, hipFuncAttributeMaxDynamicSharedMemorySize, LDS_BYTES) != hipSuccess) { fprintf(stderr, "kernel_launch: hipFuncSetAttribute failed\n"); grid = -1; return; }
        if (hipOccupancyMaxActiveBlocksPerMultiprocessor(&per_cu, (const void*)hymba_fwd, NWAVES * 64, LDS_BYTES) != hipSuccess || per_cu < 1)
            fprintf(stderr, "kernel_launch: note: occupancy query reports %d workgroups per CU\n", per_cu);
        (void)hipGetLastError();
        grid = cus;
    }
    if (grid < 0) return;
    if (hipMemsetAsync((char*)d_ws + WS_CTL, 0, CTL_ZERO_BYTES, stream) != hipSuccess) { fprintf(stderr, "kernel_launch: hipMemsetAsync failed\n"); return; }
    Args a{};
    for (int i = 0; i < 31; ++i) a.in[i] = (const float*)d_in[i];
    a.out = (float*)d_out; a.ws = (unsigned char*)d_ws;
    for (int li = 0; li < MK_N_LAUNCHES; ++li) {
        a.ph_lo = (MK_N_LAUNCHES == 1) ? 0 : li; a.ph_hi = (MK_N_LAUNCHES == 1) ? NPHASES : li + 1; a.li = li;
        hipLaunchKernelGGL(hymba_fwd, dim3(grid), dim3(NWAVES * 64), LDS_BYTES, stream, a);
        const hipError_t le = hipPeekAtLastError();
        if (le != hipSuccess) { fprintf(stderr, "kernel_launch: launch %d failed: %s\n", li, hipGetErrorName(le)); break; }
    }
}
```

```cpp
#include <hip/hip_runtime.h>
#include <cstdio>
#include <cstdint>
#define MK_N_LAUNCHES 1
constexpr int DM = 2048, SEQ = 2048, NB = 4, MP = NB * SEQ  , NDEC = 32, MV = MP + NDEC  , MPAD = 8448  ;
constexpr int DFF = 5504, ATTW = 1024, KVW = 256, RWW = 1024, NQH = 16, NKVH = 4, HD = 64, RWH = 16, WIN = 128;
constexpr int ATT_COLS = ATTW + 2 * KVW  , SHC = 3 * RWW + 64 + 64 + 128  , INC = ATT_COLS + SHC  ;
constexpr float RMS_EPS = 1e-5f, GN_EPS = 64e-5f, LOG2E = 1.4426950408889634f;
constexpr float QSCALE = 0.125f * LOG2E;
constexpr size_t O_YP = 0, O_YS = O_YP + (size_t)MP * DM, O_KP = O_YS + (size_t)NDEC * DM, O_VP = O_KP + (size_t)NB * WIN * KVW, O_WP = O_VP + (size_t)NB * WIN * KVW,
                 O_SP = O_WP + (size_t)NB * RWH * HD * HD, O_KS = O_SP + (size_t)NB * SHC, O_VS = O_KS + (size_t)NDEC * WIN * KVW, O_WS = O_VS + (size_t)NDEC * WIN * KVW,
                 O_SS = O_WS + (size_t)NDEC * RWH * HD * HD, O_END = O_SS + (size_t)NDEC * SHC;
namespace pg8 {
#define PG8_LAS __attribute__((address_space(3)))
typedef unsigned short bf16_t;
typedef short bf16x8 __attribute__((ext_vector_type(8)));
typedef float f32x4 __attribute__((ext_vector_type(4)));
typedef unsigned u32x4 __attribute__((ext_vector_type(4)));
constexpr int BM = 256, BK = 64, HALF = 128, HTB = HALF * BK * 2  , STAGE_BYTES = 8 * HTB, NXCD = 8, WGM = 8;

__host__ __device__ __forceinline__ int lds_byte(int r, int c) { const int st = (r >> 4) * 2 + (c >> 5), rr = r & 15, cc = c & 31, ob = rr * 64 + cc * 2; return st * 1024 + (ob ^ (((ob >> 9) & 1) << 5)); }
__host__ __device__ __forceinline__ void stage_rc(int b, int& R, int& C) { const int st = b / 1024, sb = b % 1024, swz = sb ^ (((sb >> 9) & 1) << 5); R = (st >> 1) * 16 + swz / 64; C = (st & 1) * 32 + (swz % 64) / 2; }
__host__ __device__ __forceinline__ int perm32(int rho) { const int n = rho >> 4, i = rho & 15; return 8 * (i >> 2) + 4 * n + (i & 3); }

struct Unit { int pm, pn; };
struct Gemm { const bf16_t* A; const bf16_t* Bt; int M, N, K; };

struct StaticOrder {
    int nM, nN, nwg, G, c;
    __host__ __device__ void init(int M, int N, int G_, int c_) { nM = M / BM; nN = N / BM; nwg = nM * nN; G = G_; c = c_; }
    __host__ __device__ bool next(int i, Unit& u) const {
        const long L = (long)i * G + c; if (L >= nwg) return false;
        int wgid = (int)L; { const int q = nwg / NXCD, r = nwg % NXCD, xcd = wgid % NXCD, off = wgid / NXCD; wgid = (xcd < r ? xcd * (q + 1) : r * (q + 1) + (xcd - r) * q) + off; }
        const int nig = WGM * nN, gid = wgid / nig, fm = gid * WGM, gsz = (nM - fm) < WGM ? (nM - fm) : WGM;
        u.pm = fm + ((wgid % nig) % gsz); u.pn = (wgid % nig) / gsz; return true;
    }
    __device__ __forceinline__ void a_ready(const Unit&) const {}
    __device__ __forceinline__ void done(const Unit&) const {}
};

__device__ __forceinline__ unsigned cvt_pk_bf16(float lo, float hi) { unsigned r; asm volatile("v_cvt_pk_bf16_f32 %0, %1, %2" : "=v"(r) : "v"(lo), "v"(hi)); return r; }
__device__ __forceinline__ float silu_mul(float g, float u) { return g * u * __builtin_amdgcn_rcpf(1.0f + __builtin_amdgcn_exp2f(-g * LOG2E)); }

struct EpiSwiglu {
    static constexpr bool PERM = true, AFTER_DRAIN = false;
    bf16_t* O; const float* ssq;
    __device__ __forceinline__ void operator()(const f32x4 (&acc)[2][2][4][2], const Unit& u, int wr, int wc, int fr, int fq) const {
        const int row0 = u.pm * BM + wr * 64 + fr, col0 = u.pn * HALF + wc * 32 + 8 * fq;
#pragma unroll
        for (int ai = 0; ai < 2; ++ai)
#pragma unroll
            for (int m = 0; m < 4; ++m) { const int row = row0 + ai * HALF + m * 16;
                const float s = __builtin_amdgcn_rsqf(ssq[row] * (1.0f / DM) + RMS_EPS);
                const f32x4 g0 = acc[ai][0][m][0] * s, g1 = acc[ai][0][m][1] * s, u0 = acc[ai][1][m][0] * s, u1 = acc[ai][1][m][1] * s;
                u32x4 w; w.x = cvt_pk_bf16(silu_mul(g0[0], u0[0]), silu_mul(g0[1], u0[1])); w.y = cvt_pk_bf16(silu_mul(g0[2], u0[2]), silu_mul(g0[3], u0[3]));
                w.z = cvt_pk_bf16(silu_mul(g1[0], u1[0]), silu_mul(g1[1], u1[1])); w.w = cvt_pk_bf16(silu_mul(g1[2], u1[2]), silu_mul(g1[3], u1[3]));
                *(u32x4*)(O + (size_t)row * DFF + col0) = w; }
    }
};

struct EpiResid {
    static constexpr bool PERM = true, AFTER_DRAIN = false;
    const float* xi_p; const float* xi_s; float* xo_p; float* xo_s; bf16_t* XB; float* ssq; float alpha;
    __device__ __forceinline__ void operator()(const f32x4 (&acc)[2][2][4][2], const Unit& u, int wr, int wc, int fr, int fq) const {
        const int row0 = u.pm * BM + wr * 64 + fr, col0 = u.pn * BM + wc * 32 + 8 * fq;
#pragma unroll
        for (int ai = 0; ai < 2; ++ai)
#pragma unroll
            for (int m = 0; m < 4; ++m) { const int row = row0 + ai * HALF + m * 16; const bool valid = row < MV;
                const size_t ro = row < MP ? (size_t)row * DM : (size_t)(row - MP) * DM;
                const float* src = (row < MP ? xi_p : xi_s) + ro; float* dst = (row < MP ? xo_p : xo_s) + ro;
                float sq = 0.f;
#pragma unroll
                for (int bj = 0; bj < 2; ++bj) { const int col = col0 + bj * HALF;
                    f32x4 x0 = (f32x4){0.f, 0.f, 0.f, 0.f}, x1 = x0;
                    if (valid) { x0 = *(const f32x4*)(src + col); x1 = *(const f32x4*)(src + col + 4); }
                    const f32x4 y0 = x0 + acc[ai][bj][m][0] * alpha, y1 = x1 + acc[ai][bj][m][1] * alpha;
                    if (valid) { *(f32x4*)(dst + col) = y0; *(f32x4*)(dst + col + 4) = y1; }
                    sq += (y0[0] * y0[0] + y0[1] * y0[1]) + (y0[2] * y0[2] + y0[3] * y0[3]) + (y1[0] * y1[0] + y1[1] * y1[1]) + (y1[2] * y1[2] + y1[3] * y1[3]);
                    if (XB) { u32x4 w; w.x = cvt_pk_bf16(y0[0], y0[1]); w.y = cvt_pk_bf16(y0[2], y0[3]); w.z = cvt_pk_bf16(y1[0], y1[1]); w.w = cvt_pk_bf16(y1[2], y1[3]);
                        *(u32x4*)(XB + (size_t)row * DM + col) = w; } }
                sq += __shfl_xor(sq, 16); sq += __shfl_xor(sq, 32);
                if (fq == 0 && valid) atomicAdd(ssq + row, sq); }
    }
};

struct EpiWin {
    static constexpr bool PERM = true, AFTER_DRAIN = false;
    const float* ssq; bf16_t* QB; bf16_t* KB; bf16_t* VB; float* PR; float* out;
    __device__ __forceinline__ void operator()(const f32x4 (&acc)[2][2][4][2], const Unit& u, int wr, int wc, int fr, int fq) const {
        const int row0 = u.pm * BM + wr * 64 + fr, cl0 = wc * 32 + 8 * fq;
        const int pn = u.pn;
#pragma unroll
        for (int ai = 0; ai < 2; ++ai)
#pragma unroll
            for (int m = 0; m < 4; ++m) { const int row = row0 + ai * HALF + m * 16; const bool valid = row < MV;
                float s = __builtin_amdgcn_rsqf(ssq[row] * (1.0f / DM) + RMS_EPS);
                if (pn < 4) s *= QSCALE;
#pragma unroll
                for (int bj = 0; bj < 2; ++bj) { const int cl = cl0 + bj * HALF;
                    const f32x4 y0 = acc[ai][bj][m][0] * s, y1 = acc[ai][bj][m][1] * s;
                    if (pn < 6) { u32x4 w; w.x = cvt_pk_bf16(y0[0], y0[1]); w.y = cvt_pk_bf16(y0[2], y0[3]); w.z = cvt_pk_bf16(y1[0], y1[1]); w.w = cvt_pk_bf16(y1[2], y1[3]);
                        if (pn < 4) *(u32x4*)(QB + (size_t)row * ATTW + pn * BM + cl) = w;
                        else { *(u32x4*)((pn == 4 ? KB : VB) + (size_t)row * KVW + cl) = w;
                            if (valid) { float* o = nullptr;
                                if (row >= MP) o = out + (pn == 4 ? O_KS : O_VS) + ((size_t)(row - MP) * WIN + (WIN - 1)) * KVW + cl;
                                else if ((row & (SEQ - 1)) >= SEQ - WIN) o = out + (pn == 4 ? O_KP : O_VP) + ((size_t)(row >> 11) * WIN + ((row & (SEQ - 1)) - (SEQ - WIN))) * KVW + cl;
                                if (o) { *(f32x4*)o = y0; *(f32x4*)(o + 4) = y1; } } }
                    } else { const int cs = (pn - 6) * BM + cl;
                        *(f32x4*)(PR + (size_t)row * SHC + cs) = y0; *(f32x4*)(PR + (size_t)row * SHC + cs + 4) = y1;
                        if (valid) { float* o = nullptr;
                            if (row >= MP) o = out + O_SS + (size_t)(row - MP) * SHC + cs;
                            else if ((row & (SEQ - 1)) == SEQ - 1) o = out + O_SP + (size_t)(row >> 11) * SHC + cs;
                            if (o) { *(f32x4*)o = y0; *(f32x4*)(o + 4) = y1; } } } }
            }
    }
};
template <class Epi, class Sched, bool ALIGN_EPI = false, bool SP2 = false>
__device__ __forceinline__ void gemm_phase(PG8_LAS unsigned char* lds, const Gemm g, const Sched& S, const Epi& E) {
    int tid_ = threadIdx.x; asm volatile("" : "+v"(tid_)); const int tid = tid_, wid = __builtin_amdgcn_readfirstlane(tid >> 6), lane = tid & 63, wr = wid >> 2, wc = wid & 3, fr = lane & 15, fq = lane >> 4;
    const int K = g.K, nt = K / BK;
    unsigned voffA[2], voffB[2];
#pragma unroll
    for (int i = 0; i < 2; ++i) { int R, C; stage_rc(tid * 16 + i * 8192, R, C); const int Rb = Epi::PERM ? ((R & ~31) + perm32(R & 31)) : R;
        voffA[i] = (unsigned)(R * K + C) * 2u; voffB[i] = (unsigned)(Rb * K + C) * 2u; }
    const size_t kstep = (size_t)(BK * 2);
    const size_t hstep = (size_t)HALF * K * 2;
    const size_t tstep = 2 * hstep;
    const unsigned ldsw = (unsigned)wid * 1024u;
    const int aoff = lds_byte(wr * 64 + fr, fq * 8), boff = lds_byte(wc * 32 + fr, fq * 8);
#define PG8_SA(b, h) (((b) * 2 + (h)) * HTB)
#define PG8_SB(b, h) ((4 + (b) * 2 + (h)) * HTB)
#define PG8_STAGE(bufoff, gbase, voff) do { _Pragma("unroll") for (int _i = 0; _i < 2; ++_i) \
        __builtin_amdgcn_global_load_lds((const unsigned*)((const char*)(gbase) + (voff)[_i]), (PG8_LAS unsigned*)(lds + (bufoff) + ldsw + _i * 8192), 16, 0, 0); } while (0)
#define PG8_LDA(dst, b, h) do { _Pragma("unroll") for (int m = 0; m < 4; ++m) _Pragma("unroll") for (int k = 0; k < 2; ++k) dst[m][k] = *(const PG8_LAS bf16x8*)(lds + PG8_SA(b, h) + aoff + m * 2048 + k * 1024); } while (0)
#define PG8_LDB(dst, b, h) do { _Pragma("unroll") for (int n = 0; n < 2; ++n) _Pragma("unroll") for (int k = 0; k < 2; ++k) dst[n][k] = *(const PG8_LAS bf16x8*)(lds + PG8_SB(b, h) + boff + n * 2048 + k * 1024); } while (0)
#define PG8_MMA(ai, bj, At, Bt) do { __builtin_amdgcn_s_setprio(1); _Pragma("unroll") for (int m = 0; m < 4; ++m) _Pragma("unroll") for (int n = 0; n < 2; ++n) _Pragma("unroll") for (int k = 0; k < 2; ++k) \
        acc[ai][bj][m][n] = __builtin_amdgcn_mfma_f32_16x16x32_bf16(Bt[n][k], At[m][k], acc[ai][bj][m][n], 0, 0, 0); __builtin_amdgcn_s_setprio(0); } while (0)
#define PG8_WAIT_V(n) asm volatile("s_waitcnt vmcnt(" #n ")" ::: "memory")
#define PG8_WAIT_L(n) asm volatile("s_waitcnt lgkmcnt(" #n ")" ::: "memory")
#define PG8_BAR __builtin_amdgcn_s_barrier()
#define PG8_SCHED __builtin_amdgcn_sched_barrier(0)
    Unit cur, nxt; int ui = 0;
    if (!S.next(0, cur)) return;
    f32x4 acc[2][2][4][2];
#pragma unroll
    for (int a = 0; a < 2; ++a)
#pragma unroll
        for (int b = 0; b < 2; ++b)
#pragma unroll
            for (int m = 0; m < 4; ++m)
#pragma unroll
                for (int n = 0; n < 2; ++n) acc[a][b][m][n] = (f32x4){0.f, 0.f, 0.f, 0.f};
    bf16x8 At[4][2], B0[2][2], B1[2][2];
    const char* cA = (const char*)g.A + (size_t)cur.pm * tstep; const char* cB = (const char*)g.Bt + (size_t)cur.pn * tstep;
    S.a_ready(cur);
    if constexpr (SP2) {
        PG8_STAGE(PG8_SB(0, 0), cB, voffB); PG8_STAGE(PG8_SB(0, 1), cB + hstep, voffB); PG8_STAGE(PG8_SA(0, 0), cA, voffA); PG8_STAGE(PG8_SA(0, 1), cA + hstep, voffA);
        if (wr == 1) PG8_BAR;
        PG8_WAIT_V(2); PG8_BAR;
        PG8_STAGE(PG8_SB(1, 0), cB + kstep, voffB); PG8_STAGE(PG8_SA(1, 0), cA + kstep, voffA); PG8_STAGE(PG8_SB(1, 1), cB + hstep + kstep, voffB);
        PG8_WAIT_V(6); PG8_BAR;
    } else {
        PG8_STAGE(PG8_SB(0, 0), cB, voffB); PG8_STAGE(PG8_SA(0, 0), cA, voffA); PG8_STAGE(PG8_SB(0, 1), cB + hstep, voffB); PG8_STAGE(PG8_SA(0, 1), cA + hstep, voffA);
        if (wr == 1) PG8_BAR;
        PG8_WAIT_V(4); PG8_BAR;
        PG8_STAGE(PG8_SB(1, 0), cB + kstep, voffB); PG8_STAGE(PG8_SA(1, 0), cA + kstep, voffA); PG8_STAGE(PG8_SB(1, 1), cB + hstep + kstep, voffB);
        PG8_WAIT_V(6); PG8_BAR;
    }
    for (;;) {
        const bool has_next = S.next(ui + 1, nxt);
        const char* nA = has_next ? (const char*)g.A + (size_t)nxt.pm * tstep : cA; const char* nB = has_next ? (const char*)g.Bt + (size_t)nxt.pn * tstep : cB;
        for (int t = 0; t < nt; t += 2) {
            const bool last = (t == nt - 2);
            const char* a1 = cA + (size_t)(t + 1) * kstep;
            const char* a2 = last ? nA : cA + (size_t)(t + 2) * kstep; const char* b2 = last ? nB : cB + (size_t)(t + 2) * kstep;
            const char* a3 = a2 + kstep; const char* b3 = b2 + kstep;
            if (last && has_next) S.a_ready(nxt);
            if constexpr (SP2) {
            PG8_LDB(B0, 0, 0); PG8_LDB(B1, 0, 1); PG8_SCHED; PG8_LDA(At, 0, 0); PG8_STAGE(PG8_SA(1, 1), a1 + hstep, voffA);
            PG8_WAIT_V(8); PG8_WAIT_L(0); PG8_BAR; PG8_MMA(0, 0, At, B0); PG8_MMA(0, 1, At, B1); PG8_BAR; PG8_SCHED;
            PG8_LDA(At, 0, 1); PG8_STAGE(PG8_SB(0, 0), b2, voffB); PG8_STAGE(PG8_SB(0, 1), b2 + hstep, voffB); PG8_STAGE(PG8_SA(0, 0), a2, voffA);
            PG8_WAIT_V(8); PG8_WAIT_L(0); PG8_BAR; PG8_MMA(1, 0, At, B0); PG8_MMA(1, 1, At, B1); PG8_BAR; PG8_SCHED;
            PG8_LDB(B0, 1, 0); PG8_LDB(B1, 1, 1); PG8_SCHED; PG8_LDA(At, 1, 0); PG8_STAGE(PG8_SA(0, 1), a2 + hstep, voffA);
            PG8_WAIT_V(8); PG8_WAIT_L(0); PG8_BAR; PG8_MMA(0, 0, At, B0); PG8_MMA(0, 1, At, B1); PG8_BAR; PG8_SCHED;
            PG8_LDA(At, 1, 1); PG8_STAGE(PG8_SB(1, 0), b3, voffB); PG8_STAGE(PG8_SB(1, 1), b3 + hstep, voffB); PG8_STAGE(PG8_SA(1, 0), a3, voffA);
            PG8_WAIT_V(8); PG8_WAIT_L(0); PG8_BAR; PG8_MMA(1, 0, At, B0); PG8_MMA(1, 1, At, B1); PG8_BAR; PG8_SCHED;
            } else {
            PG8_LDB(B0, 0, 0); PG8_SCHED; PG8_LDA(At, 0, 0); PG8_STAGE(PG8_SA(1, 1), a1 + hstep, voffA);
            PG8_WAIT_L(8); PG8_BAR; PG8_WAIT_L(0); PG8_MMA(0, 0, At, B0); PG8_BAR; PG8_SCHED;
            PG8_LDB(B1, 0, 1); PG8_STAGE(PG8_SB(0, 0), b2, voffB);
            PG8_BAR; PG8_WAIT_L(0); PG8_MMA(0, 1, At, B1); PG8_BAR;
            PG8_LDA(At, 0, 1); PG8_STAGE(PG8_SA(0, 0), a2, voffA);
            PG8_BAR; PG8_WAIT_L(0); PG8_MMA(1, 0, At, B0); PG8_BAR; PG8_SCHED;
            PG8_STAGE(PG8_SB(0, 1), b2 + hstep, voffB);
            PG8_WAIT_V(6); PG8_BAR; PG8_MMA(1, 1, At, B1); PG8_BAR;
            PG8_LDB(B0, 1, 0); PG8_SCHED; PG8_LDA(At, 1, 0); PG8_STAGE(PG8_SA(0, 1), a2 + hstep, voffA);
            PG8_WAIT_L(8); PG8_BAR; PG8_WAIT_L(0); PG8_MMA(0, 0, At, B0); PG8_BAR; PG8_SCHED;
            PG8_LDB(B1, 1, 1); PG8_STAGE(PG8_SB(1, 0), b3, voffB);
            PG8_BAR; PG8_WAIT_L(0); PG8_MMA(0, 1, At, B1); PG8_BAR;
            PG8_LDA(At, 1, 1); PG8_STAGE(PG8_SA(1, 0), a3, voffA);
            PG8_BAR; PG8_WAIT_L(0); PG8_MMA(1, 0, At, B0); PG8_BAR; PG8_SCHED;
            PG8_STAGE(PG8_SB(1, 1), b3 + hstep, voffB);
            PG8_WAIT_V(6); PG8_BAR; PG8_MMA(1, 1, At, B1); PG8_BAR;
            }
        }
        if constexpr (ALIGN_EPI) { if (wr == 0) PG8_BAR; }
        if constexpr (!Epi::AFTER_DRAIN) { E(acc, cur, wr, wc, fr, fq); S.done(cur); }
        if (!has_next) break;
#pragma unroll
        for (int a = 0; a < 2; ++a)
#pragma unroll
            for (int b = 0; b < 2; ++b)
#pragma unroll
                for (int m = 0; m < 4; ++m)
#pragma unroll
                    for (int n = 0; n < 2; ++n) acc[a][b][m][n] = (f32x4){0.f, 0.f, 0.f, 0.f};
        cur = nxt; cA = nA; cB = nB; ++ui;
        if constexpr (ALIGN_EPI) { if (wr == 1) PG8_BAR; }
    }
    PG8_WAIT_V(0);
    if constexpr (!ALIGN_EPI) { if (wr == 0) PG8_BAR; }
    PG8_BAR;
    if constexpr (Epi::AFTER_DRAIN) { E.fused(acc, cur, wr, wc, fr, fq, lds, wid, lane); S.done(cur); }
#undef PG8_SA
#undef PG8_SB
#undef PG8_STAGE
#undef PG8_LDA
#undef PG8_LDB
#undef PG8_MMA
#undef PG8_WAIT_V
#undef PG8_WAIT_L
#undef PG8_BAR
#undef PG8_SCHED
}
}
#define GAS __attribute__((address_space(1)))
#define LAS __attribute__((address_space(3)))
typedef unsigned short bf16;
typedef unsigned v4u __attribute__((ext_vector_type(4)));
typedef float f32x4 __attribute__((ext_vector_type(4)));
typedef short bf16x8 __attribute__((ext_vector_type(8)));
typedef GAS unsigned gu32;
typedef GAS unsigned long long gu64;
#define RLX_AGENT __ATOMIC_RELAXED, __HIP_MEMORY_SCOPE_AGENT
#define LDS_WAIT() asm volatile("s_waitcnt lgkmcnt(0)" ::: "memory")
#define VM_WAIT() asm volatile("s_waitcnt vmcnt(0)" ::: "memory")
__device__ __forceinline__ unsigned long long rt() { return __builtin_amdgcn_s_memrealtime(); }
__device__ __forceinline__ unsigned f2bf(float f) { unsigned u = __builtin_bit_cast(unsigned, f); return (u + 0x7fffu + ((u >> 16) & 1u)) >> 16; }
__device__ __forceinline__ unsigned pk2(float lo, float hi) { return f2bf(lo) | (f2bf(hi) << 16); }

#define XB_TMO      128
#define XB_XCNT(j)  (256  + 64 * (j))
#define XB_XSUB(j)  (1280 + 64 * (j))
#define XB_XGEN(j)  (2304 + 64 * (j))
#define XB_TOP      3328
#define XB_TOPGEN   3392
#define XCD_BAR_WORDS 3456
#define XB_SPIN_CAP (1u << 18)

__device__ __forceinline__ unsigned xb_ld(unsigned* p)              { return __hip_atomic_load(p, __ATOMIC_RELAXED, __HIP_MEMORY_SCOPE_AGENT); }
__device__ __forceinline__ unsigned xb_add(unsigned* p, unsigned v) { return __hip_atomic_fetch_add(p, v, __ATOMIC_RELAXED, __HIP_MEMORY_SCOPE_AGENT); }
__device__ __forceinline__ unsigned xb_xcc_id() { return (unsigned)__builtin_amdgcn_s_getreg((3 << 11) | 20) & 0xFu; }
#define XB_SPIN(cond, bar) do { unsigned _sp = 0; while (cond) { __builtin_amdgcn_s_sleep(1); \
    if ((++_sp & 255u) == 0u) { if (xb_ld(&(bar)[XB_TMO])) break; if (_sp > XB_SPIN_CAP) { atomicAdd(&(bar)[XB_TMO], 1u); break; } } } } while (0)

struct XcdBarrier {
    unsigned* bar; unsigned x;
    volatile LAS unsigned* st;
};

__device__ __forceinline__ XcdBarrier xcd_barrier_post(unsigned* bar, volatile LAS unsigned* st) {
    XcdBarrier b; b.bar = bar; b.x = xb_xcc_id(); b.st = st;
    if (threadIdx.x == 0) (void)xb_add(&bar[XB_XCNT(b.x)], 1u);
    return b;
}
__device__ __forceinline__ void xcd_barrier_complete(unsigned* bar, unsigned x, unsigned& nloc, unsigned& nx) {
    const unsigned G = gridDim.x * gridDim.y * gridDim.z;
    unsigned sum, cnt, mine, sp = 0u;
    for (;;) {
        sum = 0u; cnt = 0u; mine = 0u;
#pragma unroll
        for (unsigned j = 0; j < 16; ++j) { const unsigned c = xb_ld(&bar[XB_XCNT(j)]); sum += c; cnt += (c > 0u) ? 1u : 0u; mine = (j == x) ? c : mine; }
        if (sum == G) break;
        __builtin_amdgcn_s_sleep(1);
        if ((++sp & 255u) == 0u) { if (xb_ld(&bar[XB_TMO])) break; if (sp > XB_SPIN_CAP) { atomicAdd(&bar[XB_TMO], 1u); break; } }
    }
    nloc = mine > 0u ? mine : 1u; nx = cnt > 0u ? cnt : 1u;
}

__device__ __forceinline__ void xcd_barrier(const XcdBarrier& b) {
    asm volatile("s_waitcnt vmcnt(0)" ::: "memory");
    __syncthreads();
    if (threadIdx.x == 0) {
        unsigned* bar = b.bar;
        __builtin_amdgcn_s_waitcnt(0);
        unsigned nloc = b.st[0], nx = b.st[1];
        if (nloc == 0u) { xcd_barrier_complete(bar, b.x, nloc, nx); b.st[0] = nloc; b.st[1] = nx; }
        const unsigned old = xb_add(&bar[XB_XSUB(b.x)], 1u);
        const unsigned gen = old / nloc;
        if (old + 1u == (gen + 1u) * nloc) {
            __builtin_amdgcn_fence(__ATOMIC_RELEASE, "agent");
            asm volatile("s_waitcnt vmcnt(0)" ::: "memory");
            const unsigned og = xb_add(&bar[XB_TOP], 1u);
            const unsigned tg = og / nx;
            if (og + 1u == (tg + 1u) * nx) xb_add(&bar[XB_TOPGEN], 1u);
            else XB_SPIN(xb_ld(&bar[XB_TOPGEN]) == tg, bar);
            __builtin_amdgcn_fence(__ATOMIC_ACQUIRE, "agent");
            xb_add(&bar[XB_XGEN(b.x)], 1u);
            asm volatile("s_waitcnt vmcnt(0)" ::: "memory");
        } else {
            XB_SPIN(xb_ld(&bar[XB_XGEN(b.x)]) == gen, bar);
            __builtin_amdgcn_fence(__ATOMIC_ACQUIRE, "agent");
            asm volatile("s_waitcnt vmcnt(0)" ::: "memory");
        }
    }
    __syncthreads();
}
constexpr size_t MiB = 1u << 20;
constexpr size_t WS_CTL = 0, CTL_ZERO_BYTES = 1 * MiB;
constexpr size_t WS_BIAS = 1 * MiB, WS_W2T = WS_BIAS + 16384, WS_A2T = WS_W2T + 131072, WS_G2T = WS_A2T + 131072;
constexpr size_t WS_WGU1 = 2 * MiB, WS_WD1 = WS_WGU1 + 43 * MiB, WS_WINB = WS_WD1 + 21 * MiB + MiB / 2;
constexpr size_t WS_WOUT = 86 * MiB, WS_WGU2 = 94 * MiB, WS_WD2 = 137 * MiB;
constexpr size_t WS_XB = 159 * MiB;
constexpr size_t WS_ACT = 192 * MiB;
constexpr size_t WS_QB = 300 * MiB, WS_KB = WS_QB + 16 * MiB + MiB / 2, WS_VB = WS_KB + 4 * MiB + MiB / 8;
constexpr size_t WS_DD = 325 * MiB, WS_LG = 358 * MiB, WS_EE = WS_LG + 16 * MiB + MiB / 2, WS_END = WS_EE + 16 * MiB + MiB / 2;
constexpr size_t WS_SLAB = WS_END, WS_END2 = WS_SLAB + 1 * MiB;
constexpr size_t VEC16 = 16 * MiB + MiB / 2;
constexpr size_t WS_KK = WS_WGU1, WS_BB = WS_KK + VEC16, WS_KP = WS_BB + VEC16, WS_RR = WS_KP + VEC16, WS_VV = WS_RR + VEC16;
constexpr size_t WS_X2B = WS_WGU1;
static_assert(WS_VV + VEC16 <= WS_WOUT && WS_WINB + 19 * MiB <= WS_WOUT && WS_WD2 + 22 * MiB <= WS_XB && WS_XB + 33 * MiB <= WS_ACT && WS_VB + 4 * MiB + MiB / 8 <= WS_DD && WS_DD + 33 * MiB <= WS_LG, "d_ws map");
constexpr int CW_BAR = 4096;
constexpr int CW_SSQ0 = 16384, CW_SSQ1 = CW_SSQ0 + MPAD, CW_SSQ2 = CW_SSQ1 + MPAD, CW_SSQ3 = CW_SSQ2 + MPAD;
constexpr int CW_SKC = 8192;
constexpr int CW_SSQD = CW_SSQ3 + MPAD;
static_assert((CW_SSQD + MPAD) * 4 <= (int)CTL_ZERO_BYTES, "CTL");
constexpr int RING_OFF = 0, RING_BYTES = 131072;
constexpr int LDSCTL_OFF = RING_BYTES, MISC_OFF = LDSCTL_OFF + 320;
constexpr int LDS_BYTES = 147456;
constexpr int NWAVES = 8;
constexpr int NPHASES = 11;
#ifndef MK_N_LAUNCHES
#define MK_N_LAUNCHES 1
#endif

__constant__ unsigned char T5B[129] = {0, 1, 2, 3, 4, 5, 6, 7, 8, 9, 10, 11, 12, 13, 14, 15, 16, 16, 16, 17, 17, 18, 18, 18, 19, 19, 19, 20, 20, 20, 20, 21, 21, 21, 21, 22, 22, 22, 22, 22, 23, 23, 23, 23, 23, 23, 24, 24, 24, 24, 24, 24, 25, 25, 25, 25, 25, 25, 25, 26, 26, 26, 26, 26, 26, 26, 26, 27, 27, 27, 27, 27, 27, 27, 27, 27, 27, 28, 28, 28, 28, 28, 28, 28, 28, 28, 28, 29, 29, 29, 29, 29, 29, 29, 29, 29, 29, 29, 29, 30, 30, 30, 30, 30, 30, 30, 30, 30, 30, 30, 30, 30, 30, 31, 31, 31, 31, 31, 31, 31, 31, 31, 31, 31, 31, 31, 31, 31, 31};

struct Args { const float* in[31]; float* out; unsigned char* ws; int ph_lo, ph_hi, li, pad; };

struct Frame {
    LAS unsigned char* lds;
    volatile LAS unsigned* MISC;
    gu32* ctl;
    int tid, lane, wave, G;
    float* out; unsigned char* ws;
};
typedef float f32x2 __attribute__((ext_vector_type(2)));
__device__ __forceinline__ float bf2f(unsigned short u) { return __builtin_bit_cast(float, (unsigned)u << 16); }
__device__ __forceinline__ unsigned short f2bfs(float f) { return (unsigned short)f2bf(f); }
__device__ __forceinline__ float wave_sum(float v) {
#pragma unroll
    for (int o = 1; o < 64; o <<= 1) v += __shfl_xor(v, o);
    return v;
}
__device__ __forceinline__ float wave_max(float v) {
#pragma unroll
    for (int o = 1; o < 64; o <<= 1) v = fmaxf(v, __shfl_xor(v, o));
    return v;
}
template <int CTRL> __device__ __forceinline__ float dpp_f(float x) { return __builtin_bit_cast(float, __builtin_amdgcn_update_dpp(0, __builtin_bit_cast(int, x), CTRL, 0xf, 0xf, true)); }
__device__ __forceinline__ float allsum16(float x) { x += dpp_f<0x128>(x); x += dpp_f<0x124>(x); x += dpp_f<0x122>(x); x += dpp_f<0x121>(x); return x; }
__device__ __forceinline__ float sigmoidf_(float x) { return __builtin_amdgcn_rcpf(1.0f + __builtin_amdgcn_exp2f(-x * LOG2E)); }
__device__ __forceinline__ float tanhf_(float x) { return 1.0f - 2.0f * __builtin_amdgcn_rcpf(1.0f + __builtin_amdgcn_exp2f(2.0f * LOG2E * x)); }

__device__ __forceinline__ void p0_transpose_item(const float* W, int K, int N, bf16* WT, int kb, int nb, int drow, const float* kscale, LAS float* scr, int lane) {
    const int k0 = 64 * kb, n0 = 32 * nb;
#pragma unroll 8
    for (int i = 0; i < 32; ++i) { const int kk = 2 * i + (lane >> 5); float v = W[(size_t)(k0 + kk) * N + n0 + (lane & 31)]; if (kscale) v *= kscale[k0 + kk]; scr[kk * 33 + (lane & 31)] = v; }
    LDS_WAIT(); asm volatile("" ::: "memory");
    const int c = lane & 7;
#pragma unroll
    for (int j = 0; j < 4; ++j) { const int n = (lane >> 3) + 8 * j; const LAS float* s = scr + (8 * c) * 33 + n;
        v4u o; o.x = pk2(s[0 * 33], s[1 * 33]); o.y = pk2(s[2 * 33], s[3 * 33]); o.z = pk2(s[4 * 33], s[5 * 33]); o.w = pk2(s[6 * 33], s[7 * 33]);
        *(GAS v4u*)(WT + (size_t)(drow + n) * K + k0 + 8 * c) = o; }
    LDS_WAIT(); asm volatile("" ::: "memory");
}
__device__ __forceinline__ int gu_row(int n0, int up) { return 256 * (n0 >> 7) + (n0 & 127) + 128 * up; }

__device__ __forceinline__ void p0_prologue(Frame& F, const Args& A) {
    LAS float* scr = (LAS float*)(F.lds + RING_OFF + F.wave * 16384);
    const int gw = blockIdx.x * NWAVES + F.wave, NGW = F.G * NWAVES, lane = F.lane;
    unsigned char* ws = F.ws;
    constexpr int I_GU = (DM / 64) * (DFF / 32), I_D = (DFF / 64) * (DM / 32), I_IN = (DM / 64) * (INC / 32), I_OUT = (DM / 64) * (DM / 32), I_L64 = RWW / 32, I_L128 = 2 * (RWW / 32);
    constexpr int NITEMS = 4 * I_GU + 2 * I_D + I_IN + I_OUT + 2 * I_L64 + I_L128;
    for (int it = gw; it < NITEMS; it += NGW) {
        int r = it;
        if (r < I_GU) { const int kb = r / (DFF / 32), nb = r % (DFF / 32); p0_transpose_item(A.in[8], DM, DFF, (bf16*)(ws + WS_WGU1), kb, nb, gu_row(32 * nb, 0), A.in[7], scr, lane); continue; } r -= I_GU;
        if (r < I_GU) { const int kb = r / (DFF / 32), nb = r % (DFF / 32); p0_transpose_item(A.in[9], DM, DFF, (bf16*)(ws + WS_WGU1), kb, nb, gu_row(32 * nb, 1), A.in[7], scr, lane); continue; } r -= I_GU;
        if (r < I_D)  { const int kb = r / (DM / 32), nb = r % (DM / 32); p0_transpose_item(A.in[10], DFF, DM, (bf16*)(ws + WS_WD1), kb, nb, 32 * nb, nullptr, scr, lane); continue; } r -= I_D;
        if (r < I_IN) { const int kb = r / (INC / 32), nb = r % (INC / 32); p0_transpose_item(A.in[12], DM, INC, (bf16*)(ws + WS_WINB), kb, nb, 32 * nb, A.in[11], scr, lane); continue; } r -= I_IN;
        if (r < I_OUT) { const int kb = r / (DM / 32), nb = r % (DM / 32); p0_transpose_item(A.in[25], DM, DM, (bf16*)(ws + WS_WOUT), kb, nb, 32 * nb, nullptr, scr, lane); continue; } r -= I_OUT;
        if (r < I_GU) { const int kb = r / (DFF / 32), nb = r % (DFF / 32); p0_transpose_item(A.in[27], DM, DFF, (bf16*)(ws + WS_WGU2), kb, nb, gu_row(32 * nb, 0), A.in[26], scr, lane); continue; } r -= I_GU;
        if (r < I_GU) { const int kb = r / (DFF / 32), nb = r % (DFF / 32); p0_transpose_item(A.in[28], DM, DFF, (bf16*)(ws + WS_WGU2), kb, nb, gu_row(32 * nb, 1), A.in[26], scr, lane); continue; } r -= I_GU;
        if (r < I_D)  { const int kb = r / (DM / 32), nb = r % (DM / 32); p0_transpose_item(A.in[29], DFF, DM, (bf16*)(ws + WS_WD2), kb, nb, 32 * nb, nullptr, scr, lane); continue; } r -= I_D;
        if (r < I_L64) { p0_transpose_item(A.in[16], 64, RWW, (bf16*)(ws + WS_W2T), 0, r, 32 * r, nullptr, scr, lane); continue; } r -= I_L64;
        if (r < I_L64) { p0_transpose_item(A.in[18], 64, RWW, (bf16*)(ws + WS_A2T), 0, r, 32 * r, nullptr, scr, lane); continue; } r -= I_L64;
        { const int kb = r / (RWW / 32), nb = r % (RWW / 32); p0_transpose_item(A.in[19], 128, RWW, (bf16*)(ws + WS_G2T), kb, nb, 32 * nb, nullptr, scr, lane); }
    }
    bf16* XB = (bf16*)(ws + WS_XB); float* ssq0 = (float*)(F.ctl + CW_SSQ0);
    for (int m = gw; m < MPAD; m += NGW) {
        GAS unsigned long long* o8 = (GAS unsigned long long*)(XB + (size_t)m * DM) + lane;
        if (m < MV) {
            const float* xrow = m < MP ? A.in[0] + (size_t)m * DM : A.in[1] + (size_t)(m - MP) * DM;
            const GAS f32x4* xr = (const GAS f32x4*)xrow + lane; f32x4 v[8]; float s = 0.f;
#pragma unroll
            for (int j = 0; j < 8; ++j) { v[j] = xr[64 * j]; s += (v[j].x * v[j].x + v[j].y * v[j].y) + (v[j].z * v[j].z + v[j].w * v[j].w); }
            s = wave_sum(s);
#pragma unroll
            for (int j = 0; j < 8; ++j) o8[64 * j] = (unsigned long long)pk2(v[j].x, v[j].y) | ((unsigned long long)pk2(v[j].z, v[j].w) << 32);
            if (lane == 0) ssq0[m] = s;
        } else {
#pragma unroll
            for (int j = 0; j < 8; ++j) o8[64 * j] = 0ull;
        }
    }
    float* bt = (float*)(ws + WS_BIAS);
    for (int i = blockIdx.x * (NWAVES * 64) + F.tid; i < 129 * NQH; i += F.G * NWAVES * 64) bt[i] = A.in[6][(int)T5B[i >> 4] * NQH + (i & 15)] * LOG2E;
}
constexpr int PREP_TILES = (MV + 63) / 64  , PREP_UNITS = PREP_TILES * RWH;
constexpr int PA_PITCH = 528;
constexpr int PA_OFF = 0, PW_OFF = 64 * PA_PITCH  , PMAT = 64 * 65 * 4  ;
__device__ __forceinline__ void prep_unit(Frame& F, const Args& A, int mt, int h) {
    const int tid = F.tid, lane = F.lane, wave = F.wave, m0 = mt * 64;
    unsigned char* ws = F.ws;
    const float* PR = (const float*)(ws + WS_ACT);
    const float* mu = A.in[14];
    LAS unsigned char* lds = F.lds;
    { const int row = tid >> 3, cc = tid & 7, m = m0 + row; const int c0 = 3 * RWW + 32 * cc;
      const bool valid = m < MV;
      const float* p = PR + (size_t)m * SHC + c0;
      const float* pv = nullptr;
      if (valid) { if (m >= MP) pv = A.in[5] + (size_t)(m - MP) * SHC + c0; else if ((m & (SEQ - 1)) != 0) pv = PR + (size_t)(m - 1) * SHC + c0; }
#pragma unroll
      for (int q = 0; q < 8; ++q) {
          f32x4 a = (f32x4){0.f, 0.f, 0.f, 0.f}, b = a;
          if (valid) a = *(const f32x4*)(p + 4 * q);
          if (pv) b = *(const f32x4*)(pv + 4 * q);
          const f32x4 m4 = *(const f32x4*)(mu + c0 + 4 * q);
          f32x4 x = a + m4 * (b - a);
          if (cc < 2) { x.x = tanhf_(x.x); x.y = tanhf_(x.y); x.z = tanhf_(x.z); x.w = tanhf_(x.w); }
          else if (cc >= 4) { x.x = sigmoidf_(x.x); x.y = sigmoidf_(x.y); x.z = sigmoidf_(x.z); x.w = sigmoidf_(x.w); }
          if (!valid) x = (f32x4){0.f, 0.f, 0.f, 0.f};
          *(LAS unsigned long long*)(lds + PA_OFF + row * PA_PITCH + (32 * cc + 4 * q) * 2) = (unsigned long long)pk2(x.x, x.y) | ((unsigned long long)pk2(x.z, x.w) << 32);
      } }
    __syncthreads();
    { const int mtile = wave & 3, nh = wave >> 2, ln = lane & 15, q4 = lane >> 4;
#pragma unroll
      for (int mat = 0; mat < 3; ++mat) {
          const int kbase = mat == 0 ? 0 : (mat == 1 ? 64 : 128), KM = mat == 2 ? 128 : 64;
          const bf16* Bt = (const bf16*)(ws + (mat == 0 ? WS_W2T : (mat == 1 ? WS_A2T : WS_G2T)));
#pragma unroll
          for (int n2 = 0; n2 < 2; ++n2) { const int nt = 2 * nh + n2; f32x4 acc = (f32x4){0.f, 0.f, 0.f, 0.f};
#pragma unroll
              for (int ks = 0; ks < KM / 32; ++ks) {
                  const bf16x8 a = *(const LAS bf16x8*)(lds + PA_OFF + (16 * mtile + ln) * PA_PITCH + (kbase + 32 * ks + 8 * q4) * 2);
                  const bf16x8 b = *(const GAS bf16x8*)(Bt + (size_t)(64 * h + 16 * nt + ln) * KM + 32 * ks + 8 * q4);
                  acc = __builtin_amdgcn_mfma_f32_16x16x32_bf16(a, b, acc, 0, 0, 0); }
              LAS float* o = (LAS float*)(lds + PW_OFF + mat * PMAT);
#pragma unroll
              for (int r = 0; r < 4; ++r) o[(16 * mtile + 4 * q4 + r) * 65 + 16 * nt + ln] = acc[r]; } } }
    __syncthreads();
    { const int hc = 64 * h + lane;
      const float mu_r = mu[hc], mu_k = mu[RWW + hc], mu_v = mu[2 * RWW + hc];
      const float w0 = A.in[15][hc], a0 = A.in[17][hc], k_k = A.in[20][hc], k_a = A.in[21][hc], r_k = A.in[22][hc], ln_w = A.in[23][hc], ln_b = A.in[24][hc];
      bf16* KK = (bf16*)(ws + WS_KK); bf16* BB = (bf16*)(ws + WS_BB); bf16* KP = (bf16*)(ws + WS_KP); bf16* RR = (bf16*)(ws + WS_RR); bf16* VV = (bf16*)(ws + WS_VV);
      float* DD = (float*)(ws + WS_DD); bf16* LG = (bf16*)(ws + WS_LG); bf16* EE = (bf16*)(ws + WS_EE);
      const LAS float* Wp = (const LAS float*)(lds + PW_OFF); const LAS float* Ap = (const LAS float*)(lds + PW_OFF + PMAT); const LAS float* Gp = (const LAS float*)(lds + PW_OFF + 2 * PMAT);
      for (int tt = 0; tt < 8; ++tt) { const int tok = 8 * wave + tt, m = m0 + tok;
          if (m >= MV) break;
          const float* p = PR + (size_t)m * SHC + hc;
          float pr = p[0], pk = p[RWW], pvv = p[2 * RWW], qr = 0.f, qk = 0.f, qv = 0.f;
          if (m >= MP) { const float* s = A.in[5] + (size_t)(m - MP) * SHC + hc; qr = s[0]; qk = s[RWW]; qv = s[2 * RWW]; }
          else if ((m & (SEQ - 1)) != 0) { const float* s = p - SHC; qr = s[0]; qk = s[RWW]; qv = s[2 * RWW]; }
          const float xr = pr + mu_r * (qr - pr), xk = pk + mu_k * (qk - pk), xv = pvv + mu_v * (qv - pvv);
          const float wpre = w0 + Wp[tok * 65 + lane];
          const float dec = __builtin_amdgcn_exp2f(-0.6065306597126334f * LOG2E * sigmoidf_(wpre));
          const float aa = sigmoidf_(a0 + Ap[tok * 65 + lane]);
          const float gg = Gp[tok * 65 + lane];
          float kk = xk * k_k; const float n2 = wave_sum(kk * kk); kk = kk / fmaxf(sqrtf(n2), 1e-12f);
          const float kp = xk * (1.0f + (aa - 1.0f) * k_a);
          const float bonus = wave_sum(xr * kp * r_k);
          const size_t o = (size_t)m * RWW + hc;
          KK[o] = f2bfs(kk); BB[o] = f2bfs(kk * aa); KP[o] = f2bfs(kp); RR[o] = f2bfs(xr); VV[o] = f2bfs(xv); DD[o] = dec;
          LG[o] = f2bfs(ln_w * gg); EE[o] = f2bfs((ln_b + bonus * xv) * gg); }
    }
}

constexpr int AK_PITCH = 144, AV_PITCH = 592, AP_PITCH = 336;
constexpr int AK_OFF = 0, AV_OFF = 272 * AK_PITCH  , AP_OFF = AV_OFF + 64 * AV_PITCH  , AB_OFF = AP_OFF + 8 * 16 * AP_PITCH  ;
static_assert(AB_OFF + 129 * 4 * 4 <= RING_BYTES, "attention LDS");
__device__ __forceinline__ void attn_unit(Frame& F, const Args& A, int b, int blk, int hk) {
    const int tid = F.tid, lane = F.lane, wave = F.wave;
    unsigned char* ws = F.ws; LAS unsigned char* lds = F.lds;
    const bf16* QB = (const bf16*)(ws + WS_QB); const bf16* KB = (const bf16*)(ws + WS_KB); const bf16* VB = (const bf16*)(ws + WS_VB); bf16* MX = (bf16*)(ws + WS_XB);
    const int mq0 = b * SEQ + blk * 128, mk0 = mq0 - 128;
    for (int i = tid; i < 16 * AK_PITCH / 4; i += NWAVES * 64) ((LAS unsigned*)(lds + AK_OFF + 256 * AK_PITCH))[i] = 0u;
    for (int i = tid; i < 64 * 16; i += NWAVES * 64) ((LAS unsigned*)(lds + AV_OFF + (i >> 4) * AV_PITCH + 512))[i & 15] = 0u;
#pragma unroll
    for (int it = 0; it < 4; ++it) { const int idx = it * 512 + tid, row = idx >> 3, ch = idx & 7;
        v4u kv = (v4u){0u, 0u, 0u, 0u}, vv = kv;
        if (blk > 0 || row >= 128) { kv = *(const GAS v4u*)(KB + (size_t)(mk0 + row) * KVW + hk * 64 + ch * 8); vv = *(const GAS v4u*)(VB + (size_t)(mk0 + row) * KVW + hk * 64 + ch * 8); }
        *(LAS v4u*)(lds + AK_OFF + row * AK_PITCH + ch * 16) = kv;
        LAS unsigned short* vt = (LAS unsigned short*)(lds + AV_OFF + (8 * ch) * AV_PITCH + row * 2);
        vt[0 * (AV_PITCH / 2)] = (unsigned short)(vv.x & 0xffffu); vt[1 * (AV_PITCH / 2)] = (unsigned short)(vv.x >> 16);
        vt[2 * (AV_PITCH / 2)] = (unsigned short)(vv.y & 0xffffu); vt[3 * (AV_PITCH / 2)] = (unsigned short)(vv.y >> 16);
        vt[4 * (AV_PITCH / 2)] = (unsigned short)(vv.z & 0xffffu); vt[5 * (AV_PITCH / 2)] = (unsigned short)(vv.z >> 16);
        vt[6 * (AV_PITCH / 2)] = (unsigned short)(vv.w & 0xffffu); vt[7 * (AV_PITCH / 2)] = (unsigned short)(vv.w >> 16); }
    { const float* bt = (const float*)(ws + WS_BIAS); LAS float* bl = (LAS float*)(lds + AB_OFF);
      for (int i = tid; i < 129 * 4; i += NWAVES * 64) bl[i] = bt[(i >> 2) * NQH + 4 * hk + (i & 3)]; }
    __syncthreads();
    const int g = wave >> 1, half = wave & 1, head = 4 * hk + g, ln = lane & 15, q4 = lane >> 4;
    const float sink2 = A.in[13][head] * LOG2E;
    const LAS float* bl = (const LAS float*)(lds + AB_OFF);
    LAS unsigned char* Pw = lds + AP_OFF + wave * (16 * AP_PITCH);
    for (int rb = 0; rb < 4; ++rb) {
        const int i0 = 64 * half + 16 * rb, kt0 = i0 >> 4;
        bf16x8 qf[2];
#pragma unroll
        for (int ks = 0; ks < 2; ++ks) qf[ks] = *(const GAS bf16x8*)(QB + (size_t)(mq0 + i0 + ln) * ATTW + head * 64 + 32 * ks + 8 * q4);
        f32x4 s[10];
#pragma unroll
        for (int j = 0; j < 10; ++j) { f32x4 acc = (f32x4){0.f, 0.f, 0.f, 0.f};
#pragma unroll
            for (int ks = 0; ks < 2; ++ks) { const bf16x8 kf = *(const LAS bf16x8*)(lds + AK_OFF + (16 * (kt0 + j) + ln) * AK_PITCH + (32 * ks + 8 * q4) * 2);
                acc = __builtin_amdgcn_mfma_f32_16x16x32_bf16(qf[ks], kf, acc, 0, 0, 0); }
            s[j] = acc; }
        float mx[4] = {-INFINITY, -INFINITY, -INFINITY, -INFINITY};
#pragma unroll
        for (int j = 0; j < 10; ++j) { const int kj = 16 * (kt0 + j) + ln;
#pragma unroll
            for (int r = 0; r < 4; ++r) { const int dist = 128 + i0 + 4 * q4 + r - kj; const bool ok = dist >= 0 && dist <= 128 && (blk > 0 || kj >= 128);
                const int dc = dist < 0 ? 0 : (dist > 128 ? 128 : dist);
                const float v = ok ? s[j][r] + bl[dc * 4 + g] : -INFINITY; s[j][r] = v; mx[r] = fmaxf(mx[r], v); } }
        float l[4];
#pragma unroll
        for (int r = 0; r < 4; ++r) { float m_ = mx[r]; m_ = fmaxf(m_, __shfl_xor(m_, 1)); m_ = fmaxf(m_, __shfl_xor(m_, 2)); m_ = fmaxf(m_, __shfl_xor(m_, 4)); m_ = fmaxf(m_, __shfl_xor(m_, 8));
            mx[r] = fmaxf(m_, sink2); l[r] = 0.f; }
#pragma unroll
        for (int j = 0; j < 10; ++j)
#pragma unroll
            for (int r = 0; r < 4; ++r) { const float p = __builtin_amdgcn_exp2f(s[j][r] - mx[r]); l[r] += p;
                *(LAS unsigned short*)(Pw + (4 * q4 + r) * AP_PITCH + (16 * j + ln) * 2) = f2bfs(p); }
#pragma unroll
        for (int r = 0; r < 4; ++r) { float t = l[r]; t += __shfl_xor(t, 1); t += __shfl_xor(t, 2); t += __shfl_xor(t, 4); t += __shfl_xor(t, 8);
            l[r] = __builtin_amdgcn_rcpf(t + __builtin_amdgcn_exp2f(sink2 - mx[r])); }
        f32x4 o[4];
#pragma unroll
        for (int dt = 0; dt < 4; ++dt) o[dt] = (f32x4){0.f, 0.f, 0.f, 0.f};
#pragma unroll
        for (int st = 0; st < 5; ++st) { const bf16x8 pf = *(const LAS bf16x8*)(Pw + ln * AP_PITCH + (32 * st + 8 * q4) * 2);
#pragma unroll
            for (int dt = 0; dt < 4; ++dt) { const bf16x8 vf = *(const LAS bf16x8*)(lds + AV_OFF + (16 * dt + ln) * AV_PITCH + (16 * kt0 + 32 * st + 8 * q4) * 2);
                o[dt] = __builtin_amdgcn_mfma_f32_16x16x32_bf16(pf, vf, o[dt], 0, 0, 0); } }
#pragma unroll
        for (int dt = 0; dt < 4; ++dt)
#pragma unroll
            for (int r = 0; r < 4; ++r) MX[(size_t)(mq0 + i0 + 4 * q4 + r) * DM + head * 64 + 16 * dt + ln] = f2bfs(o[dt][r] * l[r]);
    }
    __syncthreads();
}

__device__ __forceinline__ void dec_attn_unit(Frame& F, const Args& A, int du) {
    const int lane = F.lane, wave = F.wave; unsigned char* ws = F.ws;
    const int idx = du * 8 + wave, b = idx >> 4, head = idx & 15, hk = head >> 2, m = MP + b;
    LAS float* qs = (LAS float*)(F.lds + wave * 1024); LAS float* ps = qs + 64;
    const bf16* QB = (const bf16*)(ws + WS_QB); bf16* MX = (bf16*)(ws + WS_XB);
    const float* bt = (const float*)(ws + WS_BIAS);
    const float sink2 = A.in[13][head] * LOG2E;
    const float qv = bf2f(QB[(size_t)m * ATTW + head * 64 + lane]);
    qs[lane] = qv;
    LDS_WAIT(); asm volatile("" ::: "memory");
    float sc[2];
#pragma unroll
    for (int pi = 0; pi < 2; ++pi) { const int pos = lane + 64 * pi; const float* kr = A.in[2] + ((size_t)(b * WIN + pos) * NKVH + hk) * HD; float d = 0.f;
#pragma unroll
        for (int j = 0; j < 16; ++j) { const f32x4 k4 = *(const f32x4*)(kr + 4 * j); const f32x4 q4v = *(const LAS f32x4*)(qs + 4 * j); d += (k4.x * q4v.x + k4.y * q4v.y) + (k4.z * q4v.z + k4.w * q4v.w); }
        sc[pi] = d + bt[(WIN - pos) * NQH + head]; }
    const float* kn = F.out + O_KS + ((size_t)b * WIN + (WIN - 1)) * KVW + hk * HD; const float* vn = F.out + O_VS + ((size_t)b * WIN + (WIN - 1)) * KVW + hk * HD;
    const float snew = wave_sum(qv * kn[lane]) + bt[head];
    const float mx = fmaxf(fmaxf(wave_max(fmaxf(sc[0], sc[1])), snew), sink2);
    const float p0 = __builtin_amdgcn_exp2f(sc[0] - mx), p1 = __builtin_amdgcn_exp2f(sc[1] - mx), pn = __builtin_amdgcn_exp2f(snew - mx);
    const float linv = __builtin_amdgcn_rcpf(wave_sum(p0 + p1) + pn + __builtin_amdgcn_exp2f(sink2 - mx));
    ps[lane] = p0; ps[lane + 64] = p1;
    LDS_WAIT(); asm volatile("" ::: "memory");
    const float* vr = A.in[3] + ((size_t)(b * WIN) * NKVH + hk) * HD + lane; float o = pn * vn[lane];
#pragma unroll 8
    for (int pos = 0; pos < WIN; ++pos) o += ps[pos] * vr[(size_t)pos * NKVH * HD];
    MX[(size_t)m * DM + head * 64 + lane] = f2bfs(o * linv);
    LDS_WAIT(); asm volatile("" ::: "memory");
}

constexpr int SC_T = 32, SC_REC = 1344  , SC_BUF = SC_T * SC_REC  ;
struct ScanRegs { v4u kk, bb, kp, rr, vv; f32x4 d0, d1; };
__device__ __forceinline__ void scan_load(ScanRegs& R, const unsigned char* ws, int m, int h, int rq, int part) {
    const size_t o = (size_t)m * RWW + 64 * h + 8 * part;
    R.kk = *(const GAS v4u*)((const bf16*)(ws + WS_KK) + o); R.bb = *(const GAS v4u*)((const bf16*)(ws + WS_BB) + o);
    R.kp = *(const GAS v4u*)((const bf16*)(ws + WS_KP) + o); R.rr = *(const GAS v4u*)((const bf16*)(ws + WS_RR) + o);
    R.d0 = *(const GAS f32x4*)((const float*)(ws + WS_DD) + o); R.d1 = *(const GAS f32x4*)((const float*)(ws + WS_DD) + o + 4);
    R.vv = (v4u){0u, 0u, 0u, 0u};
    if (part < 2) R.vv = *(const GAS v4u*)((const bf16*)(ws + WS_VV) + (size_t)m * RWW + 64 * h + 16 * rq + 8 * part);
}
__device__ __forceinline__ void st8(LAS unsigned char* p, v4u u) {
    *(LAS f32x4*)p = (f32x4){__builtin_bit_cast(float, u.x << 16), __builtin_bit_cast(float, u.x & 0xffff0000u), __builtin_bit_cast(float, u.y << 16), __builtin_bit_cast(float, u.y & 0xffff0000u)};
    *(LAS f32x4*)(p + 16) = (f32x4){__builtin_bit_cast(float, u.z << 16), __builtin_bit_cast(float, u.z & 0xffff0000u), __builtin_bit_cast(float, u.w << 16), __builtin_bit_cast(float, u.w & 0xffff0000u)};
}
__device__ __forceinline__ void scan_store(const ScanRegs& R, LAS unsigned char* rec, int part) {
    st8(rec + 0 + 32 * part, R.kk); *(LAS f32x4*)(rec + 256 + 32 * part) = R.d0; *(LAS f32x4*)(rec + 256 + 32 * part + 16) = R.d1;
    st8(rec + 512 + 32 * part, R.bb); st8(rec + 768 + 32 * part, R.kp); st8(rec + 1024 + 32 * part, R.rr);
    if (part < 2) st8(rec + 1280 + 32 * part, R.vv);
}
constexpr int SC_YOFF = 2 * SC_BUF, SC_YBUF = SC_T * 16 * 4 * 4  ;
static_assert(SC_YOFF + 2 * SC_YBUF <= RING_BYTES, "scan LDS");
struct ScanVec { f32x2 kk0, kk1, d0, d1, b0, b1, k0, k1, r0, r1; float v; };
__device__ __forceinline__ void scan_ld(ScanVec& x, const LAS unsigned char* base, const LAS unsigned char* vb, int t) {
    const f32x4 kk = *(const LAS f32x4*)(base + t * SC_REC), dd = *(const LAS f32x4*)(base + t * SC_REC + 256), bb = *(const LAS f32x4*)(base + t * SC_REC + 512),
                kp = *(const LAS f32x4*)(base + t * SC_REC + 768), rr = *(const LAS f32x4*)(base + t * SC_REC + 1024);
    x.kk0 = (f32x2){kk.x, kk.y}; x.kk1 = (f32x2){kk.z, kk.w}; x.d0 = (f32x2){dd.x, dd.y}; x.d1 = (f32x2){dd.z, dd.w}; x.b0 = (f32x2){bb.x, bb.y}; x.b1 = (f32x2){bb.z, bb.w};
    x.k0 = (f32x2){kp.x, kp.y}; x.k1 = (f32x2){kp.z, kp.w}; x.r0 = (f32x2){rr.x, rr.y}; x.r1 = (f32x2){rr.z, rr.w};
    x.v = *(const LAS float*)(vb + t * SC_REC);
}
__device__ __forceinline__ void scan_yflush(const LAS unsigned char* yb, float* YS, int ptid) {
#pragma unroll
    for (int i = 0; i < 2; ++i) { const int o = ptid + 256 * i, t = o >> 4, r = o & 15; const f32x4 q = *(const LAS f32x4*)(yb + o * 16);
        YS[(size_t)t * RWW + r] = (q.x + q.y) + (q.z + q.w); }
}
__device__ __forceinline__ void scan_unit(Frame& F, int c) {
    const int b = c >> 6, h = (c >> 2) & 15, rq = c & 3, lane = F.lane, wave = F.wave;
    unsigned char* ws = F.ws; LAS unsigned char* lds = F.lds;
    const int mb = b * SEQ; constexpr int NCH = SEQ / SC_T;
    if (wave >= 4) {
        const int ptid = F.tid - 256, tok = ptid >> 3, part = ptid & 7;
        float* YS = (float*)(ws + WS_ACT) + (size_t)mb * RWW + 64 * h + 16 * rq;
        ScanRegs cur, nxt;
        scan_load(cur, ws, mb + tok, h, rq, part);
        scan_load(nxt, ws, mb + SC_T + tok, h, rq, part);
        scan_store(cur, lds + tok * SC_REC, part);
        __syncthreads();
        for (int ch = 0; ch < NCH; ++ch) {
            cur = nxt;
            if (ch + 2 < NCH) scan_load(nxt, ws, mb + (ch + 2) * SC_T + tok, h, rq, part);
            if (ch + 1 < NCH) scan_store(cur, lds + ((ch + 1) & 1) * SC_BUF + tok * SC_REC, part);
            if (ch > 0) scan_yflush(lds + SC_YOFF + ((ch - 1) & 1) * SC_YBUF, YS + (size_t)(ch - 1) * SC_T * RWW, ptid);
            __syncthreads();
        }
        scan_yflush(lds + SC_YOFF + ((NCH - 1) & 1) * SC_YBUF, YS + (size_t)(NCH - 1) * SC_T * RWW, ptid);
    } else {
        const int rl = 4 * wave + (lane >> 4), p = lane & 15, row = 16 * rq + rl;
        f32x2 S0 = (f32x2){0.f, 0.f}, S1 = S0;
        __builtin_amdgcn_s_setprio(2);
        __syncthreads();
        for (int ch = 0; ch < NCH; ++ch) {
            const LAS unsigned char* base = lds + (ch & 1) * SC_BUF + p * 16;
            const LAS unsigned char* vb = lds + (ch & 1) * SC_BUF + 1280 + rl * 4;
            LAS unsigned char* yb = lds + SC_YOFF + (ch & 1) * SC_YBUF + (rl * 4 + (p & 3)) * 4;
            ScanVec cur; scan_ld(cur, base, vb, 0);
#pragma unroll
            for (int t = 0; t < SC_T; ++t) {
                ScanVec nxt; scan_ld(nxt, base, vb, t + 1 < SC_T ? t + 1 : t);
                f32x2 a = S0 * cur.kk0; a = S1 * cur.kk1 + a;
                const float sa = -allsum16(a.x + a.y);
                const f32x2 sa2 = (f32x2){sa, sa}, v2 = (f32x2){cur.v, cur.v};
                f32x2 u0 = cur.b0 * sa2, u1 = cur.b1 * sa2;
                u0 = S0 * cur.d0 + u0; u1 = S1 * cur.d1 + u1;
                S0 = cur.k0 * v2 + u0; S1 = cur.k1 * v2 + u1;
                f32x2 q = S0 * cur.r0; q = S1 * cur.r1 + q;
                float y = q.x + q.y; y += dpp_f<0x128>(y); y += dpp_f<0x124>(y);
                *(LAS float*)(yb + t * 256) = y;
                cur = nxt;
            }
            __syncthreads();
        }
        __builtin_amdgcn_s_setprio(0);
        *(f32x4*)(F.out + O_WP + ((size_t)(b * RWH + h) * HD + row) * HD + 4 * p) = (f32x4){S0.x, S0.y, S1.x, S1.y};
    }
}
__device__ __forceinline__ void dec_rwkv_unit(Frame& F, const Args& A, int du) {
    const int lane = F.lane, wave = F.wave; unsigned char* ws = F.ws;
    const int idx = du * 8 + wave, b = idx >> 4, h = idx & 15, m = MP + b;
    LAS float* vec = (LAS float*)(F.lds + wave * 1280);
    const size_t o = (size_t)m * RWW + 64 * h + lane;
    vec[lane] = bf2f(((const bf16*)(ws + WS_KK))[o]); vec[64 + lane] = ((const float*)(ws + WS_DD))[o]; vec[128 + lane] = bf2f(((const bf16*)(ws + WS_BB))[o]);
    vec[192 + lane] = bf2f(((const bf16*)(ws + WS_KP))[o]); vec[256 + lane] = bf2f(((const bf16*)(ws + WS_RR))[o]);
    const float vi = bf2f(((const bf16*)(ws + WS_VV))[o]);
    const size_t so = ((size_t)(b * RWH + h) * HD + lane) * HD;
    const float* Sp = A.in[4] + so; f32x4 S[16];
#pragma unroll
    for (int j = 0; j < 16; ++j) S[j] = *(const f32x4*)(Sp + 4 * j);
    LDS_WAIT(); asm volatile("" ::: "memory");
    float sa = 0.f;
#pragma unroll
    for (int j = 0; j < 16; ++j) { const f32x4 kk = *(const LAS f32x4*)(vec + 4 * j); sa += (S[j].x * kk.x + S[j].y * kk.y) + (S[j].z * kk.z + S[j].w * kk.w); asm volatile("" ::: "memory"); }
    sa = -sa; float y = 0.f; float* So = F.out + O_WS + so;
#pragma unroll
    for (int j = 0; j < 16; ++j) { const f32x4 dd = *(const LAS f32x4*)(vec + 64 + 4 * j), bb = *(const LAS f32x4*)(vec + 128 + 4 * j), kp = *(const LAS f32x4*)(vec + 192 + 4 * j), rr = *(const LAS f32x4*)(vec + 256 + 4 * j);
        S[j] = S[j] * dd + bb * sa + kp * vi; y += (S[j].x * rr.x + S[j].y * rr.y) + (S[j].z * rr.z + S[j].w * rr.w);
        *(f32x4*)(So + 4 * j) = S[j]; asm volatile("" ::: "memory"); }
    ((float*)(ws + WS_ACT))[o] = y;
    LDS_WAIT(); asm volatile("" ::: "memory");
}

constexpr int SK_S = 4;
__device__ __forceinline__ void skinny_units(Frame& F, const bf16* Arows, int lda, const bf16* Bt, int K, unsigned* cnt, float* slabs,
                                             const float* xi_s, float* xo_s, bf16* XBd, float* ssq, float alpha) {
    const int tid = F.tid, lane = F.lane, wave = F.wave, ln = lane & 15, q4 = lane >> 4, ksteps = K / 32;
    LAS unsigned char* lds = F.lds;
    for (int u = blockIdx.x; u < 32 * SK_S; u += F.G) {
        const int nb = u & 31, sl = u >> 5, n0 = 64 * nb, ks0 = sl * ksteps / SK_S, ks1 = (sl + 1) * ksteps / SK_S;
        f32x4 acc[2][4];
#pragma unroll
        for (int mt = 0; mt < 2; ++mt)
#pragma unroll
            for (int nt = 0; nt < 4; ++nt) acc[mt][nt] = (f32x4){0.f, 0.f, 0.f, 0.f};
        const bf16* ap = Arows + (size_t)ln * lda + 8 * q4; const bf16* bp = Bt + (size_t)(n0 + ln) * K + 8 * q4;
#pragma unroll 2
        for (int ks = ks0 + wave; ks < ks1; ks += 8) { const int k = 32 * ks;
            bf16x8 a[2], b[4];
#pragma unroll
            for (int mt = 0; mt < 2; ++mt) a[mt] = *(const GAS bf16x8*)(ap + (size_t)(16 * mt) * lda + k);
#pragma unroll
            for (int nt = 0; nt < 4; ++nt) b[nt] = *(const GAS bf16x8*)(bp + (size_t)(16 * nt) * K + k);
#pragma unroll
            for (int mt = 0; mt < 2; ++mt)
#pragma unroll
                for (int nt = 0; nt < 4; ++nt) acc[mt][nt] = __builtin_amdgcn_mfma_f32_16x16x32_bf16(a[mt], b[nt], acc[mt][nt], 0, 0, 0); }
#pragma unroll
        for (int mt = 0; mt < 2; ++mt)
#pragma unroll
            for (int nt = 0; nt < 4; ++nt) *(LAS f32x4*)(lds + ((wave * 8 + mt * 4 + nt) * 64 + lane) * 16) = acc[mt][nt];
        __syncthreads();
        { const int tile = tid >> 6, l = tid & 63; f32x4 sum = (f32x4){0.f, 0.f, 0.f, 0.f};
#pragma unroll
          for (int w = 0; w < 8; ++w) sum += *(const LAS f32x4*)(lds + ((w * 8 + tile) * 64 + l) * 16);
          float* sp = slabs + (size_t)sl * 32 * DM + (size_t)(16 * (tile >> 2) + 4 * (l >> 4)) * DM + n0 + 16 * (tile & 3) + (l & 15);
          sp[0] = sum.x; sp[DM] = sum.y; sp[2 * DM] = sum.z; sp[3 * DM] = sum.w; }
        VM_WAIT(); __syncthreads();
        if (tid == 0) { __builtin_amdgcn_fence(__ATOMIC_RELEASE, "agent"); VM_WAIT();
            const unsigned t = __hip_atomic_fetch_add(cnt + nb, 1u, __ATOMIC_RELAXED, __HIP_MEMORY_SCOPE_AGENT);
            const unsigned last = (t == (unsigned)(SK_S - 1)) ? 1u : 0u;
            if (last) { __builtin_amdgcn_fence(__ATOMIC_ACQUIRE, "agent"); VM_WAIT(); }
            *(LAS unsigned*)(lds + 65536) = last; }
        __syncthreads();
        const unsigned last = *(const LAS unsigned*)(lds + 65536);
        if (last) {
            const int row = tid >> 4, c4 = (tid & 15) * 4, col = n0 + c4;
            f32x4 a4 = (f32x4){0.f, 0.f, 0.f, 0.f};
#pragma unroll
            for (int s2 = 0; s2 < SK_S; ++s2) a4 += *(const GAS f32x4*)(slabs + (size_t)s2 * 32 * DM + (size_t)row * DM + col);
            const f32x4 x0 = *(const f32x4*)(xi_s + (size_t)row * DM + col);
            const f32x4 y = x0 + a4 * alpha;
            *(f32x4*)(xo_s + (size_t)row * DM + col) = y;
            if (XBd) *(GAS unsigned long long*)(XBd + (size_t)(MP + row) * DM + col) = (unsigned long long)pk2(y.x, y.y) | ((unsigned long long)pk2(y.z, y.w) << 32);
            float sq = (y.x * y.x + y.y * y.y) + (y.z * y.z + y.w * y.w);
            sq += __shfl_xor(sq, 1); sq += __shfl_xor(sq, 2); sq += __shfl_xor(sq, 4); sq += __shfl_xor(sq, 8);
            if ((tid & 15) == 0) atomicAdd(ssq + MP + row, sq);
        }
        __syncthreads();
    }
}
__global__ void __launch_bounds__(NWAVES * 64, 2) hymba_fwd(Args args) {
    extern __shared__ __attribute__((aligned(16))) unsigned char lds_raw[];
    { const int t0_ = threadIdx.x;
      for (int u = t0_; u < (LDS_BYTES - LDSCTL_OFF) / 4; u += NWAVES * 64) ((LAS unsigned*)((LAS unsigned char*)lds_raw + LDSCTL_OFF))[u] = 0u; }
    __syncthreads();
    XcdBarrier bar; bar.bar = (unsigned*)((gu32*)(args.ws + WS_CTL) + CW_BAR); bar.x = 0; bar.st = nullptr;
    if (MK_N_LAUNCHES == 1) bar = xcd_barrier_post((unsigned*)((gu32*)(args.ws + WS_CTL) + CW_BAR), (volatile LAS unsigned*)((LAS unsigned char*)lds_raw + MISC_OFF) + 8);
    const int lo = args.ph_lo, hi = args.ph_hi;
#ifndef PH_MASK
#define PH_MASK 0x7ff
#endif
#define IN(k) (((PH_MASK >> (k)) & 1) && lo <= (k) && (k) < hi)
#define SEAM(k) do { if (IN(k) && IN((k) + 1)) xcd_barrier(bar); } while (0)
#ifndef PROBE_REP
#define PROBE_REP 0
#endif
#define NREP(k) (1 + ((PROBE_REP >> (k)) & 1))
#define PHASE_FRAME() Frame F; { int t_ = threadIdx.x; asm volatile("" : "+v"(t_)); F.lds = (LAS unsigned char*)lds_raw; F.MISC = (volatile LAS unsigned*)(F.lds + MISC_OFF); F.tid = t_; F.lane = t_ & 63; \
        F.wave = __builtin_amdgcn_readfirstlane(t_ >> 6); F.G = gridDim.x; F.out = args.out; F.ws = args.ws; F.ctl = (gu32*)(args.ws + WS_CTL); } \
    unsigned char* ws = F.ws; const int gw = blockIdx.x * NWAVES + F.wave, NGW = F.G * NWAVES; (void)gw; (void)NGW; \
    bf16* XB = (bf16*)(ws + WS_XB); bf16* ACT = (bf16*)(ws + WS_ACT); bf16* X2B = (bf16*)(ws + WS_X2B); (void)XB; (void)ACT; (void)X2B; \
    float* ssq0 = (float*)(F.ctl + CW_SSQ0); float* ssq1 = (float*)(F.ctl + CW_SSQ1); float* ssq2 = (float*)(F.ctl + CW_SSQ2); float* ssq3 = (float*)(F.ctl + CW_SSQ3); float* ssqd = (float*)(F.ctl + CW_SSQD); (void)ssqd; (void)ssq0; (void)ssq1; (void)ssq2; (void)ssq3; \
    float* yp = args.out + O_YP; float* ys = args.out + O_YS; (void)yp; (void)ys;

    if (IN(0)) for (int rep = 0; rep < NREP(0); ++rep) { PHASE_FRAME(); p0_prologue(F, args); if (rep + 1 < NREP(0)) xcd_barrier(bar); else SEAM(0); }
    if (IN(1)) for (int rep = 0; rep < NREP(1); ++rep) { PHASE_FRAME(); pg8::Gemm g{XB, (const bf16*)(ws + WS_WGU1), MPAD, 2 * DFF, DM}; pg8::StaticOrder S; S.init(MPAD, 2 * DFF, F.G, (int)blockIdx.x);
        pg8::EpiSwiglu E{ACT, ssq0};
        pg8::gemm_phase<pg8::EpiSwiglu, pg8::StaticOrder, true, true>(F.lds + RING_OFF, g, S, E); if (rep + 1 < NREP(1)) xcd_barrier(bar); else SEAM(1); }
    if (IN(2)) for (int rep = 0; rep < NREP(2); ++rep) { PHASE_FRAME(); pg8::Gemm g{ACT, (const bf16*)(ws + WS_WD1), MP, DM, DFF}; pg8::StaticOrder S; S.init(MP, DM, F.G, (int)blockIdx.x);
        pg8::EpiResid E{args.in[0], args.in[1], yp, ys, XB, rep ? ssqd : ssq1, 0.5f};
        pg8::gemm_phase<pg8::EpiResid, pg8::StaticOrder, true, true>(F.lds + RING_OFF, g, S, E);
        skinny_units(F, ACT + (size_t)MP * DFF, DFF, (const bf16*)(ws + WS_WD1), DFF, (unsigned*)(F.ctl + CW_SKC + 64 * rep), (float*)(ws + WS_SLAB), args.in[1], ys, XB, rep ? ssqd : ssq1, 0.5f);
        if (rep + 1 < NREP(2)) xcd_barrier(bar); else SEAM(2); }
    if (IN(3)) for (int rep = 0; rep < NREP(3); ++rep) { PHASE_FRAME(); pg8::Gemm g{XB, (const bf16*)(ws + WS_WINB), MPAD, INC, DM}; pg8::StaticOrder S; S.init(MPAD, INC, F.G, (int)blockIdx.x);
        pg8::EpiWin E{ssq1, (bf16*)(ws + WS_QB), (bf16*)(ws + WS_KB), (bf16*)(ws + WS_VB), (float*)(ws + WS_ACT), args.out};
        pg8::gemm_phase<pg8::EpiWin, pg8::StaticOrder, true, true>(F.lds + RING_OFF, g, S, E); if (rep + 1 < NREP(3)) xcd_barrier(bar); else SEAM(3); }
    if (IN(4)) for (int rep = 0; rep < NREP(4); ++rep) { PHASE_FRAME();
        for (int u = blockIdx.x; u < NB * 16 * NKVH; u += F.G) attn_unit(F, args, u >> 6, (u >> 2) & 15, u & 3);
        for (int u = blockIdx.x; u < PREP_UNITS; u += F.G) prep_unit(F, args, u >> 4, u & 15);
        __syncthreads();
        for (int u = (int)F.G - 1 - (int)blockIdx.x; u < NDEC * NQH / 8; u += F.G) dec_attn_unit(F, args, u);
        __syncthreads();
        { const int n4 = NDEC * (WIN - 1) * KVW / 4;
          for (int i = blockIdx.x * (NWAVES * 64) + F.tid; i < 2 * n4; i += F.G * NWAVES * 64) { const int t = i >= n4, j = t ? i - n4 : i; const int bb = j / ((WIN - 1) * KVW / 4), r = j % ((WIN - 1) * KVW / 4);
              const f32x4 v = *((const f32x4*)(args.in[2 + t] + (size_t)bb * WIN * KVW + KVW) + r);
              *((f32x4*)(args.out + (t ? O_VS : O_KS) + (size_t)bb * WIN * KVW) + r) = v; } }
        if (rep + 1 < NREP(4)) xcd_barrier(bar); else SEAM(4); }
    if (IN(5)) for (int rep = 0; rep < NREP(5); ++rep) { PHASE_FRAME();
        for (int u = blockIdx.x; u < NB * RWH * 4; u += F.G) scan_unit(F, u);
        __syncthreads();
        for (int u = blockIdx.x; u < NDEC * RWH / 8; u += F.G) dec_rwkv_unit(F, args, u);
        if (rep + 1 < NREP(5)) xcd_barrier(bar); else SEAM(5); }
    if (IN(6)) for (int rep = 0; rep < NREP(6); ++rep) { PHASE_FRAME(); const float* YS = (const float*)(ws + WS_ACT); const bf16* LG = (const bf16*)(ws + WS_LG); const bf16* EE = (const bf16*)(ws + WS_EE);
        for (int u = gw; u < MV * RWH; u += NGW) { const size_t o = (size_t)(u >> 4) * RWW + 64 * (u & 15) + F.lane;
            const float y = YS[o], mean = wave_sum(y) * (1.0f / 64.0f), dl = y - mean, var = wave_sum(dl * dl) * (1.0f / 64.0f);
            const float r = dl * __builtin_amdgcn_rsqf(var + GN_EPS) * bf2f(LG[o]) + bf2f(EE[o]);
            XB[(size_t)(u >> 4) * DM + ATTW + 64 * (u & 15) + F.lane] = f2bfs(r); }
        if (rep + 1 < NREP(6)) xcd_barrier(bar); else SEAM(6); }
    if (IN(7)) for (int rep = 0; rep < NREP(7); ++rep) { PHASE_FRAME(); pg8::Gemm g{XB, (const bf16*)(ws + WS_WOUT), MP, DM, DM}; pg8::StaticOrder S; S.init(MP, DM, F.G, (int)blockIdx.x);
        pg8::EpiResid E{yp, ys, yp, ys, rep ? nullptr : X2B, rep ? ssqd : ssq2, rep ? 0.0f : 1.0f};
        pg8::gemm_phase<pg8::EpiResid, pg8::StaticOrder, true, true>(F.lds + RING_OFF, g, S, E);
        skinny_units(F, XB + (size_t)MP * DM, DM, (const bf16*)(ws + WS_WOUT), DM, (unsigned*)(F.ctl + CW_SKC + 128 + 64 * rep), (float*)(ws + WS_SLAB), ys, ys, rep ? nullptr : X2B, rep ? ssqd : ssq2, rep ? 0.0f : 1.0f);
        if (rep + 1 < NREP(7)) xcd_barrier(bar); else SEAM(7); }
    if (IN(8)) for (int rep = 0; rep < NREP(8); ++rep) { PHASE_FRAME(); pg8::Gemm g{X2B, (const bf16*)(ws + WS_WGU2), MPAD, 2 * DFF, DM}; pg8::StaticOrder S; S.init(MPAD, 2 * DFF, F.G, (int)blockIdx.x);
        pg8::EpiSwiglu E{ACT, ssq2};
        pg8::gemm_phase<pg8::EpiSwiglu, pg8::StaticOrder, true, true>(F.lds + RING_OFF, g, S, E); if (rep + 1 < NREP(8)) xcd_barrier(bar); else SEAM(8); }
    if (IN(9)) for (int rep = 0; rep < NREP(9); ++rep) { PHASE_FRAME(); pg8::Gemm g{ACT, (const bf16*)(ws + WS_WD2), MP, DM, DFF}; pg8::StaticOrder S; S.init(MP, DM, F.G, (int)blockIdx.x);
        pg8::EpiResid E{yp, ys, yp, ys, nullptr, rep ? ssqd : ssq3, rep ? 0.0f : 0.5f};
        pg8::gemm_phase<pg8::EpiResid, pg8::StaticOrder, true, true>(F.lds + RING_OFF, g, S, E);
        skinny_units(F, ACT + (size_t)MP * DFF, DFF, (const bf16*)(ws + WS_WD2), DFF, (unsigned*)(F.ctl + CW_SKC + 256 + 64 * rep), (float*)(ws + WS_SLAB), ys, ys, nullptr, rep ? ssqd : ssq3, rep ? 0.0f : 0.5f);
        if (rep + 1 < NREP(9)) xcd_barrier(bar); else SEAM(9); }
    if (IN(10)) for (int rep = 0; rep < NREP(10); ++rep) { PHASE_FRAME(); const float* fn = args.in[30];
        for (int m = gw; m < MV; m += NGW) { float* xr = m < MP ? yp + (size_t)m * DM : ys + (size_t)(m - MP) * DM;
            const float s = rep ? 1.0f : __builtin_amdgcn_rsqf(ssq3[m] * (1.0f / DM) + RMS_EPS);
            GAS f32x4* x4 = (GAS f32x4*)xr + F.lane; const GAS f32x4* f4 = (const GAS f32x4*)fn + F.lane;
#pragma unroll
            for (int j = 0; j < 8; ++j) x4[64 * j] = rep ? x4[64 * j] * s : x4[64 * j] * s * f4[64 * j]; } if (NREP(10) > 1 && rep == 0) xcd_barrier(bar); }
#undef IN
#undef SEAM
}

extern "C" void kernel_launch(void* const* d_in, const int* in_sizes, int n_in, void* d_out, int out_size, void* d_ws, size_t ws_size, hipStream_t stream) {
    static int grid = 0;
    if (grid == 0) {
        if (n_in != 31 || in_sizes[0] != MP * DM || (size_t)out_size != O_END || ws_size < WS_END2) {
            fprintf(stderr, "kernel_launch: unexpected shapes: n_in %d in0 %d out %d (want %zu) ws %zu (want >= %zu); nothing launched\n", n_in, n_in > 0 ? in_sizes[0] : -1, out_size, (size_t)O_END, ws_size, (size_t)WS_END2);
            grid = -1; return; }
        int dev = 0, cus = 0, per_cu = 0;
        if (hipGetDevice(&dev) != hipSuccess || hipDeviceGetAttribute(&cus, hipDeviceAttributeMultiprocessorCount, dev) != hipSuccess) { fprintf(stderr, "kernel_launch: device query failed\n"); grid = -1; return; }
        if (hipFuncSetAttribute((const void*)hymba_fwd, hipFuncAttributeMaxDynamicSharedMemorySize, LDS_BYTES) != hipSuccess) { fprintf(stderr, "kernel_launch: hipFuncSetAttribute failed\n"); grid = -1; return; }
        if (hipOccupancyMaxActiveBlocksPerMultiprocessor(&per_cu, (const void*)hymba_fwd, NWAVES * 64, LDS_BYTES) != hipSuccess || per_cu < 1)
            fprintf(stderr, "kernel_launch: note: occupancy query reports %d workgroups per CU\n", per_cu);
        (void)hipGetLastError();
        grid = cus;
    }
    if (grid < 0) return;
    if (hipMemsetAsync((char*)d_ws + WS_CTL, 0, CTL_ZERO_BYTES, stream) != hipSuccess) { fprintf(stderr, "kernel_launch: hipMemsetAsync failed\n"); return; }
    Args a{};
    for (int i = 0; i < 31; ++i) a.in[i] = (const float*)d_in[i];
    a.out = (float*)d_out; a.ws = (unsigned char*)d_ws;
    for (int li = 0; li < MK_N_LAUNCHES; ++li) {
        a.ph_lo = (MK_N_LAUNCHES == 1) ? 0 : li; a.ph_hi = (MK_N_LAUNCHES == 1) ? NPHASES : li + 1; a.li = li;
        hipLaunchKernelGGL(hymba_fwd, dim3(grid), dim3(NWAVES * 64), LDS_BYTES, stream, a);
        const hipError_t le = hipPeekAtLastError();
        if (le != hipSuccess) { fprintf(stderr, "kernel_launch: launch %d failed: %s\n", li, hipGetErrorName(le)); break; }
    }
}
```

```cpp
#include <hip/hip_runtime.h>
#include <cstdio>
#include <cstdint>
#define MK_N_LAUNCHES 1
constexpr int DM = 2048, SEQ = 2048, NB = 4, MP = NB * SEQ  , NDEC = 32, MV = MP + NDEC  , MPAD = 8448  ;
constexpr int DFF = 5504, ATTW = 1024, KVW = 256, RWW = 1024, NQH = 16, NKVH = 4, HD = 64, RWH = 16, WIN = 128;
constexpr int ATT_COLS = ATTW + 2 * KVW  , SHC = 3 * RWW + 64 + 64 + 128  , INC = ATT_COLS + SHC  ;
constexpr float RMS_EPS = 1e-5f, GN_EPS = 64e-5f, LOG2E = 1.4426950408889634f;
constexpr float QSCALE = 0.125f * LOG2E;
constexpr size_t O_YP = 0, O_YS = O_YP + (size_t)MP * DM, O_KP = O_YS + (size_t)NDEC * DM, O_VP = O_KP + (size_t)NB * WIN * KVW, O_WP = O_VP + (size_t)NB * WIN * KVW,
                 O_SP = O_WP + (size_t)NB * RWH * HD * HD, O_KS = O_SP + (size_t)NB * SHC, O_VS = O_KS + (size_t)NDEC * WIN * KVW, O_WS = O_VS + (size_t)NDEC * WIN * KVW,
                 O_SS = O_WS + (size_t)NDEC * RWH * HD * HD, O_END = O_SS + (size_t)NDEC * SHC;
namespace pg8 {
#define PG8_LAS __attribute__((address_space(3)))
typedef unsigned short bf16_t;
typedef short bf16x8 __attribute__((ext_vector_type(8)));
typedef float f32x4 __attribute__((ext_vector_type(4)));
typedef unsigned u32x4 __attribute__((ext_vector_type(4)));
constexpr int BM = 256, BK = 64, HALF = 128, HTB = HALF * BK * 2  , STAGE_BYTES = 8 * HTB, NXCD = 8, WGM = 8;

__host__ __device__ __forceinline__ int lds_byte(int r, int c) { const int st = (r >> 4) * 2 + (c >> 5), rr = r & 15, cc = c & 31, ob = rr * 64 + cc * 2; return st * 1024 + (ob ^ (((ob >> 9) & 1) << 5)); }
__host__ __device__ __forceinline__ void stage_rc(int b, int& R, int& C) { const int st = b / 1024, sb = b % 1024, swz = sb ^ (((sb >> 9) & 1) << 5); R = (st >> 1) * 16 + swz / 64; C = (st & 1) * 32 + (swz % 64) / 2; }
__host__ __device__ __forceinline__ int perm32(int rho) { const int n = rho >> 4, i = rho & 15; return 8 * (i >> 2) + 4 * n + (i & 3); }

struct Unit { int pm, pn; };
struct Gemm { const bf16_t* A; const bf16_t* Bt; int M, N, K; };

struct StaticOrder {
    int nM, nN, nwg, G, c;
    __host__ __device__ void init(int M, int N, int G_, int c_) { nM = M / BM; nN = N / BM; nwg = nM * nN; G = G_; c = c_; }
    __host__ __device__ bool next(int i, Unit& u) const {
        const long L = (long)i * G + c; if (L >= nwg) return false;
        int wgid = (int)L; { const int q = nwg / NXCD, r = nwg % NXCD, xcd = wgid % NXCD, off = wgid / NXCD; wgid = (xcd < r ? xcd * (q + 1) : r * (q + 1) + (xcd - r) * q) + off; }
        const int nig = WGM * nN, gid = wgid / nig, fm = gid * WGM, gsz = (nM - fm) < WGM ? (nM - fm) : WGM;
        u.pm = fm + ((wgid % nig) % gsz); u.pn = (wgid % nig) / gsz; return true;
    }
    __device__ __forceinline__ void a_ready(const Unit&) const {}
    __device__ __forceinline__ void done(const Unit&) const {}
};

__device__ __forceinline__ unsigned cvt_pk_bf16(float lo, float hi) { unsigned r; asm volatile("v_cvt_pk_bf16_f32 %0, %1, %2" : "=v"(r) : "v"(lo), "v"(hi)); return r; }
__device__ __forceinline__ float silu_mul(float g, float u) { return g * u * __builtin_amdgcn_rcpf(1.0f + __builtin_amdgcn_exp2f(-g * LOG2E)); }

struct EpiSwiglu {
    static constexpr bool PERM = true, AFTER_DRAIN = false;
    bf16_t* O; const float* ssq;
    __device__ __forceinline__ void operator()(const f32x4 (&acc)[2][2][4][2], const Unit& u, int wr, int wc, int fr, int fq) const {
        const int row0 = u.pm * BM + wr * 64 + fr, col0 = u.pn * HALF + wc * 32 + 8 * fq;
#pragma unroll
        for (int ai = 0; ai < 2; ++ai)
#pragma unroll
            for (int m = 0; m < 4; ++m) { const int row = row0 + ai * HALF + m * 16;
                const float s = __builtin_amdgcn_rsqf(ssq[row] * (1.0f / DM) + RMS_EPS);
                const f32x4 g0 = acc[ai][0][m][0] * s, g1 = acc[ai][0][m][1] * s, u0 = acc[ai][1][m][0] * s, u1 = acc[ai][1][m][1] * s;
                u32x4 w; w.x = cvt_pk_bf16(silu_mul(g0[0], u0[0]), silu_mul(g0[1], u0[1])); w.y = cvt_pk_bf16(silu_mul(g0[2], u0[2]), silu_mul(g0[3], u0[3]));
                w.z = cvt_pk_bf16(silu_mul(g1[0], u1[0]), silu_mul(g1[1], u1[1])); w.w = cvt_pk_bf16(silu_mul(g1[2], u1[2]), silu_mul(g1[3], u1[3]));
                *(u32x4*)(O + (size_t)row * DFF + col0) = w; }
    }
};

struct EpiResid {
    static constexpr bool PERM = true, AFTER_DRAIN = false;
    const float* xi_p; const float* xi_s; float* xo_p; float* xo_s; bf16_t* XB; float* ssq; float alpha;
    __device__ __forceinline__ void operator()(const f32x4 (&acc)[2][2][4][2], const Unit& u, int wr, int wc, int fr, int fq) const {
        const int row0 = u.pm * BM + wr * 64 + fr, col0 = u.pn * BM + wc * 32 + 8 * fq;
#pragma unroll
        for (int ai = 0; ai < 2; ++ai)
#pragma unroll
            for (int m = 0; m < 4; ++m) { const int row = row0 + ai * HALF + m * 16; const bool valid = row < MV;
                const size_t ro = row < MP ? (size_t)row * DM : (size_t)(row - MP) * DM;
                const float* src = (row < MP ? xi_p : xi_s) + ro; float* dst = (row < MP ? xo_p : xo_s) + ro;
                float sq = 0.f;
#pragma unroll
                for (int bj = 0; bj < 2; ++bj) { const int col = col0 + bj * HALF;
                    f32x4 x0 = (f32x4){0.f, 0.f, 0.f, 0.f}, x1 = x0;
                    if (valid) { x0 = *(const f32x4*)(src + col); x1 = *(const f32x4*)(src + col + 4); }
                    const f32x4 y0 = x0 + acc[ai][bj][m][0] * alpha, y1 = x1 + acc[ai][bj][m][1] * alpha;
                    if (valid) { *(f32x4*)(dst + col) = y0; *(f32x4*)(dst + col + 4) = y1; }
                    sq += (y0[0] * y0[0] + y0[1] * y0[1]) + (y0[2] * y0[2] + y0[3] * y0[3]) + (y1[0] * y1[0] + y1[1] * y1[1]) + (y1[2] * y1[2] + y1[3] * y1[3]);
                    if (XB) { u32x4 w; w.x = cvt_pk_bf16(y0[0], y0[1]); w.y = cvt_pk_bf16(y0[2], y0[3]); w.z = cvt_pk_bf16(y1[0], y1[1]); w.w = cvt_pk_bf16(y1[2], y1[3]);
                        *(u32x4*)(XB + (size_t)row * DM + col) = w; } }
                sq += __shfl_xor(sq, 16); sq += __shfl_xor(sq, 32);
                if (fq == 0 && valid) atomicAdd(ssq + row, sq); }
    }
};

struct EpiWin {
    static constexpr bool PERM = true, AFTER_DRAIN = false;
    const float* ssq; bf16_t* QB; bf16_t* KB; bf16_t* VB; float* PR; float* out;
    __device__ __forceinline__ void operator()(const f32x4 (&acc)[2][2][4][2], const Unit& u, int wr, int wc, int fr, int fq) const {
        const int row0 = u.pm * BM + wr * 64 + fr, cl0 = wc * 32 + 8 * fq;
        const int pn = u.pn;
#pragma unroll
        for (int ai = 0; ai < 2; ++ai)
#pragma unroll
            for (int m = 0; m < 4; ++m) { const int row = row0 + ai * HALF + m * 16; const bool valid = row < MV;
                float s = __builtin_amdgcn_rsqf(ssq[row] * (1.0f / DM) + RMS_EPS);
                if (pn < 4) s *= QSCALE;
#pragma unroll
                for (int bj = 0; bj < 2; ++bj) { const int cl = cl0 + bj * HALF;
                    const f32x4 y0 = acc[ai][bj][m][0] * s, y1 = acc[ai][bj][m][1] * s;
                    if (pn < 6) { u32x4 w; w.x = cvt_pk_bf16(y0[0], y0[1]); w.y = cvt_pk_bf16(y0[2], y0[3]); w.z = cvt_pk_bf16(y1[0], y1[1]); w.w = cvt_pk_bf16(y1[2], y1[3]);
                        if (pn < 4) *(u32x4*)(QB + (size_t)row * ATTW + pn * BM + cl) = w;
                        else { *(u32x4*)((pn == 4 ? KB : VB) + (size_t)row * KVW + cl) = w;
                            if (valid) { float* o = nullptr;
                                if (row >= MP) o = out + (pn == 4 ? O_KS : O_VS) + ((size_t)(row - MP) * WIN + (WIN - 1)) * KVW + cl;
                                else if ((row & (SEQ - 1)) >= SEQ - WIN) o = out + (pn == 4 ? O_KP : O_VP) + ((size_t)(row >> 11) * WIN + ((row & (SEQ - 1)) - (SEQ - WIN))) * KVW + cl;
                                if (o) { *(f32x4*)o = y0; *(f32x4*)(o + 4) = y1; } } }
                    } else { const int cs = (pn - 6) * BM + cl;
                        *(f32x4*)(PR + (size_t)row * SHC + cs) = y0; *(f32x4*)(PR + (size_t)row * SHC + cs + 4) = y1;
                        if (valid) { float* o = nullptr;
                            if (row >= MP) o = out + O_SS + (size_t)(row - MP) * SHC + cs;
                            else if ((row & (SEQ - 1)) == SEQ - 1) o = out + O_SP + (size_t)(row >> 11) * SHC + cs;
                            if (o) { *(f32x4*)o = y0; *(f32x4*)(o + 4) = y1; } } } }
            }
    }
};
template <class Epi, class Sched, bool ALIGN_EPI = false, bool SP2 = false>
__device__ __forceinline__ void gemm_phase(PG8_LAS unsigned char* lds, const Gemm g, const Sched& S, const Epi& E) {
    int tid_ = threadIdx.x; asm volatile("" : "+v"(tid_)); const int tid = tid_, wid = __builtin_amdgcn_readfirstlane(tid >> 6), lane = tid & 63, wr = wid >> 2, wc = wid & 3, fr = lane & 15, fq = lane >> 4;
    const int K = g.K, nt = K / BK;
    unsigned voffA[2], voffB[2];
#pragma unroll
    for (int i = 0; i < 2; ++i) { int R, C; stage_rc(tid * 16 + i * 8192, R, C); const int Rb = Epi::PERM ? ((R & ~31) + perm32(R & 31)) : R;
        voffA[i] = (unsigned)(R * K + C) * 2u; voffB[i] = (unsigned)(Rb * K + C) * 2u; }
    const size_t kstep = (size_t)(BK * 2);
    const size_t hstep = (size_t)HALF * K * 2;
    const size_t tstep = 2 * hstep;
    const unsigned ldsw = (unsigned)wid * 1024u;
    const int aoff = lds_byte(wr * 64 + fr, fq * 8), boff = lds_byte(wc * 32 + fr, fq * 8);
#define PG8_SA(b, h) (((b) * 2 + (h)) * HTB)
#define PG8_SB(b, h) ((4 + (b) * 2 + (h)) * HTB)
#define PG8_STAGE(bufoff, gbase, voff) do { _Pragma("unroll") for (int _i = 0; _i < 2; ++_i) \
        __builtin_amdgcn_global_load_lds((const unsigned*)((const char*)(gbase) + (voff)[_i]), (PG8_LAS unsigned*)(lds + (bufoff) + ldsw + _i * 8192), 16, 0, 0); } while (0)
#define PG8_LDA(dst, b, h) do { _Pragma("unroll") for (int m = 0; m < 4; ++m) _Pragma("unroll") for (int k = 0; k < 2; ++k) dst[m][k] = *(const PG8_LAS bf16x8*)(lds + PG8_SA(b, h) + aoff + m * 2048 + k * 1024); } while (0)
#define PG8_LDB(dst, b, h) do { _Pragma("unroll") for (int n = 0; n < 2; ++n) _Pragma("unroll") for (int k = 0; k < 2; ++k) dst[n][k] = *(const PG8_LAS bf16x8*)(lds + PG8_SB(b, h) + boff + n * 2048 + k * 1024); } while (0)
#define PG8_MMA(ai, bj, At, Bt) do { __builtin_amdgcn_s_setprio(1); _Pragma("unroll") for (int m = 0; m < 4; ++m) _Pragma("unroll") for (int n = 0; n < 2; ++n) _Pragma("unroll") for (int k = 0; k < 2; ++k) \
        acc[ai][bj][m][n] = __builtin_amdgcn_mfma_f32_16x16x32_bf16(Bt[n][k], At[m][k], acc[ai][bj][m][n], 0, 0, 0); __builtin_amdgcn_s_setprio(0); } while (0)
#define PG8_WAIT_V(n) asm volatile("s_waitcnt vmcnt(" #n ")" ::: "memory")
#define PG8_WAIT_L(n) asm volatile("s_waitcnt lgkmcnt(" #n ")" ::: "memory")
#define PG8_BAR __builtin_amdgcn_s_barrier()
#define PG8_SCHED __builtin_amdgcn_sched_barrier(0)
    Unit cur, nxt; int ui = 0;
    if (!S.next(0, cur)) return;
    f32x4 acc[2][2][4][2];
#pragma unroll
    for (int a = 0; a < 2; ++a)
#pragma unroll
        for (int b = 0; b < 2; ++b)
#pragma unroll
            for (int m = 0; m < 4; ++m)
#pragma unroll
                for (int n = 0; n < 2; ++n) acc[a][b][m][n] = (f32x4){0.f, 0.f, 0.f, 0.f};
    bf16x8 At[4][2], B0[2][2], B1[2][2];
    const char* cA = (const char*)g.A + (size_t)cur.pm * tstep; const char* cB = (const char*)g.Bt + (size_t)cur.pn * tstep;
    S.a_ready(cur);
    if constexpr (SP2) {
        PG8_STAGE(PG8_SB(0, 0), cB, voffB); PG8_STAGE(PG8_SB(0, 1), cB + hstep, voffB); PG8_STAGE(PG8_SA(0, 0), cA, voffA); PG8_STAGE(PG8_SA(0, 1), cA + hstep, voffA);
        if (wr == 1) PG8_BAR;
        PG8_WAIT_V(2); PG8_BAR;
        PG8_STAGE(PG8_SB(1, 0), cB + kstep, voffB); PG8_STAGE(PG8_SA(1, 0), cA + kstep, voffA); PG8_STAGE(PG8_SB(1, 1), cB + hstep + kstep, voffB);
        PG8_WAIT_V(6); PG8_BAR;
    } else {
        PG8_STAGE(PG8_SB(0, 0), cB, voffB); PG8_STAGE(PG8_SA(0, 0), cA, voffA); PG8_STAGE(PG8_SB(0, 1), cB + hstep, voffB); PG8_STAGE(PG8_SA(0, 1), cA + hstep, voffA);
        if (wr == 1) PG8_BAR;
        PG8_WAIT_V(4); PG8_BAR;
        PG8_STAGE(PG8_SB(1, 0), cB + kstep, voffB); PG8_STAGE(PG8_SA(1, 0), cA + kstep, voffA); PG8_STAGE(PG8_SB(1, 1), cB + hstep + kstep, voffB);
        PG8_WAIT_V(6); PG8_BAR;
    }
    for (;;) {
        const bool has_next = S.next(ui + 1, nxt);
        const char* nA = has_next ? (const char*)g.A + (size_t)nxt.pm * tstep : cA; const char* nB = has_next ? (const char*)g.Bt + (size_t)nxt.pn * tstep : cB;
        for (int t = 0; t < nt; t += 2) {
            const bool last = (t == nt - 2);
            const char* a1 = cA + (size_t)(t + 1) * kstep;
            const char* a2 = last ? nA : cA + (size_t)(t + 2) * kstep; const char* b2 = last ? nB : cB + (size_t)(t + 2) * kstep;
            const char* a3 = a2 + kstep; const char* b3 = b2 + kstep;
            if (last && has_next) S.a_ready(nxt);
            if constexpr (SP2) {
            PG8_LDB(B0, 0, 0); PG8_LDB(B1, 0, 1); PG8_SCHED; PG8_LDA(At, 0, 0); PG8_STAGE(PG8_SA(1, 1), a1 + hstep, voffA);
            PG8_WAIT_V(8); PG8_WAIT_L(0); PG8_BAR; PG8_MMA(0, 0, At, B0); PG8_MMA(0, 1, At, B1); PG8_BAR; PG8_SCHED;
            PG8_LDA(At, 0, 1); PG8_STAGE(PG8_SB(0, 0), b2, voffB); PG8_STAGE(PG8_SB(0, 1), b2 + hstep, voffB); PG8_STAGE(PG8_SA(0, 0), a2, voffA);
            PG8_WAIT_V(8); PG8_WAIT_L(0); PG8_BAR; PG8_MMA(1, 0, At, B0); PG8_MMA(1, 1, At, B1); PG8_BAR; PG8_SCHED;
            PG8_LDB(B0, 1, 0); PG8_LDB(B1, 1, 1); PG8_SCHED; PG8_LDA(At, 1, 0); PG8_STAGE(PG8_SA(0, 1), a2 + hstep, voffA);
            PG8_WAIT_V(8); PG8_WAIT_L(0); PG8_BAR; PG8_MMA(0, 0, At, B0); PG8_MMA(0, 1, At, B1); PG8_BAR; PG8_SCHED;
            PG8_LDA(At, 1, 1); PG8_STAGE(PG8_SB(1, 0), b3, voffB); PG8_STAGE(PG8_SB(1, 1), b3 + hstep, voffB); PG8_STAGE(PG8_SA(1, 0), a3, voffA);
            PG8_WAIT_V(8); PG8_WAIT_L(0); PG8_BAR; PG8_MMA(1, 0, At, B0); PG8_MMA(1, 1, At, B1); PG8_BAR; PG8_SCHED;
            } else {
            PG8_LDB(B0, 0, 0); PG8_SCHED; PG8_LDA(At, 0, 0); PG8_STAGE(PG8_SA(1, 1), a1 + hstep, voffA);
            PG8_WAIT_L(8); PG8_BAR; PG8_WAIT_L(0); PG8_MMA(0, 0, At, B0); PG8_BAR; PG8_SCHED;
            PG8_LDB(B1, 0, 1); PG8_STAGE(PG8_SB(0, 0), b2, voffB);
            PG8_BAR; PG8_WAIT_L(0); PG8_MMA(0, 1, At, B1); PG8_BAR;
            PG8_LDA(At, 0, 1); PG8_STAGE(PG8_SA(0, 0), a2, voffA);
            PG8_BAR; PG8_WAIT_L(0); PG8_MMA(1, 0, At, B0); PG8_BAR; PG8_SCHED;
            PG8_STAGE(PG8_SB(0, 1), b2 + hstep, voffB);
            PG8_WAIT_V(6); PG8_BAR; PG8_MMA(1, 1, At, B1); PG8_BAR;
            PG8_LDB(B0, 1, 0); PG8_SCHED; PG8_LDA(At, 1, 0); PG8_STAGE(PG8_SA(0, 1), a2 + hstep, voffA);
            PG8_WAIT_L(8); PG8_BAR; PG8_WAIT_L(0); PG8_MMA(0, 0, At, B0); PG8_BAR; PG8_SCHED;
            PG8_LDB(B1, 1, 1); PG8_STAGE(PG8_SB(1, 0), b3, voffB);
            PG8_BAR; PG8_WAIT_L(0); PG8_MMA(0, 1, At, B1); PG8_BAR;
            PG8_LDA(At, 1, 1); PG8_STAGE(PG8_SA(1, 0), a3, voffA);
            PG8_BAR; PG8_WAIT_L(0); PG8_MMA(1, 0, At, B0); PG8_BAR; PG8_SCHED;
            PG8_STAGE(PG8_SB(1, 1), b3 + hstep, voffB);
            PG8_WAIT_V(6); PG8_BAR; PG8_MMA(1, 1, At, B1); PG8_BAR;
            }
        }
        if constexpr (ALIGN_EPI) { if (wr == 0) PG8_BAR; }
        if constexpr (!Epi::AFTER_DRAIN) { E(acc, cur, wr, wc, fr, fq); S.done(cur); }
        if (!has_next) break;
#pragma unroll
        for (int a = 0; a < 2; ++a)
#pragma unroll
            for (int b = 0; b < 2; ++b)
#pragma unroll
                for (int m = 0; m < 4; ++m)
#pragma unroll
                    for (int n = 0; n < 2; ++n) acc[a][b][m][n] = (f32x4){0.f, 0.f, 0.f, 0.f};
        cur = nxt; cA = nA; cB = nB; ++ui;
        if constexpr (ALIGN_EPI) { if (wr == 1) PG8_BAR; }
    }
    PG8_WAIT_V(0);
    if constexpr (!ALIGN_EPI) { if (wr == 0) PG8_BAR; }
    PG8_BAR;
    if constexpr (Epi::AFTER_DRAIN) { E.fused(acc, cur, wr, wc, fr, fq, lds, wid, lane); S.done(cur); }
#undef PG8_SA
#undef PG8_SB
#undef PG8_STAGE
#undef PG8_LDA
#undef PG8_LDB
#undef PG8_MMA
#undef PG8_WAIT_V
#undef PG8_WAIT_L
#undef PG8_BAR
#undef PG8_SCHED
}
}
#define GAS __attribute__((address_space(1)))
#define LAS __attribute__((address_space(3)))
typedef unsigned short bf16;
typedef unsigned v4u __attribute__((ext_vector_type(4)));
typedef float f32x4 __attribute__((ext_vector_type(4)));
typedef short bf16x8 __attribute__((ext_vector_type(8)));
typedef GAS unsigned gu32;
typedef GAS unsigned long long gu64;
#define RLX_AGENT __ATOMIC_RELAXED, __HIP_MEMORY_SCOPE_AGENT
#define LDS_WAIT() asm volatile("s_waitcnt lgkmcnt(0)" ::: "memory")
#define VM_WAIT() asm volatile("s_waitcnt vmcnt(0)" ::: "memory")
__device__ __forceinline__ unsigned long long rt() { return __builtin_amdgcn_s_memrealtime(); }
__device__ __forceinline__ unsigned f2bf(float f) { unsigned u = __builtin_bit_cast(unsigned, f); return (u + 0x7fffu + ((u >> 16) & 1u)) >> 16; }
__device__ __forceinline__ unsigned pk2(float lo, float hi) { return f2bf(lo) | (f2bf(hi) << 16); }

#define XB_TMO      128
#define XB_XCNT(j)  (256  + 64 * (j))
#define XB_XSUB(j)  (1280 + 64 * (j))
#define XB_XGEN(j)  (2304 + 64 * (j))
#define XB_TOP      3328
#define XB_TOPGEN   3392
#define XCD_BAR_WORDS 3456
#define XB_SPIN_CAP (1u << 18)

__device__ __forceinline__ unsigned xb_ld(unsigned* p)              { return __hip_atomic_load(p, __ATOMIC_RELAXED, __HIP_MEMORY_SCOPE_AGENT); }
__device__ __forceinline__ unsigned xb_add(unsigned* p, unsigned v) { return __hip_atomic_fetch_add(p, v, __ATOMIC_RELAXED, __HIP_MEMORY_SCOPE_AGENT); }
__device__ __forceinline__ unsigned xb_xcc_id() { return (unsigned)__builtin_amdgcn_s_getreg((3 << 11) | 20) & 0xFu; }
#define XB_SPIN(cond, bar) do { unsigned _sp = 0; while (cond) { __builtin_amdgcn_s_sleep(1); \
    if ((++_sp & 255u) == 0u) { if (xb_ld(&(bar)[XB_TMO])) break; if (_sp > XB_SPIN_CAP) { atomicAdd(&(bar)[XB_TMO], 1u); break; } } } } while (0)

struct XcdBarrier {
    unsigned* bar; unsigned x;
    volatile LAS unsigned* st;
};

__device__ __forceinline__ XcdBarrier xcd_barrier_post(unsigned* bar, volatile LAS unsigned* st) {
    XcdBarrier b; b.bar = bar; b.x = xb_xcc_id(); b.st = st;
    if (threadIdx.x == 0) (void)xb_add(&bar[XB_XCNT(b.x)], 1u);
    return b;
}
__device__ __forceinline__ void xcd_barrier_complete(unsigned* bar, unsigned x, unsigned& nloc, unsigned& nx) {
    const unsigned G = gridDim.x * gridDim.y * gridDim.z;
    unsigned sum, cnt, mine, sp = 0u;
    for (;;) {
        sum = 0u; cnt = 0u; mine = 0u;
#pragma unroll
        for (unsigned j = 0; j < 16; ++j) { const unsigned c = xb_ld(&bar[XB_XCNT(j)]); sum += c; cnt += (c > 0u) ? 1u : 0u; mine = (j == x) ? c : mine; }
        if (sum == G) break;
        __builtin_amdgcn_s_sleep(1);
        if ((++sp & 255u) == 0u) { if (xb_ld(&bar[XB_TMO])) break; if (sp > XB_SPIN_CAP) { atomicAdd(&bar[XB_TMO], 1u); break; } }
    }
    nloc = mine > 0u ? mine : 1u; nx = cnt > 0u ? cnt : 1u;
}

__device__ __forceinline__ void xcd_barrier(const XcdBarrier& b) {
    asm volatile("s_waitcnt vmcnt(0)" ::: "memory");
    __syncthreads();
    if (threadIdx.x == 0) {
        unsigned* bar = b.bar;
        __builtin_amdgcn_s_waitcnt(0);
        unsigned nloc = b.st[0], nx = b.st[1];
        if (nloc == 0u) { xcd_barrier_complete(bar, b.x, nloc, nx); b.st[0] = nloc; b.st[1] = nx; }
        const unsigned old = xb_add(&bar[XB_XSUB(b.x)], 1u);
        const unsigned gen = old / nloc;
        if (old + 1u == (gen + 1u) * nloc) {
            __builtin_amdgcn_fence(__ATOMIC_RELEASE, "agent");
            asm volatile("s_waitcnt vmcnt(0)" ::: "memory");
            const unsigned og = xb_add(&bar[XB_TOP], 1u);
            const unsigned tg = og / nx;
            if (og + 1u == (tg + 1u) * nx) xb_add(&bar[XB_TOPGEN], 1u);
            else XB_SPIN(xb_ld(&bar[XB_TOPGEN]) == tg, bar);
            __builtin_amdgcn_fence(__ATOMIC_ACQUIRE, "agent");
            xb_add(&bar[XB_XGEN(b.x)], 1u);
            asm volatile("s_waitcnt vmcnt(0)" ::: "memory");
        } else {
            XB_SPIN(xb_ld(&bar[XB_XGEN(b.x)]) == gen, bar);
            __builtin_amdgcn_fence(__ATOMIC_ACQUIRE, "agent");
            asm volatile("s_waitcnt vmcnt(0)" ::: "memory");
        }
    }
    __syncthreads();
}
constexpr size_t MiB = 1u << 20;
constexpr size_t WS_CTL = 0, CTL_ZERO_BYTES = 1 * MiB;
constexpr size_t WS_BIAS = 1 * MiB, WS_W2T = WS_BIAS + 16384, WS_A2T = WS_W2T + 131072, WS_G2T = WS_A2T + 131072;
constexpr size_t WS_WGU1 = 2 * MiB, WS_WD1 = WS_WGU1 + 43 * MiB, WS_WINB = WS_WD1 + 21 * MiB + MiB / 2;
constexpr size_t WS_WOUT = 86 * MiB, WS_WGU2 = 94 * MiB, WS_WD2 = 137 * MiB;
constexpr size_t WS_XB = 159 * MiB;
constexpr size_t WS_ACT = 192 * MiB;
constexpr size_t WS_QB = 300 * MiB, WS_KB = WS_QB + 16 * MiB + MiB / 2, WS_VB = WS_KB + 4 * MiB + MiB / 8;
constexpr size_t WS_DD = 325 * MiB, WS_LG = 358 * MiB, WS_EE = WS_LG + 16 * MiB + MiB / 2, WS_END = WS_EE + 16 * MiB + MiB / 2;
constexpr size_t WS_SLAB = WS_END, WS_END2 = WS_SLAB + 1 * MiB;
constexpr size_t VEC16 = 16 * MiB + MiB / 2;
constexpr size_t WS_KK = WS_WGU1, WS_BB = WS_KK + VEC16, WS_KP = WS_BB + VEC16, WS_RR = WS_KP + VEC16, WS_VV = WS_RR + VEC16;
constexpr size_t WS_X2B = WS_WGU1;
static_assert(WS_VV + VEC16 <= WS_WOUT && WS_WINB + 19 * MiB <= WS_WOUT && WS_WD2 + 22 * MiB <= WS_XB && WS_XB + 33 * MiB <= WS_ACT && WS_VB + 4 * MiB + MiB / 8 <= WS_DD && WS_DD + 33 * MiB <= WS_LG, "d_ws map");
constexpr int CW_BAR = 4096;
constexpr int CW_SSQ0 = 16384, CW_SSQ1 = CW_SSQ0 + MPAD, CW_SSQ2 = CW_SSQ1 + MPAD, CW_SSQ3 = CW_SSQ2 + MPAD;
constexpr int CW_SKC = 8192;
constexpr int CW_SSQD = CW_SSQ3 + MPAD;
static_assert((CW_SSQD + MPAD) * 4 <= (int)CTL_ZERO_BYTES, "CTL");
constexpr int RING_OFF = 0, RING_BYTES = 131072;
constexpr int LDSCTL_OFF = RING_BYTES, MISC_OFF = LDSCTL_OFF + 320;
constexpr int LDS_BYTES = 147456;
constexpr int NWAVES = 8;
constexpr int NPHASES = 11;
#ifndef MK_N_LAUNCHES
#define MK_N_LAUNCHES 1
#endif

__constant__ unsigned char T5B[129] = {0, 1, 2, 3, 4, 5, 6, 7, 8, 9, 10, 11, 12, 13, 14, 15, 16, 16, 16, 17, 17, 18, 18, 18, 19, 19, 19, 20, 20, 20, 20, 21, 21, 21, 21, 22, 22, 22, 22, 22, 23, 23, 23, 23, 23, 23, 24, 24, 24, 24, 24, 24, 25, 25, 25, 25, 25, 25, 25, 26, 26, 26, 26, 26, 26, 26, 26, 27, 27, 27, 27, 27, 27, 27, 27, 27, 27, 28, 28, 28, 28, 28, 28, 28, 28, 28, 28, 29, 29, 29, 29, 29, 29, 29, 29, 29, 29, 29, 29, 30, 30, 30, 30, 30, 30, 30, 30, 30, 30, 30, 30, 30, 30, 31, 31, 31, 31, 31, 31, 31, 31, 31, 31, 31, 31, 31, 31, 31, 31};

struct Args { const float* in[31]; float* out; unsigned char* ws; int ph_lo, ph_hi, li, pad; };

struct Frame {
    LAS unsigned char* lds;
    volatile LAS unsigned* MISC;
    gu32* ctl;
    int tid, lane, wave, G;
    float* out; unsigned char* ws;
};
typedef float f32x2 __attribute__((ext_vector_type(2)));
__device__ __forceinline__ float bf2f(unsigned short u) { return __builtin_bit_cast(float, (unsigned)u << 16); }
__device__ __forceinline__ unsigned short f2bfs(float f) { return (unsigned short)f2bf(f); }
__device__ __forceinline__ float wave_sum(float v) {
#pragma unroll
    for (int o = 1; o < 64; o <<= 1) v += __shfl_xor(v, o);
    return v;
}
__device__ __forceinline__ float wave_max(float v) {
#pragma unroll
    for (int o = 1; o < 64; o <<= 1) v = fmaxf(v, __shfl_xor(v, o));
    return v;
}
template <int CTRL> __device__ __forceinline__ float dpp_f(float x) { return __builtin_bit_cast(float, __builtin_amdgcn_update_dpp(0, __builtin_bit_cast(int, x), CTRL, 0xf, 0xf, true)); }
__device__ __forceinline__ float allsum16(float x) { x += dpp_f<0x128>(x); x += dpp_f<0x124>(x); x += dpp_f<0x122>(x); x += dpp_f<0x121>(x); return x; }
__device__ __forceinline__ float sigmoidf_(float x) { return __builtin_amdgcn_rcpf(1.0f + __builtin_amdgcn_exp2f(-x * LOG2E)); }
__device__ __forceinline__ float tanhf_(float x) { return 1.0f - 2.0f * __builtin_amdgcn_rcpf(1.0f + __builtin_amdgcn_exp2f(2.0f * LOG2E * x)); }

constexpr int TP_PITCH = 136;
__device__ __forceinline__ void p0_transpose_item(const float* W, int K, int N, bf16* WT, int kb, int nb, int drow, const float* kscale, LAS unsigned char* scr, int lane) {
    const int k0 = 64 * kb, n0 = 64 * nb, g = lane >> 4, c = lane & 15;
    f32x4 v[16];
#pragma unroll
    for (int j = 0; j < 4; ++j)
#pragma unroll
        for (int r = 0; r < 4; ++r) v[4 * j + r] = *(const GAS f32x4*)(W + (size_t)(k0 + 16 * j + 4 * g + r) * N + n0 + 4 * c);
    if (kscale) {
#pragma unroll
        for (int j = 0; j < 4; ++j) { const f32x4 s4 = *(const GAS f32x4*)(kscale + k0 + 16 * j + 4 * g);
            v[4 * j + 0] *= s4.x; v[4 * j + 1] *= s4.y; v[4 * j + 2] *= s4.z; v[4 * j + 3] *= s4.w; } }
#pragma unroll
    for (int j = 0; j < 4; ++j)
#pragma unroll
        for (int e = 0; e < 4; ++e)
            *(LAS unsigned long long*)(scr + (4 * c + e) * TP_PITCH + (16 * j + 4 * g) * 2) = (unsigned long long)pk2(v[4 * j + 0][e], v[4 * j + 1][e]) | ((unsigned long long)pk2(v[4 * j + 2][e], v[4 * j + 3][e]) << 32);
    LDS_WAIT(); asm volatile("" ::: "memory");
#pragma unroll
    for (int i = 0; i < 8; ++i) { const int n = 8 * i + (lane >> 3), kc = lane & 7;
        const LAS unsigned char* s = scr + n * TP_PITCH + kc * 16;
        v4u o; o.x = *(const LAS unsigned*)(s); o.y = *(const LAS unsigned*)(s + 4); o.z = *(const LAS unsigned*)(s + 8); o.w = *(const LAS unsigned*)(s + 12);
        *(GAS v4u*)(WT + (size_t)(drow + n) * K + k0 + 8 * kc) = o; }
    LDS_WAIT(); asm volatile("" ::: "memory");
}
__device__ __forceinline__ int gu_row(int n0, int up) { return 256 * (n0 >> 7) + (n0 & 127) + 128 * up; }

constexpr int I_GU = (DM / 64) * (DFF / 64), I_D = (DFF / 64) * (DM / 64), I_IN = (DM / 64) * (INC / 64), I_OUT = (DM / 64) * (DM / 64), I_L64 = RWW / 64, I_L128 = 2 * (RWW / 64);
constexpr int CV_EARLY = 2 * I_GU + I_D + I_IN + 2 * I_L64 + I_L128, CV_LATE1 = I_OUT + I_GU, CV_LATE2 = I_GU + I_D, CV_ALL = CV_EARLY + CV_LATE1 + CV_LATE2;
__device__ __forceinline__ void convert_items(Frame& F, const Args& A, int first, int count, int rank, int nranks) {
    LAS unsigned char* scr = F.lds + RING_OFF + F.wave * 16384;
    const int lane = F.lane; unsigned char* ws = F.ws;
    for (int it = first + rank * NWAVES + F.wave; it < first + count; it += nranks * NWAVES) {
        int r = it;
        if (r < I_GU) { const int kb = r / (DFF / 64), nb = r % (DFF / 64); p0_transpose_item(A.in[8], DM, DFF, (bf16*)(ws + WS_WGU1), kb, nb, gu_row(64 * nb, 0), A.in[7], scr, lane); continue; } r -= I_GU;
        if (r < I_GU) { const int kb = r / (DFF / 64), nb = r % (DFF / 64); p0_transpose_item(A.in[9], DM, DFF, (bf16*)(ws + WS_WGU1), kb, nb, gu_row(64 * nb, 1), A.in[7], scr, lane); continue; } r -= I_GU;
        if (r < I_D)  { const int kb = r / (DM / 64), nb = r % (DM / 64); p0_transpose_item(A.in[10], DFF, DM, (bf16*)(ws + WS_WD1), kb, nb, 64 * nb, nullptr, scr, lane); continue; } r -= I_D;
        if (r < I_IN) { const int kb = r / (INC / 64), nb = r % (INC / 64); p0_transpose_item(A.in[12], DM, INC, (bf16*)(ws + WS_WINB), kb, nb, 64 * nb, A.in[11], scr, lane); continue; } r -= I_IN;
        if (r < I_L64) { p0_transpose_item(A.in[16], 64, RWW, (bf16*)(ws + WS_W2T), 0, r, 64 * r, nullptr, scr, lane); continue; } r -= I_L64;
        if (r < I_L64) { p0_transpose_item(A.in[18], 64, RWW, (bf16*)(ws + WS_A2T), 0, r, 64 * r, nullptr, scr, lane); continue; } r -= I_L64;
        if (r < I_L128) { const int kb = r / (RWW / 64), nb = r % (RWW / 64); p0_transpose_item(A.in[19], 128, RWW, (bf16*)(ws + WS_G2T), kb, nb, 64 * nb, nullptr, scr, lane); continue; } r -= I_L128;
        if (r < I_OUT) { const int kb = r / (DM / 64), nb = r % (DM / 64); p0_transpose_item(A.in[25], DM, DM, (bf16*)(ws + WS_WOUT), kb, nb, 64 * nb, nullptr, scr, lane); continue; } r -= I_OUT;
        if (r < I_GU) { const int kb = r / (DFF / 64), nb = r % (DFF / 64); p0_transpose_item(A.in[27], DM, DFF, (bf16*)(ws + WS_WGU2), kb, nb, gu_row(64 * nb, 0), A.in[26], scr, lane); continue; } r -= I_GU;
        if (r < I_GU) { const int kb = r / (DFF / 64), nb = r % (DFF / 64); p0_transpose_item(A.in[28], DM, DFF, (bf16*)(ws + WS_WGU2), kb, nb, gu_row(64 * nb, 1), A.in[26], scr, lane); continue; } r -= I_GU;
        { const int kb = r / (DM / 64), nb = r % (DM / 64); p0_transpose_item(A.in[29], DFF, DM, (bf16*)(ws + WS_WD2), kb, nb, 64 * nb, nullptr, scr, lane); }
    }
}
__device__ __forceinline__ void p0_prologue(Frame& F, const Args& A) {
    const int gw = blockIdx.x * NWAVES + F.wave, NGW = F.G * NWAVES, lane = F.lane;
    unsigned char* ws = F.ws;
#ifdef CV_ALL_IN_P0
    convert_items(F, A, 0, CV_ALL, blockIdx.x, F.G);
#else
    convert_items(F, A, 0, CV_EARLY, blockIdx.x, F.G);
#endif
    bf16* XB = (bf16*)(ws + WS_XB); float* ssq0 = (float*)(F.ctl + CW_SSQ0);
    for (int m = gw; m < MPAD; m += NGW) {
        GAS unsigned long long* o8 = (GAS unsigned long long*)(XB + (size_t)m * DM) + lane;
        if (m < MV) {
            const float* xrow = m < MP ? A.in[0] + (size_t)m * DM : A.in[1] + (size_t)(m - MP) * DM;
            const GAS f32x4* xr = (const GAS f32x4*)xrow + lane; f32x4 v[8]; float s = 0.f;
#pragma unroll
            for (int j = 0; j < 8; ++j) { v[j] = xr[64 * j]; s += (v[j].x * v[j].x + v[j].y * v[j].y) + (v[j].z * v[j].z + v[j].w * v[j].w); }
            s = wave_sum(s);
#pragma unroll
            for (int j = 0; j < 8; ++j) o8[64 * j] = (unsigned long long)pk2(v[j].x, v[j].y) | ((unsigned long long)pk2(v[j].z, v[j].w) << 32);
            if (lane == 0) ssq0[m] = s;
        } else {
#pragma unroll
            for (int j = 0; j < 8; ++j) o8[64 * j] = 0ull;
        }
    }
    float* bt = (float*)(ws + WS_BIAS);
    for (int i = blockIdx.x * (NWAVES * 64) + F.tid; i < 129 * NQH; i += F.G * NWAVES * 64) bt[i] = A.in[6][(int)T5B[i >> 4] * NQH + (i & 15)] * LOG2E;
}
constexpr int PREP_TILES = (MV + 63) / 64  , PREP_UNITS = PREP_TILES * RWH;
constexpr int PA_PITCH = 528;
constexpr int PW_LD = 68;
constexpr int PA_OFF = 0, PW_OFF = 64 * PA_PITCH  , PMAT = 64 * PW_LD * 4  , PC_OFF = PW_OFF + 3 * PMAT  ;
__device__ __forceinline__ float qsum8(float x) {
    x += dpp_f<0xB1>(x); x += dpp_f<0x4E>(x); x += dpp_f<0x141>(x); return x; }
__device__ __forceinline__ void prep_phase(Frame& F, const Args& A) {
    const int tid = F.tid, lane = F.lane, wave = F.wave;
    unsigned char* ws = F.ws; LAS unsigned char* lds = F.lds;
    const float* PR = (const float*)(ws + WS_ACT);
    const float* mu = A.in[14];
    int hcur = -1;
    bf16x8 bfr[16];
#pragma unroll
    for (int i = 0; i < 16; ++i) bfr[i] = (bf16x8){0, 0, 0, 0, 0, 0, 0, 0};
    const int mtile = wave & 3, nh = wave >> 2, ln = lane & 15, q4 = lane >> 4;
    for (int u = blockIdx.x; u < PREP_UNITS; u += F.G) {
        const int mt = u >> 4, h = u & 15, m0 = mt * 64;
        if (h != hcur) {
            __syncthreads();
            hcur = h;
            { LAS float* cst = (LAS float*)(lds + PC_OFF);
              for (int i = tid; i < 10 * 64; i += NWAVES * 64) { const int a = i >> 6, c = i & 63, hc = 64 * h + c; float v;
                  if (a < 3) v = mu[a * RWW + hc]; else v = A.in[a == 3 ? 15 : (a == 4 ? 17 : (a == 5 ? 20 : (a == 6 ? 21 : (a == 7 ? 22 : (a == 8 ? 23 : 24)))))][hc];
                  cst[i] = v; } }
#pragma unroll
            for (int mat = 0; mat < 3; ++mat) { const int KM = mat == 2 ? 128 : 64; const bf16* Bt = (const bf16*)(ws + (mat == 0 ? WS_W2T : (mat == 1 ? WS_A2T : WS_G2T)));
#pragma unroll
                for (int n2 = 0; n2 < 2; ++n2)
#pragma unroll
                    for (int ks = 0; ks < KM / 32; ++ks)
                        bfr[(mat == 0 ? 0 : (mat == 1 ? 4 : 8)) + n2 * (KM / 32) + ks] = *(const GAS bf16x8*)(Bt + (size_t)(64 * h + 16 * (2 * nh + n2) + ln) * KM + 32 * ks + 8 * q4); }
            __syncthreads();
        }
        const int row1 = tid >> 3, cc = tid & 7, m1 = m0 + row1, c01 = 3 * RWW + 32 * cc;
        const bool valid1 = m1 < MV;
        f32x4 xa[8], xb[8];
        { const float* p = PR + (size_t)(valid1 ? m1 : MV - 1) * SHC + c01; const float* pv = nullptr;
          if (valid1) { if (m1 >= MP) pv = A.in[5] + (size_t)(m1 - MP) * SHC + c01; else if ((m1 & (SEQ - 1)) != 0) pv = p - SHC; }
#pragma unroll
          for (int q = 0; q < 8; ++q) { xa[q] = *(const GAS f32x4*)(p + 4 * q); xb[q] = pv ? *(const GAS f32x4*)(pv + 4 * q) : (f32x4){0.f, 0.f, 0.f, 0.f}; } }
        const int t3 = lane >> 3, cq = lane & 7, tok3 = 8 * wave + t3, m3 = m0 + tok3, hc0 = 64 * h + 8 * cq;
        const bool valid3 = m3 < MV;
        f32x4 cr[2], ck[2], cv[2], pr[2], pk[2], pv3[2];
        { const float* p = PR + (size_t)(valid3 ? m3 : MV - 1) * SHC + hc0; const float* q = nullptr;
          if (valid3) { if (m3 >= MP) q = A.in[5] + (size_t)(m3 - MP) * SHC + hc0; else if ((m3 & (SEQ - 1)) != 0) q = p - SHC; }
#pragma unroll
          for (int e = 0; e < 2; ++e) { cr[e] = *(const GAS f32x4*)(p + 4 * e); ck[e] = *(const GAS f32x4*)(p + RWW + 4 * e); cv[e] = *(const GAS f32x4*)(p + 2 * RWW + 4 * e);
              const f32x4 z = (f32x4){0.f, 0.f, 0.f, 0.f};
              pr[e] = q ? *(const GAS f32x4*)(q + 4 * e) : z; pk[e] = q ? *(const GAS f32x4*)(q + RWW + 4 * e) : z; pv3[e] = q ? *(const GAS f32x4*)(q + 2 * RWW + 4 * e) : z; } }
#pragma unroll
        for (int q = 0; q < 8; ++q) {
            const f32x4 m4 = *(const GAS f32x4*)(mu + c01 + 4 * q);
            f32x4 x = xa[q] + m4 * (xb[q] - xa[q]);
            if (cc < 2) { x.x = tanhf_(x.x); x.y = tanhf_(x.y); x.z = tanhf_(x.z); x.w = tanhf_(x.w); }
            else if (cc >= 4) { x.x = sigmoidf_(x.x); x.y = sigmoidf_(x.y); x.z = sigmoidf_(x.z); x.w = sigmoidf_(x.w); }
            if (!valid1) x = (f32x4){0.f, 0.f, 0.f, 0.f};
            *(LAS unsigned long long*)(lds + PA_OFF + row1 * PA_PITCH + (32 * cc + 4 * q) * 2) = (unsigned long long)pk2(x.x, x.y) | ((unsigned long long)pk2(x.z, x.w) << 32);
        }
        __syncthreads();
#pragma unroll
        for (int mat = 0; mat < 3; ++mat) { const int kbase = mat == 0 ? 0 : (mat == 1 ? 64 : 128), KM = mat == 2 ? 128 : 64;
#pragma unroll
            for (int n2 = 0; n2 < 2; ++n2) { const int nt = 2 * nh + n2; f32x4 acc = (f32x4){0.f, 0.f, 0.f, 0.f};
#pragma unroll
                for (int ks = 0; ks < KM / 32; ++ks) {
                    const bf16x8 a = *(const LAS bf16x8*)(lds + PA_OFF + (16 * mtile + ln) * PA_PITCH + (kbase + 32 * ks + 8 * q4) * 2);
                    acc = __builtin_amdgcn_mfma_f32_16x16x32_bf16(a, bfr[(mat == 0 ? 0 : (mat == 1 ? 4 : 8)) + n2 * (KM / 32) + ks], acc, 0, 0, 0); }
                LAS float* o = (LAS float*)(lds + PW_OFF + mat * PMAT);
#pragma unroll
                for (int r = 0; r < 4; ++r) o[(16 * mtile + 4 * q4 + r) * PW_LD + 16 * nt + ln] = acc[r]; } }
        __syncthreads();
        { const LAS float* cst = (const LAS float*)(lds + PC_OFF) + 8 * cq;
          const LAS float* Wp = (const LAS float*)(lds + PW_OFF) + tok3 * PW_LD + 8 * cq; const LAS float* Ap = Wp + PMAT / 4; const LAS float* Gp = Ap + PMAT / 4;
          float xr[8], xk[8], xv[8], kkr[8], kp[8], aa[8], gg[8], dec[8]; float n2 = 0.f, bon = 0.f;
#pragma unroll
          for (int e = 0; e < 2; ++e) {
              const f32x4 mur = *(const LAS f32x4*)(cst + 0 * 64 + 4 * e), muk = *(const LAS f32x4*)(cst + 1 * 64 + 4 * e), muv = *(const LAS f32x4*)(cst + 2 * 64 + 4 * e);
              const f32x4 w0 = *(const LAS f32x4*)(cst + 3 * 64 + 4 * e), a0 = *(const LAS f32x4*)(cst + 4 * 64 + 4 * e), k_k = *(const LAS f32x4*)(cst + 5 * 64 + 4 * e);
              const f32x4 k_a = *(const LAS f32x4*)(cst + 6 * 64 + 4 * e), r_k = *(const LAS f32x4*)(cst + 7 * 64 + 4 * e);
              const f32x4 wl = *(const LAS f32x4*)(Wp + 4 * e), al = *(const LAS f32x4*)(Ap + 4 * e), gl = *(const LAS f32x4*)(Gp + 4 * e);
              const f32x4 r4 = cr[e] + mur * (pr[e] - cr[e]), k4 = ck[e] + muk * (pk[e] - ck[e]), v4 = cv[e] + muv * (pv3[e] - cv[e]);
#pragma unroll
              for (int j = 0; j < 4; ++j) { const int i = 4 * e + j;
                  xr[i] = r4[j]; xk[i] = k4[j]; xv[i] = v4[j];
                  dec[i] = __builtin_amdgcn_exp2f(-0.6065306597126334f * LOG2E * sigmoidf_(w0[j] + wl[j]));
                  aa[i] = sigmoidf_(a0[j] + al[j]); gg[i] = gl[j];
                  kkr[i] = xk[i] * k_k[j]; n2 += kkr[i] * kkr[i];
                  kp[i] = xk[i] * (1.0f + (aa[i] - 1.0f) * k_a[j]);
                  bon += xr[i] * kp[i] * r_k[j]; } }
          n2 = qsum8(n2); bon = qsum8(bon);
          const float inv = 1.0f / fmaxf(sqrtf(n2), 1e-12f);
          if (valid3) {
              const size_t o = (size_t)m3 * RWW + hc0;
              const f32x4 lw0 = *(const LAS f32x4*)(cst + 8 * 64), lw1 = *(const LAS f32x4*)(cst + 8 * 64 + 4), lb0 = *(const LAS f32x4*)(cst + 9 * 64), lb1 = *(const LAS f32x4*)(cst + 9 * 64 + 4);
              float lgv[8], eev[8];
#pragma unroll
              for (int i = 0; i < 8; ++i) { kkr[i] *= inv; const float lw = i < 4 ? lw0[i & 3] : lw1[i & 3], lb = i < 4 ? lb0[i & 3] : lb1[i & 3]; lgv[i] = lw * gg[i]; eev[i] = (lb + bon * xv[i]) * gg[i]; }
#define PK8(a) (v4u){pk2(a[0], a[1]), pk2(a[2], a[3]), pk2(a[4], a[5]), pk2(a[6], a[7])}
              float bbv[8];
#pragma unroll
              for (int i = 0; i < 8; ++i) bbv[i] = kkr[i] * aa[i];
              *(GAS v4u*)((bf16*)(ws + WS_KK) + o) = PK8(kkr); *(GAS v4u*)((bf16*)(ws + WS_BB) + o) = PK8(bbv); *(GAS v4u*)((bf16*)(ws + WS_KP) + o) = PK8(kp);
              *(GAS v4u*)((bf16*)(ws + WS_RR) + o) = PK8(xr); *(GAS v4u*)((bf16*)(ws + WS_VV) + o) = PK8(xv);
              *(GAS v4u*)((bf16*)(ws + WS_LG) + o) = PK8(lgv); *(GAS v4u*)((bf16*)(ws + WS_EE) + o) = PK8(eev);
#undef PK8
              *(GAS f32x4*)((float*)(ws + WS_DD) + o) = (f32x4){dec[0], dec[1], dec[2], dec[3]}; *(GAS f32x4*)((float*)(ws + WS_DD) + o + 4) = (f32x4){dec[4], dec[5], dec[6], dec[7]};
          } }
    }
}

constexpr int AK_PITCH = 144, AV_PITCH = 592, AP_PITCH = 336;
constexpr int AK_OFF = 0, AV_OFF = 272 * AK_PITCH  , AP_OFF = AV_OFF + 64 * AV_PITCH  , AB_OFF = AP_OFF + 8 * 16 * AP_PITCH  ;
static_assert(AB_OFF + 129 * 4 * 4 <= RING_BYTES, "attention LDS");
__device__ __forceinline__ void attn_unit(Frame& F, const Args& A, int b, int blk, int hk) {
    const int tid = F.tid, lane = F.lane, wave = F.wave;
    unsigned char* ws = F.ws; LAS unsigned char* lds = F.lds;
    const bf16* QB = (const bf16*)(ws + WS_QB); const bf16* KB = (const bf16*)(ws + WS_KB); const bf16* VB = (const bf16*)(ws + WS_VB); bf16* MX = (bf16*)(ws + WS_XB);
    const int mq0 = b * SEQ + blk * 128, mk0 = mq0 - 128;
    for (int i = tid; i < 16 * AK_PITCH / 4; i += NWAVES * 64) ((LAS unsigned*)(lds + AK_OFF + 256 * AK_PITCH))[i] = 0u;
    for (int i = tid; i < 64 * 16; i += NWAVES * 64) ((LAS unsigned*)(lds + AV_OFF + (i >> 4) * AV_PITCH + 512))[i & 15] = 0u;
#pragma unroll
    for (int it = 0; it < 4; ++it) { const int idx = it * 512 + tid, row = idx >> 3, ch = idx & 7;
        v4u kv = (v4u){0u, 0u, 0u, 0u}, vv = kv;
        if (blk > 0 || row >= 128) { kv = *(const GAS v4u*)(KB + (size_t)(mk0 + row) * KVW + hk * 64 + ch * 8); vv = *(const GAS v4u*)(VB + (size_t)(mk0 + row) * KVW + hk * 64 + ch * 8); }
        *(LAS v4u*)(lds + AK_OFF + row * AK_PITCH + ch * 16) = kv;
        LAS unsigned short* vt = (LAS unsigned short*)(lds + AV_OFF + (8 * ch) * AV_PITCH + row * 2);
        vt[0 * (AV_PITCH / 2)] = (unsigned short)(vv.x & 0xffffu); vt[1 * (AV_PITCH / 2)] = (unsigned short)(vv.x >> 16);
        vt[2 * (AV_PITCH / 2)] = (unsigned short)(vv.y & 0xffffu); vt[3 * (AV_PITCH / 2)] = (unsigned short)(vv.y >> 16);
        vt[4 * (AV_PITCH / 2)] = (unsigned short)(vv.z & 0xffffu); vt[5 * (AV_PITCH / 2)] = (unsigned short)(vv.z >> 16);
        vt[6 * (AV_PITCH / 2)] = (unsigned short)(vv.w & 0xffffu); vt[7 * (AV_PITCH / 2)] = (unsigned short)(vv.w >> 16); }
    { const float* bt = (const float*)(ws + WS_BIAS); LAS float* bl = (LAS float*)(lds + AB_OFF);
      for (int i = tid; i < 129 * 4; i += NWAVES * 64) bl[i] = bt[(i >> 2) * NQH + 4 * hk + (i & 3)]; }
    __syncthreads();
    const int g = wave >> 1, half = wave & 1, head = 4 * hk + g, ln = lane & 15, q4 = lane >> 4;
    const float sink2 = A.in[13][head] * LOG2E;
    const LAS float* bl = (const LAS float*)(lds + AB_OFF);
    LAS unsigned char* Pw = lds + AP_OFF + wave * (16 * AP_PITCH);
    bf16x8 qfa[4][2];
#pragma unroll
    for (int rb = 0; rb < 4; ++rb)
#pragma unroll
        for (int ks = 0; ks < 2; ++ks) qfa[rb][ks] = *(const GAS bf16x8*)(QB + (size_t)(mq0 + 64 * half + 16 * rb + ln) * ATTW + head * 64 + 32 * ks + 8 * q4);
#pragma unroll
    for (int rb = 0; rb < 4; ++rb) {
        const int i0 = 64 * half + 16 * rb, kt0 = i0 >> 4;
        bf16x8 qf[2]; qf[0] = qfa[rb][0]; qf[1] = qfa[rb][1];
        f32x4 s[10];
#pragma unroll
        for (int j = 0; j < 10; ++j) { f32x4 acc = (f32x4){0.f, 0.f, 0.f, 0.f};
#pragma unroll
            for (int ks = 0; ks < 2; ++ks) { const bf16x8 kf = *(const LAS bf16x8*)(lds + AK_OFF + (16 * (kt0 + j) + ln) * AK_PITCH + (32 * ks + 8 * q4) * 2);
                acc = __builtin_amdgcn_mfma_f32_16x16x32_bf16(qf[ks], kf, acc, 0, 0, 0); }
            s[j] = acc; }
        float mx[4] = {-INFINITY, -INFINITY, -INFINITY, -INFINITY};
#pragma unroll
        for (int j = 0; j < 10; ++j) { const int kj = 16 * (kt0 + j) + ln;
#pragma unroll
            for (int r = 0; r < 4; ++r) { const int dist = 128 + i0 + 4 * q4 + r - kj; const bool ok = dist >= 0 && dist <= 128 && (blk > 0 || kj >= 128);
                const int dc = dist < 0 ? 0 : (dist > 128 ? 128 : dist);
                const float v = ok ? s[j][r] + bl[dc * 4 + g] : -INFINITY; s[j][r] = v; mx[r] = fmaxf(mx[r], v); } }
        float l[4];
#pragma unroll
        for (int r = 0; r < 4; ++r) { float m_ = mx[r]; m_ = fmaxf(m_, __shfl_xor(m_, 1)); m_ = fmaxf(m_, __shfl_xor(m_, 2)); m_ = fmaxf(m_, __shfl_xor(m_, 4)); m_ = fmaxf(m_, __shfl_xor(m_, 8));
            mx[r] = fmaxf(m_, sink2); l[r] = 0.f; }
#pragma unroll
        for (int j = 0; j < 10; ++j)
#pragma unroll
            for (int r = 0; r < 4; ++r) { const float p = __builtin_amdgcn_exp2f(s[j][r] - mx[r]); l[r] += p;
                *(LAS unsigned short*)(Pw + (4 * q4 + r) * AP_PITCH + (16 * j + ln) * 2) = f2bfs(p); }
#pragma unroll
        for (int r = 0; r < 4; ++r) { float t = l[r]; t += __shfl_xor(t, 1); t += __shfl_xor(t, 2); t += __shfl_xor(t, 4); t += __shfl_xor(t, 8);
            l[r] = __builtin_amdgcn_rcpf(t + __builtin_amdgcn_exp2f(sink2 - mx[r])); }
        f32x4 o[4];
#pragma unroll
        for (int dt = 0; dt < 4; ++dt) o[dt] = (f32x4){0.f, 0.f, 0.f, 0.f};
#pragma unroll
        for (int st = 0; st < 5; ++st) { const bf16x8 pf = *(const LAS bf16x8*)(Pw + ln * AP_PITCH + (32 * st + 8 * q4) * 2);
#pragma unroll
            for (int dt = 0; dt < 4; ++dt) { const bf16x8 vf = *(const LAS bf16x8*)(lds + AV_OFF + (16 * dt + ln) * AV_PITCH + (16 * kt0 + 32 * st + 8 * q4) * 2);
                o[dt] = __builtin_amdgcn_mfma_f32_16x16x32_bf16(pf, vf, o[dt], 0, 0, 0); } }
#pragma unroll
        for (int dt = 0; dt < 4; ++dt)
#pragma unroll
            for (int r = 0; r < 4; ++r) *(LAS unsigned short*)(Pw + (4 * q4 + r) * AP_PITCH + (16 * dt + ln) * 2) = f2bfs(o[dt][r] * l[r]);
#pragma unroll
        for (int i = 0; i < 2; ++i) { const int qrow = 8 * i + (lane >> 3), ch = lane & 7;
            const v4u ov = *(const LAS v4u*)(Pw + qrow * AP_PITCH + ch * 16);
            *(GAS v4u*)(MX + (size_t)(mq0 + i0 + qrow) * DM + head * 64 + ch * 8) = ov; }
    }
    __syncthreads();
}

__device__ __forceinline__ void dec_attn_unit(Frame& F, const Args& A, int du) {
    const int lane = F.lane, wave = F.wave; unsigned char* ws = F.ws;
    const int idx = du * 8 + wave, b = idx >> 4, head = idx & 15, hk = head >> 2, m = MP + b;
    LAS float* qs = (LAS float*)(F.lds + wave * 1024); LAS float* ps = qs + 64;
    const bf16* QB = (const bf16*)(ws + WS_QB); bf16* MX = (bf16*)(ws + WS_XB);
    const float* bt = (const float*)(ws + WS_BIAS);
    const float sink2 = A.in[13][head] * LOG2E;
    const float qv = bf2f(QB[(size_t)m * ATTW + head * 64 + lane]);
    qs[lane] = qv;
    LDS_WAIT(); asm volatile("" ::: "memory");
    float sc[2];
#pragma unroll
    for (int pi = 0; pi < 2; ++pi) { const int pos = lane + 64 * pi; const float* kr = A.in[2] + ((size_t)(b * WIN + pos) * NKVH + hk) * HD; float d = 0.f;
#pragma unroll
        for (int j = 0; j < 16; ++j) { const f32x4 k4 = *(const f32x4*)(kr + 4 * j); const f32x4 q4v = *(const LAS f32x4*)(qs + 4 * j); d += (k4.x * q4v.x + k4.y * q4v.y) + (k4.z * q4v.z + k4.w * q4v.w); }
        sc[pi] = d + bt[(WIN - pos) * NQH + head]; }
    const float* kn = F.out + O_KS + ((size_t)b * WIN + (WIN - 1)) * KVW + hk * HD; const float* vn = F.out + O_VS + ((size_t)b * WIN + (WIN - 1)) * KVW + hk * HD;
    const float snew = wave_sum(qv * kn[lane]) + bt[head];
    const float mx = fmaxf(fmaxf(wave_max(fmaxf(sc[0], sc[1])), snew), sink2);
    const float p0 = __builtin_amdgcn_exp2f(sc[0] - mx), p1 = __builtin_amdgcn_exp2f(sc[1] - mx), pn = __builtin_amdgcn_exp2f(snew - mx);
    const float linv = __builtin_amdgcn_rcpf(wave_sum(p0 + p1) + pn + __builtin_amdgcn_exp2f(sink2 - mx));
    ps[lane] = p0; ps[lane + 64] = p1;
    LDS_WAIT(); asm volatile("" ::: "memory");
    const float* vr = A.in[3] + ((size_t)(b * WIN) * NKVH + hk) * HD + lane; float o = pn * vn[lane];
#pragma unroll 8
    for (int pos = 0; pos < WIN; ++pos) o += ps[pos] * vr[(size_t)pos * NKVH * HD];
    MX[(size_t)m * DM + head * 64 + lane] = f2bfs(o * linv);
    LDS_WAIT(); asm volatile("" ::: "memory");
}

constexpr int SC_T = 32, SC_REC = 1344  , SC_BUF = SC_T * SC_REC  ;
struct ScanRegs { v4u kk, bb, kp, rr, vv; f32x4 d0, d1; };
__device__ __forceinline__ void scan_load(ScanRegs& R, const unsigned char* ws, int m, int h, int rq, int part) {
    const size_t o = (size_t)m * RWW + 64 * h + 8 * part;
    R.kk = *(const GAS v4u*)((const bf16*)(ws + WS_KK) + o); R.bb = *(const GAS v4u*)((const bf16*)(ws + WS_BB) + o);
    R.kp = *(const GAS v4u*)((const bf16*)(ws + WS_KP) + o); R.rr = *(const GAS v4u*)((const bf16*)(ws + WS_RR) + o);
    R.d0 = *(const GAS f32x4*)((const float*)(ws + WS_DD) + o); R.d1 = *(const GAS f32x4*)((const float*)(ws + WS_DD) + o + 4);
    R.vv = (v4u){0u, 0u, 0u, 0u};
    if (part < 2) R.vv = *(const GAS v4u*)((const bf16*)(ws + WS_VV) + (size_t)m * RWW + 64 * h + 16 * rq + 8 * part);
}
__device__ __forceinline__ void st8(LAS unsigned char* p, v4u u) {
    *(LAS f32x4*)p = (f32x4){__builtin_bit_cast(float, u.x << 16), __builtin_bit_cast(float, u.x & 0xffff0000u), __builtin_bit_cast(float, u.y << 16), __builtin_bit_cast(float, u.y & 0xffff0000u)};
    *(LAS f32x4*)(p + 16) = (f32x4){__builtin_bit_cast(float, u.z << 16), __builtin_bit_cast(float, u.z & 0xffff0000u), __builtin_bit_cast(float, u.w << 16), __builtin_bit_cast(float, u.w & 0xffff0000u)};
}
__device__ __forceinline__ void scan_store(const ScanRegs& R, LAS unsigned char* rec, int part) {
    st8(rec + 0 + 32 * part, R.kk); *(LAS f32x4*)(rec + 256 + 32 * part) = R.d0; *(LAS f32x4*)(rec + 256 + 32 * part + 16) = R.d1;
    st8(rec + 512 + 32 * part, R.bb); st8(rec + 768 + 32 * part, R.kp); st8(rec + 1024 + 32 * part, R.rr);
    if (part < 2) st8(rec + 1280 + 32 * part, R.vv);
}
constexpr int SC_YOFF = 2 * SC_BUF, SC_YBUF = SC_T * 16 * 4 * 4  ;
static_assert(SC_YOFF + 2 * SC_YBUF <= RING_BYTES, "scan LDS");
struct ScanVec { f32x2 kk0, kk1, d0, d1, b0, b1, k0, k1, r0, r1; float v; };
__device__ __forceinline__ void scan_ld(ScanVec& x, const LAS unsigned char* base, const LAS unsigned char* vb, int t) {
    const f32x4 kk = *(const LAS f32x4*)(base + t * SC_REC), dd = *(const LAS f32x4*)(base + t * SC_REC + 256), bb = *(const LAS f32x4*)(base + t * SC_REC + 512),
                kp = *(const LAS f32x4*)(base + t * SC_REC + 768), rr = *(const LAS f32x4*)(base + t * SC_REC + 1024);
    x.kk0 = (f32x2){kk.x, kk.y}; x.kk1 = (f32x2){kk.z, kk.w}; x.d0 = (f32x2){dd.x, dd.y}; x.d1 = (f32x2){dd.z, dd.w}; x.b0 = (f32x2){bb.x, bb.y}; x.b1 = (f32x2){bb.z, bb.w};
    x.k0 = (f32x2){kp.x, kp.y}; x.k1 = (f32x2){kp.z, kp.w}; x.r0 = (f32x2){rr.x, rr.y}; x.r1 = (f32x2){rr.z, rr.w};
    x.v = *(const LAS float*)(vb + t * SC_REC);
}
__device__ __forceinline__ void scan_yflush(const LAS unsigned char* yb, float* YS, int ptid) {
#pragma unroll
    for (int i = 0; i < 2; ++i) { const int o = ptid + 256 * i, t = o >> 4, r = o & 15; const f32x4 q = *(const LAS f32x4*)(yb + o * 16);
        YS[(size_t)t * RWW + r] = (q.x + q.y) + (q.z + q.w); }
}
__device__ __forceinline__ void scan_unit(Frame& F, int c) {
    const int b = c >> 6, h = (c >> 2) & 15, rq = c & 3, lane = F.lane, wave = F.wave;
    unsigned char* ws = F.ws; LAS unsigned char* lds = F.lds;
    const int mb = b * SEQ; constexpr int NCH = SEQ / SC_T;
    if (wave >= 4) {
        const int ptid = F.tid - 256, tok = ptid >> 3, part = ptid & 7;
        float* YS = (float*)(ws + WS_ACT) + (size_t)mb * RWW + 64 * h + 16 * rq;
        ScanRegs cur, nxt;
        scan_load(cur, ws, mb + tok, h, rq, part);
        scan_load(nxt, ws, mb + SC_T + tok, h, rq, part);
        scan_store(cur, lds + tok * SC_REC, part);
        __syncthreads();
        for (int ch = 0; ch < NCH; ++ch) {
            cur = nxt;
            if (ch + 2 < NCH) scan_load(nxt, ws, mb + (ch + 2) * SC_T + tok, h, rq, part);
            if (ch + 1 < NCH) scan_store(cur, lds + ((ch + 1) & 1) * SC_BUF + tok * SC_REC, part);
            if (ch > 0) scan_yflush(lds + SC_YOFF + ((ch - 1) & 1) * SC_YBUF, YS + (size_t)(ch - 1) * SC_T * RWW, ptid);
            __syncthreads();
        }
        scan_yflush(lds + SC_YOFF + ((NCH - 1) & 1) * SC_YBUF, YS + (size_t)(NCH - 1) * SC_T * RWW, ptid);
    } else {
        const int rl = 4 * wave + (lane >> 4), p = lane & 15, row = 16 * rq + rl;
        f32x2 S0 = (f32x2){0.f, 0.f}, S1 = S0;
        __builtin_amdgcn_s_setprio(2);
        __syncthreads();
        for (int ch = 0; ch < NCH; ++ch) {
            const LAS unsigned char* base = lds + (ch & 1) * SC_BUF + p * 16;
            const LAS unsigned char* vb = lds + (ch & 1) * SC_BUF + 1280 + rl * 4;
            LAS unsigned char* yb = lds + SC_YOFF + (ch & 1) * SC_YBUF + (rl * 4 + (p & 3)) * 4;
            ScanVec cur; scan_ld(cur, base, vb, 0);
#pragma unroll
            for (int t = 0; t < SC_T; ++t) {
                ScanVec nxt; scan_ld(nxt, base, vb, t + 1 < SC_T ? t + 1 : t);
                f32x2 a = S0 * cur.kk0; a = S1 * cur.kk1 + a;
                const float sa = -allsum16(a.x + a.y);
                const f32x2 sa2 = (f32x2){sa, sa}, v2 = (f32x2){cur.v, cur.v};
                f32x2 u0 = cur.b0 * sa2, u1 = cur.b1 * sa2;
                u0 = S0 * cur.d0 + u0; u1 = S1 * cur.d1 + u1;
                S0 = cur.k0 * v2 + u0; S1 = cur.k1 * v2 + u1;
                f32x2 q = S0 * cur.r0; q = S1 * cur.r1 + q;
                float y = q.x + q.y; y += dpp_f<0x128>(y); y += dpp_f<0x124>(y);
                *(LAS float*)(yb + t * 256) = y;
                cur = nxt;
            }
            __syncthreads();
        }
        __builtin_amdgcn_s_setprio(0);
        *(f32x4*)(F.out + O_WP + ((size_t)(b * RWH + h) * HD + row) * HD + 4 * p) = (f32x4){S0.x, S0.y, S1.x, S1.y};
    }
}
__device__ __forceinline__ void dec_rwkv_unit(Frame& F, const Args& A, int du) {
    const int lane = F.lane, wave = F.wave; unsigned char* ws = F.ws;
    const int idx = du * 8 + wave, b = idx >> 4, h = idx & 15, m = MP + b;
    LAS float* vec = (LAS float*)(F.lds + wave * 1280);
    const size_t o = (size_t)m * RWW + 64 * h + lane;
    vec[lane] = bf2f(((const bf16*)(ws + WS_KK))[o]); vec[64 + lane] = ((const float*)(ws + WS_DD))[o]; vec[128 + lane] = bf2f(((const bf16*)(ws + WS_BB))[o]);
    vec[192 + lane] = bf2f(((const bf16*)(ws + WS_KP))[o]); vec[256 + lane] = bf2f(((const bf16*)(ws + WS_RR))[o]);
    const float vi = bf2f(((const bf16*)(ws + WS_VV))[o]);
    const size_t so = ((size_t)(b * RWH + h) * HD + lane) * HD;
    const float* Sp = A.in[4] + so; f32x4 S[16];
#pragma unroll
    for (int j = 0; j < 16; ++j) S[j] = *(const f32x4*)(Sp + 4 * j);
    LDS_WAIT(); asm volatile("" ::: "memory");
    float sa = 0.f;
#pragma unroll
    for (int j = 0; j < 16; ++j) { const f32x4 kk = *(const LAS f32x4*)(vec + 4 * j); sa += (S[j].x * kk.x + S[j].y * kk.y) + (S[j].z * kk.z + S[j].w * kk.w); asm volatile("" ::: "memory"); }
    sa = -sa; float y = 0.f; float* So = F.out + O_WS + so;
#pragma unroll
    for (int j = 0; j < 16; ++j) { const f32x4 dd = *(const LAS f32x4*)(vec + 64 + 4 * j), bb = *(const LAS f32x4*)(vec + 128 + 4 * j), kp = *(const LAS f32x4*)(vec + 192 + 4 * j), rr = *(const LAS f32x4*)(vec + 256 + 4 * j);
        S[j] = S[j] * dd + bb * sa + kp * vi; y += (S[j].x * rr.x + S[j].y * rr.y) + (S[j].z * rr.z + S[j].w * rr.w);
        *(f32x4*)(So + 4 * j) = S[j]; asm volatile("" ::: "memory"); }
    ((float*)(ws + WS_ACT))[o] = y;
    LDS_WAIT(); asm volatile("" ::: "memory");
}

constexpr int SK_S = 4;
__device__ __forceinline__ void skinny_units(Frame& F, const bf16* Arows, int lda, const bf16* Bt, int K, unsigned* cnt, float* slabs,
                                             const float* xi_s, float* xo_s, bf16* XBd, float* ssq, float alpha) {
    const int tid = F.tid, lane = F.lane, wave = F.wave, ln = lane & 15, q4 = lane >> 4, ksteps = K / 32;
    LAS unsigned char* lds = F.lds;
    for (int u = blockIdx.x; u < 32 * SK_S; u += F.G) {
        const int nb = u & 31, sl = u >> 5, n0 = 64 * nb, ks0 = sl * ksteps / SK_S, ks1 = (sl + 1) * ksteps / SK_S;
        f32x4 acc[2][4];
#pragma unroll
        for (int mt = 0; mt < 2; ++mt)
#pragma unroll
            for (int nt = 0; nt < 4; ++nt) acc[mt][nt] = (f32x4){0.f, 0.f, 0.f, 0.f};
        const bf16* ap = Arows + (size_t)ln * lda + 8 * q4; const bf16* bp = Bt + (size_t)(n0 + ln) * K + 8 * q4;
#pragma unroll 2
        for (int ks = ks0 + wave; ks < ks1; ks += 8) { const int k = 32 * ks;
            bf16x8 a[2], b[4];
#pragma unroll
            for (int mt = 0; mt < 2; ++mt) a[mt] = *(const GAS bf16x8*)(ap + (size_t)(16 * mt) * lda + k);
#pragma unroll
            for (int nt = 0; nt < 4; ++nt) b[nt] = *(const GAS bf16x8*)(bp + (size_t)(16 * nt) * K + k);
#pragma unroll
            for (int mt = 0; mt < 2; ++mt)
#pragma unroll
                for (int nt = 0; nt < 4; ++nt) acc[mt][nt] = __builtin_amdgcn_mfma_f32_16x16x32_bf16(a[mt], b[nt], acc[mt][nt], 0, 0, 0); }
#pragma unroll
        for (int mt = 0; mt < 2; ++mt)
#pragma unroll
            for (int nt = 0; nt < 4; ++nt) *(LAS f32x4*)(lds + ((wave * 8 + mt * 4 + nt) * 64 + lane) * 16) = acc[mt][nt];
        __syncthreads();
        { const int tile = tid >> 6, l = tid & 63; f32x4 sum = (f32x4){0.f, 0.f, 0.f, 0.f};
#pragma unroll
          for (int w = 0; w < 8; ++w) sum += *(const LAS f32x4*)(lds + ((w * 8 + tile) * 64 + l) * 16);
          float* sp = slabs + (size_t)sl * 32 * DM + (size_t)(16 * (tile >> 2) + 4 * (l >> 4)) * DM + n0 + 16 * (tile & 3) + (l & 15);
          sp[0] = sum.x; sp[DM] = sum.y; sp[2 * DM] = sum.z; sp[3 * DM] = sum.w; }
        VM_WAIT(); __syncthreads();
        if (tid == 0) { __builtin_amdgcn_fence(__ATOMIC_RELEASE, "agent"); VM_WAIT();
            const unsigned t = __hip_atomic_fetch_add(cnt + nb, 1u, __ATOMIC_RELAXED, __HIP_MEMORY_SCOPE_AGENT);
            const unsigned last = (t == (unsigned)(SK_S - 1)) ? 1u : 0u;
            if (last) { __builtin_amdgcn_fence(__ATOMIC_ACQUIRE, "agent"); VM_WAIT(); }
            *(LAS unsigned*)(lds + 65536) = last; }
        __syncthreads();
        const unsigned last = *(const LAS unsigned*)(lds + 65536);
        if (last) {
            const int row = tid >> 4, c4 = (tid & 15) * 4, col = n0 + c4;
            f32x4 a4 = (f32x4){0.f, 0.f, 0.f, 0.f};
#pragma unroll
            for (int s2 = 0; s2 < SK_S; ++s2) a4 += *(const GAS f32x4*)(slabs + (size_t)s2 * 32 * DM + (size_t)row * DM + col);
            const f32x4 x0 = *(const f32x4*)(xi_s + (size_t)row * DM + col);
            const f32x4 y = x0 + a4 * alpha;
            *(f32x4*)(xo_s + (size_t)row * DM + col) = y;
            if (XBd) *(GAS unsigned long long*)(XBd + (size_t)(MP + row) * DM + col) = (unsigned long long)pk2(y.x, y.y) | ((unsigned long long)pk2(y.z, y.w) << 32);
            float sq = (y.x * y.x + y.y * y.y) + (y.z * y.z + y.w * y.w);
            sq += __shfl_xor(sq, 1); sq += __shfl_xor(sq, 2); sq += __shfl_xor(sq, 4); sq += __shfl_xor(sq, 8);
            if ((tid & 15) == 0) atomicAdd(ssq + MP + row, sq);
        }
        __syncthreads();
    }
}
__global__ void __launch_bounds__(NWAVES * 64, 2) hymba_fwd(Args args) {
    extern __shared__ __attribute__((aligned(16))) unsigned char lds_raw[];
    { const int t0_ = threadIdx.x;
      for (int u = t0_; u < (LDS_BYTES - LDSCTL_OFF) / 4; u += NWAVES * 64) ((LAS unsigned*)((LAS unsigned char*)lds_raw + LDSCTL_OFF))[u] = 0u; }
    __syncthreads();
    XcdBarrier bar; bar.bar = (unsigned*)((gu32*)(args.ws + WS_CTL) + CW_BAR); bar.x = 0; bar.st = nullptr;
    if (MK_N_LAUNCHES == 1) bar = xcd_barrier_post((unsigned*)((gu32*)(args.ws + WS_CTL) + CW_BAR), (volatile LAS unsigned*)((LAS unsigned char*)lds_raw + MISC_OFF) + 8);
    const int lo = args.ph_lo, hi = args.ph_hi;
#ifndef PH_MASK
#define PH_MASK 0x7ff
#endif
#define IN(k) (((PH_MASK >> (k)) & 1) && lo <= (k) && (k) < hi)
#define SEAM(k) do { if (IN(k) && IN((k) + 1)) xcd_barrier(bar); } while (0)
#ifndef PROBE_REP
#define PROBE_REP 0
#endif
#define NREP(k) (1 + ((PROBE_REP >> (k)) & 1))
#define PHASE_FRAME() Frame F; { int t_ = threadIdx.x; asm volatile("" : "+v"(t_)); F.lds = (LAS unsigned char*)lds_raw; F.MISC = (volatile LAS unsigned*)(F.lds + MISC_OFF); F.tid = t_; F.lane = t_ & 63; \
        F.wave = __builtin_amdgcn_readfirstlane(t_ >> 6); F.G = gridDim.x; F.out = args.out; F.ws = args.ws; F.ctl = (gu32*)(args.ws + WS_CTL); } \
    unsigned char* ws = F.ws; const int gw = blockIdx.x * NWAVES + F.wave, NGW = F.G * NWAVES; (void)gw; (void)NGW; \
    bf16* XB = (bf16*)(ws + WS_XB); bf16* ACT = (bf16*)(ws + WS_ACT); bf16* X2B = (bf16*)(ws + WS_X2B); (void)XB; (void)ACT; (void)X2B; \
    float* ssq0 = (float*)(F.ctl + CW_SSQ0); float* ssq1 = (float*)(F.ctl + CW_SSQ1); float* ssq2 = (float*)(F.ctl + CW_SSQ2); float* ssq3 = (float*)(F.ctl + CW_SSQ3); float* ssqd = (float*)(F.ctl + CW_SSQD); (void)ssqd; (void)ssq0; (void)ssq1; (void)ssq2; (void)ssq3; \
    float* yp = args.out + O_YP; float* ys = args.out + O_YS; (void)yp; (void)ys;

    if (IN(0)) for (int rep = 0; rep < NREP(0); ++rep) { PHASE_FRAME(); p0_prologue(F, args); if (rep + 1 < NREP(0)) xcd_barrier(bar); else SEAM(0); }
    if (IN(1)) for (int rep = 0; rep < NREP(1); ++rep) { PHASE_FRAME(); pg8::Gemm g{XB, (const bf16*)(ws + WS_WGU1), MPAD, 2 * DFF, DM}; pg8::StaticOrder S; S.init(MPAD, 2 * DFF, F.G, (int)blockIdx.x);
        pg8::EpiSwiglu E{ACT, ssq0};
        pg8::gemm_phase<pg8::EpiSwiglu, pg8::StaticOrder, true, true>(F.lds + RING_OFF, g, S, E);
#ifndef CV_ALL_IN_P0
        { const int nfull = S.nwg % F.G; if (rep == 0 && nfull != 0 && (int)blockIdx.x >= nfull) convert_items(F, args, CV_EARLY, CV_LATE1, (int)blockIdx.x - nfull, F.G - nfull);
          else if (rep == 0 && nfull == 0) convert_items(F, args, CV_EARLY, CV_LATE1, blockIdx.x, F.G); }
#endif
        if (rep + 1 < NREP(1)) xcd_barrier(bar); else SEAM(1); }
    if (IN(2)) for (int rep = 0; rep < NREP(2); ++rep) { PHASE_FRAME(); pg8::Gemm g{ACT, (const bf16*)(ws + WS_WD1), MP, DM, DFF}; pg8::StaticOrder S; S.init(MP, DM, F.G, (int)blockIdx.x);
        pg8::EpiResid E{args.in[0], args.in[1], yp, ys, XB, rep ? ssqd : ssq1, 0.5f};
        pg8::gemm_phase<pg8::EpiResid, pg8::StaticOrder, true, true>(F.lds + RING_OFF, g, S, E);
        skinny_units(F, ACT + (size_t)MP * DFF, DFF, (const bf16*)(ws + WS_WD1), DFF, (unsigned*)(F.ctl + CW_SKC + 64 * rep), (float*)(ws + WS_SLAB), args.in[1], ys, XB, rep ? ssqd : ssq1, 0.5f);
        if (rep + 1 < NREP(2)) xcd_barrier(bar); else SEAM(2); }
    if (IN(3)) for (int rep = 0; rep < NREP(3); ++rep) { PHASE_FRAME(); pg8::Gemm g{XB, (const bf16*)(ws + WS_WINB), MPAD, INC, DM}; pg8::StaticOrder S; S.init(MPAD, INC, F.G, (int)blockIdx.x);
        pg8::EpiWin E{ssq1, (bf16*)(ws + WS_QB), (bf16*)(ws + WS_KB), (bf16*)(ws + WS_VB), (float*)(ws + WS_ACT), args.out};
        pg8::gemm_phase<pg8::EpiWin, pg8::StaticOrder, true, true>(F.lds + RING_OFF, g, S, E);
#ifndef CV_ALL_IN_P0
        { const int nfull = S.nwg % F.G; if (rep == 0 && nfull != 0 && (int)blockIdx.x >= nfull) convert_items(F, args, CV_EARLY + CV_LATE1, CV_LATE2, (int)blockIdx.x - nfull, F.G - nfull);
          else if (rep == 0 && nfull == 0) convert_items(F, args, CV_EARLY + CV_LATE1, CV_LATE2, blockIdx.x, F.G); }
#endif
        if (rep + 1 < NREP(3)) xcd_barrier(bar); else SEAM(3); }
    if (IN(4)) for (int rep = 0; rep < NREP(4); ++rep) { PHASE_FRAME();
        for (int r2 = 0; r2 < 1 + ((PROBE_REP >> 11) & 1); ++r2)
        for (int u = blockIdx.x; u < NB * 16 * NKVH; u += F.G) attn_unit(F, args, u >> 6, (u >> 2) & 15, u & 3);
        for (int r2 = 0; r2 < 1 + ((PROBE_REP >> 12) & 1); ++r2) { __syncthreads(); prep_phase(F, args); }
        __syncthreads();
        for (int r2 = 0; r2 < 1 + ((PROBE_REP >> 13) & 1); ++r2)
        for (int u = (int)F.G - 1 - (int)blockIdx.x; u < NDEC * NQH / 8; u += F.G) dec_attn_unit(F, args, u);
        __syncthreads();
        { const int n4 = NDEC * (WIN - 1) * KVW / 4;
          for (int i = blockIdx.x * (NWAVES * 64) + F.tid; i < 2 * n4; i += F.G * NWAVES * 64) { const int t = i >= n4, j = t ? i - n4 : i; const int bb = j / ((WIN - 1) * KVW / 4), r = j % ((WIN - 1) * KVW / 4);
              const f32x4 v = *((const f32x4*)(args.in[2 + t] + (size_t)bb * WIN * KVW + KVW) + r);
              *((f32x4*)(args.out + (t ? O_VS : O_KS) + (size_t)bb * WIN * KVW) + r) = v; } }
        if (rep + 1 < NREP(4)) xcd_barrier(bar); else SEAM(4); }
    if (IN(5)) for (int rep = 0; rep < NREP(5); ++rep) { PHASE_FRAME();
        for (int u = blockIdx.x; u < NB * RWH * 4; u += F.G) scan_unit(F, u);
        __syncthreads();
        for (int u = blockIdx.x; u < NDEC * RWH / 8; u += F.G) dec_rwkv_unit(F, args, u);
        if (rep + 1 < NREP(5)) xcd_barrier(bar); else SEAM(5); }
    if (IN(6)) for (int rep = 0; rep < NREP(6); ++rep) { PHASE_FRAME(); const float* YS = (const float*)(ws + WS_ACT); const bf16* LG = (const bf16*)(ws + WS_LG); const bf16* EE = (const bf16*)(ws + WS_EE);
        for (int u = gw; u < MV * RWH; u += NGW) { const size_t o = (size_t)(u >> 4) * RWW + 64 * (u & 15) + F.lane;
            const float y = YS[o], mean = wave_sum(y) * (1.0f / 64.0f), dl = y - mean, var = wave_sum(dl * dl) * (1.0f / 64.0f);
            const float r = dl * __builtin_amdgcn_rsqf(var + GN_EPS) * bf2f(LG[o]) + bf2f(EE[o]);
            XB[(size_t)(u >> 4) * DM + ATTW + 64 * (u & 15) + F.lane] = f2bfs(r); }
        if (rep + 1 < NREP(6)) xcd_barrier(bar); else SEAM(6); }
    if (IN(7)) for (int rep = 0; rep < NREP(7); ++rep) { PHASE_FRAME(); pg8::Gemm g{XB, (const bf16*)(ws + WS_WOUT), MP, DM, DM}; pg8::StaticOrder S; S.init(MP, DM, F.G, (int)blockIdx.x);
        pg8::EpiResid E{yp, ys, yp, ys, rep ? nullptr : X2B, rep ? ssqd : ssq2, rep ? 0.0f : 1.0f};
        pg8::gemm_phase<pg8::EpiResid, pg8::StaticOrder, true, true>(F.lds + RING_OFF, g, S, E);
        skinny_units(F, XB + (size_t)MP * DM, DM, (const bf16*)(ws + WS_WOUT), DM, (unsigned*)(F.ctl + CW_SKC + 128 + 64 * rep), (float*)(ws + WS_SLAB), ys, ys, rep ? nullptr : X2B, rep ? ssqd : ssq2, rep ? 0.0f : 1.0f);
        if (rep + 1 < NREP(7)) xcd_barrier(bar); else SEAM(7); }
    if (IN(8)) for (int rep = 0; rep < NREP(8); ++rep) { PHASE_FRAME(); pg8::Gemm g{X2B, (const bf16*)(ws + WS_WGU2), MPAD, 2 * DFF, DM}; pg8::StaticOrder S; S.init(MPAD, 2 * DFF, F.G, (int)blockIdx.x);
        pg8::EpiSwiglu E{ACT, ssq2};
        pg8::gemm_phase<pg8::EpiSwiglu, pg8::StaticOrder, true, true>(F.lds + RING_OFF, g, S, E); if (rep + 1 < NREP(8)) xcd_barrier(bar); else SEAM(8); }
    if (IN(9)) for (int rep = 0; rep < NREP(9); ++rep) { PHASE_FRAME(); pg8::Gemm g{ACT, (const bf16*)(ws + WS_WD2), MP, DM, DFF}; pg8::StaticOrder S; S.init(MP, DM, F.G, (int)blockIdx.x);
        pg8::EpiResid E{yp, ys, yp, ys, nullptr, rep ? ssqd : ssq3, rep ? 0.0f : 0.5f};
        pg8::gemm_phase<pg8::EpiResid, pg8::StaticOrder, true, true>(F.lds + RING_OFF, g, S, E);
        skinny_units(F, ACT + (size_t)MP * DFF, DFF, (const bf16*)(ws + WS_WD2), DFF, (unsigned*)(F.ctl + CW_SKC + 256 + 64 * rep), (float*)(ws + WS_SLAB), ys, ys, nullptr, rep ? ssqd : ssq3, rep ? 0.0f : 0.5f);
        if (rep + 1 < NREP(9)) xcd_barrier(bar); else SEAM(9); }
    if (IN(10)) for (int rep = 0; rep < NREP(10); ++rep) { PHASE_FRAME(); const float* fn = args.in[30];
        for (int m = gw; m < MV; m += NGW) { float* xr = m < MP ? yp + (size_t)m * DM : ys + (size_t)(m - MP) * DM;
            const float s = rep ? 1.0f : __builtin_amdgcn_rsqf(ssq3[m] * (1.0f / DM) + RMS_EPS);
            GAS f32x4* x4 = (GAS f32x4*)xr + F.lane; const GAS f32x4* f4 = (const GAS f32x4*)fn + F.lane;
#pragma unroll
            for (int j = 0; j < 8; ++j) x4[64 * j] = rep ? x4[64 * j] * s : x4[64 * j] * s * f4[64 * j]; } if (NREP(10) > 1 && rep == 0) xcd_barrier(bar); }
#undef IN
#undef SEAM
}

extern "C" void kernel_launch(void* const* d_in, const int* in_sizes, int n_in, void* d_out, int out_size, void* d_ws, size_t ws_size, hipStream_t stream) {
    static int grid = 0;
    if (grid == 0) {
        if (n_in != 31 || in_sizes[0] != MP * DM || (size_t)out_size != O_END || ws_size < WS_END2) {
            fprintf(stderr, "kernel_launch: unexpected shapes: n_in %d in0 %d out %d (want %zu) ws %zu (want >= %zu); nothing launched\n", n_in, n_in > 0 ? in_sizes[0] : -1, out_size, (size_t)O_END, ws_size, (size_t)WS_END2);
            grid = -1; return; }
        int dev = 0, cus = 0, per_cu = 0;
        if (hipGetDevice(&dev) != hipSuccess || hipDeviceGetAttribute(&cus, hipDeviceAttributeMultiprocessorCount, dev) != hipSuccess) { fprintf(stderr, "kernel_launch: device query failed\n"); grid = -1; return; }
        if (hipFuncSetAttribute((const void*)hymba_fwd, hipFuncAttributeMaxDynamicSharedMemorySize, LDS_BYTES) != hipSuccess) { fprintf(stderr, "kernel_launch: hipFuncSetAttribute failed\n"); grid = -1; return; }
        if (hipOccupancyMaxActiveBlocksPerMultiprocessor(&per_cu, (const void*)hymba_fwd, NWAVES * 64, LDS_BYTES) != hipSuccess || per_cu < 1)
            fprintf(stderr, "kernel_launch: note: occupancy query reports %d workgroups per CU\n", per_cu);
        (void)hipGetLastError();
        grid = cus;
    }
    if (grid < 0) return;
    if (hipMemsetAsync((char*)d_ws + WS_CTL, 0, CTL_ZERO_BYTES, stream) != hipSuccess) { fprintf(stderr, "kernel_launch: hipMemsetAsync failed\n"); return; }
    Args a{};
    for (int i = 0; i < 31; ++i) a.in[i] = (const float*)d_in[i];
    a.out = (float*)d_out; a.ws = (unsigned char*)d_ws;
    for (int li = 0; li < MK_N_LAUNCHES; ++li) {
        a.ph_lo = (MK_N_LAUNCHES == 1) ? 0 : li; a.ph_hi = (MK_N_LAUNCHES == 1) ? NPHASES : li + 1; a.li = li;
        hipLaunchKernelGGL(hymba_fwd, dim3(grid), dim3(NWAVES * 64), LDS_BYTES, stream, a);
        const hipError_t le = hipPeekAtLastError();
        if (le != hipSuccess) { fprintf(stderr, "kernel_launch: launch %d failed: %s\n", li, hipGetErrorName(le)); break; }
    }
}
```

```cpp
#include <hip/hip_runtime.h>
#include <cstdio>
#include <cstdint>
#define MK_N_LAUNCHES 1
constexpr int DM = 2048, SEQ = 2048, NB = 4, MP = NB * SEQ  , NDEC = 32, MV = MP + NDEC  , MPAD = 8448  ;
constexpr int DFF = 5504, ATTW = 1024, KVW = 256, RWW = 1024, NQH = 16, NKVH = 4, HD = 64, RWH = 16, WIN = 128;
constexpr int ATT_COLS = ATTW + 2 * KVW  , SHC = 3 * RWW + 64 + 64 + 128  , INC = ATT_COLS + SHC  ;
constexpr float RMS_EPS = 1e-5f, GN_EPS = 64e-5f, LOG2E = 1.4426950408889634f;
constexpr float QSCALE = 0.125f * LOG2E;
constexpr size_t O_YP = 0, O_YS = O_YP + (size_t)MP * DM, O_KP = O_YS + (size_t)NDEC * DM, O_VP = O_KP + (size_t)NB * WIN * KVW, O_WP = O_VP + (size_t)NB * WIN * KVW,
                 O_SP = O_WP + (size_t)NB * RWH * HD * HD, O_KS = O_SP + (size_t)NB * SHC, O_VS = O_KS + (size_t)NDEC * WIN * KVW, O_WS = O_VS + (size_t)NDEC * WIN * KVW,
                 O_SS = O_WS + (size_t)NDEC * RWH * HD * HD, O_END = O_SS + (size_t)NDEC * SHC;
namespace pg8 {
#define PG8_LAS __attribute__((address_space(3)))
typedef unsigned short bf16_t;
typedef short bf16x8 __attribute__((ext_vector_type(8)));
typedef float f32x4 __attribute__((ext_vector_type(4)));
typedef unsigned u32x4 __attribute__((ext_vector_type(4)));
constexpr int BM = 256, BK = 64, HALF = 128, HTB = HALF * BK * 2  , STAGE_BYTES = 8 * HTB, NXCD = 8, WGM = 8;

__host__ __device__ __forceinline__ int lds_byte(int r, int c) { const int st = (r >> 4) * 2 + (c >> 5), rr = r & 15, cc = c & 31, ob = rr * 64 + cc * 2; return st * 1024 + (ob ^ (((ob >> 9) & 1) << 5)); }
__host__ __device__ __forceinline__ void stage_rc(int b, int& R, int& C) { const int st = b / 1024, sb = b % 1024, swz = sb ^ (((sb >> 9) & 1) << 5); R = (st >> 1) * 16 + swz / 64; C = (st & 1) * 32 + (swz % 64) / 2; }
__host__ __device__ __forceinline__ int perm32(int rho) { const int n = rho >> 4, i = rho & 15; return 8 * (i >> 2) + 4 * n + (i & 3); }

struct Unit { int pm, pn; };
struct Gemm { const bf16_t* A; const bf16_t* Bt; int M, N, K; };

struct StaticOrder {
    int nM, nN, nwg, G, c;
    __host__ __device__ void init(int M, int N, int G_, int c_) { nM = M / BM; nN = N / BM; nwg = nM * nN; G = G_; c = c_; }
    __host__ __device__ bool next(int i, Unit& u) const {
        const long L = (long)i * G + c; if (L >= nwg) return false;
        int wgid = (int)L; { const int q = nwg / NXCD, r = nwg % NXCD, xcd = wgid % NXCD, off = wgid / NXCD; wgid = (xcd < r ? xcd * (q + 1) : r * (q + 1) + (xcd - r) * q) + off; }
        const int nig = WGM * nN, gid = wgid / nig, fm = gid * WGM, gsz = (nM - fm) < WGM ? (nM - fm) : WGM;
        u.pm = fm + ((wgid % nig) % gsz); u.pn = (wgid % nig) / gsz; return true;
    }
    __device__ __forceinline__ void a_ready(const Unit&) const {}
    __device__ __forceinline__ void done(const Unit&) const {}
};

__device__ __forceinline__ unsigned cvt_pk_bf16(float lo, float hi) { unsigned r; asm volatile("v_cvt_pk_bf16_f32 %0, %1, %2" : "=v"(r) : "v"(lo), "v"(hi)); return r; }
__device__ __forceinline__ float silu_mul(float g, float u) { return g * u * __builtin_amdgcn_rcpf(1.0f + __builtin_amdgcn_exp2f(-g * LOG2E)); }

struct EpiSwiglu {
    static constexpr bool PERM = true, AFTER_DRAIN = false;
    bf16_t* O; const float* ssq;
    __device__ __forceinline__ void operator()(const f32x4 (&acc)[2][2][4][2], const Unit& u, int wr, int wc, int fr, int fq) const {
        const int row0 = u.pm * BM + wr * 64 + fr, col0 = u.pn * HALF + wc * 32 + 8 * fq;
#pragma unroll
        for (int ai = 0; ai < 2; ++ai)
#pragma unroll
            for (int m = 0; m < 4; ++m) { const int row = row0 + ai * HALF + m * 16;
                const float s = __builtin_amdgcn_rsqf(ssq[row] * (1.0f / DM) + RMS_EPS);
                const f32x4 g0 = acc[ai][0][m][0] * s, g1 = acc[ai][0][m][1] * s, u0 = acc[ai][1][m][0] * s, u1 = acc[ai][1][m][1] * s;
                u32x4 w; w.x = cvt_pk_bf16(silu_mul(g0[0], u0[0]), silu_mul(g0[1], u0[1])); w.y = cvt_pk_bf16(silu_mul(g0[2], u0[2]), silu_mul(g0[3], u0[3]));
                w.z = cvt_pk_bf16(silu_mul(g1[0], u1[0]), silu_mul(g1[1], u1[1])); w.w = cvt_pk_bf16(silu_mul(g1[2], u1[2]), silu_mul(g1[3], u1[3]));
                *(u32x4*)(O + (size_t)row * DFF + col0) = w; }
    }
};

struct EpiResid {
    static constexpr bool PERM = true, AFTER_DRAIN = false;
    const float* xi_p; const float* xi_s; float* xo_p; float* xo_s; bf16_t* XB; float* ssq; float alpha;
    __device__ __forceinline__ void operator()(const f32x4 (&acc)[2][2][4][2], const Unit& u, int wr, int wc, int fr, int fq) const {
        const int row0 = u.pm * BM + wr * 64 + fr, col0 = u.pn * BM + wc * 32 + 8 * fq;
#pragma unroll
        for (int ai = 0; ai < 2; ++ai)
#pragma unroll
            for (int m = 0; m < 4; ++m) { const int row = row0 + ai * HALF + m * 16; const bool valid = row < MV;
                const size_t ro = row < MP ? (size_t)row * DM : (size_t)(row - MP) * DM;
                const float* src = (row < MP ? xi_p : xi_s) + ro; float* dst = (row < MP ? xo_p : xo_s) + ro;
                float sq = 0.f;
#pragma unroll
                for (int bj = 0; bj < 2; ++bj) { const int col = col0 + bj * HALF;
                    f32x4 x0 = (f32x4){0.f, 0.f, 0.f, 0.f}, x1 = x0;
                    if (valid) { x0 = *(const f32x4*)(src + col); x1 = *(const f32x4*)(src + col + 4); }
                    const f32x4 y0 = x0 + acc[ai][bj][m][0] * alpha, y1 = x1 + acc[ai][bj][m][1] * alpha;
                    if (valid) { *(f32x4*)(dst + col) = y0; *(f32x4*)(dst + col + 4) = y1; }
                    sq += (y0[0] * y0[0] + y0[1] * y0[1]) + (y0[2] * y0[2] + y0[3] * y0[3]) + (y1[0] * y1[0] + y1[1] * y1[1]) + (y1[2] * y1[2] + y1[3] * y1[3]);
                    if (XB) { u32x4 w; w.x = cvt_pk_bf16(y0[0], y0[1]); w.y = cvt_pk_bf16(y0[2], y0[3]); w.z = cvt_pk_bf16(y1[0], y1[1]); w.w = cvt_pk_bf16(y1[2], y1[3]);
                        *(u32x4*)(XB + (size_t)row * DM + col) = w; } }
                sq += __shfl_xor(sq, 16); sq += __shfl_xor(sq, 32);
                if (fq == 0 && valid) atomicAdd(ssq + row, sq); }
    }
};

struct EpiWin {
    static constexpr bool PERM = true, AFTER_DRAIN = false;
    const float* ssq; bf16_t* QB; bf16_t* KB; bf16_t* VB; float* PR; float* out;
    __device__ __forceinline__ void operator()(const f32x4 (&acc)[2][2][4][2], const Unit& u, int wr, int wc, int fr, int fq) const {
        const int row0 = u.pm * BM + wr * 64 + fr, cl0 = wc * 32 + 8 * fq;
        const int pn = u.pn;
#pragma unroll
        for (int ai = 0; ai < 2; ++ai)
#pragma unroll
            for (int m = 0; m < 4; ++m) { const int row = row0 + ai * HALF + m * 16; const bool valid = row < MV;
                float s = __builtin_amdgcn_rsqf(ssq[row] * (1.0f / DM) + RMS_EPS);
                if (pn < 4) s *= QSCALE;
#pragma unroll
                for (int bj = 0; bj < 2; ++bj) { const int cl = cl0 + bj * HALF;
                    const f32x4 y0 = acc[ai][bj][m][0] * s, y1 = acc[ai][bj][m][1] * s;
                    if (pn < 6) { u32x4 w; w.x = cvt_pk_bf16(y0[0], y0[1]); w.y = cvt_pk_bf16(y0[2], y0[3]); w.z = cvt_pk_bf16(y1[0], y1[1]); w.w = cvt_pk_bf16(y1[2], y1[3]);
                        if (pn < 4) *(u32x4*)(QB + (size_t)row * ATTW + pn * BM + cl) = w;
                        else { *(u32x4*)((pn == 4 ? KB : VB) + (size_t)row * KVW + cl) = w;
                            if (valid) { float* o = nullptr;
                                if (row >= MP) o = out + (pn == 4 ? O_KS : O_VS) + ((size_t)(row - MP) * WIN + (WIN - 1)) * KVW + cl;
                                else if ((row & (SEQ - 1)) >= SEQ - WIN) o = out + (pn == 4 ? O_KP : O_VP) + ((size_t)(row >> 11) * WIN + ((row & (SEQ - 1)) - (SEQ - WIN))) * KVW + cl;
                                if (o) { *(f32x4*)o = y0; *(f32x4*)(o + 4) = y1; } } }
                    } else { const int cs = (pn - 6) * BM + cl;
                        *(f32x4*)(PR + (size_t)row * SHC + cs) = y0; *(f32x4*)(PR + (size_t)row * SHC + cs + 4) = y1;
                        if (valid) { float* o = nullptr;
                            if (row >= MP) o = out + O_SS + (size_t)(row - MP) * SHC + cs;
                            else if ((row & (SEQ - 1)) == SEQ - 1) o = out + O_SP + (size_t)(row >> 11) * SHC + cs;
                            if (o) { *(f32x4*)o = y0; *(f32x4*)(o + 4) = y1; } } } }
            }
    }
};
template <class Epi, class Sched, bool ALIGN_EPI = false, bool SP2 = false>
__device__ __forceinline__ void gemm_phase(PG8_LAS unsigned char* lds, const Gemm g, const Sched& S, const Epi& E) {
    int tid_ = threadIdx.x; asm volatile("" : "+v"(tid_)); const int tid = tid_, wid = __builtin_amdgcn_readfirstlane(tid >> 6), lane = tid & 63, wr = wid >> 2, wc = wid & 3, fr = lane & 15, fq = lane >> 4;
    const int K = g.K, nt = K / BK;
    unsigned voffA[2], voffB[2];
#pragma unroll
    for (int i = 0; i < 2; ++i) { int R, C; stage_rc(tid * 16 + i * 8192, R, C); const int Rb = Epi::PERM ? ((R & ~31) + perm32(R & 31)) : R;
        voffA[i] = (unsigned)(R * K + C) * 2u; voffB[i] = (unsigned)(Rb * K + C) * 2u; }
    const size_t kstep = (size_t)(BK * 2);
    const size_t hstep = (size_t)HALF * K * 2;
    const size_t tstep = 2 * hstep;
    const unsigned ldsw = (unsigned)wid * 1024u;
    const int aoff = lds_byte(wr * 64 + fr, fq * 8), boff = lds_byte(wc * 32 + fr, fq * 8);
#define PG8_SA(b, h) (((b) * 2 + (h)) * HTB)
#define PG8_SB(b, h) ((4 + (b) * 2 + (h)) * HTB)
#define PG8_STAGE(bufoff, gbase, voff) do { _Pragma("unroll") for (int _i = 0; _i < 2; ++_i) \
        __builtin_amdgcn_global_load_lds((const unsigned*)((const char*)(gbase) + (voff)[_i]), (PG8_LAS unsigned*)(lds + (bufoff) + ldsw + _i * 8192), 16, 0, 0); } while (0)
#define PG8_LDA(dst, b, h) do { _Pragma("unroll") for (int m = 0; m < 4; ++m) _Pragma("unroll") for (int k = 0; k < 2; ++k) dst[m][k] = *(const PG8_LAS bf16x8*)(lds + PG8_SA(b, h) + aoff + m * 2048 + k * 1024); } while (0)
#define PG8_LDB(dst, b, h) do { _Pragma("unroll") for (int n = 0; n < 2; ++n) _Pragma("unroll") for (int k = 0; k < 2; ++k) dst[n][k] = *(const PG8_LAS bf16x8*)(lds + PG8_SB(b, h) + boff + n * 2048 + k * 1024); } while (0)
#define PG8_MMA(ai, bj, At, Bt) do { __builtin_amdgcn_s_setprio(1); _Pragma("unroll") for (int m = 0; m < 4; ++m) _Pragma("unroll") for (int n = 0; n < 2; ++n) _Pragma("unroll") for (int k = 0; k < 2; ++k) \
        acc[ai][bj][m][n] = __builtin_amdgcn_mfma_f32_16x16x32_bf16(Bt[n][k], At[m][k], acc[ai][bj][m][n], 0, 0, 0); __builtin_amdgcn_s_setprio(0); } while (0)
#define PG8_WAIT_V(n) asm volatile("s_waitcnt vmcnt(" #n ")" ::: "memory")
#define PG8_WAIT_L(n) asm volatile("s_waitcnt lgkmcnt(" #n ")" ::: "memory")
#define PG8_BAR __builtin_amdgcn_s_barrier()
#define PG8_SCHED __builtin_amdgcn_sched_barrier(0)
    Unit cur, nxt; int ui = 0;
    if (!S.next(0, cur)) return;
    f32x4 acc[2][2][4][2];
#pragma unroll
    for (int a = 0; a < 2; ++a)
#pragma unroll
        for (int b = 0; b < 2; ++b)
#pragma unroll
            for (int m = 0; m < 4; ++m)
#pragma unroll
                for (int n = 0; n < 2; ++n) acc[a][b][m][n] = (f32x4){0.f, 0.f, 0.f, 0.f};
    bf16x8 At[4][2], B0[2][2], B1[2][2];
    const char* cA = (const char*)g.A + (size_t)cur.pm * tstep; const char* cB = (const char*)g.Bt + (size_t)cur.pn * tstep;
    S.a_ready(cur);
    if constexpr (SP2) {
        PG8_STAGE(PG8_SB(0, 0), cB, voffB); PG8_STAGE(PG8_SB(0, 1), cB + hstep, voffB); PG8_STAGE(PG8_SA(0, 0), cA, voffA); PG8_STAGE(PG8_SA(0, 1), cA + hstep, voffA);
        if (wr == 1) PG8_BAR;
        PG8_WAIT_V(2); PG8_BAR;
        PG8_STAGE(PG8_SB(1, 0), cB + kstep, voffB); PG8_STAGE(PG8_SA(1, 0), cA + kstep, voffA); PG8_STAGE(PG8_SB(1, 1), cB + hstep + kstep, voffB);
        PG8_WAIT_V(6); PG8_BAR;
    } else {
        PG8_STAGE(PG8_SB(0, 0), cB, voffB); PG8_STAGE(PG8_SA(0, 0), cA, voffA); PG8_STAGE(PG8_SB(0, 1), cB + hstep, voffB); PG8_STAGE(PG8_SA(0, 1), cA + hstep, voffA);
        if (wr == 1) PG8_BAR;
        PG8_WAIT_V(4); PG8_BAR;
        PG8_STAGE(PG8_SB(1, 0), cB + kstep, voffB); PG8_STAGE(PG8_SA(1, 0), cA + kstep, voffA); PG8_STAGE(PG8_SB(1, 1), cB + hstep + kstep, voffB);
        PG8_WAIT_V(6); PG8_BAR;
    }
    for (;;) {
        const bool has_next = S.next(ui + 1, nxt);
        const char* nA = has_next ? (const char*)g.A + (size_t)nxt.pm * tstep : cA; const char* nB = has_next ? (const char*)g.Bt + (size_t)nxt.pn * tstep : cB;
        for (int t = 0; t < nt; t += 2) {
            const bool last = (t == nt - 2);
            const char* a1 = cA + (size_t)(t + 1) * kstep;
            const char* a2 = last ? nA : cA + (size_t)(t + 2) * kstep; const char* b2 = last ? nB : cB + (size_t)(t + 2) * kstep;
            const char* a3 = a2 + kstep; const char* b3 = b2 + kstep;
            if (last && has_next) S.a_ready(nxt);
            if constexpr (SP2) {
            PG8_LDB(B0, 0, 0); PG8_LDB(B1, 0, 1); PG8_SCHED; PG8_LDA(At, 0, 0); PG8_STAGE(PG8_SA(1, 1), a1 + hstep, voffA);
            PG8_WAIT_V(8); PG8_WAIT_L(0); PG8_BAR; PG8_MMA(0, 0, At, B0); PG8_MMA(0, 1, At, B1); PG8_BAR; PG8_SCHED;
            PG8_LDA(At, 0, 1); PG8_STAGE(PG8_SB(0, 0), b2, voffB); PG8_STAGE(PG8_SB(0, 1), b2 + hstep, voffB); PG8_STAGE(PG8_SA(0, 0), a2, voffA);
            PG8_WAIT_V(8); PG8_WAIT_L(0); PG8_BAR; PG8_MMA(1, 0, At, B0); PG8_MMA(1, 1, At, B1); PG8_BAR; PG8_SCHED;
            PG8_LDB(B0, 1, 0); PG8_LDB(B1, 1, 1); PG8_SCHED; PG8_LDA(At, 1, 0); PG8_STAGE(PG8_SA(0, 1), a2 + hstep, voffA);
            PG8_WAIT_V(8); PG8_WAIT_L(0); PG8_BAR; PG8_MMA(0, 0, At, B0); PG8_MMA(0, 1, At, B1); PG8_BAR; PG8_SCHED;
            PG8_LDA(At, 1, 1); PG8_STAGE(PG8_SB(1, 0), b3, voffB); PG8_STAGE(PG8_SB(1, 1), b3 + hstep, voffB); PG8_STAGE(PG8_SA(1, 0), a3, voffA);
            PG8_WAIT_V(8); PG8_WAIT_L(0); PG8_BAR; PG8_MMA(1, 0, At, B0); PG8_MMA(1, 1, At, B1); PG8_BAR; PG8_SCHED;
            } else {
            PG8_LDB(B0, 0, 0); PG8_SCHED; PG8_LDA(At, 0, 0); PG8_STAGE(PG8_SA(1, 1), a1 + hstep, voffA);
            PG8_WAIT_L(8); PG8_BAR; PG8_WAIT_L(0); PG8_MMA(0, 0, At, B0); PG8_BAR; PG8_SCHED;
            PG8_LDB(B1, 0, 1); PG8_STAGE(PG8_SB(0, 0), b2, voffB);
            PG8_BAR; PG8_WAIT_L(0); PG8_MMA(0, 1, At, B1); PG8_BAR;
            PG8_LDA(At, 0, 1); PG8_STAGE(PG8_SA(0, 0), a2, voffA);
            PG8_BAR; PG8_WAIT_L(0); PG8_MMA(1, 0, At, B0); PG8_BAR; PG8_SCHED;
            PG8_STAGE(PG8_SB(0, 1), b2 + hstep, voffB);
            PG8_WAIT_V(6); PG8_BAR; PG8_MMA(1, 1, At, B1); PG8_BAR;
            PG8_LDB(B0, 1, 0); PG8_SCHED; PG8_LDA(At, 1, 0); PG8_STAGE(PG8_SA(0, 1), a2 + hstep, voffA);
            PG8_WAIT_L(8); PG8_BAR; PG8_WAIT_L(0); PG8_MMA(0, 0, At, B0); PG8_BAR; PG8_SCHED;
            PG8_LDB(B1, 1, 1); PG8_STAGE(PG8_SB(1, 0), b3, voffB);
            PG8_BAR; PG8_WAIT_L(0); PG8_MMA(0, 1, At, B1); PG8_BAR;
            PG8_LDA(At, 1, 1); PG8_STAGE(PG8_SA(1, 0), a3, voffA);
            PG8_BAR; PG8_WAIT_L(0); PG8_MMA(1, 0, At, B0); PG8_BAR; PG8_SCHED;
            PG8_STAGE(PG8_SB(1, 1), b3 + hstep, voffB);
            PG8_WAIT_V(6); PG8_BAR; PG8_MMA(1, 1, At, B1); PG8_BAR;
            }
        }
        if constexpr (ALIGN_EPI) { if (wr == 0) PG8_BAR; }
        if constexpr (!Epi::AFTER_DRAIN) { E(acc, cur, wr, wc, fr, fq); S.done(cur); }
        if (!has_next) break;
#pragma unroll
        for (int a = 0; a < 2; ++a)
#pragma unroll
            for (int b = 0; b < 2; ++b)
#pragma unroll
                for (int m = 0; m < 4; ++m)
#pragma unroll
                    for (int n = 0; n < 2; ++n) acc[a][b][m][n] = (f32x4){0.f, 0.f, 0.f, 0.f};
        cur = nxt; cA = nA; cB = nB; ++ui;
        if constexpr (ALIGN_EPI) { if (wr == 1) PG8_BAR; }
    }
    PG8_WAIT_V(0);
    if constexpr (!ALIGN_EPI) { if (wr == 0) PG8_BAR; }
    PG8_BAR;
    if constexpr (Epi::AFTER_DRAIN) { E.fused(acc, cur, wr, wc, fr, fq, lds, wid, lane); S.done(cur); }
#undef PG8_SA
#undef PG8_SB
#undef PG8_STAGE
#undef PG8_LDA
#undef PG8_LDB
#undef PG8_MMA
#undef PG8_WAIT_V
#undef PG8_WAIT_L
#undef PG8_BAR
#undef PG8_SCHED
}
}
#define GAS __attribute__((address_space(1)))
#define LAS __attribute__((address_space(3)))
typedef unsigned short bf16;
typedef unsigned v4u __attribute__((ext_vector_type(4)));
typedef float f32x4 __attribute__((ext_vector_type(4)));
typedef short bf16x8 __attribute__((ext_vector_type(8)));
typedef GAS unsigned gu32;
typedef GAS unsigned long long gu64;
#define RLX_AGENT __ATOMIC_RELAXED, __HIP_MEMORY_SCOPE_AGENT
#define LDS_WAIT() asm volatile("s_waitcnt lgkmcnt(0)" ::: "memory")
#define VM_WAIT() asm volatile("s_waitcnt vmcnt(0)" ::: "memory")
__device__ __forceinline__ unsigned long long rt() { return __builtin_amdgcn_s_memrealtime(); }
__device__ __forceinline__ unsigned f2bf(float f) { unsigned u = __builtin_bit_cast(unsigned, f); return (u + 0x7fffu + ((u >> 16) & 1u)) >> 16; }
__device__ __forceinline__ unsigned pk2(float lo, float hi) { return f2bf(lo) | (f2bf(hi) << 16); }

#define XB_TMO      128
#define XB_XCNT(j)  (256  + 64 * (j))
#define XB_XSUB(j)  (1280 + 64 * (j))
#define XB_XGEN(j)  (2304 + 64 * (j))
#define XB_TOP      3328
#define XB_TOPGEN   3392
#define XCD_BAR_WORDS 3456
#define XB_SPIN_CAP (1u << 18)

__device__ __forceinline__ unsigned xb_ld(unsigned* p)              { return __hip_atomic_load(p, __ATOMIC_RELAXED, __HIP_MEMORY_SCOPE_AGENT); }
__device__ __forceinline__ unsigned xb_add(unsigned* p, unsigned v) { return __hip_atomic_fetch_add(p, v, __ATOMIC_RELAXED, __HIP_MEMORY_SCOPE_AGENT); }
__device__ __forceinline__ unsigned xb_xcc_id() { return (unsigned)__builtin_amdgcn_s_getreg((3 << 11) | 20) & 0xFu; }
#define XB_SPIN(cond, bar) do { unsigned _sp = 0; while (cond) { __builtin_amdgcn_s_sleep(1); \
    if ((++_sp & 255u) == 0u) { if (xb_ld(&(bar)[XB_TMO])) break; if (_sp > XB_SPIN_CAP) { atomicAdd(&(bar)[XB_TMO], 1u); break; } } } } while (0)

struct XcdBarrier {
    unsigned* bar; unsigned x;
    volatile LAS unsigned* st;
};

__device__ __forceinline__ XcdBarrier xcd_barrier_post(unsigned* bar, volatile LAS unsigned* st) {
    XcdBarrier b; b.bar = bar; b.x = xb_xcc_id(); b.st = st;
    if (threadIdx.x == 0) (void)xb_add(&bar[XB_XCNT(b.x)], 1u);
    return b;
}
__device__ __forceinline__ void xcd_barrier_complete(unsigned* bar, unsigned x, unsigned& nloc, unsigned& nx) {
    const unsigned G = gridDim.x * gridDim.y * gridDim.z;
    unsigned sum, cnt, mine, sp = 0u;
    for (;;) {
        sum = 0u; cnt = 0u; mine = 0u;
#pragma unroll
        for (unsigned j = 0; j < 16; ++j) { const unsigned c = xb_ld(&bar[XB_XCNT(j)]); sum += c; cnt += (c > 0u) ? 1u : 0u; mine = (j == x) ? c : mine; }
        if (sum == G) break;
        __builtin_amdgcn_s_sleep(1);
        if ((++sp & 255u) == 0u) { if (xb_ld(&bar[XB_TMO])) break; if (sp > XB_SPIN_CAP) { atomicAdd(&bar[XB_TMO], 1u); break; } }
    }
    nloc = mine > 0u ? mine : 1u; nx = cnt > 0u ? cnt : 1u;
}

__device__ __forceinline__ void xcd_barrier(const XcdBarrier& b) {
    asm volatile("s_waitcnt vmcnt(0)" ::: "memory");
    __syncthreads();
    if (threadIdx.x == 0) {
        unsigned* bar = b.bar;
        __builtin_amdgcn_s_waitcnt(0);
        unsigned nloc = b.st[0], nx = b.st[1];
        if (nloc == 0u) { xcd_barrier_complete(bar, b.x, nloc, nx); b.st[0] = nloc; b.st[1] = nx; }
        const unsigned old = xb_add(&bar[XB_XSUB(b.x)], 1u);
        const unsigned gen = old / nloc;
        if (old + 1u == (gen + 1u) * nloc) {
            __builtin_amdgcn_fence(__ATOMIC_RELEASE, "agent");
            asm volatile("s_waitcnt vmcnt(0)" ::: "memory");
            const unsigned og = xb_add(&bar[XB_TOP], 1u);
            const unsigned tg = og / nx;
            if (og + 1u == (tg + 1u) * nx) xb_add(&bar[XB_TOPGEN], 1u);
            else XB_SPIN(xb_ld(&bar[XB_TOPGEN]) == tg, bar);
            __builtin_amdgcn_fence(__ATOMIC_ACQUIRE, "agent");
            xb_add(&bar[XB_XGEN(b.x)], 1u);
            asm volatile("s_waitcnt vmcnt(0)" ::: "memory");
        } else {
            XB_SPIN(xb_ld(&bar[XB_XGEN(b.x)]) == gen, bar);
            __builtin_amdgcn_fence(__ATOMIC_ACQUIRE, "agent");
            asm volatile("s_waitcnt vmcnt(0)" ::: "memory");
        }
    }
    __syncthreads();
}
constexpr size_t MiB = 1u << 20;
constexpr size_t WS_CTL = 0, CTL_ZERO_BYTES = 1 * MiB;
constexpr size_t WS_BIAS = 1 * MiB, WS_W2T = WS_BIAS + 16384, WS_A2T = WS_W2T + 131072, WS_G2T = WS_A2T + 131072;
constexpr size_t WS_WGU1 = 2 * MiB, WS_WD1 = WS_WGU1 + 43 * MiB, WS_WINB = WS_WD1 + 21 * MiB + MiB / 2;
constexpr size_t WS_WOUT = 86 * MiB, WS_WGU2 = 94 * MiB, WS_WD2 = 137 * MiB;
constexpr size_t WS_XB = 159 * MiB;
constexpr size_t WS_ACT = 192 * MiB;
constexpr size_t WS_QB = 300 * MiB, WS_KB = WS_QB + 16 * MiB + MiB / 2, WS_VB = WS_KB + 4 * MiB + MiB / 8;
constexpr size_t WS_DD = 325 * MiB, WS_LG = 358 * MiB, WS_EE = WS_LG + 16 * MiB + MiB / 2, WS_END = WS_EE + 16 * MiB + MiB / 2;
constexpr size_t WS_SLAB = WS_END, WS_DEC = WS_SLAB + 1 * MiB, WS_END2 = WS_DEC + 6 * (size_t)NDEC * RWW * 4;
constexpr size_t VEC16 = 16 * MiB + MiB / 2;
constexpr size_t WS_KK = WS_WGU1, WS_BB = WS_KK + VEC16, WS_KP = WS_BB + VEC16, WS_RR = WS_KP + VEC16, WS_VV = WS_RR + VEC16;
constexpr size_t WS_X2B = WS_WGU1;
static_assert(WS_VV + VEC16 <= WS_WOUT && WS_WINB + 19 * MiB <= WS_WOUT && WS_WD2 + 22 * MiB <= WS_XB && WS_XB + 33 * MiB <= WS_ACT && WS_VB + 4 * MiB + MiB / 8 <= WS_DD && WS_DD + 33 * MiB <= WS_LG, "d_ws map");
constexpr int CW_BAR = 4096;
constexpr int CW_SSQ0 = 16384, CW_SSQ1 = CW_SSQ0 + MPAD, CW_SSQ2 = CW_SSQ1 + MPAD, CW_SSQ3 = CW_SSQ2 + MPAD;
constexpr int CW_SKC = 8192;
constexpr int CW_SSQD = CW_SSQ3 + MPAD;
static_assert((CW_SSQD + MPAD) * 4 <= (int)CTL_ZERO_BYTES, "CTL");
constexpr int RING_OFF = 0, RING_BYTES = 131072;
constexpr int LDSCTL_OFF = RING_BYTES, MISC_OFF = LDSCTL_OFF + 320;
constexpr int LDS_BYTES = 147456;
constexpr int NWAVES = 8;
constexpr int NPHASES = 11;
#ifndef MK_N_LAUNCHES
#define MK_N_LAUNCHES 1
#endif

__constant__ unsigned char T5B[129] = {0, 1, 2, 3, 4, 5, 6, 7, 8, 9, 10, 11, 12, 13, 14, 15, 16, 16, 16, 17, 17, 18, 18, 18, 19, 19, 19, 20, 20, 20, 20, 21, 21, 21, 21, 22, 22, 22, 22, 22, 23, 23, 23, 23, 23, 23, 24, 24, 24, 24, 24, 24, 25, 25, 25, 25, 25, 25, 25, 26, 26, 26, 26, 26, 26, 26, 26, 27, 27, 27, 27, 27, 27, 27, 27, 27, 27, 28, 28, 28, 28, 28, 28, 28, 28, 28, 28, 29, 29, 29, 29, 29, 29, 29, 29, 29, 29, 29, 29, 30, 30, 30, 30, 30, 30, 30, 30, 30, 30, 30, 30, 30, 30, 31, 31, 31, 31, 31, 31, 31, 31, 31, 31, 31, 31, 31, 31, 31, 31};

struct Args { const float* in[31]; float* out; unsigned char* ws; int ph_lo, ph_hi, li, pad; };

struct Frame {
    LAS unsigned char* lds;
    volatile LAS unsigned* MISC;
    gu32* ctl;
    int tid, lane, wave, G;
    float* out; unsigned char* ws;
};
typedef float f32x2 __attribute__((ext_vector_type(2)));
__device__ __forceinline__ float bf2f(unsigned short u) { return __builtin_bit_cast(float, (unsigned)u << 16); }
__device__ __forceinline__ unsigned short f2bfs(float f) { return (unsigned short)f2bf(f); }
__device__ __forceinline__ float wave_sum(float v) {
#pragma unroll
    for (int o = 1; o < 64; o <<= 1) v += __shfl_xor(v, o);
    return v;
}
__device__ __forceinline__ float wave_max(float v) {
#pragma unroll
    for (int o = 1; o < 64; o <<= 1) v = fmaxf(v, __shfl_xor(v, o));
    return v;
}
template <int CTRL> __device__ __forceinline__ float dpp_f(float x) { return __builtin_bit_cast(float, __builtin_amdgcn_update_dpp(0, __builtin_bit_cast(int, x), CTRL, 0xf, 0xf, true)); }
__device__ __forceinline__ float allsum16(float x) { x += dpp_f<0x128>(x); x += dpp_f<0x124>(x); x += dpp_f<0x122>(x); x += dpp_f<0x121>(x); return x; }
__device__ __forceinline__ float sigmoidf_(float x) { return __builtin_amdgcn_rcpf(1.0f + __builtin_amdgcn_exp2f(-x * LOG2E)); }
__device__ __forceinline__ float tanhf_(float x) { return 1.0f - 2.0f * __builtin_amdgcn_rcpf(1.0f + __builtin_amdgcn_exp2f(2.0f * LOG2E * x)); }

constexpr int TP_PITCH = 136;
__device__ __forceinline__ void p0_transpose_item(const float* W, int K, int N, bf16* WT, int kb, int nb, int drow, const float* kscale, LAS unsigned char* scr, int lane) {
    const int k0 = 64 * kb, n0 = 64 * nb, g = lane >> 4, c = lane & 15;
    f32x4 v[16];
#pragma unroll
    for (int j = 0; j < 4; ++j)
#pragma unroll
        for (int r = 0; r < 4; ++r) v[4 * j + r] = *(const GAS f32x4*)(W + (size_t)(k0 + 16 * j + 4 * g + r) * N + n0 + 4 * c);
    if (kscale) {
#pragma unroll
        for (int j = 0; j < 4; ++j) { const f32x4 s4 = *(const GAS f32x4*)(kscale + k0 + 16 * j + 4 * g);
            v[4 * j + 0] *= s4.x; v[4 * j + 1] *= s4.y; v[4 * j + 2] *= s4.z; v[4 * j + 3] *= s4.w; } }
#pragma unroll
    for (int j = 0; j < 4; ++j)
#pragma unroll
        for (int e = 0; e < 4; ++e)
            *(LAS unsigned long long*)(scr + (4 * c + e) * TP_PITCH + (16 * j + 4 * g) * 2) = (unsigned long long)pk2(v[4 * j + 0][e], v[4 * j + 1][e]) | ((unsigned long long)pk2(v[4 * j + 2][e], v[4 * j + 3][e]) << 32);
    LDS_WAIT(); asm volatile("" ::: "memory");
#pragma unroll
    for (int i = 0; i < 8; ++i) { const int n = 8 * i + (lane >> 3), kc = lane & 7;
        const LAS unsigned char* s = scr + n * TP_PITCH + kc * 16;
        v4u o; o.x = *(const LAS unsigned*)(s); o.y = *(const LAS unsigned*)(s + 4); o.z = *(const LAS unsigned*)(s + 8); o.w = *(const LAS unsigned*)(s + 12);
        *(GAS v4u*)(WT + (size_t)(drow + n) * K + k0 + 8 * kc) = o; }
    LDS_WAIT(); asm volatile("" ::: "memory");
}
__device__ __forceinline__ int gu_row(int n0, int up) { return 256 * (n0 >> 7) + (n0 & 127) + 128 * up; }

constexpr int I_GU = (DM / 64) * (DFF / 64), I_D = (DFF / 64) * (DM / 64), I_IN = (DM / 64) * (INC / 64), I_OUT = (DM / 64) * (DM / 64), I_L64 = RWW / 64, I_L128 = 2 * (RWW / 64);
constexpr int CV_EARLY = 2 * I_GU + I_D + I_IN + 2 * I_L64 + I_L128, CV_LATE1 = I_OUT + I_GU, CV_LATE2 = I_GU + I_D, CV_ALL = CV_EARLY + CV_LATE1 + CV_LATE2;
__device__ __forceinline__ void convert_items(Frame& F, const Args& A, int first, int count, int rank, int nranks) {
    LAS unsigned char* scr = F.lds + RING_OFF + F.wave * 16384;
    const int lane = F.lane; unsigned char* ws = F.ws;
    for (int it = first + rank * NWAVES + F.wave; it < first + count; it += nranks * NWAVES) {
        int r = it;
        if (r < I_GU) { const int kb = r / (DFF / 64), nb = r % (DFF / 64); p0_transpose_item(A.in[8], DM, DFF, (bf16*)(ws + WS_WGU1), kb, nb, gu_row(64 * nb, 0), A.in[7], scr, lane); continue; } r -= I_GU;
        if (r < I_GU) { const int kb = r / (DFF / 64), nb = r % (DFF / 64); p0_transpose_item(A.in[9], DM, DFF, (bf16*)(ws + WS_WGU1), kb, nb, gu_row(64 * nb, 1), A.in[7], scr, lane); continue; } r -= I_GU;
        if (r < I_D)  { const int kb = r / (DM / 64), nb = r % (DM / 64); p0_transpose_item(A.in[10], DFF, DM, (bf16*)(ws + WS_WD1), kb, nb, 64 * nb, nullptr, scr, lane); continue; } r -= I_D;
        if (r < I_IN) { const int kb = r / (INC / 64), nb = r % (INC / 64); p0_transpose_item(A.in[12], DM, INC, (bf16*)(ws + WS_WINB), kb, nb, 64 * nb, A.in[11], scr, lane); continue; } r -= I_IN;
        if (r < I_L64) { p0_transpose_item(A.in[16], 64, RWW, (bf16*)(ws + WS_W2T), 0, r, 64 * r, nullptr, scr, lane); continue; } r -= I_L64;
        if (r < I_L64) { p0_transpose_item(A.in[18], 64, RWW, (bf16*)(ws + WS_A2T), 0, r, 64 * r, nullptr, scr, lane); continue; } r -= I_L64;
        if (r < I_L128) { const int kb = r / (RWW / 64), nb = r % (RWW / 64); p0_transpose_item(A.in[19], 128, RWW, (bf16*)(ws + WS_G2T), kb, nb, 64 * nb, nullptr, scr, lane); continue; } r -= I_L128;
        if (r < I_OUT) { const int kb = r / (DM / 64), nb = r % (DM / 64); p0_transpose_item(A.in[25], DM, DM, (bf16*)(ws + WS_WOUT), kb, nb, 64 * nb, nullptr, scr, lane); continue; } r -= I_OUT;
        if (r < I_GU) { const int kb = r / (DFF / 64), nb = r % (DFF / 64); p0_transpose_item(A.in[27], DM, DFF, (bf16*)(ws + WS_WGU2), kb, nb, gu_row(64 * nb, 0), A.in[26], scr, lane); continue; } r -= I_GU;
        if (r < I_GU) { const int kb = r / (DFF / 64), nb = r % (DFF / 64); p0_transpose_item(A.in[28], DM, DFF, (bf16*)(ws + WS_WGU2), kb, nb, gu_row(64 * nb, 1), A.in[26], scr, lane); continue; } r -= I_GU;
        { const int kb = r / (DM / 64), nb = r % (DM / 64); p0_transpose_item(A.in[29], DFF, DM, (bf16*)(ws + WS_WD2), kb, nb, 64 * nb, nullptr, scr, lane); }
    }
}
__device__ __forceinline__ void p0_prologue(Frame& F, const Args& A) {
    const int gw = blockIdx.x * NWAVES + F.wave, NGW = F.G * NWAVES, lane = F.lane;
    unsigned char* ws = F.ws;
#ifdef CV_ALL_IN_P0
    convert_items(F, A, 0, CV_ALL, blockIdx.x, F.G);
#else
    convert_items(F, A, 0, CV_EARLY, blockIdx.x, F.G);
#endif
    bf16* XB = (bf16*)(ws + WS_XB); float* ssq0 = (float*)(F.ctl + CW_SSQ0);
    for (int m = gw; m < MPAD; m += NGW) {
        GAS unsigned long long* o8 = (GAS unsigned long long*)(XB + (size_t)m * DM) + lane;
        if (m < MV) {
            const float* xrow = m < MP ? A.in[0] + (size_t)m * DM : A.in[1] + (size_t)(m - MP) * DM;
            const GAS f32x4* xr = (const GAS f32x4*)xrow + lane; f32x4 v[8]; float s = 0.f;
#pragma unroll
            for (int j = 0; j < 8; ++j) { v[j] = xr[64 * j]; s += (v[j].x * v[j].x + v[j].y * v[j].y) + (v[j].z * v[j].z + v[j].w * v[j].w); }
            s = wave_sum(s);
#pragma unroll
            for (int j = 0; j < 8; ++j) o8[64 * j] = (unsigned long long)pk2(v[j].x, v[j].y) | ((unsigned long long)pk2(v[j].z, v[j].w) << 32);
            if (lane == 0) ssq0[m] = s;
        } else {
#pragma unroll
            for (int j = 0; j < 8; ++j) o8[64 * j] = 0ull;
        }
    }
    float* bt = (float*)(ws + WS_BIAS);
    for (int i = blockIdx.x * (NWAVES * 64) + F.tid; i < 129 * NQH; i += F.G * NWAVES * 64) bt[i] = A.in[6][(int)T5B[i >> 4] * NQH + (i & 15)] * LOG2E;
}
constexpr int PREP_TILES = (MV + 63) / 64  , PREP_UNITS = PREP_TILES * RWH;
constexpr int PA_PITCH = 528;
constexpr int PW_LD = 68;
constexpr int PA_OFF = 0, PW_OFF = 64 * PA_PITCH  , PMAT = 64 * PW_LD * 4  , PC_OFF = 114688;
constexpr int CB_FA = 0, CB_FR = 2048, CB_FNK = 4096, CB_FT = 4608, CB_FMB = 5120, CB_FMK = 5632, CB_FBG = 6144, CB_FKG = 8192, CB_FV = 10240, CB_GC = 12288, CB_BYTES = 12544, CB_STRIDE = 13312;
constexpr int NCHUNK = SEQ / 16;
constexpr size_t CH_NA = (WS_WOUT - WS_WGU1) / CB_STRIDE, CH_NB = (WS_LG - WS_DD) / CB_STRIDE;
static_assert(CH_NA + CH_NB >= (size_t)NB * RWH * NCHUNK, "chunk blocks");
__device__ __forceinline__ unsigned char* chunk_block(unsigned char* ws, int g) { return (size_t)g < CH_NA ? ws + WS_WGU1 + (size_t)g * CB_STRIDE : ws + WS_DD + ((size_t)g - CH_NA) * CB_STRIDE; }
constexpr int CD_OFF = 0, CKK_OFF = 16384, CBB_OFF = 24576, CKP_OFF = 32768, CRR_OFF = 40960, CS_OFF = 49152;
static_assert(PW_OFF + 3 * PMAT <= PC_OFF && CS_OFF + 4 * 16384 <= PC_OFF && PC_OFF + 2560 <= RING_BYTES, "prep LDS");
constexpr int SC_FA = 0, SC_FR = 2048, SC_FBH = 4096, SC_FKH = 6144, SC_FBG = 8192, SC_FKG = 10240, SC_FV = 12288, SC_NB = 14336, SC_TT = 15360;
typedef short s16x4 __attribute__((ext_vector_type(4)));
typedef __bf16 bf16x2_t __attribute__((ext_vector_type(2)));
__device__ __forceinline__ unsigned cvtpk_c(float lo, float hi) { const f32x2 v = {lo, hi}; return __builtin_bit_cast(unsigned, __builtin_convertvector(v, bf16x2_t)); }
__device__ __forceinline__ unsigned long long pack4bf(f32x4 v) { return (unsigned long long)cvtpk_c(v.x, v.y) | ((unsigned long long)cvtpk_c(v.z, v.w) << 32); }
__device__ __forceinline__ void chunk_stage(LAS unsigned char* lds, int c, unsigned char* blk, int lane) {
    asm volatile("" : "+v"(lane));
    LAS unsigned char* sc = lds + CS_OFF + c * 16384;
    const int j = lane, tk0 = 16 * c;
    const int ks = j >> 5, jj = j & 31, qf = (jj & 15) >> 2, ef = 4 * (jj >> 4) + (jj & 3);
    const int fslot = (ks * 64 + qf * 16) * 16 + ef * 2;
    const int jt = j >> 4, jl = j & 15;
    float g = 1.f; float bh[16], kh[16];
#pragma unroll
    for (int t = 0; t < 16; ++t) { const int tk = tk0 + t;
        const float d = *(const LAS float*)(lds + CD_OFF + (tk * 64 + j) * 4);
        const float kk = bf2f(*(const LAS unsigned short*)(lds + CKK_OFF + (tk * 64 + j) * 2)), bb = bf2f(*(const LAS unsigned short*)(lds + CBB_OFF + (tk * 64 + j) * 2));
        const float kp = bf2f(*(const LAS unsigned short*)(lds + CKP_OFF + (tk * 64 + j) * 2)), rr = bf2f(*(const LAS unsigned short*)(lds + CRR_OFF + (tk * 64 + j) * 2));
        const float ah = g * kk; g *= d; const float rh = g * rr; const float ig = 1.0f / g;
        bh[t] = bb * ig; kh[t] = kp * ig;
        *(LAS unsigned short*)(sc + SC_FA + fslot + 16 * t) = f2bfs(ah); *(LAS unsigned short*)(sc + SC_FR + fslot + 16 * t) = f2bfs(rh);
        *(LAS unsigned short*)(sc + SC_FBH + fslot + 16 * t) = f2bfs(bh[t]); *(LAS unsigned short*)(sc + SC_FKH + fslot + 16 * t) = f2bfs(kh[t]); }
    *(GAS float*)(blk + CB_GC + 4 * j) = g;
#pragma unroll
    for (int t = 0; t < 16; ++t) { const int off = ((jt * 64 + (t >> 2) * 16 + jl) * 4 + (t & 3)) * 2;
        *(LAS unsigned short*)(sc + SC_FBG + off) = f2bfs(bh[t] * g); *(LAS unsigned short*)(sc + SC_FKG + off) = f2bfs(kh[t] * g); }
    const int x = lane & 15, q = lane >> 4;
    bf16x8 aB[2], aK[2], bA[2], bR[2];
#pragma unroll
    for (int k2 = 0; k2 < 2; ++k2) { aB[k2] = *(const LAS bf16x8*)(sc + SC_FBH + (k2 * 64 + lane) * 16); aK[k2] = *(const LAS bf16x8*)(sc + SC_FKH + (k2 * 64 + lane) * 16);
        bA[k2] = *(const LAS bf16x8*)(sc + SC_FA + (k2 * 64 + lane) * 16); bR[k2] = *(const LAS bf16x8*)(sc + SC_FR + (k2 * 64 + lane) * 16); }
    f32x4 nb = (f32x4){0.f, 0.f, 0.f, 0.f}, nk = nb, mb_ = nb, mk = nb;
#pragma unroll
    for (int k2 = 0; k2 < 2; ++k2) { nb = __builtin_amdgcn_mfma_f32_16x16x32_bf16(aB[k2], bA[k2], nb, 0, 0, 0); nk = __builtin_amdgcn_mfma_f32_16x16x32_bf16(aK[k2], bA[k2], nk, 0, 0, 0);
        mb_ = __builtin_amdgcn_mfma_f32_16x16x32_bf16(aB[k2], bR[k2], mb_, 0, 0, 0); mk = __builtin_amdgcn_mfma_f32_16x16x32_bf16(aK[k2], bR[k2], mk, 0, 0, 0); }
#pragma unroll
    for (int r = 0; r < 4; ++r) { const int s_ = 4 * q + r; if (!(s_ < x)) { nb[r] = 0.f; nk[r] = 0.f; } if (!(s_ <= x)) { mb_[r] = 0.f; mk[r] = 0.f; } }
    *(GAS unsigned long long*)(blk + CB_FNK + lane * 8) = pack4bf(nk); *(GAS unsigned long long*)(blk + CB_FMB + lane * 8) = pack4bf(mb_); *(GAS unsigned long long*)(blk + CB_FMK + lane * 8) = pack4bf(mk);
    LAS float* nbs = (LAS float*)(sc + SC_NB);
#pragma unroll
    for (int r = 0; r < 4; ++r) nbs[(4 * q + r) * 16 + x] = nb[r];
    float Tc[16];
#pragma unroll
    for (int t = 0; t < 16; ++t) { float a_ = (x == t) ? 1.f : 0.f;
#pragma unroll
        for (int s_ = 0; s_ < t; ++s_) a_ -= Tc[s_] * nbs[s_ * 16 + t];
        Tc[t] = a_; asm volatile("" ::: "memory"); }
    LAS float* tts = (LAS float*)(sc + SC_TT);
#pragma unroll
    for (int t = 0; t < 16; ++t) tts[x * 16 + t] = Tc[t];
    { f32x4 tv;
#pragma unroll
      for (int e = 0; e < 4; ++e) tv[e] = -tts[(4 * q + e) * 16 + x];
      *(GAS unsigned long long*)(blk + CB_FT + lane * 8) = pack4bf(tv); }
#pragma unroll
    for (int i = 0; i < 4; ++i) *(GAS v4u*)(blk + CB_FA + (i * 64 + lane) * 16) = *(const LAS v4u*)(sc + SC_FA + (i * 64 + lane) * 16);
#pragma unroll
    for (int i = 0; i < 6; ++i) *(GAS v4u*)(blk + CB_FBG + (i * 64 + lane) * 16) = *(const LAS v4u*)(sc + SC_FBG + (i * 64 + lane) * 16);
}
__device__ __forceinline__ float qsum8(float x) {
    x += dpp_f<0xB1>(x); x += dpp_f<0x4E>(x); x += dpp_f<0x141>(x); return x; }
__device__ __forceinline__ void prep_phase(Frame& F, const Args& A) {
    const int tid = F.tid, lane = F.lane, wave = F.wave;
    unsigned char* ws = F.ws; LAS unsigned char* lds = F.lds;
    const float* PR = (const float*)(ws + WS_ACT);
    const float* mu = A.in[14];
    int hcur = -1;
    const int mtile = wave & 3, nh = wave >> 2, ln = lane & 15, q4 = lane >> 4;
    for (int u = blockIdx.x; u < PREP_UNITS; u += F.G) {
        const int mt = u >> 4, h = u & 15, m0 = mt * 64;
        if (h != hcur) {
            __syncthreads();
            hcur = h;
            { LAS float* cst = (LAS float*)(lds + PC_OFF);
              for (int i = tid; i < 10 * 64; i += NWAVES * 64) { const int a = i >> 6, c = i & 63, hc = 64 * h + c; float v;
                  if (a < 3) v = mu[a * RWW + hc]; else v = A.in[a == 3 ? 15 : (a == 4 ? 17 : (a == 5 ? 20 : (a == 6 ? 21 : (a == 7 ? 22 : (a == 8 ? 23 : 24)))))][hc];
                  cst[i] = v; } }
            __syncthreads();
        }
        const int row1 = tid >> 3, cc = tid & 7, m1 = m0 + row1, c01 = 3 * RWW + 32 * cc;
        const bool valid1 = m1 < MV;
        f32x4 xa[8], xb[8];
        { const float* p = PR + (size_t)(valid1 ? m1 : MV - 1) * SHC + c01; const float* pv = nullptr;
          if (valid1) { if (m1 >= MP) pv = A.in[5] + (size_t)(m1 - MP) * SHC + c01; else if ((m1 & (SEQ - 1)) != 0) pv = p - SHC; }
#pragma unroll
          for (int q = 0; q < 8; ++q) { xa[q] = *(const GAS f32x4*)(p + 4 * q); xb[q] = pv ? *(const GAS f32x4*)(pv + 4 * q) : (f32x4){0.f, 0.f, 0.f, 0.f}; } }
        const int t3 = lane >> 3, cq = lane & 7, tok3 = 8 * wave + t3, m3 = m0 + tok3, hc0 = 64 * h + 8 * cq;
        const bool valid3 = m3 < MV;
        f32x4 cr[2], ck[2], cv[2], pr[2], pk[2], pv3[2];
        { const float* p = PR + (size_t)(valid3 ? m3 : MV - 1) * SHC + hc0; const float* q = nullptr;
          if (valid3) { if (m3 >= MP) q = A.in[5] + (size_t)(m3 - MP) * SHC + hc0; else if ((m3 & (SEQ - 1)) != 0) q = p - SHC; }
#pragma unroll
          for (int e = 0; e < 2; ++e) { cr[e] = *(const GAS f32x4*)(p + 4 * e); ck[e] = *(const GAS f32x4*)(p + RWW + 4 * e); cv[e] = *(const GAS f32x4*)(p + 2 * RWW + 4 * e);
              const f32x4 z = (f32x4){0.f, 0.f, 0.f, 0.f};
              pr[e] = q ? *(const GAS f32x4*)(q + 4 * e) : z; pk[e] = q ? *(const GAS f32x4*)(q + RWW + 4 * e) : z; pv3[e] = q ? *(const GAS f32x4*)(q + 2 * RWW + 4 * e) : z; } }
#pragma unroll
        for (int q = 0; q < 8; ++q) {
            const f32x4 m4 = *(const GAS f32x4*)(mu + c01 + 4 * q);
            f32x4 x = xa[q] + m4 * (xb[q] - xa[q]);
            if (cc < 2) { x.x = tanhf_(x.x); x.y = tanhf_(x.y); x.z = tanhf_(x.z); x.w = tanhf_(x.w); }
            else if (cc >= 4) { x.x = sigmoidf_(x.x); x.y = sigmoidf_(x.y); x.z = sigmoidf_(x.z); x.w = sigmoidf_(x.w); }
            if (!valid1) x = (f32x4){0.f, 0.f, 0.f, 0.f};
            *(LAS unsigned long long*)(lds + PA_OFF + row1 * PA_PITCH + (32 * cc + 4 * q) * 2) = (unsigned long long)pk2(x.x, x.y) | ((unsigned long long)pk2(x.z, x.w) << 32);
        }
        __syncthreads();
#pragma unroll
        for (int mat = 0; mat < 3; ++mat) { const int kbase = mat == 0 ? 0 : (mat == 1 ? 64 : 128), KM = mat == 2 ? 128 : 64;
#pragma unroll
            for (int n2 = 0; n2 < 2; ++n2) { const int nt = 2 * nh + n2; f32x4 acc = (f32x4){0.f, 0.f, 0.f, 0.f};
#pragma unroll
                for (int ks = 0; ks < KM / 32; ++ks) {
                    const bf16x8 a = *(const LAS bf16x8*)(lds + PA_OFF + (16 * mtile + ln) * PA_PITCH + (kbase + 32 * ks + 8 * q4) * 2);
                    const bf16x8 bq = *(const GAS bf16x8*)((const bf16*)(ws + (mat == 0 ? WS_W2T : (mat == 1 ? WS_A2T : WS_G2T))) + (size_t)(64 * h + 16 * nt + ln) * KM + 32 * ks + 8 * q4);
                    acc = __builtin_amdgcn_mfma_f32_16x16x32_bf16(a, bq, acc, 0, 0, 0); }
                LAS float* o = (LAS float*)(lds + PW_OFF + mat * PMAT);
#pragma unroll
                for (int r = 0; r < 4; ++r) o[(16 * mtile + 4 * q4 + r) * PW_LD + 16 * nt + ln] = acc[r]; } }
        __syncthreads();
        { const LAS float* cst = (const LAS float*)(lds + PC_OFF) + 8 * cq;
          const LAS float* Wp = (const LAS float*)(lds + PW_OFF) + tok3 * PW_LD + 8 * cq; const LAS float* Ap = Wp + PMAT / 4; const LAS float* Gp = Ap + PMAT / 4;
          float xr[8], xk[8], xv[8], kkr[8], kp[8], aa[8], gg[8], dec[8]; float n2 = 0.f, bon = 0.f;
#pragma unroll
          for (int e = 0; e < 2; ++e) {
              const f32x4 mur = *(const LAS f32x4*)(cst + 0 * 64 + 4 * e), muk = *(const LAS f32x4*)(cst + 1 * 64 + 4 * e), muv = *(const LAS f32x4*)(cst + 2 * 64 + 4 * e);
              const f32x4 w0 = *(const LAS f32x4*)(cst + 3 * 64 + 4 * e), a0 = *(const LAS f32x4*)(cst + 4 * 64 + 4 * e), k_k = *(const LAS f32x4*)(cst + 5 * 64 + 4 * e);
              const f32x4 k_a = *(const LAS f32x4*)(cst + 6 * 64 + 4 * e), r_k = *(const LAS f32x4*)(cst + 7 * 64 + 4 * e);
              const f32x4 wl = *(const LAS f32x4*)(Wp + 4 * e), al = *(const LAS f32x4*)(Ap + 4 * e), gl = *(const LAS f32x4*)(Gp + 4 * e);
              const f32x4 r4 = cr[e] + mur * (pr[e] - cr[e]), k4 = ck[e] + muk * (pk[e] - ck[e]), v4 = cv[e] + muv * (pv3[e] - cv[e]);
#pragma unroll
              for (int j = 0; j < 4; ++j) { const int i = 4 * e + j;
                  xr[i] = r4[j]; xk[i] = k4[j]; xv[i] = v4[j];
                  dec[i] = __builtin_amdgcn_exp2f(-0.6065306597126334f * LOG2E * sigmoidf_(w0[j] + wl[j]));
                  aa[i] = sigmoidf_(a0[j] + al[j]); gg[i] = gl[j];
                  kkr[i] = xk[i] * k_k[j]; n2 += kkr[i] * kkr[i];
                  kp[i] = xk[i] * (1.0f + (aa[i] - 1.0f) * k_a[j]);
                  bon += xr[i] * kp[i] * r_k[j]; } }
          n2 = qsum8(n2); bon = qsum8(bon);
          const float inv = 1.0f / fmaxf(sqrtf(n2), 1e-12f);
          float lgv[8], eev[8], bbv[8];
          { const f32x4 lw0 = *(const LAS f32x4*)(cst + 8 * 64), lw1 = *(const LAS f32x4*)(cst + 8 * 64 + 4), lb0 = *(const LAS f32x4*)(cst + 9 * 64), lb1 = *(const LAS f32x4*)(cst + 9 * 64 + 4);
#pragma unroll
            for (int i = 0; i < 8; ++i) { kkr[i] *= inv; bbv[i] = kkr[i] * aa[i]; const float lw = i < 4 ? lw0[i & 3] : lw1[i & 3], lb = i < 4 ? lb0[i & 3] : lb1[i & 3]; lgv[i] = lw * gg[i]; eev[i] = (lb + bon * xv[i]) * gg[i]; } }
#define PK8(a) (v4u){pk2(a[0], a[1]), pk2(a[2], a[3]), pk2(a[4], a[5]), pk2(a[6], a[7])}
          if (valid3) { const size_t o = (size_t)m3 * RWW + hc0;
              *(GAS v4u*)((bf16*)(ws + WS_LG) + o) = PK8(lgv); *(GAS v4u*)((bf16*)(ws + WS_EE) + o) = PK8(eev); }
          if (m0 >= MP) {
              if (valid3) { float* dv = (float*)(ws + WS_DEC) + (size_t)(m3 - MP) * RWW + hc0;
#define ST8(arr, a) { *(GAS f32x4*)(dv + (size_t)(arr) * NDEC * RWW) = (f32x4){a[0], a[1], a[2], a[3]}; *(GAS f32x4*)(dv + (size_t)(arr) * NDEC * RWW + 4) = (f32x4){a[4], a[5], a[6], a[7]}; }
                  ST8(0, kkr) ST8(1, dec) ST8(2, bbv) ST8(3, kp) ST8(4, xr) ST8(5, xv)
#undef ST8
              }
          } else {
              __syncthreads();
              *(LAS f32x4*)(lds + CD_OFF + (tok3 * 64 + 8 * cq) * 4) = (f32x4){dec[0], dec[1], dec[2], dec[3]}; *(LAS f32x4*)(lds + CD_OFF + (tok3 * 64 + 8 * cq) * 4 + 16) = (f32x4){dec[4], dec[5], dec[6], dec[7]};
              *(LAS v4u*)(lds + CKK_OFF + (tok3 * 64 + 8 * cq) * 2) = PK8(kkr); *(LAS v4u*)(lds + CBB_OFF + (tok3 * 64 + 8 * cq) * 2) = PK8(bbv);
              *(LAS v4u*)(lds + CKP_OFF + (tok3 * 64 + 8 * cq) * 2) = PK8(kp); *(LAS v4u*)(lds + CRR_OFF + (tok3 * 64 + 8 * cq) * 2) = PK8(xr);
              { LAS unsigned char* fv = lds + CS_OFF + (tok3 >> 4) * 16384 + SC_FV; const int t_ = tok3 & 15;
#pragma unroll
                for (int i = 0; i < 8; ++i) { const int ch = 8 * cq + i; *(LAS unsigned short*)(fv + (((ch >> 4) * 64 + (t_ >> 2) * 16 + (ch & 15)) * 4 + (t_ & 3)) * 2) = f2bfs(xv[i]); } }
              __syncthreads();
              if (wave < 4) chunk_stage(lds, wave, chunk_block(ws, ((m0 >> 11) * RWH + h) * NCHUNK + ((m0 & (SEQ - 1)) >> 4) + wave), lane);
              __syncthreads();
          }
#undef PK8
        }
    }
}

constexpr int AK_PITCH = 144, AV_PITCH = 592, AP_PITCH = 336;
constexpr int AK_OFF = 0, AV_OFF = 272 * AK_PITCH  , AP_OFF = AV_OFF + 64 * AV_PITCH  , AB_OFF = AP_OFF + 8 * 16 * AP_PITCH  ;
static_assert(AB_OFF + 129 * 4 * 4 <= RING_BYTES, "attention LDS");
__device__ __forceinline__ void attn_unit(Frame& F, const Args& A, int b, int blk, int hk) {
    const int tid = F.tid, lane = F.lane, wave = F.wave;
    unsigned char* ws = F.ws; LAS unsigned char* lds = F.lds;
    const bf16* QB = (const bf16*)(ws + WS_QB); const bf16* KB = (const bf16*)(ws + WS_KB); const bf16* VB = (const bf16*)(ws + WS_VB); bf16* MX = (bf16*)(ws + WS_XB);
    const int mq0 = b * SEQ + blk * 128, mk0 = mq0 - 128;
    for (int i = tid; i < 16 * AK_PITCH / 4; i += NWAVES * 64) ((LAS unsigned*)(lds + AK_OFF + 256 * AK_PITCH))[i] = 0u;
    for (int i = tid; i < 64 * 16; i += NWAVES * 64) ((LAS unsigned*)(lds + AV_OFF + (i >> 4) * AV_PITCH + 512))[i & 15] = 0u;
#pragma unroll
    for (int it = 0; it < 4; ++it) { const int idx = it * 512 + tid, row = idx >> 3, ch = idx & 7;
        v4u kv = (v4u){0u, 0u, 0u, 0u}, vv = kv;
        if (blk > 0 || row >= 128) { kv = *(const GAS v4u*)(KB + (size_t)(mk0 + row) * KVW + hk * 64 + ch * 8); vv = *(const GAS v4u*)(VB + (size_t)(mk0 + row) * KVW + hk * 64 + ch * 8); }
        *(LAS v4u*)(lds + AK_OFF + row * AK_PITCH + ch * 16) = kv;
        LAS unsigned short* vt = (LAS unsigned short*)(lds + AV_OFF + (8 * ch) * AV_PITCH + row * 2);
        vt[0 * (AV_PITCH / 2)] = (unsigned short)(vv.x & 0xffffu); vt[1 * (AV_PITCH / 2)] = (unsigned short)(vv.x >> 16);
        vt[2 * (AV_PITCH / 2)] = (unsigned short)(vv.y & 0xffffu); vt[3 * (AV_PITCH / 2)] = (unsigned short)(vv.y >> 16);
        vt[4 * (AV_PITCH / 2)] = (unsigned short)(vv.z & 0xffffu); vt[5 * (AV_PITCH / 2)] = (unsigned short)(vv.z >> 16);
        vt[6 * (AV_PITCH / 2)] = (unsigned short)(vv.w & 0xffffu); vt[7 * (AV_PITCH / 2)] = (unsigned short)(vv.w >> 16); }
    { const float* bt = (const float*)(ws + WS_BIAS); LAS float* bl = (LAS float*)(lds + AB_OFF);
      for (int i = tid; i < 129 * 4; i += NWAVES * 64) bl[i] = bt[(i >> 2) * NQH + 4 * hk + (i & 3)]; }
    __syncthreads();
    const int g = wave >> 1, half = wave & 1, head = 4 * hk + g, ln = lane & 15, q4 = lane >> 4;
    const float sink2 = A.in[13][head] * LOG2E;
    const LAS float* bl = (const LAS float*)(lds + AB_OFF);
    LAS unsigned char* Pw = lds + AP_OFF + wave * (16 * AP_PITCH);
    bf16x8 qfa[4][2];
#pragma unroll
    for (int rb = 0; rb < 4; ++rb)
#pragma unroll
        for (int ks = 0; ks < 2; ++ks) qfa[rb][ks] = *(const GAS bf16x8*)(QB + (size_t)(mq0 + 64 * half + 16 * rb + ln) * ATTW + head * 64 + 32 * ks + 8 * q4);
#pragma unroll
    for (int rb = 0; rb < 4; ++rb) {
        const int i0 = 64 * half + 16 * rb, kt0 = i0 >> 4;
        bf16x8 qf[2]; qf[0] = qfa[rb][0]; qf[1] = qfa[rb][1];
        f32x4 s[10];
#pragma unroll
        for (int j = 0; j < 10; ++j) { f32x4 acc = (f32x4){0.f, 0.f, 0.f, 0.f};
#pragma unroll
            for (int ks = 0; ks < 2; ++ks) { const bf16x8 kf = *(const LAS bf16x8*)(lds + AK_OFF + (16 * (kt0 + j) + ln) * AK_PITCH + (32 * ks + 8 * q4) * 2);
                acc = __builtin_amdgcn_mfma_f32_16x16x32_bf16(qf[ks], kf, acc, 0, 0, 0); }
            s[j] = acc; }
        float mx[4] = {-INFINITY, -INFINITY, -INFINITY, -INFINITY};
#pragma unroll
        for (int j = 0; j < 10; ++j) { const int kj = 16 * (kt0 + j) + ln;
#pragma unroll
            for (int r = 0; r < 4; ++r) { const int dist = 128 + i0 + 4 * q4 + r - kj; const bool ok = dist >= 0 && dist <= 128 && (blk > 0 || kj >= 128);
                const int dc = dist < 0 ? 0 : (dist > 128 ? 128 : dist);
                const float v = ok ? s[j][r] + bl[dc * 4 + g] : -INFINITY; s[j][r] = v; mx[r] = fmaxf(mx[r], v); } }
        float l[4];
#pragma unroll
        for (int r = 0; r < 4; ++r) { float m_ = mx[r]; m_ = fmaxf(m_, __shfl_xor(m_, 1)); m_ = fmaxf(m_, __shfl_xor(m_, 2)); m_ = fmaxf(m_, __shfl_xor(m_, 4)); m_ = fmaxf(m_, __shfl_xor(m_, 8));
            mx[r] = fmaxf(m_, sink2); l[r] = 0.f; }
#pragma unroll
        for (int j = 0; j < 10; ++j)
#pragma unroll
            for (int r = 0; r < 4; ++r) { const float p = __builtin_amdgcn_exp2f(s[j][r] - mx[r]); l[r] += p;
                *(LAS unsigned short*)(Pw + (4 * q4 + r) * AP_PITCH + (16 * j + ln) * 2) = f2bfs(p); }
#pragma unroll
        for (int r = 0; r < 4; ++r) { float t = l[r]; t += __shfl_xor(t, 1); t += __shfl_xor(t, 2); t += __shfl_xor(t, 4); t += __shfl_xor(t, 8);
            l[r] = __builtin_amdgcn_rcpf(t + __builtin_amdgcn_exp2f(sink2 - mx[r])); }
        f32x4 o[4];
#pragma unroll
        for (int dt = 0; dt < 4; ++dt) o[dt] = (f32x4){0.f, 0.f, 0.f, 0.f};
#pragma unroll
        for (int st = 0; st < 5; ++st) { const bf16x8 pf = *(const LAS bf16x8*)(Pw + ln * AP_PITCH + (32 * st + 8 * q4) * 2);
#pragma unroll
            for (int dt = 0; dt < 4; ++dt) { const bf16x8 vf = *(const LAS bf16x8*)(lds + AV_OFF + (16 * dt + ln) * AV_PITCH + (16 * kt0 + 32 * st + 8 * q4) * 2);
                o[dt] = __builtin_amdgcn_mfma_f32_16x16x32_bf16(pf, vf, o[dt], 0, 0, 0); } }
#pragma unroll
        for (int dt = 0; dt < 4; ++dt)
#pragma unroll
            for (int r = 0; r < 4; ++r) *(LAS unsigned short*)(Pw + (4 * q4 + r) * AP_PITCH + (16 * dt + ln) * 2) = f2bfs(o[dt][r] * l[r]);
#pragma unroll
        for (int i = 0; i < 2; ++i) { const int qrow = 8 * i + (lane >> 3), ch = lane & 7;
            const v4u ov = *(const LAS v4u*)(Pw + qrow * AP_PITCH + ch * 16);
            *(GAS v4u*)(MX + (size_t)(mq0 + i0 + qrow) * DM + head * 64 + ch * 8) = ov; }
    }
    __syncthreads();
}

__device__ __forceinline__ void dec_attn_unit(Frame& F, const Args& A, int du) {
    const int lane = F.lane, wave = F.wave; unsigned char* ws = F.ws;
    const int idx = du * 8 + wave, b = idx >> 4, head = idx & 15, hk = head >> 2, m = MP + b;
    LAS float* qs = (LAS float*)(F.lds + wave * 1024); LAS float* ps = qs + 64;
    const bf16* QB = (const bf16*)(ws + WS_QB); bf16* MX = (bf16*)(ws + WS_XB);
    const float* bt = (const float*)(ws + WS_BIAS);
    const float sink2 = A.in[13][head] * LOG2E;
    const float qv = bf2f(QB[(size_t)m * ATTW + head * 64 + lane]);
    qs[lane] = qv;
    LDS_WAIT(); asm volatile("" ::: "memory");
    float sc[2];
#pragma unroll
    for (int pi = 0; pi < 2; ++pi) { const int pos = lane + 64 * pi; const float* kr = A.in[2] + ((size_t)(b * WIN + pos) * NKVH + hk) * HD; float d = 0.f;
#pragma unroll
        for (int j = 0; j < 16; ++j) { const f32x4 k4 = *(const f32x4*)(kr + 4 * j); const f32x4 q4v = *(const LAS f32x4*)(qs + 4 * j); d += (k4.x * q4v.x + k4.y * q4v.y) + (k4.z * q4v.z + k4.w * q4v.w); }
        sc[pi] = d + bt[(WIN - pos) * NQH + head]; }
    const float* kn = F.out + O_KS + ((size_t)b * WIN + (WIN - 1)) * KVW + hk * HD; const float* vn = F.out + O_VS + ((size_t)b * WIN + (WIN - 1)) * KVW + hk * HD;
    const float snew = wave_sum(qv * kn[lane]) + bt[head];
    const float mx = fmaxf(fmaxf(wave_max(fmaxf(sc[0], sc[1])), snew), sink2);
    const float p0 = __builtin_amdgcn_exp2f(sc[0] - mx), p1 = __builtin_amdgcn_exp2f(sc[1] - mx), pn = __builtin_amdgcn_exp2f(snew - mx);
    const float linv = __builtin_amdgcn_rcpf(wave_sum(p0 + p1) + pn + __builtin_amdgcn_exp2f(sink2 - mx));
    ps[lane] = p0; ps[lane + 64] = p1;
    LDS_WAIT(); asm volatile("" ::: "memory");
    const float* vr = A.in[3] + ((size_t)(b * WIN) * NKVH + hk) * HD + lane; float o = pn * vn[lane];
#pragma unroll 8
    for (int pos = 0; pos < WIN; ++pos) o += ps[pos] * vr[(size_t)pos * NKVH * HD];
    MX[(size_t)m * DM + head * 64 + lane] = f2bfs(o * linv);
    LDS_WAIT(); asm volatile("" ::: "memory");
}

constexpr int SC_T = 32, SC_REC = 1344  , SC_BUF = SC_T * SC_REC  ;
struct ScanRegs { v4u kk, bb, kp, rr, vv; f32x4 d0, d1; };
__device__ __forceinline__ void scan_load(ScanRegs& R, const unsigned char* ws, int m, int h, int rq, int part) {
    const size_t o = (size_t)m * RWW + 64 * h + 8 * part;
    R.kk = *(const GAS v4u*)((const bf16*)(ws + WS_KK) + o); R.bb = *(const GAS v4u*)((const bf16*)(ws + WS_BB) + o);
    R.kp = *(const GAS v4u*)((const bf16*)(ws + WS_KP) + o); R.rr = *(const GAS v4u*)((const bf16*)(ws + WS_RR) + o);
    R.d0 = *(const GAS f32x4*)((const float*)(ws + WS_DD) + o); R.d1 = *(const GAS f32x4*)((const float*)(ws + WS_DD) + o + 4);
    R.vv = (v4u){0u, 0u, 0u, 0u};
    if (part < 2) R.vv = *(const GAS v4u*)((const bf16*)(ws + WS_VV) + (size_t)m * RWW + 64 * h + 16 * rq + 8 * part);
}
__device__ __forceinline__ void st8(LAS unsigned char* p, v4u u) {
    *(LAS f32x4*)p = (f32x4){__builtin_bit_cast(float, u.x << 16), __builtin_bit_cast(float, u.x & 0xffff0000u), __builtin_bit_cast(float, u.y << 16), __builtin_bit_cast(float, u.y & 0xffff0000u)};
    *(LAS f32x4*)(p + 16) = (f32x4){__builtin_bit_cast(float, u.z << 16), __builtin_bit_cast(float, u.z & 0xffff0000u), __builtin_bit_cast(float, u.w << 16), __builtin_bit_cast(float, u.w & 0xffff0000u)};
}
__device__ __forceinline__ void scan_store(const ScanRegs& R, LAS unsigned char* rec, int part) {
    st8(rec + 0 + 32 * part, R.kk); *(LAS f32x4*)(rec + 256 + 32 * part) = R.d0; *(LAS f32x4*)(rec + 256 + 32 * part + 16) = R.d1;
    st8(rec + 512 + 32 * part, R.bb); st8(rec + 768 + 32 * part, R.kp); st8(rec + 1024 + 32 * part, R.rr);
    if (part < 2) st8(rec + 1280 + 32 * part, R.vv);
}
constexpr int SC_YOFF = 2 * SC_BUF, SC_YBUF = SC_T * 16 * 4 * 4  ;
static_assert(SC_YOFF + 2 * SC_YBUF <= RING_BYTES, "scan LDS");
struct ScanVec { f32x2 kk0, kk1, d0, d1, b0, b1, k0, k1, r0, r1; float v; };
__device__ __forceinline__ void scan_ld(ScanVec& x, const LAS unsigned char* base, const LAS unsigned char* vb, int t) {
    const f32x4 kk = *(const LAS f32x4*)(base + t * SC_REC), dd = *(const LAS f32x4*)(base + t * SC_REC + 256), bb = *(const LAS f32x4*)(base + t * SC_REC + 512),
                kp = *(const LAS f32x4*)(base + t * SC_REC + 768), rr = *(const LAS f32x4*)(base + t * SC_REC + 1024);
    x.kk0 = (f32x2){kk.x, kk.y}; x.kk1 = (f32x2){kk.z, kk.w}; x.d0 = (f32x2){dd.x, dd.y}; x.d1 = (f32x2){dd.z, dd.w}; x.b0 = (f32x2){bb.x, bb.y}; x.b1 = (f32x2){bb.z, bb.w};
    x.k0 = (f32x2){kp.x, kp.y}; x.k1 = (f32x2){kp.z, kp.w}; x.r0 = (f32x2){rr.x, rr.y}; x.r1 = (f32x2){rr.z, rr.w};
    x.v = *(const LAS float*)(vb + t * SC_REC);
}
__device__ __forceinline__ void scan_yflush(const LAS unsigned char* yb, float* YS, int ptid) {
#pragma unroll
    for (int i = 0; i < 2; ++i) { const int o = ptid + 256 * i, t = o >> 4, r = o & 15; const f32x4 q = *(const LAS f32x4*)(yb + o * 16);
        YS[(size_t)t * RWW + r] = (q.x + q.y) + (q.z + q.w); }
}
__device__ __forceinline__ void scan_unit(Frame& F, int c) {
    const int b = c >> 6, h = (c >> 2) & 15, rq = c & 3, lane = F.lane, wave = F.wave;
    unsigned char* ws = F.ws; LAS unsigned char* lds = F.lds;
    const int mb = b * SEQ; constexpr int NCH = SEQ / SC_T;
    if (wave >= 4) {
        const int ptid = F.tid - 256, tok = ptid >> 3, part = ptid & 7;
        float* YS = (float*)(ws + WS_ACT) + (size_t)mb * RWW + 64 * h + 16 * rq;
        ScanRegs cur, nxt;
        scan_load(cur, ws, mb + tok, h, rq, part);
        scan_load(nxt, ws, mb + SC_T + tok, h, rq, part);
        scan_store(cur, lds + tok * SC_REC, part);
        __syncthreads();
        for (int ch = 0; ch < NCH; ++ch) {
            cur = nxt;
            if (ch + 2 < NCH) scan_load(nxt, ws, mb + (ch + 2) * SC_T + tok, h, rq, part);
            if (ch + 1 < NCH) scan_store(cur, lds + ((ch + 1) & 1) * SC_BUF + tok * SC_REC, part);
            if (ch > 0) scan_yflush(lds + SC_YOFF + ((ch - 1) & 1) * SC_YBUF, YS + (size_t)(ch - 1) * SC_T * RWW, ptid);
            __syncthreads();
        }
        scan_yflush(lds + SC_YOFF + ((NCH - 1) & 1) * SC_YBUF, YS + (size_t)(NCH - 1) * SC_T * RWW, ptid);
    } else {
        const int rl = 4 * wave + (lane >> 4), p = lane & 15, row = 16 * rq + rl;
        f32x2 S0 = (f32x2){0.f, 0.f}, S1 = S0;
        __builtin_amdgcn_s_setprio(2);
        __syncthreads();
        for (int ch = 0; ch < NCH; ++ch) {
            const LAS unsigned char* base = lds + (ch & 1) * SC_BUF + p * 16;
            const LAS unsigned char* vb = lds + (ch & 1) * SC_BUF + 1280 + rl * 4;
            LAS unsigned char* yb = lds + SC_YOFF + (ch & 1) * SC_YBUF + (rl * 4 + (p & 3)) * 4;
            ScanVec cur; scan_ld(cur, base, vb, 0);
#pragma unroll
            for (int t = 0; t < SC_T; ++t) {
                ScanVec nxt; scan_ld(nxt, base, vb, t + 1 < SC_T ? t + 1 : t);
                f32x2 a = S0 * cur.kk0; a = S1 * cur.kk1 + a;
                const float sa = -allsum16(a.x + a.y);
                const f32x2 sa2 = (f32x2){sa, sa}, v2 = (f32x2){cur.v, cur.v};
                f32x2 u0 = cur.b0 * sa2, u1 = cur.b1 * sa2;
                u0 = S0 * cur.d0 + u0; u1 = S1 * cur.d1 + u1;
                S0 = cur.k0 * v2 + u0; S1 = cur.k1 * v2 + u1;
                f32x2 q = S0 * cur.r0; q = S1 * cur.r1 + q;
                float y = q.x + q.y; y += dpp_f<0x128>(y); y += dpp_f<0x124>(y);
                *(LAS float*)(yb + t * 256) = y;
                cur = nxt;
            }
            __syncthreads();
        }
        __builtin_amdgcn_s_setprio(0);
        *(f32x4*)(F.out + O_WP + ((size_t)(b * RWH + h) * HD + row) * HD + 4 * p) = (f32x4){S0.x, S0.y, S1.x, S1.y};
    }
}
__device__ __forceinline__ void dec_rwkv_unit(Frame& F, const Args& A, int du) {
    const int lane = F.lane, wave = F.wave; unsigned char* ws = F.ws;
    const int idx = du * 8 + wave, b = idx >> 4, h = idx & 15, m = MP + b;
    LAS float* vec = (LAS float*)(F.lds + wave * 1280);
    const size_t o = (size_t)m * RWW + 64 * h + lane;
    const float* dv = (const float*)(ws + WS_DEC) + (size_t)b * RWW + 64 * h + lane;
    vec[lane] = dv[0]; vec[64 + lane] = dv[(size_t)1 * NDEC * RWW]; vec[128 + lane] = dv[(size_t)2 * NDEC * RWW];
    vec[192 + lane] = dv[(size_t)3 * NDEC * RWW]; vec[256 + lane] = dv[(size_t)4 * NDEC * RWW];
    const float vi = dv[(size_t)5 * NDEC * RWW];
    const size_t so = ((size_t)(b * RWH + h) * HD + lane) * HD;
    const float* Sp = A.in[4] + so; f32x4 S[16];
#pragma unroll
    for (int j = 0; j < 16; ++j) S[j] = *(const f32x4*)(Sp + 4 * j);
    LDS_WAIT(); asm volatile("" ::: "memory");
    float sa = 0.f;
#pragma unroll
    for (int j = 0; j < 16; ++j) { const f32x4 kk = *(const LAS f32x4*)(vec + 4 * j); sa += (S[j].x * kk.x + S[j].y * kk.y) + (S[j].z * kk.z + S[j].w * kk.w); asm volatile("" ::: "memory"); }
    sa = -sa; float y = 0.f; float* So = F.out + O_WS + so;
#pragma unroll
    for (int j = 0; j < 16; ++j) { const f32x4 dd = *(const LAS f32x4*)(vec + 64 + 4 * j), bb = *(const LAS f32x4*)(vec + 128 + 4 * j), kp = *(const LAS f32x4*)(vec + 192 + 4 * j), rr = *(const LAS f32x4*)(vec + 256 + 4 * j);
        S[j] = S[j] * dd + bb * sa + kp * vi; y += (S[j].x * rr.x + S[j].y * rr.y) + (S[j].z * rr.z + S[j].w * rr.w);
        *(f32x4*)(So + 4 * j) = S[j]; asm volatile("" ::: "memory"); }
    ((float*)(ws + WS_ACT))[o] = y;
    LDS_WAIT(); asm volatile("" ::: "memory");
}


constexpr int SC2_NS = 8, SC2_D = SC2_NS - 1;
static_assert(SC2_NS * CB_STRIDE <= RING_BYTES, "scan ring");
__device__ __forceinline__ void scan2_unit(Frame& F, int c) {
    const int b = c >> 4, h = c & 15, lane = F.lane, wave = F.wave;
    unsigned char* ws = F.ws; LAS unsigned char* lds = F.lds;
    const int mb = b * SEQ, g0 = (b * RWH + h) * NCHUNK;
#define SC2_BAR() do { asm volatile("" ::: "memory"); __builtin_amdgcn_s_barrier(); asm volatile("" ::: "memory"); } while (0)
    if (wave >= 4) {
        const int lw = wave - 4;
#define SC2_ISSUE(cc) do { const unsigned char* blk_ = chunk_block(ws, g0 + (cc)); LAS unsigned char* sl_ = lds + ((cc) & (SC2_NS - 1)) * CB_STRIDE; \
            for (int p_ = lw; p_ < 13; p_ += 4) __builtin_amdgcn_global_load_lds((const unsigned*)(blk_ + p_ * 1024 + lane * 16), (LAS unsigned*)(sl_ + p_ * 1024), 16, 0, 0); } while (0)
#define SC2_WAIT() do { if (lw == 0) asm volatile("s_waitcnt vmcnt(24)" ::: "memory"); else asm volatile("s_waitcnt vmcnt(18)" ::: "memory"); } while (0)
        for (int cc = 0; cc < SC2_D; ++cc) SC2_ISSUE(cc);
        SC2_WAIT(); SC2_BAR();
        for (int cc = 0; cc < NCHUNK; ++cc) {
            if (cc + SC2_D < NCHUNK) { SC2_ISSUE(cc + SC2_D); SC2_WAIT(); } else asm volatile("s_waitcnt vmcnt(0)" ::: "memory");
            SC2_BAR();
        }
#undef SC2_ISSUE
#undef SC2_WAIT
    } else {
        const int it = wave, x = lane & 15, q = lane >> 4;
        f32x4 S[4];
#pragma unroll
        for (int jt = 0; jt < 4; ++jt) S[jt] = (f32x4){0.f, 0.f, 0.f, 0.f};
        float* YS = (float*)(ws + WS_ACT) + (size_t)mb * RWW + 64 * h + 16 * it + x;
        SC2_BAR();
        for (int cc = 0; cc < NCHUNK; ++cc) {
            const LAS unsigned char* sl = lds + (cc & (SC2_NS - 1)) * CB_STRIDE;
            bf16x8 fa[2], fr[2];
#pragma unroll
            for (int k2 = 0; k2 < 2; ++k2) { fa[k2] = *(const LAS bf16x8*)(sl + CB_FA + (k2 * 64 + lane) * 16); fr[k2] = *(const LAS bf16x8*)(sl + CB_FR + (k2 * 64 + lane) * 16); }
            const s16x4 fnk = *(const LAS s16x4*)(sl + CB_FNK + lane * 8), ft = *(const LAS s16x4*)(sl + CB_FT + lane * 8), fmb = *(const LAS s16x4*)(sl + CB_FMB + lane * 8), fmk = *(const LAS s16x4*)(sl + CB_FMK + lane * 8);
            const s16x4 fv = *(const LAS s16x4*)(sl + CB_FV + (it * 64 + lane) * 8);
            s16x4 fbg[4], fkg[4]; f32x4 gc[4];
#pragma unroll
            for (int jt = 0; jt < 4; ++jt) { fbg[jt] = *(const LAS s16x4*)(sl + CB_FBG + (jt * 64 + lane) * 8); fkg[jt] = *(const LAS s16x4*)(sl + CB_FKG + (jt * 64 + lane) * 8);
                gc[jt] = *(const LAS f32x4*)(sl + CB_GC + (16 * jt + 4 * q) * 4); }
            bf16x8 sb[2];
#pragma unroll
            for (int k2 = 0; k2 < 2; ++k2) { const unsigned long long lo = pack4bf(S[2 * k2]), hi = pack4bf(S[2 * k2 + 1]);
                v4u w_; w_.x = (unsigned)lo; w_.y = (unsigned)(lo >> 32); w_.z = (unsigned)hi; w_.w = (unsigned)(hi >> 32); sb[k2] = __builtin_bit_cast(bf16x8, w_); }
            f32x4 X = (f32x4){0.f, 0.f, 0.f, 0.f};
            X = __builtin_amdgcn_mfma_f32_16x16x32_bf16(fa[0], sb[0], X, 0, 0, 0); X = __builtin_amdgcn_mfma_f32_16x16x32_bf16(fa[1], sb[1], X, 0, 0, 0);
            X = __builtin_amdgcn_mfma_f32_16x16x16bf16_1k(fnk, fv, X, 0, 0, 0);
            const s16x4 xb = __builtin_bit_cast(s16x4, pack4bf(X));
            const f32x4 U = __builtin_amdgcn_mfma_f32_16x16x16bf16_1k(ft, xb, (f32x4){0.f, 0.f, 0.f, 0.f}, 0, 0, 0);
            const s16x4 ub = __builtin_bit_cast(s16x4, pack4bf(U));
            f32x4 Y = (f32x4){0.f, 0.f, 0.f, 0.f};
            Y = __builtin_amdgcn_mfma_f32_16x16x32_bf16(fr[0], sb[0], Y, 0, 0, 0); Y = __builtin_amdgcn_mfma_f32_16x16x32_bf16(fr[1], sb[1], Y, 0, 0, 0);
            Y = __builtin_amdgcn_mfma_f32_16x16x16bf16_1k(fmb, ub, Y, 0, 0, 0); Y = __builtin_amdgcn_mfma_f32_16x16x16bf16_1k(fmk, fv, Y, 0, 0, 0);
#pragma unroll
            for (int jt = 0; jt < 4; ++jt) { f32x4 t_ = S[jt] * gc[jt];
                t_ = __builtin_amdgcn_mfma_f32_16x16x16bf16_1k(fbg[jt], ub, t_, 0, 0, 0); S[jt] = __builtin_amdgcn_mfma_f32_16x16x16bf16_1k(fkg[jt], fv, t_, 0, 0, 0); }
#pragma unroll
            for (int r = 0; r < 4; ++r) YS[(size_t)(16 * cc + 4 * q + r) * RWW] = Y[r];
            asm volatile("s_waitcnt lgkmcnt(0)" ::: "memory");
            SC2_BAR();
        }
#pragma unroll
        for (int jt = 0; jt < 4; ++jt) *(f32x4*)(F.out + O_WP + ((size_t)(b * RWH + h) * HD + 16 * it + x) * HD + 16 * jt + 4 * q) = S[jt];
    }
#undef SC2_BAR
}

constexpr int SK_S = 4;
__device__ __forceinline__ void skinny_units(Frame& F, const bf16* Arows, int lda, const bf16* Bt, int K, unsigned* cnt, float* slabs,
                                             const float* xi_s, float* xo_s, bf16* XBd, float* ssq, float alpha) {
    const int tid = F.tid, lane = F.lane, wave = F.wave, ln = lane & 15, q4 = lane >> 4, ksteps = K / 32;
    LAS unsigned char* lds = F.lds;
    for (int u = blockIdx.x; u < 32 * SK_S; u += F.G) {
        const int nb = u & 31, sl = u >> 5, n0 = 64 * nb, ks0 = sl * ksteps / SK_S, ks1 = (sl + 1) * ksteps / SK_S;
        f32x4 acc[2][4];
#pragma unroll
        for (int mt = 0; mt < 2; ++mt)
#pragma unroll
            for (int nt = 0; nt < 4; ++nt) acc[mt][nt] = (f32x4){0.f, 0.f, 0.f, 0.f};
        const bf16* ap = Arows + (size_t)ln * lda + 8 * q4; const bf16* bp = Bt + (size_t)(n0 + ln) * K + 8 * q4;
#pragma unroll 2
        for (int ks = ks0 + wave; ks < ks1; ks += 8) { const int k = 32 * ks;
            bf16x8 a[2], b[4];
#pragma unroll
            for (int mt = 0; mt < 2; ++mt) a[mt] = *(const GAS bf16x8*)(ap + (size_t)(16 * mt) * lda + k);
#pragma unroll
            for (int nt = 0; nt < 4; ++nt) b[nt] = *(const GAS bf16x8*)(bp + (size_t)(16 * nt) * K + k);
#pragma unroll
            for (int mt = 0; mt < 2; ++mt)
#pragma unroll
                for (int nt = 0; nt < 4; ++nt) acc[mt][nt] = __builtin_amdgcn_mfma_f32_16x16x32_bf16(a[mt], b[nt], acc[mt][nt], 0, 0, 0); }
#pragma unroll
        for (int mt = 0; mt < 2; ++mt)
#pragma unroll
            for (int nt = 0; nt < 4; ++nt) *(LAS f32x4*)(lds + ((wave * 8 + mt * 4 + nt) * 64 + lane) * 16) = acc[mt][nt];
        __syncthreads();
        { const int tile = tid >> 6, l = tid & 63; f32x4 sum = (f32x4){0.f, 0.f, 0.f, 0.f};
#pragma unroll
          for (int w = 0; w < 8; ++w) sum += *(const LAS f32x4*)(lds + ((w * 8 + tile) * 64 + l) * 16);
          float* sp = slabs + (size_t)sl * 32 * DM + (size_t)(16 * (tile >> 2) + 4 * (l >> 4)) * DM + n0 + 16 * (tile & 3) + (l & 15);
          sp[0] = sum.x; sp[DM] = sum.y; sp[2 * DM] = sum.z; sp[3 * DM] = sum.w; }
        VM_WAIT(); __syncthreads();
        if (tid == 0) { __builtin_amdgcn_fence(__ATOMIC_RELEASE, "agent"); VM_WAIT();
            const unsigned t = __hip_atomic_fetch_add(cnt + nb, 1u, __ATOMIC_RELAXED, __HIP_MEMORY_SCOPE_AGENT);
            const unsigned last = (t == (unsigned)(SK_S - 1)) ? 1u : 0u;
            if (last) { __builtin_amdgcn_fence(__ATOMIC_ACQUIRE, "agent"); VM_WAIT(); }
            *(LAS unsigned*)(lds + 65536) = last; }
        __syncthreads();
        const unsigned last = *(const LAS unsigned*)(lds + 65536);
        if (last) {
            const int row = tid >> 4, c4 = (tid & 15) * 4, col = n0 + c4;
            f32x4 a4 = (f32x4){0.f, 0.f, 0.f, 0.f};
#pragma unroll
            for (int s2 = 0; s2 < SK_S; ++s2) a4 += *(const GAS f32x4*)(slabs + (size_t)s2 * 32 * DM + (size_t)row * DM + col);
            const f32x4 x0 = *(const f32x4*)(xi_s + (size_t)row * DM + col);
            const f32x4 y = x0 + a4 * alpha;
            *(f32x4*)(xo_s + (size_t)row * DM + col) = y;
            if (XBd) *(GAS unsigned long long*)(XBd + (size_t)(MP + row) * DM + col) = (unsigned long long)pk2(y.x, y.y) | ((unsigned long long)pk2(y.z, y.w) << 32);
            float sq = (y.x * y.x + y.y * y.y) + (y.z * y.z + y.w * y.w);
            sq += __shfl_xor(sq, 1); sq += __shfl_xor(sq, 2); sq += __shfl_xor(sq, 4); sq += __shfl_xor(sq, 8);
            if ((tid & 15) == 0) atomicAdd(ssq + MP + row, sq);
        }
        __syncthreads();
    }
}
__global__ void __launch_bounds__(NWAVES * 64, 2) hymba_fwd(Args args) {
    extern __shared__ __attribute__((aligned(16))) unsigned char lds_raw[];
    { const int t0_ = threadIdx.x;
      for (int u = t0_; u < (LDS_BYTES - LDSCTL_OFF) / 4; u += NWAVES * 64) ((LAS unsigned*)((LAS unsigned char*)lds_raw + LDSCTL_OFF))[u] = 0u; }
    __syncthreads();
    XcdBarrier bar; bar.bar = (unsigned*)((gu32*)(args.ws + WS_CTL) + CW_BAR); bar.x = 0; bar.st = nullptr;
    if (MK_N_LAUNCHES == 1) bar = xcd_barrier_post((unsigned*)((gu32*)(args.ws + WS_CTL) + CW_BAR), (volatile LAS unsigned*)((LAS unsigned char*)lds_raw + MISC_OFF) + 8);
    const int lo = args.ph_lo, hi = args.ph_hi;
#ifndef PH_MASK
#define PH_MASK 0x7ff
#endif
#define IN(k) (((PH_MASK >> (k)) & 1) && lo <= (k) && (k) < hi)
#define SEAM(k) do { if (IN(k) && IN((k) + 1)) xcd_barrier(bar); } while (0)
#ifndef PROBE_REP
#define PROBE_REP 0
#endif
#define NREP(k) (1 + ((PROBE_REP >> (k)) & 1))
#define PHASE_FRAME() Frame F; { int t_ = threadIdx.x; asm volatile("" : "+v"(t_)); F.lds = (LAS unsigned char*)lds_raw; F.MISC = (volatile LAS unsigned*)(F.lds + MISC_OFF); F.tid = t_; F.lane = t_ & 63; \
        F.wave = __builtin_amdgcn_readfirstlane(t_ >> 6); F.G = gridDim.x; F.out = args.out; F.ws = args.ws; F.ctl = (gu32*)(args.ws + WS_CTL); } \
    unsigned char* ws = F.ws; const int gw = blockIdx.x * NWAVES + F.wave, NGW = F.G * NWAVES; (void)gw; (void)NGW; \
    bf16* XB = (bf16*)(ws + WS_XB); bf16* ACT = (bf16*)(ws + WS_ACT); bf16* X2B = (bf16*)(ws + WS_X2B); (void)XB; (void)ACT; (void)X2B; \
    float* ssq0 = (float*)(F.ctl + CW_SSQ0); float* ssq1 = (float*)(F.ctl + CW_SSQ1); float* ssq2 = (float*)(F.ctl + CW_SSQ2); float* ssq3 = (float*)(F.ctl + CW_SSQ3); float* ssqd = (float*)(F.ctl + CW_SSQD); (void)ssqd; (void)ssq0; (void)ssq1; (void)ssq2; (void)ssq3; \
    float* yp = args.out + O_YP; float* ys = args.out + O_YS; (void)yp; (void)ys;

    if (IN(0)) for (int rep = 0; rep < NREP(0); ++rep) { PHASE_FRAME(); p0_prologue(F, args); if (rep + 1 < NREP(0)) xcd_barrier(bar); else SEAM(0); }
    if (IN(1)) for (int rep = 0; rep < NREP(1); ++rep) { PHASE_FRAME(); pg8::Gemm g{XB, (const bf16*)(ws + WS_WGU1), MPAD, 2 * DFF, DM}; pg8::StaticOrder S; S.init(MPAD, 2 * DFF, F.G, (int)blockIdx.x);
        pg8::EpiSwiglu E{ACT, ssq0};
        pg8::gemm_phase<pg8::EpiSwiglu, pg8::StaticOrder, true, true>(F.lds + RING_OFF, g, S, E);
#ifndef CV_ALL_IN_P0
        { const int nfull = S.nwg % F.G; if (rep == 0 && nfull != 0 && (int)blockIdx.x >= nfull) convert_items(F, args, CV_EARLY, CV_LATE1, (int)blockIdx.x - nfull, F.G - nfull);
          else if (rep == 0 && nfull == 0) convert_items(F, args, CV_EARLY, CV_LATE1, blockIdx.x, F.G); }
#endif
        if (rep + 1 < NREP(1)) xcd_barrier(bar); else SEAM(1); }
    if (IN(2)) for (int rep = 0; rep < NREP(2); ++rep) { PHASE_FRAME(); pg8::Gemm g{ACT, (const bf16*)(ws + WS_WD1), MP, DM, DFF}; pg8::StaticOrder S; S.init(MP, DM, F.G, (int)blockIdx.x);
        pg8::EpiResid E{args.in[0], args.in[1], yp, ys, XB, rep ? ssqd : ssq1, 0.5f};
        pg8::gemm_phase<pg8::EpiResid, pg8::StaticOrder, true, true>(F.lds + RING_OFF, g, S, E);
        skinny_units(F, ACT + (size_t)MP * DFF, DFF, (const bf16*)(ws + WS_WD1), DFF, (unsigned*)(F.ctl + CW_SKC + 64 * rep), (float*)(ws + WS_SLAB), args.in[1], ys, XB, rep ? ssqd : ssq1, 0.5f);
        if (rep + 1 < NREP(2)) xcd_barrier(bar); else SEAM(2); }
    if (IN(3)) for (int rep = 0; rep < NREP(3); ++rep) { PHASE_FRAME(); pg8::Gemm g{XB, (const bf16*)(ws + WS_WINB), MPAD, INC, DM}; pg8::StaticOrder S; S.init(MPAD, INC, F.G, (int)blockIdx.x);
        pg8::EpiWin E{ssq1, (bf16*)(ws + WS_QB), (bf16*)(ws + WS_KB), (bf16*)(ws + WS_VB), (float*)(ws + WS_ACT), args.out};
        pg8::gemm_phase<pg8::EpiWin, pg8::StaticOrder, true, true>(F.lds + RING_OFF, g, S, E);
#ifndef CV_ALL_IN_P0
        { const int nfull = S.nwg % F.G; if (rep == 0 && nfull != 0 && (int)blockIdx.x >= nfull) convert_items(F, args, CV_EARLY + CV_LATE1, CV_LATE2, (int)blockIdx.x - nfull, F.G - nfull);
          else if (rep == 0 && nfull == 0) convert_items(F, args, CV_EARLY + CV_LATE1, CV_LATE2, blockIdx.x, F.G); }
#endif
        if (rep + 1 < NREP(3)) xcd_barrier(bar); else SEAM(3); }
    if (IN(4)) for (int rep = 0; rep < NREP(4); ++rep) { PHASE_FRAME();
        for (int r2 = 0; r2 < 1 + ((PROBE_REP >> 11) & 1); ++r2)
        for (int u = blockIdx.x; u < NB * 16 * NKVH; u += F.G) attn_unit(F, args, u >> 6, (u >> 2) & 15, u & 3);
        for (int r2 = 0; r2 < 1 + ((PROBE_REP >> 12) & 1); ++r2) { __syncthreads(); prep_phase(F, args); }
        __syncthreads();
        for (int r2 = 0; r2 < 1 + ((PROBE_REP >> 13) & 1); ++r2)
        for (int u = (int)F.G - 1 - (int)blockIdx.x; u < NDEC * NQH / 8; u += F.G) dec_attn_unit(F, args, u);
        __syncthreads();
        { const int n4 = NDEC * (WIN - 1) * KVW / 4;
          for (int i = blockIdx.x * (NWAVES * 64) + F.tid; i < 2 * n4; i += F.G * NWAVES * 64) { const int t = i >= n4, j = t ? i - n4 : i; const int bb = j / ((WIN - 1) * KVW / 4), r = j % ((WIN - 1) * KVW / 4);
              const f32x4 v = *((const f32x4*)(args.in[2 + t] + (size_t)bb * WIN * KVW + KVW) + r);
              *((f32x4*)(args.out + (t ? O_VS : O_KS) + (size_t)bb * WIN * KVW) + r) = v; } }
        if (rep + 1 < NREP(4)) xcd_barrier(bar); else SEAM(4); }
    if (IN(5)) for (int rep = 0; rep < NREP(5); ++rep) { PHASE_FRAME();
        if ((int)blockIdx.x < NB * RWH) scan2_unit(F, blockIdx.x);
        else for (int u = (int)blockIdx.x - NB * RWH; u < NDEC * RWH / 8; u += F.G - NB * RWH) dec_rwkv_unit(F, args, u);
        if (rep + 1 < NREP(5)) xcd_barrier(bar); else SEAM(5); }
    if (IN(6)) for (int rep = 0; rep < NREP(6); ++rep) { PHASE_FRAME(); const float* YS = (const float*)(ws + WS_ACT); const bf16* LG = (const bf16*)(ws + WS_LG); const bf16* EE = (const bf16*)(ws + WS_EE);
        for (int u = gw; u < MV * RWH; u += NGW) { const size_t o = (size_t)(u >> 4) * RWW + 64 * (u & 15) + F.lane;
            const float y = YS[o], mean = wave_sum(y) * (1.0f / 64.0f), dl = y - mean, var = wave_sum(dl * dl) * (1.0f / 64.0f);
            const float r = dl * __builtin_amdgcn_rsqf(var + GN_EPS) * bf2f(LG[o]) + bf2f(EE[o]);
            XB[(size_t)(u >> 4) * DM + ATTW + 64 * (u & 15) + F.lane] = f2bfs(r); }
        if (rep + 1 < NREP(6)) xcd_barrier(bar); else SEAM(6); }
    if (IN(7)) for (int rep = 0; rep < NREP(7); ++rep) { PHASE_FRAME(); pg8::Gemm g{XB, (const bf16*)(ws + WS_WOUT), MP, DM, DM}; pg8::StaticOrder S; S.init(MP, DM, F.G, (int)blockIdx.x);
        pg8::EpiResid E{yp, ys, yp, ys, rep ? nullptr : X2B, rep ? ssqd : ssq2, rep ? 0.0f : 1.0f};
        pg8::gemm_phase<pg8::EpiResid, pg8::StaticOrder, true, true>(F.lds + RING_OFF, g, S, E);
        skinny_units(F, XB + (size_t)MP * DM, DM, (const bf16*)(ws + WS_WOUT), DM, (unsigned*)(F.ctl + CW_SKC + 128 + 64 * rep), (float*)(ws + WS_SLAB), ys, ys, rep ? nullptr : X2B, rep ? ssqd : ssq2, rep ? 0.0f : 1.0f);
        if (rep + 1 < NREP(7)) xcd_barrier(bar); else SEAM(7); }
    if (IN(8)) for (int rep = 0; rep < NREP(8); ++rep) { PHASE_FRAME(); pg8::Gemm g{X2B, (const bf16*)(ws + WS_WGU2), MPAD, 2 * DFF, DM}; pg8::StaticOrder S; S.init(MPAD, 2 * DFF, F.G, (int)blockIdx.x);
        pg8::EpiSwiglu E{ACT, ssq2};
        pg8::gemm_phase<pg8::EpiSwiglu, pg8::StaticOrder, true, true>(F.lds + RING_OFF, g, S, E); if (rep + 1 < NREP(8)) xcd_barrier(bar); else SEAM(8); }
    if (IN(9)) for (int rep = 0; rep < NREP(9); ++rep) { PHASE_FRAME(); pg8::Gemm g{ACT, (const bf16*)(ws + WS_WD2), MP, DM, DFF}; pg8::StaticOrder S; S.init(MP, DM, F.G, (int)blockIdx.x);
        pg8::EpiResid E{yp, ys, yp, ys, nullptr, rep ? ssqd : ssq3, rep ? 0.0f : 0.5f};
        pg8::gemm_phase<pg8::EpiResid, pg8::StaticOrder, true, true>(F.lds + RING_OFF, g, S, E);
        skinny_units(F, ACT + (size_t)MP * DFF, DFF, (const bf16*)(ws + WS_WD2), DFF, (unsigned*)(F.ctl + CW_SKC + 256 + 64 * rep), (float*)(ws + WS_SLAB), ys, ys, nullptr, rep ? ssqd : ssq3, rep ? 0.0f : 0.5f);
        if (rep + 1 < NREP(9)) xcd_barrier(bar); else SEAM(9); }
    if (IN(10)) for (int rep = 0; rep < NREP(10); ++rep) { PHASE_FRAME(); const float* fn = args.in[30];
        for (int m = gw; m < MV; m += NGW) { float* xr = m < MP ? yp + (size_t)m * DM : ys + (size_t)(m - MP) * DM;
            const float s = rep ? 1.0f : __builtin_amdgcn_rsqf(ssq3[m] * (1.0f / DM) + RMS_EPS);
            GAS f32x4* x4 = (GAS f32x4*)xr + F.lane; const GAS f32x4* f4 = (const GAS f32x4*)fn + F.lane;
#pragma unroll
            for (int j = 0; j < 8; ++j) x4[64 * j] = rep ? x4[64 * j] * s : x4[64 * j] * s * f4[64 * j]; } if (NREP(10) > 1 && rep == 0) xcd_barrier(bar); }
#undef IN
#undef SEAM
}

extern "C" void kernel_launch(void* const* d_in, const int* in_sizes, int n_in, void* d_out, int out_size, void* d_ws, size_t ws_size, hipStream_t stream) {
    static int grid = 0;
    if (grid == 0) {
        if (n_in != 31 || in_sizes[0] != MP * DM || (size_t)out_size != O_END || ws_size < WS_END2) {
            fprintf(stderr, "kernel_launch: unexpected shapes: n_in %d in0 %d out %d (want %zu) ws %zu (want >= %zu); nothing launched\n", n_in, n_in > 0 ? in_sizes[0] : -1, out_size, (size_t)O_END, ws_size, (size_t)WS_END2);
            grid = -1; return; }
        int dev = 0, cus = 0, per_cu = 0;
        if (hipGetDevice(&dev) != hipSuccess || hipDeviceGetAttribute(&cus, hipDeviceAttributeMultiprocessorCount, dev) != hipSuccess) { fprintf(stderr, "kernel_launch: device query failed\n"); grid = -1; return; }
        if (hipFuncSetAttribute((const void*)hymba_fwd, hipFuncAttributeMaxDynamicSharedMemorySize, LDS_BYTES) != hipSuccess) { fprintf(stderr, "kernel_launch: hipFuncSetAttribute failed\n"); grid = -1; return; }
        if (hipOccupancyMaxActiveBlocksPerMultiprocessor(&per_cu, (const void*)hymba_fwd, NWAVES * 64, LDS_BYTES) != hipSuccess || per_cu < 1)
            fprintf(stderr, "kernel_launch: note: occupancy query reports %d workgroups per CU\n", per_cu);
        (void)hipGetLastError();
        grid = cus;
    }
    if (grid < 0) return;
    if (hipMemsetAsync((char*)d_ws + WS_CTL, 0, CTL_ZERO_BYTES, stream) != hipSuccess) { fprintf(stderr, "kernel_launch: hipMemsetAsync failed\n"); return; }
    Args a{};
    for (int i = 0; i < 31; ++i) a.in[i] = (const float*)d_in[i];
    a.out = (float*)d_out; a.ws = (unsigned char*)d_ws;
    for (int li = 0; li < MK_N_LAUNCHES; ++li) {
        a.ph_lo = (MK_N_LAUNCHES == 1) ? 0 : li; a.ph_hi = (MK_N_LAUNCHES == 1) ? NPHASES : li + 1; a.li = li;
        hipLaunchKernelGGL(hymba_fwd, dim3(grid), dim3(NWAVES * 64), LDS_BYTES, stream, a);
        const hipError_t le = hipPeekAtLastError();
        if (le != hipSuccess) { fprintf(stderr, "kernel_launch: launch %d failed: %s\n", li, hipGetErrorName(le)); break; }
    }
}
```

```cpp
#include <hip/hip_runtime.h>
#include <cstdio>
#include <cstdint>
#define MK_N_LAUNCHES 1
constexpr int DM = 2048, SEQ = 2048, NB = 4, MP = NB * SEQ  , NDEC = 32, MV = MP + NDEC  , MPAD = 8448  ;
constexpr int DFF = 5504, ATTW = 1024, KVW = 256, RWW = 1024, NQH = 16, NKVH = 4, HD = 64, RWH = 16, WIN = 128;
constexpr int ATT_COLS = ATTW + 2 * KVW  , SHC = 3 * RWW + 64 + 64 + 128  , INC = ATT_COLS + SHC  ;
constexpr float RMS_EPS = 1e-5f, GN_EPS = 64e-5f, LOG2E = 1.4426950408889634f;
constexpr float QSCALE = 0.125f * LOG2E;
constexpr size_t O_YP = 0, O_YS = O_YP + (size_t)MP * DM, O_KP = O_YS + (size_t)NDEC * DM, O_VP = O_KP + (size_t)NB * WIN * KVW, O_WP = O_VP + (size_t)NB * WIN * KVW,
                 O_SP = O_WP + (size_t)NB * RWH * HD * HD, O_KS = O_SP + (size_t)NB * SHC, O_VS = O_KS + (size_t)NDEC * WIN * KVW, O_WS = O_VS + (size_t)NDEC * WIN * KVW,
                 O_SS = O_WS + (size_t)NDEC * RWH * HD * HD, O_END = O_SS + (size_t)NDEC * SHC;
namespace pg8 {
#define PG8_LAS __attribute__((address_space(3)))
typedef unsigned short bf16_t;
typedef short bf16x8 __attribute__((ext_vector_type(8)));
typedef float f32x4 __attribute__((ext_vector_type(4)));
typedef unsigned u32x4 __attribute__((ext_vector_type(4)));
constexpr int BM = 256, BK = 64, HALF = 128, HTB = HALF * BK * 2  , STAGE_BYTES = 8 * HTB, NXCD = 8, WGM = 8;

__host__ __device__ __forceinline__ int lds_byte(int r, int c) { const int st = (r >> 4) * 2 + (c >> 5), rr = r & 15, cc = c & 31, ob = rr * 64 + cc * 2; return st * 1024 + (ob ^ (((ob >> 9) & 1) << 5)); }
__host__ __device__ __forceinline__ void stage_rc(int b, int& R, int& C) { const int st = b / 1024, sb = b % 1024, swz = sb ^ (((sb >> 9) & 1) << 5); R = (st >> 1) * 16 + swz / 64; C = (st & 1) * 32 + (swz % 64) / 2; }
__host__ __device__ __forceinline__ int perm32(int rho) { const int n = rho >> 4, i = rho & 15; return 8 * (i >> 2) + 4 * n + (i & 3); }

struct Unit { int pm, pn; };
struct Gemm { const bf16_t* A; const bf16_t* Bt; int M, N, K; };

struct StaticOrder {
    int nM, nN, nwg, G, c;
    __host__ __device__ void init(int M, int N, int G_, int c_) { nM = M / BM; nN = N / BM; nwg = nM * nN; G = G_; c = c_; }
    __host__ __device__ bool next(int i, Unit& u) const {
        const long L = (long)i * G + c; if (L >= nwg) return false;
        int wgid = (int)L; { const int q = nwg / NXCD, r = nwg % NXCD, xcd = wgid % NXCD, off = wgid / NXCD; wgid = (xcd < r ? xcd * (q + 1) : r * (q + 1) + (xcd - r) * q) + off; }
        const int nig = WGM * nN, gid = wgid / nig, fm = gid * WGM, gsz = (nM - fm) < WGM ? (nM - fm) : WGM;
        u.pm = fm + ((wgid % nig) % gsz); u.pn = (wgid % nig) / gsz; return true;
    }
    __device__ __forceinline__ void a_ready(const Unit&) const {}
    __device__ __forceinline__ void done(const Unit&) const {}
};

__device__ __forceinline__ unsigned cvt_pk_bf16(float lo, float hi) { unsigned r; asm volatile("v_cvt_pk_bf16_f32 %0, %1, %2" : "=v"(r) : "v"(lo), "v"(hi)); return r; }
__device__ __forceinline__ float silu_mul(float g, float u) { return g * u * __builtin_amdgcn_rcpf(1.0f + __builtin_amdgcn_exp2f(-g * LOG2E)); }

struct EpiSwiglu {
    static constexpr bool PERM = true, AFTER_DRAIN = false;
    bf16_t* O; const float* ssq;
    __device__ __forceinline__ void operator()(const f32x4 (&acc)[2][2][4][2], const Unit& u, int wr, int wc, int fr, int fq) const {
        const int row0 = u.pm * BM + wr * 64 + fr, col0 = u.pn * HALF + wc * 32 + 8 * fq;
#pragma unroll
        for (int ai = 0; ai < 2; ++ai)
#pragma unroll
            for (int m = 0; m < 4; ++m) { const int row = row0 + ai * HALF + m * 16;
                const float s = __builtin_amdgcn_rsqf(ssq[row] * (1.0f / DM) + RMS_EPS);
                const f32x4 g0 = acc[ai][0][m][0] * s, g1 = acc[ai][0][m][1] * s, u0 = acc[ai][1][m][0] * s, u1 = acc[ai][1][m][1] * s;
                u32x4 w; w.x = cvt_pk_bf16(silu_mul(g0[0], u0[0]), silu_mul(g0[1], u0[1])); w.y = cvt_pk_bf16(silu_mul(g0[2], u0[2]), silu_mul(g0[3], u0[3]));
                w.z = cvt_pk_bf16(silu_mul(g1[0], u1[0]), silu_mul(g1[1], u1[1])); w.w = cvt_pk_bf16(silu_mul(g1[2], u1[2]), silu_mul(g1[3], u1[3]));
                *(u32x4*)(O + (size_t)row * DFF + col0) = w; }
    }
};

struct EpiResid {
    static constexpr bool PERM = true, AFTER_DRAIN = false;
    const float* xi_p; const float* xi_s; float* xo_p; float* xo_s; bf16_t* XB; float* ssq; float alpha;
    __device__ __forceinline__ void operator()(const f32x4 (&acc)[2][2][4][2], const Unit& u, int wr, int wc, int fr, int fq) const {
        const int row0 = u.pm * BM + wr * 64 + fr, col0 = u.pn * BM + wc * 32 + 8 * fq;
#pragma unroll
        for (int ai = 0; ai < 2; ++ai)
#pragma unroll
            for (int m = 0; m < 4; ++m) { const int row = row0 + ai * HALF + m * 16; const bool valid = row < MV;
                const size_t ro = row < MP ? (size_t)row * DM : (size_t)(row - MP) * DM;
                const float* src = (row < MP ? xi_p : xi_s) + ro; float* dst = (row < MP ? xo_p : xo_s) + ro;
                float sq = 0.f;
#pragma unroll
                for (int bj = 0; bj < 2; ++bj) { const int col = col0 + bj * HALF;
                    f32x4 x0 = (f32x4){0.f, 0.f, 0.f, 0.f}, x1 = x0;
                    if (valid) { x0 = *(const f32x4*)(src + col); x1 = *(const f32x4*)(src + col + 4); }
                    const f32x4 y0 = x0 + acc[ai][bj][m][0] * alpha, y1 = x1 + acc[ai][bj][m][1] * alpha;
                    if (valid) { *(f32x4*)(dst + col) = y0; *(f32x4*)(dst + col + 4) = y1; }
                    sq += (y0[0] * y0[0] + y0[1] * y0[1]) + (y0[2] * y0[2] + y0[3] * y0[3]) + (y1[0] * y1[0] + y1[1] * y1[1]) + (y1[2] * y1[2] + y1[3] * y1[3]);
                    if (XB) { u32x4 w; w.x = cvt_pk_bf16(y0[0], y0[1]); w.y = cvt_pk_bf16(y0[2], y0[3]); w.z = cvt_pk_bf16(y1[0], y1[1]); w.w = cvt_pk_bf16(y1[2], y1[3]);
                        *(u32x4*)(XB + (size_t)row * DM + col) = w; } }
                sq += __shfl_xor(sq, 16); sq += __shfl_xor(sq, 32);
                if (fq == 0 && valid) atomicAdd(ssq + row, sq); }
    }
};

struct EpiWin {
    static constexpr bool PERM = true, AFTER_DRAIN = false;
    const float* ssq; bf16_t* QB; bf16_t* KB; bf16_t* VB; bf16_t* PR; float* out;
    __device__ __forceinline__ void operator()(const f32x4 (&acc)[2][2][4][2], const Unit& u, int wr, int wc, int fr, int fq) const {
        const int row0 = u.pm * BM + wr * 64 + fr, cl0 = wc * 32 + 8 * fq;
        const int pn = u.pn;
#pragma unroll
        for (int ai = 0; ai < 2; ++ai)
#pragma unroll
            for (int m = 0; m < 4; ++m) { const int row = row0 + ai * HALF + m * 16; const bool valid = row < MV;
                float s = __builtin_amdgcn_rsqf(ssq[row] * (1.0f / DM) + RMS_EPS);
                if (pn < 4) s *= QSCALE;
#pragma unroll
                for (int bj = 0; bj < 2; ++bj) { const int cl = cl0 + bj * HALF;
                    const f32x4 y0 = acc[ai][bj][m][0] * s, y1 = acc[ai][bj][m][1] * s;
                    if (pn < 6) { u32x4 w; w.x = cvt_pk_bf16(y0[0], y0[1]); w.y = cvt_pk_bf16(y0[2], y0[3]); w.z = cvt_pk_bf16(y1[0], y1[1]); w.w = cvt_pk_bf16(y1[2], y1[3]);
                        if (pn < 4) *(u32x4*)(QB + (size_t)row * ATTW + pn * BM + cl) = w;
                        else { *(u32x4*)((pn == 4 ? KB : VB) + (size_t)row * KVW + cl) = w;
                            if (valid) { float* o = nullptr;
                                if (row >= MP) o = out + (pn == 4 ? O_KS : O_VS) + ((size_t)(row - MP) * WIN + (WIN - 1)) * KVW + cl;
                                else if ((row & (SEQ - 1)) >= SEQ - WIN) o = out + (pn == 4 ? O_KP : O_VP) + ((size_t)(row >> 11) * WIN + ((row & (SEQ - 1)) - (SEQ - WIN))) * KVW + cl;
                                if (o) { *(f32x4*)o = y0; *(f32x4*)(o + 4) = y1; } } }
                    } else { const int cs = (pn - 6) * BM + cl;
                        { u32x4 w; w.x = cvt_pk_bf16(y0[0], y0[1]); w.y = cvt_pk_bf16(y0[2], y0[3]); w.z = cvt_pk_bf16(y1[0], y1[1]); w.w = cvt_pk_bf16(y1[2], y1[3]); *(u32x4*)(PR + (size_t)row * SHC + cs) = w; }
                        if (valid) { float* o = nullptr;
                            if (row >= MP) o = out + O_SS + (size_t)(row - MP) * SHC + cs;
                            else if ((row & (SEQ - 1)) == SEQ - 1) o = out + O_SP + (size_t)(row >> 11) * SHC + cs;
                            if (o) { *(f32x4*)o = y0; *(f32x4*)(o + 4) = y1; } } } }
            }
    }
};
template <class Epi, class Sched, bool ALIGN_EPI = false, bool SP2 = false>
__device__ __forceinline__ void gemm_phase(PG8_LAS unsigned char* lds, const Gemm g, const Sched& S, const Epi& E) {
    int tid_ = threadIdx.x; asm volatile("" : "+v"(tid_)); const int tid = tid_, wid = __builtin_amdgcn_readfirstlane(tid >> 6), lane = tid & 63, wr = wid >> 2, wc = wid & 3, fr = lane & 15, fq = lane >> 4;
    const int K = g.K, nt = K / BK;
    unsigned voffA[2], voffB[2];
#pragma unroll
    for (int i = 0; i < 2; ++i) { int R, C; stage_rc(tid * 16 + i * 8192, R, C); const int Rb = Epi::PERM ? ((R & ~31) + perm32(R & 31)) : R;
        voffA[i] = (unsigned)(R * K + C) * 2u; voffB[i] = (unsigned)(Rb * K + C) * 2u; }
    const size_t kstep = (size_t)(BK * 2);
    const size_t hstep = (size_t)HALF * K * 2;
    const size_t tstep = 2 * hstep;
    const unsigned ldsw = (unsigned)wid * 1024u;
    const int aoff = lds_byte(wr * 64 + fr, fq * 8), boff = lds_byte(wc * 32 + fr, fq * 8);
#define PG8_SA(b, h) (((b) * 2 + (h)) * HTB)
#define PG8_SB(b, h) ((4 + (b) * 2 + (h)) * HTB)
#define PG8_STAGE(bufoff, gbase, voff) do { _Pragma("unroll") for (int _i = 0; _i < 2; ++_i) \
        __builtin_amdgcn_global_load_lds((const unsigned*)((const char*)(gbase) + (voff)[_i]), (PG8_LAS unsigned*)(lds + (bufoff) + ldsw + _i * 8192), 16, 0, 0); } while (0)
#define PG8_LDA(dst, b, h) do { _Pragma("unroll") for (int m = 0; m < 4; ++m) _Pragma("unroll") for (int k = 0; k < 2; ++k) dst[m][k] = *(const PG8_LAS bf16x8*)(lds + PG8_SA(b, h) + aoff + m * 2048 + k * 1024); } while (0)
#define PG8_LDB(dst, b, h) do { _Pragma("unroll") for (int n = 0; n < 2; ++n) _Pragma("unroll") for (int k = 0; k < 2; ++k) dst[n][k] = *(const PG8_LAS bf16x8*)(lds + PG8_SB(b, h) + boff + n * 2048 + k * 1024); } while (0)
#define PG8_MMA(ai, bj, At, Bt) do { __builtin_amdgcn_s_setprio(1); _Pragma("unroll") for (int m = 0; m < 4; ++m) _Pragma("unroll") for (int n = 0; n < 2; ++n) _Pragma("unroll") for (int k = 0; k < 2; ++k) \
        acc[ai][bj][m][n] = __builtin_amdgcn_mfma_f32_16x16x32_bf16(Bt[n][k], At[m][k], acc[ai][bj][m][n], 0, 0, 0); __builtin_amdgcn_s_setprio(0); } while (0)
#define PG8_WAIT_V(n) asm volatile("s_waitcnt vmcnt(" #n ")" ::: "memory")
#define PG8_WAIT_L(n) asm volatile("s_waitcnt lgkmcnt(" #n ")" ::: "memory")
#define PG8_BAR __builtin_amdgcn_s_barrier()
#define PG8_SCHED __builtin_amdgcn_sched_barrier(0)
    Unit cur, nxt; int ui = 0;
    if (!S.next(0, cur)) return;
    f32x4 acc[2][2][4][2];
#pragma unroll
    for (int a = 0; a < 2; ++a)
#pragma unroll
        for (int b = 0; b < 2; ++b)
#pragma unroll
            for (int m = 0; m < 4; ++m)
#pragma unroll
                for (int n = 0; n < 2; ++n) acc[a][b][m][n] = (f32x4){0.f, 0.f, 0.f, 0.f};
    bf16x8 At[4][2], B0[2][2], B1[2][2];
    const char* cA = (const char*)g.A + (size_t)cur.pm * tstep; const char* cB = (const char*)g.Bt + (size_t)cur.pn * tstep;
    S.a_ready(cur);
    if constexpr (SP2) {
        PG8_STAGE(PG8_SB(0, 0), cB, voffB); PG8_STAGE(PG8_SB(0, 1), cB + hstep, voffB); PG8_STAGE(PG8_SA(0, 0), cA, voffA); PG8_STAGE(PG8_SA(0, 1), cA + hstep, voffA);
        if (wr == 1) PG8_BAR;
        PG8_WAIT_V(2); PG8_BAR;
        PG8_STAGE(PG8_SB(1, 0), cB + kstep, voffB); PG8_STAGE(PG8_SA(1, 0), cA + kstep, voffA); PG8_STAGE(PG8_SB(1, 1), cB + hstep + kstep, voffB);
        PG8_WAIT_V(6); PG8_BAR;
    } else {
        PG8_STAGE(PG8_SB(0, 0), cB, voffB); PG8_STAGE(PG8_SA(0, 0), cA, voffA); PG8_STAGE(PG8_SB(0, 1), cB + hstep, voffB); PG8_STAGE(PG8_SA(0, 1), cA + hstep, voffA);
        if (wr == 1) PG8_BAR;
        PG8_WAIT_V(4); PG8_BAR;
        PG8_STAGE(PG8_SB(1, 0), cB + kstep, voffB); PG8_STAGE(PG8_SA(1, 0), cA + kstep, voffA); PG8_STAGE(PG8_SB(1, 1), cB + hstep + kstep, voffB);
        PG8_WAIT_V(6); PG8_BAR;
    }
    for (;;) {
        const bool has_next = S.next(ui + 1, nxt);
        const char* nA = has_next ? (const char*)g.A + (size_t)nxt.pm * tstep : cA; const char* nB = has_next ? (const char*)g.Bt + (size_t)nxt.pn * tstep : cB;
        for (int t = 0; t < nt; t += 2) {
            const bool last = (t == nt - 2);
            const char* a1 = cA + (size_t)(t + 1) * kstep;
            const char* a2 = last ? nA : cA + (size_t)(t + 2) * kstep; const char* b2 = last ? nB : cB + (size_t)(t + 2) * kstep;
            const char* a3 = a2 + kstep; const char* b3 = b2 + kstep;
            if (last && has_next) S.a_ready(nxt);
            if constexpr (SP2) {
            PG8_LDB(B0, 0, 0); PG8_LDB(B1, 0, 1); PG8_SCHED; PG8_LDA(At, 0, 0); PG8_STAGE(PG8_SA(1, 1), a1 + hstep, voffA);
            PG8_WAIT_V(8); PG8_WAIT_L(0); PG8_BAR; PG8_MMA(0, 0, At, B0); PG8_MMA(0, 1, At, B1); PG8_BAR; PG8_SCHED;
            PG8_LDA(At, 0, 1); PG8_STAGE(PG8_SB(0, 0), b2, voffB); PG8_STAGE(PG8_SB(0, 1), b2 + hstep, voffB); PG8_STAGE(PG8_SA(0, 0), a2, voffA);
            PG8_WAIT_V(8); PG8_WAIT_L(0); PG8_BAR; PG8_MMA(1, 0, At, B0); PG8_MMA(1, 1, At, B1); PG8_BAR; PG8_SCHED;
            PG8_LDB(B0, 1, 0); PG8_LDB(B1, 1, 1); PG8_SCHED; PG8_LDA(At, 1, 0); PG8_STAGE(PG8_SA(0, 1), a2 + hstep, voffA);
            PG8_WAIT_V(8); PG8_WAIT_L(0); PG8_BAR; PG8_MMA(0, 0, At, B0); PG8_MMA(0, 1, At, B1); PG8_BAR; PG8_SCHED;
            PG8_LDA(At, 1, 1); PG8_STAGE(PG8_SB(1, 0), b3, voffB); PG8_STAGE(PG8_SB(1, 1), b3 + hstep, voffB); PG8_STAGE(PG8_SA(1, 0), a3, voffA);
            PG8_WAIT_V(8); PG8_WAIT_L(0); PG8_BAR; PG8_MMA(1, 0, At, B0); PG8_MMA(1, 1, At, B1); PG8_BAR; PG8_SCHED;
            } else {
            PG8_LDB(B0, 0, 0); PG8_SCHED; PG8_LDA(At, 0, 0); PG8_STAGE(PG8_SA(1, 1), a1 + hstep, voffA);
            PG8_WAIT_L(8); PG8_BAR; PG8_WAIT_L(0); PG8_MMA(0, 0, At, B0); PG8_BAR; PG8_SCHED;
            PG8_LDB(B1, 0, 1); PG8_STAGE(PG8_SB(0, 0), b2, voffB);
            PG8_BAR; PG8_WAIT_L(0); PG8_MMA(0, 1, At, B1); PG8_BAR;
            PG8_LDA(At, 0, 1); PG8_STAGE(PG8_SA(0, 0), a2, voffA);
            PG8_BAR; PG8_WAIT_L(0); PG8_MMA(1, 0, At, B0); PG8_BAR; PG8_SCHED;
            PG8_STAGE(PG8_SB(0, 1), b2 + hstep, voffB);
            PG8_WAIT_V(6); PG8_BAR; PG8_MMA(1, 1, At, B1); PG8_BAR;
            PG8_LDB(B0, 1, 0); PG8_SCHED; PG8_LDA(At, 1, 0); PG8_STAGE(PG8_SA(0, 1), a2 + hstep, voffA);
            PG8_WAIT_L(8); PG8_BAR; PG8_WAIT_L(0); PG8_MMA(0, 0, At, B0); PG8_BAR; PG8_SCHED;
            PG8_LDB(B1, 1, 1); PG8_STAGE(PG8_SB(1, 0), b3, voffB);
            PG8_BAR; PG8_WAIT_L(0); PG8_MMA(0, 1, At, B1); PG8_BAR;
            PG8_LDA(At, 1, 1); PG8_STAGE(PG8_SA(1, 0), a3, voffA);
            PG8_BAR; PG8_WAIT_L(0); PG8_MMA(1, 0, At, B0); PG8_BAR; PG8_SCHED;
            PG8_STAGE(PG8_SB(1, 1), b3 + hstep, voffB);
            PG8_WAIT_V(6); PG8_BAR; PG8_MMA(1, 1, At, B1); PG8_BAR;
            }
        }
        if constexpr (ALIGN_EPI) { if (wr == 0) PG8_BAR; }
        if constexpr (!Epi::AFTER_DRAIN) { E(acc, cur, wr, wc, fr, fq); S.done(cur); }
        if (!has_next) break;
#pragma unroll
        for (int a = 0; a < 2; ++a)
#pragma unroll
            for (int b = 0; b < 2; ++b)
#pragma unroll
                for (int m = 0; m < 4; ++m)
#pragma unroll
                    for (int n = 0; n < 2; ++n) acc[a][b][m][n] = (f32x4){0.f, 0.f, 0.f, 0.f};
        cur = nxt; cA = nA; cB = nB; ++ui;
        if constexpr (ALIGN_EPI) { if (wr == 1) PG8_BAR; }
    }
    PG8_WAIT_V(0);
    if constexpr (!ALIGN_EPI) { if (wr == 0) PG8_BAR; }
    PG8_BAR;
    if constexpr (Epi::AFTER_DRAIN) { E.fused(acc, cur, wr, wc, fr, fq, lds, wid, lane); S.done(cur); }
#undef PG8_SA
#undef PG8_SB
#undef PG8_STAGE
#undef PG8_LDA
#undef PG8_LDB
#undef PG8_MMA
#undef PG8_WAIT_V
#undef PG8_WAIT_L
#undef PG8_BAR
#undef PG8_SCHED
}
}
#define GAS __attribute__((address_space(1)))
#define LAS __attribute__((address_space(3)))
typedef unsigned short bf16;
typedef unsigned v4u __attribute__((ext_vector_type(4)));
typedef float f32x4 __attribute__((ext_vector_type(4)));
typedef short bf16x8 __attribute__((ext_vector_type(8)));
typedef GAS unsigned gu32;
typedef GAS unsigned long long gu64;
#define RLX_AGENT __ATOMIC_RELAXED, __HIP_MEMORY_SCOPE_AGENT
#define LDS_WAIT() asm volatile("s_waitcnt lgkmcnt(0)" ::: "memory")
#define VM_WAIT() asm volatile("s_waitcnt vmcnt(0)" ::: "memory")
__device__ __forceinline__ unsigned long long rt() { return __builtin_amdgcn_s_memrealtime(); }
__device__ __forceinline__ unsigned f2bf(float f) { unsigned u = __builtin_bit_cast(unsigned, f); return (u + 0x7fffu + ((u >> 16) & 1u)) >> 16; }
__device__ __forceinline__ unsigned pk2(float lo, float hi) { return f2bf(lo) | (f2bf(hi) << 16); }

#define XB_TMO      128
#define XB_XCNT(j)  (256  + 64 * (j))
#define XB_XSUB(j)  (1280 + 64 * (j))
#define XB_XGEN(j)  (2304 + 64 * (j))
#define XB_TOP      3328
#define XB_TOPGEN   3392
#define XCD_BAR_WORDS 3456
#define XB_SPIN_CAP (1u << 18)

__device__ __forceinline__ unsigned xb_ld(unsigned* p)              { return __hip_atomic_load(p, __ATOMIC_RELAXED, __HIP_MEMORY_SCOPE_AGENT); }
__device__ __forceinline__ unsigned xb_add(unsigned* p, unsigned v) { return __hip_atomic_fetch_add(p, v, __ATOMIC_RELAXED, __HIP_MEMORY_SCOPE_AGENT); }
__device__ __forceinline__ unsigned xb_xcc_id() { return (unsigned)__builtin_amdgcn_s_getreg((3 << 11) | 20) & 0xFu; }
#define XB_SPIN(cond, bar) do { unsigned _sp = 0; while (cond) { __builtin_amdgcn_s_sleep(1); \
    if ((++_sp & 255u) == 0u) { if (xb_ld(&(bar)[XB_TMO])) break; if (_sp > XB_SPIN_CAP) { atomicAdd(&(bar)[XB_TMO], 1u); break; } } } } while (0)

struct XcdBarrier {
    unsigned* bar; unsigned x;
    volatile LAS unsigned* st;
};

__device__ __forceinline__ XcdBarrier xcd_barrier_post(unsigned* bar, volatile LAS unsigned* st) {
    XcdBarrier b; b.bar = bar; b.x = xb_xcc_id(); b.st = st;
    if (threadIdx.x == 0) (void)xb_add(&bar[XB_XCNT(b.x)], 1u);
    return b;
}
__device__ __forceinline__ void xcd_barrier_complete(unsigned* bar, unsigned x, unsigned& nloc, unsigned& nx) {
    const unsigned G = gridDim.x * gridDim.y * gridDim.z;
    unsigned sum, cnt, mine, sp = 0u;
    for (;;) {
        sum = 0u; cnt = 0u; mine = 0u;
#pragma unroll
        for (unsigned j = 0; j < 16; ++j) { const unsigned c = xb_ld(&bar[XB_XCNT(j)]); sum += c; cnt += (c > 0u) ? 1u : 0u; mine = (j == x) ? c : mine; }
        if (sum == G) break;
        __builtin_amdgcn_s_sleep(1);
        if ((++sp & 255u) == 0u) { if (xb_ld(&bar[XB_TMO])) break; if (sp > XB_SPIN_CAP) { atomicAdd(&bar[XB_TMO], 1u); break; } }
    }
    nloc = mine > 0u ? mine : 1u; nx = cnt > 0u ? cnt : 1u;
}

__device__ __forceinline__ void xcd_barrier(const XcdBarrier& b) {
    asm volatile("s_waitcnt vmcnt(0)" ::: "memory");
    __syncthreads();
    if (threadIdx.x == 0) {
        unsigned* bar = b.bar;
        __builtin_amdgcn_s_waitcnt(0);
        unsigned nloc = b.st[0], nx = b.st[1];
        if (nloc == 0u) { xcd_barrier_complete(bar, b.x, nloc, nx); b.st[0] = nloc; b.st[1] = nx; }
        const unsigned old = xb_add(&bar[XB_XSUB(b.x)], 1u);
        const unsigned gen = old / nloc;
        if (old + 1u == (gen + 1u) * nloc) {
            __builtin_amdgcn_fence(__ATOMIC_RELEASE, "agent");
            asm volatile("s_waitcnt vmcnt(0)" ::: "memory");
            const unsigned og = xb_add(&bar[XB_TOP], 1u);
            const unsigned tg = og / nx;
            if (og + 1u == (tg + 1u) * nx) xb_add(&bar[XB_TOPGEN], 1u);
            else XB_SPIN(xb_ld(&bar[XB_TOPGEN]) == tg, bar);
            __builtin_amdgcn_fence(__ATOMIC_ACQUIRE, "agent");
            xb_add(&bar[XB_XGEN(b.x)], 1u);
            asm volatile("s_waitcnt vmcnt(0)" ::: "memory");
        } else {
            XB_SPIN(xb_ld(&bar[XB_XGEN(b.x)]) == gen, bar);
            __builtin_amdgcn_fence(__ATOMIC_ACQUIRE, "agent");
            asm volatile("s_waitcnt vmcnt(0)" ::: "memory");
        }
    }
    __syncthreads();
}
constexpr size_t MiB = 1u << 20;
constexpr size_t WS_CTL = 0, CTL_ZERO_BYTES = 1 * MiB;
constexpr size_t WS_BIAS = 1 * MiB, WS_W2T = WS_BIAS + 16384, WS_A2T = WS_W2T + 131072, WS_G2T = WS_A2T + 131072;
constexpr size_t WS_WGU1 = 2 * MiB, WS_WD1 = WS_WGU1 + 43 * MiB, WS_WINB = WS_WD1 + 21 * MiB + MiB / 2;
constexpr size_t WS_WOUT = 86 * MiB, WS_WGU2 = 94 * MiB, WS_WD2 = 137 * MiB;
constexpr size_t WS_XB = 159 * MiB;
constexpr size_t WS_ACT = 192 * MiB;
constexpr size_t WS_QB = 300 * MiB, WS_KB = WS_QB + 16 * MiB + MiB / 2, WS_VB = WS_KB + 4 * MiB + MiB / 8;
constexpr size_t WS_DD = 325 * MiB, WS_LG = 358 * MiB, WS_EE = WS_LG + 16 * MiB + MiB / 2, WS_END = WS_EE + 16 * MiB + MiB / 2;
constexpr size_t WS_SLAB = WS_END, WS_DEC = WS_SLAB + 1 * MiB, WS_END2 = WS_DEC + 6 * (size_t)NDEC * RWW * 4;
constexpr size_t VEC16 = 16 * MiB + MiB / 2;
constexpr size_t WS_KK = WS_WGU1, WS_BB = WS_KK + VEC16, WS_KP = WS_BB + VEC16, WS_RR = WS_KP + VEC16, WS_VV = WS_RR + VEC16;
constexpr size_t WS_X2B = WS_WGU1;
static_assert(WS_VV + VEC16 <= WS_WOUT && WS_WINB + 19 * MiB <= WS_WOUT && WS_WD2 + 22 * MiB <= WS_XB && WS_XB + 33 * MiB <= WS_ACT && WS_VB + 4 * MiB + MiB / 8 <= WS_DD && WS_DD + 33 * MiB <= WS_LG, "d_ws map");
constexpr int CW_BAR = 4096;
constexpr int CW_SSQ0 = 16384, CW_SSQ1 = CW_SSQ0 + MPAD, CW_SSQ2 = CW_SSQ1 + MPAD, CW_SSQ3 = CW_SSQ2 + MPAD;
constexpr int CW_SKC = 8192;
constexpr int CW_SSQD = CW_SSQ3 + MPAD;
static_assert((CW_SSQD + MPAD) * 4 <= (int)CTL_ZERO_BYTES, "CTL");
constexpr int RING_OFF = 0, RING_BYTES = 131072;
constexpr int LDSCTL_OFF = RING_BYTES, MISC_OFF = LDSCTL_OFF + 320;
constexpr int LDS_BYTES = 147456;
constexpr int NWAVES = 8;
constexpr int NPHASES = 11;
#ifndef MK_N_LAUNCHES
#define MK_N_LAUNCHES 1
#endif

__constant__ unsigned char T5B[129] = {0, 1, 2, 3, 4, 5, 6, 7, 8, 9, 10, 11, 12, 13, 14, 15, 16, 16, 16, 17, 17, 18, 18, 18, 19, 19, 19, 20, 20, 20, 20, 21, 21, 21, 21, 22, 22, 22, 22, 22, 23, 23, 23, 23, 23, 23, 24, 24, 24, 24, 24, 24, 25, 25, 25, 25, 25, 25, 25, 26, 26, 26, 26, 26, 26, 26, 26, 27, 27, 27, 27, 27, 27, 27, 27, 27, 27, 28, 28, 28, 28, 28, 28, 28, 28, 28, 28, 29, 29, 29, 29, 29, 29, 29, 29, 29, 29, 29, 29, 30, 30, 30, 30, 30, 30, 30, 30, 30, 30, 30, 30, 30, 30, 31, 31, 31, 31, 31, 31, 31, 31, 31, 31, 31, 31, 31, 31, 31, 31};

struct Args { const float* in[31]; float* out; unsigned char* ws; int ph_lo, ph_hi, li, pad; };

struct Frame {
    LAS unsigned char* lds;
    volatile LAS unsigned* MISC;
    gu32* ctl;
    int tid, lane, wave, G;
    float* out; unsigned char* ws;
};
typedef float f32x2 __attribute__((ext_vector_type(2)));
__device__ __forceinline__ float bf2f(unsigned short u) { return __builtin_bit_cast(float, (unsigned)u << 16); }
__device__ __forceinline__ unsigned short f2bfs(float f) { return (unsigned short)f2bf(f); }
__device__ __forceinline__ float wave_sum(float v) {
#pragma unroll
    for (int o = 1; o < 64; o <<= 1) v += __shfl_xor(v, o);
    return v;
}
__device__ __forceinline__ float wave_max(float v) {
#pragma unroll
    for (int o = 1; o < 64; o <<= 1) v = fmaxf(v, __shfl_xor(v, o));
    return v;
}
template <int CTRL> __device__ __forceinline__ float dpp_f(float x) { return __builtin_bit_cast(float, __builtin_amdgcn_update_dpp(0, __builtin_bit_cast(int, x), CTRL, 0xf, 0xf, true)); }
__device__ __forceinline__ float allsum16(float x) { x += dpp_f<0x128>(x); x += dpp_f<0x124>(x); x += dpp_f<0x122>(x); x += dpp_f<0x121>(x); return x; }
__device__ __forceinline__ float sigmoidf_(float x) { return __builtin_amdgcn_rcpf(1.0f + __builtin_amdgcn_exp2f(-x * LOG2E)); }
__device__ __forceinline__ float tanhf_(float x) { return 1.0f - 2.0f * __builtin_amdgcn_rcpf(1.0f + __builtin_amdgcn_exp2f(2.0f * LOG2E * x)); }

constexpr int TP_PITCH = 136;
__device__ __forceinline__ void p0_transpose_item(const float* W, int K, int N, bf16* WT, int kb, int nb, int drow, const float* kscale, LAS unsigned char* scr, int lane) {
    const int k0 = 64 * kb, n0 = 64 * nb, g = lane >> 4, c = lane & 15;
    f32x4 v[16];
#pragma unroll
    for (int j = 0; j < 4; ++j)
#pragma unroll
        for (int r = 0; r < 4; ++r) v[4 * j + r] = *(const GAS f32x4*)(W + (size_t)(k0 + 16 * j + 4 * g + r) * N + n0 + 4 * c);
    if (kscale) {
#pragma unroll
        for (int j = 0; j < 4; ++j) { const f32x4 s4 = *(const GAS f32x4*)(kscale + k0 + 16 * j + 4 * g);
            v[4 * j + 0] *= s4.x; v[4 * j + 1] *= s4.y; v[4 * j + 2] *= s4.z; v[4 * j + 3] *= s4.w; } }
#pragma unroll
    for (int j = 0; j < 4; ++j)
#pragma unroll
        for (int e = 0; e < 4; ++e)
            *(LAS unsigned long long*)(scr + (4 * c + e) * TP_PITCH + (16 * j + 4 * g) * 2) = (unsigned long long)pk2(v[4 * j + 0][e], v[4 * j + 1][e]) | ((unsigned long long)pk2(v[4 * j + 2][e], v[4 * j + 3][e]) << 32);
    LDS_WAIT(); asm volatile("" ::: "memory");
#pragma unroll
    for (int i = 0; i < 8; ++i) { const int n = 8 * i + (lane >> 3), kc = lane & 7;
        const LAS unsigned char* s = scr + n * TP_PITCH + kc * 16;
        v4u o; o.x = *(const LAS unsigned*)(s); o.y = *(const LAS unsigned*)(s + 4); o.z = *(const LAS unsigned*)(s + 8); o.w = *(const LAS unsigned*)(s + 12);
        *(GAS v4u*)(WT + (size_t)(drow + n) * K + k0 + 8 * kc) = o; }
    LDS_WAIT(); asm volatile("" ::: "memory");
}
__device__ __forceinline__ int gu_row(int n0, int up) { return 256 * (n0 >> 7) + (n0 & 127) + 128 * up; }

constexpr int I_GU = (DM / 64) * (DFF / 64), I_D = (DFF / 64) * (DM / 64), I_IN = (DM / 64) * (INC / 64), I_OUT = (DM / 64) * (DM / 64), I_L64 = RWW / 64, I_L128 = 2 * (RWW / 64);
constexpr int CV_EARLY = 2 * I_GU + I_D + I_IN + 2 * I_L64 + I_L128, CV_LATE1 = I_OUT + I_GU, CV_LATE2 = I_GU + I_D, CV_ALL = CV_EARLY + CV_LATE1 + CV_LATE2;
__device__ __forceinline__ void convert_items(Frame& F, const Args& A, int first, int count, int rank, int nranks) {
    LAS unsigned char* scr = F.lds + RING_OFF + F.wave * 16384;
    const int lane = F.lane; unsigned char* ws = F.ws;
    for (int it = first + rank * NWAVES + F.wave; it < first + count; it += nranks * NWAVES) {
        int r = it;
        if (r < I_GU) { const int kb = r / (DFF / 64), nb = r % (DFF / 64); p0_transpose_item(A.in[8], DM, DFF, (bf16*)(ws + WS_WGU1), kb, nb, gu_row(64 * nb, 0), A.in[7], scr, lane); continue; } r -= I_GU;
        if (r < I_GU) { const int kb = r / (DFF / 64), nb = r % (DFF / 64); p0_transpose_item(A.in[9], DM, DFF, (bf16*)(ws + WS_WGU1), kb, nb, gu_row(64 * nb, 1), A.in[7], scr, lane); continue; } r -= I_GU;
        if (r < I_D)  { const int kb = r / (DM / 64), nb = r % (DM / 64); p0_transpose_item(A.in[10], DFF, DM, (bf16*)(ws + WS_WD1), kb, nb, 64 * nb, nullptr, scr, lane); continue; } r -= I_D;
        if (r < I_IN) { const int kb = r / (INC / 64), nb = r % (INC / 64); p0_transpose_item(A.in[12], DM, INC, (bf16*)(ws + WS_WINB), kb, nb, 64 * nb, A.in[11], scr, lane); continue; } r -= I_IN;
        if (r < I_L64) { p0_transpose_item(A.in[16], 64, RWW, (bf16*)(ws + WS_W2T), 0, r, 64 * r, nullptr, scr, lane); continue; } r -= I_L64;
        if (r < I_L64) { p0_transpose_item(A.in[18], 64, RWW, (bf16*)(ws + WS_A2T), 0, r, 64 * r, nullptr, scr, lane); continue; } r -= I_L64;
        if (r < I_L128) { const int kb = r / (RWW / 64), nb = r % (RWW / 64); p0_transpose_item(A.in[19], 128, RWW, (bf16*)(ws + WS_G2T), kb, nb, 64 * nb, nullptr, scr, lane); continue; } r -= I_L128;
        if (r < I_OUT) { const int kb = r / (DM / 64), nb = r % (DM / 64); p0_transpose_item(A.in[25], DM, DM, (bf16*)(ws + WS_WOUT), kb, nb, 64 * nb, nullptr, scr, lane); continue; } r -= I_OUT;
        if (r < I_GU) { const int kb = r / (DFF / 64), nb = r % (DFF / 64); p0_transpose_item(A.in[27], DM, DFF, (bf16*)(ws + WS_WGU2), kb, nb, gu_row(64 * nb, 0), A.in[26], scr, lane); continue; } r -= I_GU;
        if (r < I_GU) { const int kb = r / (DFF / 64), nb = r % (DFF / 64); p0_transpose_item(A.in[28], DM, DFF, (bf16*)(ws + WS_WGU2), kb, nb, gu_row(64 * nb, 1), A.in[26], scr, lane); continue; } r -= I_GU;
        { const int kb = r / (DM / 64), nb = r % (DM / 64); p0_transpose_item(A.in[29], DFF, DM, (bf16*)(ws + WS_WD2), kb, nb, 64 * nb, nullptr, scr, lane); }
    }
}
__device__ __forceinline__ void p0_prologue(Frame& F, const Args& A) {
    const int gw = blockIdx.x * NWAVES + F.wave, NGW = F.G * NWAVES, lane = F.lane;
    unsigned char* ws = F.ws;
#ifdef CV_ALL_IN_P0
    convert_items(F, A, 0, CV_ALL, blockIdx.x, F.G);
#else
    convert_items(F, A, 0, CV_EARLY, blockIdx.x, F.G);
#endif
    bf16* XB = (bf16*)(ws + WS_XB); float* ssq0 = (float*)(F.ctl + CW_SSQ0);
    for (int m = gw; m < MPAD; m += NGW) {
        GAS unsigned long long* o8 = (GAS unsigned long long*)(XB + (size_t)m * DM) + lane;
        if (m < MV) {
            const float* xrow = m < MP ? A.in[0] + (size_t)m * DM : A.in[1] + (size_t)(m - MP) * DM;
            const GAS f32x4* xr = (const GAS f32x4*)xrow + lane; f32x4 v[8]; float s = 0.f;
#pragma unroll
            for (int j = 0; j < 8; ++j) { v[j] = xr[64 * j]; s += (v[j].x * v[j].x + v[j].y * v[j].y) + (v[j].z * v[j].z + v[j].w * v[j].w); }
            s = wave_sum(s);
#pragma unroll
            for (int j = 0; j < 8; ++j) o8[64 * j] = (unsigned long long)pk2(v[j].x, v[j].y) | ((unsigned long long)pk2(v[j].z, v[j].w) << 32);
            if (lane == 0) ssq0[m] = s;
        } else {
#pragma unroll
            for (int j = 0; j < 8; ++j) o8[64 * j] = 0ull;
        }
    }
    float* bt = (float*)(ws + WS_BIAS);
    for (int i = blockIdx.x * (NWAVES * 64) + F.tid; i < 129 * NQH; i += F.G * NWAVES * 64) bt[i] = A.in[6][(int)T5B[i >> 4] * NQH + (i & 15)] * LOG2E;
}
constexpr int PREP_TILES = (MV + 63) / 64  , PREP_UNITS = PREP_TILES * RWH;
constexpr int PA_PITCH = 528;
constexpr int PW_LD = 68;
constexpr int PA_OFF = 0, PW_OFF = 64 * PA_PITCH  , PMAT = 64 * PW_LD * 4  , PC_OFF = 114688;
constexpr int CB_FA = 0, CB_FR = 2048, CB_FNK = 4096, CB_FT = 4608, CB_FMB = 5120, CB_FMK = 5632, CB_FBG = 6144, CB_FKG = 8192, CB_FV = 10240, CB_GC = 12288, CB_BYTES = 12544, CB_STRIDE = 13312;
constexpr int NCHUNK = SEQ / 16;
constexpr size_t CH_NA = (WS_WOUT - WS_WGU1) / CB_STRIDE, CH_NB = (WS_LG - WS_DD) / CB_STRIDE;
static_assert(CH_NA + CH_NB >= (size_t)NB * RWH * NCHUNK, "chunk blocks");
__device__ __forceinline__ unsigned char* chunk_block(unsigned char* ws, int g) { return (size_t)g < CH_NA ? ws + WS_WGU1 + (size_t)g * CB_STRIDE : ws + WS_DD + ((size_t)g - CH_NA) * CB_STRIDE; }
constexpr int LW_OFF = 0, CS2_OFF = 16384;
static_assert(PW_OFF + 3 * PMAT <= PC_OFF && CS2_OFF + 4 * 16384 <= PC_OFF && PC_OFF + 2560 <= RING_BYTES, "prep LDS");
constexpr int SC_FA = 0, SC_FR = 2048, SC_FBH = 4096, SC_FKH = 6144, SC_FBG = 8192, SC_FKG = 10240, SC_FV = 12288, SC_NB = 14336, SC_TT = 15360;
typedef short s16x4 __attribute__((ext_vector_type(4)));
typedef __bf16 bf16x2_t __attribute__((ext_vector_type(2)));
__device__ __forceinline__ unsigned cvtpk_c(float lo, float hi) { const f32x2 v = {lo, hi}; return __builtin_bit_cast(unsigned, __builtin_convertvector(v, bf16x2_t)); }
__device__ __forceinline__ unsigned long long pack4bf(f32x4 v) { return (unsigned long long)cvtpk_c(v.x, v.y) | ((unsigned long long)cvtpk_c(v.z, v.w) << 32); }
__device__ __forceinline__ void chunk_mm(LAS unsigned char* lds, int c, unsigned char* blk, int lane) {
    asm volatile("" : "+v"(lane));
    LAS unsigned char* sc = lds + CS2_OFF + c * 16384;
    const int x = lane & 15, q = lane >> 4;
    bf16x8 aB[2], aK[2], bA[2], bR[2];
#pragma unroll
    for (int k2 = 0; k2 < 2; ++k2) { aB[k2] = *(const LAS bf16x8*)(sc + SC_FBH + (k2 * 64 + lane) * 16); aK[k2] = *(const LAS bf16x8*)(sc + SC_FKH + (k2 * 64 + lane) * 16);
        bA[k2] = *(const LAS bf16x8*)(sc + SC_FA + (k2 * 64 + lane) * 16); bR[k2] = *(const LAS bf16x8*)(sc + SC_FR + (k2 * 64 + lane) * 16); }
    f32x4 nb = (f32x4){0.f, 0.f, 0.f, 0.f}, nk = nb, mb_ = nb, mk = nb;
#pragma unroll
    for (int k2 = 0; k2 < 2; ++k2) { nb = __builtin_amdgcn_mfma_f32_16x16x32_bf16(aB[k2], bA[k2], nb, 0, 0, 0); nk = __builtin_amdgcn_mfma_f32_16x16x32_bf16(aK[k2], bA[k2], nk, 0, 0, 0);
        mb_ = __builtin_amdgcn_mfma_f32_16x16x32_bf16(aB[k2], bR[k2], mb_, 0, 0, 0); mk = __builtin_amdgcn_mfma_f32_16x16x32_bf16(aK[k2], bR[k2], mk, 0, 0, 0); }
#pragma unroll
    for (int r = 0; r < 4; ++r) { const int s_ = 4 * q + r; if (!(s_ < x)) { nb[r] = 0.f; nk[r] = 0.f; } if (!(s_ <= x)) { mb_[r] = 0.f; mk[r] = 0.f; } }
    *(GAS unsigned long long*)(blk + CB_FNK + lane * 8) = pack4bf(nk); *(GAS unsigned long long*)(blk + CB_FMB + lane * 8) = pack4bf(mb_); *(GAS unsigned long long*)(blk + CB_FMK + lane * 8) = pack4bf(mk);
    LAS float* nbs = (LAS float*)(sc + SC_NB);
#pragma unroll
    for (int r = 0; r < 4; ++r) nbs[(4 * q + r) * 16 + x] = nb[r];
    float Tc[16];
#pragma unroll
    for (int t = 0; t < 16; ++t) { float a_ = (x == t) ? 1.f : 0.f;
#pragma unroll
        for (int s_ = 0; s_ < t; ++s_) a_ -= Tc[s_] * nbs[s_ * 16 + t];
        Tc[t] = a_; if ((t & 3) == 3) asm volatile("" ::: "memory"); }
    LAS float* tts = (LAS float*)(sc + SC_TT);
#pragma unroll
    for (int t = 0; t < 16; ++t) tts[x * 16 + t] = Tc[t];
    { f32x4 tv;
#pragma unroll
      for (int e = 0; e < 4; ++e) tv[e] = -tts[(4 * q + e) * 16 + x];
      *(GAS unsigned long long*)(blk + CB_FT + lane * 8) = pack4bf(tv); }
}
__device__ __forceinline__ void chunk_copy(LAS unsigned char* lds, int c, unsigned char* blk, int lane) {
    const LAS unsigned char* sc = lds + CS2_OFF + c * 16384;
#pragma unroll
    for (int i = 0; i < 4; ++i) *(GAS v4u*)(blk + CB_FA + (i * 64 + lane) * 16) = *(const LAS v4u*)(sc + SC_FA + (i * 64 + lane) * 16);
#pragma unroll
    for (int i = 0; i < 6; ++i) *(GAS v4u*)(blk + CB_FBG + (i * 64 + lane) * 16) = *(const LAS v4u*)(sc + SC_FBG + (i * 64 + lane) * 16);
}
__device__ __forceinline__ float qsum8(float x) {
    x += dpp_f<0xB1>(x); x += dpp_f<0x4E>(x); x += dpp_f<0x141>(x); return x; }
__device__ __forceinline__ void prep_phase(Frame& F, const Args& A) {
    const int tid = F.tid, lane = F.lane, wave = F.wave;
    unsigned char* ws = F.ws; LAS unsigned char* lds = F.lds;
    const bf16* PR = (const bf16*)(ws + WS_ACT);
    const float* mu = A.in[14];
    int hcur = -1;
    const int mtile = wave & 3, nh = wave >> 2, ln = lane & 15, q4 = lane >> 4;
    for (int u = blockIdx.x; u < PREP_UNITS; u += F.G) {
        const int mt = u >> 4, h = u & 15, m0 = mt * 64;
        if (h != hcur) {
            __syncthreads();
            hcur = h;
            { LAS float* cst = (LAS float*)(lds + PC_OFF);
              for (int i = tid; i < 10 * 64; i += NWAVES * 64) { const int a = i >> 6, c = i & 63, hc = 64 * h + c; float v;
                  if (a < 3) v = mu[a * RWW + hc]; else v = A.in[a == 3 ? 15 : (a == 4 ? 17 : (a == 5 ? 20 : (a == 6 ? 21 : (a == 7 ? 22 : (a == 8 ? 23 : 24)))))][hc];
                  cst[i] = v; } }
            __syncthreads();
        }
        const int row1 = tid >> 3, cc = tid & 7, m1 = m0 + row1, c01 = 3 * RWW + 32 * cc;
        const bool valid1 = m1 < MV;
        f32x4 xa[8], xb[8];
        { const bf16* p = PR + (size_t)(valid1 ? m1 : MV - 1) * SHC + c01;
          v4u ua[4], ub[4]; const v4u z4 = (v4u){0u, 0u, 0u, 0u};
#pragma unroll
          for (int q = 0; q < 4; ++q) { ua[q] = *(const GAS v4u*)(p + 8 * q); ub[q] = z4; }
          if (valid1 && m1 >= MP) { const float* pv = A.in[5] + (size_t)(m1 - MP) * SHC + c01;
#pragma unroll
              for (int q = 0; q < 8; ++q) xb[q] = *(const GAS f32x4*)(pv + 4 * q); }
          else { if (valid1 && (m1 & (SEQ - 1)) != 0) {
#pragma unroll
                  for (int q = 0; q < 4; ++q) ub[q] = *(const GAS v4u*)(p - SHC + 8 * q); }
#pragma unroll
              for (int q = 0; q < 4; ++q) { xb[2 * q] = (f32x4){__builtin_bit_cast(float, ub[q].x << 16), __builtin_bit_cast(float, ub[q].x & 0xffff0000u), __builtin_bit_cast(float, ub[q].y << 16), __builtin_bit_cast(float, ub[q].y & 0xffff0000u)};
                  xb[2 * q + 1] = (f32x4){__builtin_bit_cast(float, ub[q].z << 16), __builtin_bit_cast(float, ub[q].z & 0xffff0000u), __builtin_bit_cast(float, ub[q].w << 16), __builtin_bit_cast(float, ub[q].w & 0xffff0000u)}; } }
#pragma unroll
          for (int q = 0; q < 4; ++q) { xa[2 * q] = (f32x4){__builtin_bit_cast(float, ua[q].x << 16), __builtin_bit_cast(float, ua[q].x & 0xffff0000u), __builtin_bit_cast(float, ua[q].y << 16), __builtin_bit_cast(float, ua[q].y & 0xffff0000u)};
              xa[2 * q + 1] = (f32x4){__builtin_bit_cast(float, ua[q].z << 16), __builtin_bit_cast(float, ua[q].z & 0xffff0000u), __builtin_bit_cast(float, ua[q].w << 16), __builtin_bit_cast(float, ua[q].w & 0xffff0000u)}; } }
        const int t3 = lane >> 3, cq = lane & 7, tok3 = 8 * wave + t3, m3 = m0 + tok3, hc0 = 64 * h + 8 * cq;
        const bool valid3 = m3 < MV;
        f32x4 cr[2], ck[2], cv[2], pr[2], pk[2], pv3[2];
        { const bf16* p = PR + (size_t)(valid3 ? m3 : MV - 1) * SHC + hc0;
#define UNP(u, lo, hi) { lo = (f32x4){__builtin_bit_cast(float, u.x << 16), __builtin_bit_cast(float, u.x & 0xffff0000u), __builtin_bit_cast(float, u.y << 16), __builtin_bit_cast(float, u.y & 0xffff0000u)}; \
                         hi = (f32x4){__builtin_bit_cast(float, u.z << 16), __builtin_bit_cast(float, u.z & 0xffff0000u), __builtin_bit_cast(float, u.w << 16), __builtin_bit_cast(float, u.w & 0xffff0000u)}; }
          const v4u z4 = (v4u){0u, 0u, 0u, 0u};
          const v4u u0 = *(const GAS v4u*)p, u1 = *(const GAS v4u*)(p + RWW), u2 = *(const GAS v4u*)(p + 2 * RWW);
          v4u w0_ = z4, w1_ = z4, w2_ = z4;
          if (valid3 && m3 >= MP) { const float* q = A.in[5] + (size_t)(m3 - MP) * SHC + hc0;
#pragma unroll
              for (int e = 0; e < 2; ++e) { pr[e] = *(const GAS f32x4*)(q + 4 * e); pk[e] = *(const GAS f32x4*)(q + RWW + 4 * e); pv3[e] = *(const GAS f32x4*)(q + 2 * RWW + 4 * e); } }
          else { if (valid3 && (m3 & (SEQ - 1)) != 0) { w0_ = *(const GAS v4u*)(p - SHC); w1_ = *(const GAS v4u*)(p - SHC + RWW); w2_ = *(const GAS v4u*)(p - SHC + 2 * RWW); }
              UNP(w0_, pr[0], pr[1]) UNP(w1_, pk[0], pk[1]) UNP(w2_, pv3[0], pv3[1]) }
          UNP(u0, cr[0], cr[1]) UNP(u1, ck[0], ck[1]) UNP(u2, cv[0], cv[1])
#undef UNP
        }
#pragma unroll
        for (int q = 0; q < 8; ++q) {
            const f32x4 m4 = *(const GAS f32x4*)(mu + c01 + 4 * q);
            f32x4 x = xa[q] + m4 * (xb[q] - xa[q]);
            if (cc < 2) { x.x = tanhf_(x.x); x.y = tanhf_(x.y); x.z = tanhf_(x.z); x.w = tanhf_(x.w); }
            else if (cc >= 4) { x.x = sigmoidf_(x.x); x.y = sigmoidf_(x.y); x.z = sigmoidf_(x.z); x.w = sigmoidf_(x.w); }
            if (!valid1) x = (f32x4){0.f, 0.f, 0.f, 0.f};
            *(LAS unsigned long long*)(lds + PA_OFF + row1 * PA_PITCH + (32 * cc + 4 * q) * 2) = (unsigned long long)pk2(x.x, x.y) | ((unsigned long long)pk2(x.z, x.w) << 32);
        }
        __syncthreads();
#pragma unroll
        for (int mat = 0; mat < 3; ++mat) { const int kbase = mat == 0 ? 0 : (mat == 1 ? 64 : 128), KM = mat == 2 ? 128 : 64;
#pragma unroll
            for (int n2 = 0; n2 < 2; ++n2) { const int nt = 2 * nh + n2; f32x4 acc = (f32x4){0.f, 0.f, 0.f, 0.f};
#pragma unroll
                for (int ks = 0; ks < KM / 32; ++ks) {
                    const bf16x8 a = *(const LAS bf16x8*)(lds + PA_OFF + (16 * mtile + ln) * PA_PITCH + (kbase + 32 * ks + 8 * q4) * 2);
                    const bf16x8 bq = *(const GAS bf16x8*)((const bf16*)(ws + (mat == 0 ? WS_W2T : (mat == 1 ? WS_A2T : WS_G2T))) + (size_t)(64 * h + 16 * nt + ln) * KM + 32 * ks + 8 * q4);
                    acc = __builtin_amdgcn_mfma_f32_16x16x32_bf16(a, bq, acc, 0, 0, 0); }
                LAS float* o = (LAS float*)(lds + PW_OFF + mat * PMAT);
#pragma unroll
                for (int r = 0; r < 4; ++r) o[(16 * mtile + 4 * q4 + r) * PW_LD + 16 * nt + ln] = acc[r]; } }
        __syncthreads();
        { const LAS float* cst = (const LAS float*)(lds + PC_OFF) + 8 * cq;
          const LAS float* Wp = (const LAS float*)(lds + PW_OFF) + tok3 * PW_LD + 8 * cq; const LAS float* Ap = Wp + PMAT / 4; const LAS float* Gp = Ap + PMAT / 4;
          float xr[8], xk[8], xv[8], kkr[8], kp[8], aa[8], gg[8], dec[8], lw2[8]; float n2 = 0.f, bon = 0.f;
#pragma unroll
          for (int e = 0; e < 2; ++e) {
              const f32x4 mur = *(const LAS f32x4*)(cst + 0 * 64 + 4 * e), muk = *(const LAS f32x4*)(cst + 1 * 64 + 4 * e), muv = *(const LAS f32x4*)(cst + 2 * 64 + 4 * e);
              const f32x4 w0 = *(const LAS f32x4*)(cst + 3 * 64 + 4 * e), a0 = *(const LAS f32x4*)(cst + 4 * 64 + 4 * e), k_k = *(const LAS f32x4*)(cst + 5 * 64 + 4 * e);
              const f32x4 k_a = *(const LAS f32x4*)(cst + 6 * 64 + 4 * e), r_k = *(const LAS f32x4*)(cst + 7 * 64 + 4 * e);
              const f32x4 wl = *(const LAS f32x4*)(Wp + 4 * e), al = *(const LAS f32x4*)(Ap + 4 * e), gl = *(const LAS f32x4*)(Gp + 4 * e);
              const f32x4 r4 = cr[e] + mur * (pr[e] - cr[e]), k4 = ck[e] + muk * (pk[e] - ck[e]), v4 = cv[e] + muv * (pv3[e] - cv[e]);
#pragma unroll
              for (int j = 0; j < 4; ++j) { const int i = 4 * e + j;
                  xr[i] = r4[j]; xk[i] = k4[j]; xv[i] = v4[j];
                  lw2[i] = -0.6065306597126334f * LOG2E * sigmoidf_(w0[j] + wl[j]); dec[i] = __builtin_amdgcn_exp2f(lw2[i]);
                  aa[i] = sigmoidf_(a0[j] + al[j]); gg[i] = gl[j];
                  kkr[i] = xk[i] * k_k[j]; n2 += kkr[i] * kkr[i];
                  kp[i] = xk[i] * (1.0f + (aa[i] - 1.0f) * k_a[j]);
                  bon += xr[i] * kp[i] * r_k[j]; } }
          n2 = qsum8(n2); bon = qsum8(bon);
          const float inv = 1.0f / fmaxf(sqrtf(n2), 1e-12f);
          float lgv[8], eev[8], bbv[8];
          { const f32x4 lw0 = *(const LAS f32x4*)(cst + 8 * 64), lw1 = *(const LAS f32x4*)(cst + 8 * 64 + 4), lb0 = *(const LAS f32x4*)(cst + 9 * 64), lb1 = *(const LAS f32x4*)(cst + 9 * 64 + 4);
#pragma unroll
            for (int i = 0; i < 8; ++i) { kkr[i] *= inv; bbv[i] = kkr[i] * aa[i]; const float lw = i < 4 ? lw0[i & 3] : lw1[i & 3], lb = i < 4 ? lb0[i & 3] : lb1[i & 3]; lgv[i] = lw * gg[i]; eev[i] = (lb + bon * xv[i]) * gg[i]; } }
#define PK8(a) (v4u){pk2(a[0], a[1]), pk2(a[2], a[3]), pk2(a[4], a[5]), pk2(a[6], a[7])}
          if (valid3) { const size_t o = (size_t)m3 * RWW + hc0;
              *(GAS v4u*)((bf16*)(ws + WS_LG) + o) = PK8(lgv); *(GAS v4u*)((bf16*)(ws + WS_EE) + o) = PK8(eev); }
          if (m0 >= MP) {
              if (valid3) { float* dv = (float*)(ws + WS_DEC) + (size_t)(m3 - MP) * RWW + hc0;
#define ST8(arr, a) { *(GAS f32x4*)(dv + (size_t)(arr) * NDEC * RWW) = (f32x4){a[0], a[1], a[2], a[3]}; *(GAS f32x4*)(dv + (size_t)(arr) * NDEC * RWW + 4) = (f32x4){a[4], a[5], a[6], a[7]}; }
                  ST8(0, kkr) ST8(1, dec) ST8(2, bbv) ST8(3, kp) ST8(4, xr) ST8(5, xv)
#undef ST8
              }
          } else {
              *(LAS f32x4*)(lds + LW_OFF + (tok3 * 64 + 8 * cq) * 4) = (f32x4){lw2[0], lw2[1], lw2[2], lw2[3]}; *(LAS f32x4*)(lds + LW_OFF + (tok3 * 64 + 8 * cq) * 4 + 16) = (f32x4){lw2[4], lw2[5], lw2[6], lw2[7]};
              __syncthreads();
              const int cch = tok3 >> 4, t_ = tok3 & 15;
              float Lall[8], Lt[8];
#pragma unroll
              for (int i = 0; i < 8; ++i) { Lall[i] = 0.f; Lt[i] = 0.f; }
#pragma unroll
              for (int s_ = 0; s_ < 16; ++s_) { const LAS float* rp = (const LAS float*)(lds + LW_OFF + ((16 * cch + s_) * 64 + 8 * cq) * 4); const f32x4 a_ = *(const LAS f32x4*)rp, b_ = *(const LAS f32x4*)(rp + 4);
                  const bool in_ = s_ <= t_;
#pragma unroll
                  for (int i = 0; i < 4; ++i) { Lall[i] += a_[i]; Lall[4 + i] += b_[i]; Lt[i] += in_ ? a_[i] : 0.f; Lt[4 + i] += in_ ? b_[i] : 0.f; } }
              unsigned char* blk = chunk_block(ws, ((m0 >> 11) * RWH + h) * NCHUNK + ((m0 & (SEQ - 1)) >> 4) + cch);
              float ah[8], rh[8], bh[8], kh[8], bg[8], kg[8], gcv[8];
#pragma unroll
              for (int i = 0; i < 8; ++i) { const float gt = __builtin_amdgcn_exp2f(Lt[i]), gp = __builtin_amdgcn_exp2f(Lt[i] - lw2[i]), ig = __builtin_amdgcn_exp2f(-Lt[i]), gr = __builtin_amdgcn_exp2f(Lall[i] - Lt[i]);
                  ah[i] = gp * kkr[i]; rh[i] = gt * xr[i]; bh[i] = bbv[i] * ig; kh[i] = kp[i] * ig; bg[i] = bbv[i] * gr; kg[i] = kp[i] * gr; gcv[i] = __builtin_amdgcn_exp2f(Lall[i]); }
              if (t_ == 15) { *(GAS f32x4*)(blk + CB_GC + 32 * cq) = (f32x4){gcv[0], gcv[1], gcv[2], gcv[3]}; *(GAS f32x4*)(blk + CB_GC + 32 * cq + 16) = (f32x4){gcv[4], gcv[5], gcv[6], gcv[7]}; }
              { LAS unsigned char* sc = lds + CS2_OFF + cch * 16384;
                const int ks_ = cq >> 2, qa = 2 * (cq & 1), e0 = 4 * ((cq & 3) >> 1);
                const int a0_ = ((ks_ * 64 + qa * 16 + t_) * 8 + e0) * 2, a1_ = a0_ + 16 * 16;
#define W8(off, a) { *(LAS unsigned long long*)(sc + (off) + a0_) = (unsigned long long)cvtpk_c(a[0], a[1]) | ((unsigned long long)cvtpk_c(a[2], a[3]) << 32); \
                     *(LAS unsigned long long*)(sc + (off) + a1_) = (unsigned long long)cvtpk_c(a[4], a[5]) | ((unsigned long long)cvtpk_c(a[6], a[7]) << 32); }
                W8(SC_FA, ah) W8(SC_FR, rh) W8(SC_FBH, bh) W8(SC_FKH, kh)
#undef W8
#pragma unroll
                for (int i = 0; i < 8; ++i) { const int j_ = 8 * cq + i, off = (((j_ >> 4) * 64 + (t_ >> 2) * 16 + (j_ & 15)) * 4 + (t_ & 3)) * 2;
                    *(LAS unsigned short*)(sc + SC_FBG + off) = (unsigned short)cvtpk_c(bg[i], 0.f); *(LAS unsigned short*)(sc + SC_FKG + off) = (unsigned short)cvtpk_c(kg[i], 0.f);
                    *(LAS unsigned short*)(sc + SC_FV + off) = (unsigned short)cvtpk_c(xv[i], 0.f); } }
              __syncthreads();
              { unsigned char* blkw = chunk_block(ws, ((m0 >> 11) * RWH + h) * NCHUNK + ((m0 & (SEQ - 1)) >> 4) + (wave & 3));
                if (wave < 4) chunk_mm(lds, wave, blkw, lane); else chunk_copy(lds, wave - 4, blkw, lane); }
              __syncthreads();
          }
#undef PK8
        }
    }
}

constexpr int AK_PITCH = 144, AV_PITCH = 592, AP_PITCH = 336;
constexpr int AK_OFF = 0, AV_OFF = 272 * AK_PITCH  , AP_OFF = AV_OFF + 64 * AV_PITCH  , AB_OFF = AP_OFF + 8 * 16 * AP_PITCH  ;
static_assert(AB_OFF + 129 * 4 * 4 <= RING_BYTES, "attention LDS");
__device__ __forceinline__ void attn_unit(Frame& F, const Args& A, int b, int blk, int hk) {
    const int tid = F.tid, lane = F.lane, wave = F.wave;
    unsigned char* ws = F.ws; LAS unsigned char* lds = F.lds;
    const bf16* QB = (const bf16*)(ws + WS_QB); const bf16* KB = (const bf16*)(ws + WS_KB); const bf16* VB = (const bf16*)(ws + WS_VB); bf16* MX = (bf16*)(ws + WS_XB);
    const int mq0 = b * SEQ + blk * 128, mk0 = mq0 - 128;
    for (int i = tid; i < 16 * AK_PITCH / 4; i += NWAVES * 64) ((LAS unsigned*)(lds + AK_OFF + 256 * AK_PITCH))[i] = 0u;
    for (int i = tid; i < 64 * 16; i += NWAVES * 64) ((LAS unsigned*)(lds + AV_OFF + (i >> 4) * AV_PITCH + 512))[i & 15] = 0u;
#pragma unroll
    for (int it = 0; it < 4; ++it) { const int idx = it * 512 + tid, row = idx >> 3, ch = idx & 7;
        v4u kv = (v4u){0u, 0u, 0u, 0u}, vv = kv;
        if (blk > 0 || row >= 128) { kv = *(const GAS v4u*)(KB + (size_t)(mk0 + row) * KVW + hk * 64 + ch * 8); vv = *(const GAS v4u*)(VB + (size_t)(mk0 + row) * KVW + hk * 64 + ch * 8); }
        *(LAS v4u*)(lds + AK_OFF + row * AK_PITCH + ch * 16) = kv;
        LAS unsigned short* vt = (LAS unsigned short*)(lds + AV_OFF + (8 * ch) * AV_PITCH + row * 2);
        vt[0 * (AV_PITCH / 2)] = (unsigned short)(vv.x & 0xffffu); vt[1 * (AV_PITCH / 2)] = (unsigned short)(vv.x >> 16);
        vt[2 * (AV_PITCH / 2)] = (unsigned short)(vv.y & 0xffffu); vt[3 * (AV_PITCH / 2)] = (unsigned short)(vv.y >> 16);
        vt[4 * (AV_PITCH / 2)] = (unsigned short)(vv.z & 0xffffu); vt[5 * (AV_PITCH / 2)] = (unsigned short)(vv.z >> 16);
        vt[6 * (AV_PITCH / 2)] = (unsigned short)(vv.w & 0xffffu); vt[7 * (AV_PITCH / 2)] = (unsigned short)(vv.w >> 16); }
    { const float* bt = (const float*)(ws + WS_BIAS); LAS float* bl = (LAS float*)(lds + AB_OFF);
      for (int i = tid; i < 129 * 4; i += NWAVES * 64) bl[i] = bt[(i >> 2) * NQH + 4 * hk + (i & 3)]; }
    __syncthreads();
    const int g = wave >> 1, half = wave & 1, head = 4 * hk + g, ln = lane & 15, q4 = lane >> 4;
    const float sink2 = A.in[13][head] * LOG2E;
    const LAS float* bl = (const LAS float*)(lds + AB_OFF);
    LAS unsigned char* Pw = lds + AP_OFF + wave * (16 * AP_PITCH);
    bf16x8 qfa[4][2];
#pragma unroll
    for (int rb = 0; rb < 4; ++rb)
#pragma unroll
        for (int ks = 0; ks < 2; ++ks) qfa[rb][ks] = *(const GAS bf16x8*)(QB + (size_t)(mq0 + 64 * half + 16 * rb + ln) * ATTW + head * 64 + 32 * ks + 8 * q4);
#pragma unroll
    for (int rb = 0; rb < 4; ++rb) {
        const int i0 = 64 * half + 16 * rb, kt0 = i0 >> 4;
        bf16x8 qf[2]; qf[0] = qfa[rb][0]; qf[1] = qfa[rb][1];
        f32x4 s[10];
#pragma unroll
        for (int j = 0; j < 10; ++j) { f32x4 acc = (f32x4){0.f, 0.f, 0.f, 0.f};
#pragma unroll
            for (int ks = 0; ks < 2; ++ks) { const bf16x8 kf = *(const LAS bf16x8*)(lds + AK_OFF + (16 * (kt0 + j) + ln) * AK_PITCH + (32 * ks + 8 * q4) * 2);
                acc = __builtin_amdgcn_mfma_f32_16x16x32_bf16(qf[ks], kf, acc, 0, 0, 0); }
            s[j] = acc; }
        float mx[4] = {-INFINITY, -INFINITY, -INFINITY, -INFINITY};
#pragma unroll
        for (int j = 0; j < 10; ++j) { const int kj = 16 * (kt0 + j) + ln;
#pragma unroll
            for (int r = 0; r < 4; ++r) { const int dist = 128 + i0 + 4 * q4 + r - kj; const bool ok = dist >= 0 && dist <= 128 && (blk > 0 || kj >= 128);
                const int dc = dist < 0 ? 0 : (dist > 128 ? 128 : dist);
                const float v = ok ? s[j][r] + bl[dc * 4 + g] : -INFINITY; s[j][r] = v; mx[r] = fmaxf(mx[r], v); } }
        float l[4];
#pragma unroll
        for (int r = 0; r < 4; ++r) { float m_ = mx[r]; m_ = fmaxf(m_, __shfl_xor(m_, 1)); m_ = fmaxf(m_, __shfl_xor(m_, 2)); m_ = fmaxf(m_, __shfl_xor(m_, 4)); m_ = fmaxf(m_, __shfl_xor(m_, 8));
            mx[r] = fmaxf(m_, sink2); l[r] = 0.f; }
#pragma unroll
        for (int j = 0; j < 10; ++j)
#pragma unroll
            for (int r = 0; r < 4; ++r) { const float p = __builtin_amdgcn_exp2f(s[j][r] - mx[r]); l[r] += p;
                *(LAS unsigned short*)(Pw + (4 * q4 + r) * AP_PITCH + (16 * j + ln) * 2) = f2bfs(p); }
#pragma unroll
        for (int r = 0; r < 4; ++r) { float t = l[r]; t += __shfl_xor(t, 1); t += __shfl_xor(t, 2); t += __shfl_xor(t, 4); t += __shfl_xor(t, 8);
            l[r] = __builtin_amdgcn_rcpf(t + __builtin_amdgcn_exp2f(sink2 - mx[r])); }
        f32x4 o[4];
#pragma unroll
        for (int dt = 0; dt < 4; ++dt) o[dt] = (f32x4){0.f, 0.f, 0.f, 0.f};
#pragma unroll
        for (int st = 0; st < 5; ++st) { const bf16x8 pf = *(const LAS bf16x8*)(Pw + ln * AP_PITCH + (32 * st + 8 * q4) * 2);
#pragma unroll
            for (int dt = 0; dt < 4; ++dt) { const bf16x8 vf = *(const LAS bf16x8*)(lds + AV_OFF + (16 * dt + ln) * AV_PITCH + (16 * kt0 + 32 * st + 8 * q4) * 2);
                o[dt] = __builtin_amdgcn_mfma_f32_16x16x32_bf16(pf, vf, o[dt], 0, 0, 0); } }
#pragma unroll
        for (int dt = 0; dt < 4; ++dt)
#pragma unroll
            for (int r = 0; r < 4; ++r) *(LAS unsigned short*)(Pw + (4 * q4 + r) * AP_PITCH + (16 * dt + ln) * 2) = f2bfs(o[dt][r] * l[r]);
#pragma unroll
        for (int i = 0; i < 2; ++i) { const int qrow = 8 * i + (lane >> 3), ch = lane & 7;
            const v4u ov = *(const LAS v4u*)(Pw + qrow * AP_PITCH + ch * 16);
            *(GAS v4u*)(MX + (size_t)(mq0 + i0 + qrow) * DM + head * 64 + ch * 8) = ov; }
    }
    __syncthreads();
}

__device__ __forceinline__ void dec_attn_unit(Frame& F, const Args& A, int du) {
    const int lane = F.lane, wave = F.wave; unsigned char* ws = F.ws;
    const int idx = du * 8 + wave, b = idx >> 4, head = idx & 15, hk = head >> 2, m = MP + b;
    LAS float* qs = (LAS float*)(F.lds + wave * 1024); LAS float* ps = qs + 64;
    const bf16* QB = (const bf16*)(ws + WS_QB); bf16* MX = (bf16*)(ws + WS_XB);
    const float* bt = (const float*)(ws + WS_BIAS);
    const float sink2 = A.in[13][head] * LOG2E;
    const float qv = bf2f(QB[(size_t)m * ATTW + head * 64 + lane]);
    qs[lane] = qv;
    LDS_WAIT(); asm volatile("" ::: "memory");
    float sc[2];
#pragma unroll
    for (int pi = 0; pi < 2; ++pi) { const int pos = lane + 64 * pi; const float* kr = A.in[2] + ((size_t)(b * WIN + pos) * NKVH + hk) * HD; float d = 0.f;
#pragma unroll
        for (int j = 0; j < 16; ++j) { const f32x4 k4 = *(const f32x4*)(kr + 4 * j); const f32x4 q4v = *(const LAS f32x4*)(qs + 4 * j); d += (k4.x * q4v.x + k4.y * q4v.y) + (k4.z * q4v.z + k4.w * q4v.w); }
        sc[pi] = d + bt[(WIN - pos) * NQH + head]; }
    const float* kn = F.out + O_KS + ((size_t)b * WIN + (WIN - 1)) * KVW + hk * HD; const float* vn = F.out + O_VS + ((size_t)b * WIN + (WIN - 1)) * KVW + hk * HD;
    const float snew = wave_sum(qv * kn[lane]) + bt[head];
    const float mx = fmaxf(fmaxf(wave_max(fmaxf(sc[0], sc[1])), snew), sink2);
    const float p0 = __builtin_amdgcn_exp2f(sc[0] - mx), p1 = __builtin_amdgcn_exp2f(sc[1] - mx), pn = __builtin_amdgcn_exp2f(snew - mx);
    const float linv = __builtin_amdgcn_rcpf(wave_sum(p0 + p1) + pn + __builtin_amdgcn_exp2f(sink2 - mx));
    ps[lane] = p0; ps[lane + 64] = p1;
    LDS_WAIT(); asm volatile("" ::: "memory");
    const float* vr = A.in[3] + ((size_t)(b * WIN) * NKVH + hk) * HD + lane; float o = pn * vn[lane];
#pragma unroll 8
    for (int pos = 0; pos < WIN; ++pos) o += ps[pos] * vr[(size_t)pos * NKVH * HD];
    MX[(size_t)m * DM + head * 64 + lane] = f2bfs(o * linv);
    LDS_WAIT(); asm volatile("" ::: "memory");
}

constexpr int SC_T = 32, SC_REC = 1344  , SC_BUF = SC_T * SC_REC  ;
struct ScanRegs { v4u kk, bb, kp, rr, vv; f32x4 d0, d1; };
__device__ __forceinline__ void scan_load(ScanRegs& R, const unsigned char* ws, int m, int h, int rq, int part) {
    const size_t o = (size_t)m * RWW + 64 * h + 8 * part;
    R.kk = *(const GAS v4u*)((const bf16*)(ws + WS_KK) + o); R.bb = *(const GAS v4u*)((const bf16*)(ws + WS_BB) + o);
    R.kp = *(const GAS v4u*)((const bf16*)(ws + WS_KP) + o); R.rr = *(const GAS v4u*)((const bf16*)(ws + WS_RR) + o);
    R.d0 = *(const GAS f32x4*)((const float*)(ws + WS_DD) + o); R.d1 = *(const GAS f32x4*)((const float*)(ws + WS_DD) + o + 4);
    R.vv = (v4u){0u, 0u, 0u, 0u};
    if (part < 2) R.vv = *(const GAS v4u*)((const bf16*)(ws + WS_VV) + (size_t)m * RWW + 64 * h + 16 * rq + 8 * part);
}
__device__ __forceinline__ void st8(LAS unsigned char* p, v4u u) {
    *(LAS f32x4*)p = (f32x4){__builtin_bit_cast(float, u.x << 16), __builtin_bit_cast(float, u.x & 0xffff0000u), __builtin_bit_cast(float, u.y << 16), __builtin_bit_cast(float, u.y & 0xffff0000u)};
    *(LAS f32x4*)(p + 16) = (f32x4){__builtin_bit_cast(float, u.z << 16), __builtin_bit_cast(float, u.z & 0xffff0000u), __builtin_bit_cast(float, u.w << 16), __builtin_bit_cast(float, u.w & 0xffff0000u)};
}
__device__ __forceinline__ void scan_store(const ScanRegs& R, LAS unsigned char* rec, int part) {
    st8(rec + 0 + 32 * part, R.kk); *(LAS f32x4*)(rec + 256 + 32 * part) = R.d0; *(LAS f32x4*)(rec + 256 + 32 * part + 16) = R.d1;
    st8(rec + 512 + 32 * part, R.bb); st8(rec + 768 + 32 * part, R.kp); st8(rec + 1024 + 32 * part, R.rr);
    if (part < 2) st8(rec + 1280 + 32 * part, R.vv);
}
constexpr int SC_YOFF = 2 * SC_BUF, SC_YBUF = SC_T * 16 * 4 * 4  ;
static_assert(SC_YOFF + 2 * SC_YBUF <= RING_BYTES, "scan LDS");
struct ScanVec { f32x2 kk0, kk1, d0, d1, b0, b1, k0, k1, r0, r1; float v; };
__device__ __forceinline__ void scan_ld(ScanVec& x, const LAS unsigned char* base, const LAS unsigned char* vb, int t) {
    const f32x4 kk = *(const LAS f32x4*)(base + t * SC_REC), dd = *(const LAS f32x4*)(base + t * SC_REC + 256), bb = *(const LAS f32x4*)(base + t * SC_REC + 512),
                kp = *(const LAS f32x4*)(base + t * SC_REC + 768), rr = *(const LAS f32x4*)(base + t * SC_REC + 1024);
    x.kk0 = (f32x2){kk.x, kk.y}; x.kk1 = (f32x2){kk.z, kk.w}; x.d0 = (f32x2){dd.x, dd.y}; x.d1 = (f32x2){dd.z, dd.w}; x.b0 = (f32x2){bb.x, bb.y}; x.b1 = (f32x2){bb.z, bb.w};
    x.k0 = (f32x2){kp.x, kp.y}; x.k1 = (f32x2){kp.z, kp.w}; x.r0 = (f32x2){rr.x, rr.y}; x.r1 = (f32x2){rr.z, rr.w};
    x.v = *(const LAS float*)(vb + t * SC_REC);
}
__device__ __forceinline__ void scan_yflush(const LAS unsigned char* yb, float* YS, int ptid) {
#pragma unroll
    for (int i = 0; i < 2; ++i) { const int o = ptid + 256 * i, t = o >> 4, r = o & 15; const f32x4 q = *(const LAS f32x4*)(yb + o * 16);
        YS[(size_t)t * RWW + r] = (q.x + q.y) + (q.z + q.w); }
}
__device__ __forceinline__ void scan_unit(Frame& F, int c) {
    const int b = c >> 6, h = (c >> 2) & 15, rq = c & 3, lane = F.lane, wave = F.wave;
    unsigned char* ws = F.ws; LAS unsigned char* lds = F.lds;
    const int mb = b * SEQ; constexpr int NCH = SEQ / SC_T;
    if (wave >= 4) {
        const int ptid = F.tid - 256, tok = ptid >> 3, part = ptid & 7;
        float* YS = (float*)(ws + WS_ACT) + (size_t)mb * RWW + 64 * h + 16 * rq;
        ScanRegs cur, nxt;
        scan_load(cur, ws, mb + tok, h, rq, part);
        scan_load(nxt, ws, mb + SC_T + tok, h, rq, part);
        scan_store(cur, lds + tok * SC_REC, part);
        __syncthreads();
        for (int ch = 0; ch < NCH; ++ch) {
            cur = nxt;
            if (ch + 2 < NCH) scan_load(nxt, ws, mb + (ch + 2) * SC_T + tok, h, rq, part);
            if (ch + 1 < NCH) scan_store(cur, lds + ((ch + 1) & 1) * SC_BUF + tok * SC_REC, part);
            if (ch > 0) scan_yflush(lds + SC_YOFF + ((ch - 1) & 1) * SC_YBUF, YS + (size_t)(ch - 1) * SC_T * RWW, ptid);
            __syncthreads();
        }
        scan_yflush(lds + SC_YOFF + ((NCH - 1) & 1) * SC_YBUF, YS + (size_t)(NCH - 1) * SC_T * RWW, ptid);
    } else {
        const int rl = 4 * wave + (lane >> 4), p = lane & 15, row = 16 * rq + rl;
        f32x2 S0 = (f32x2){0.f, 0.f}, S1 = S0;
        __builtin_amdgcn_s_setprio(2);
        __syncthreads();
        for (int ch = 0; ch < NCH; ++ch) {
            const LAS unsigned char* base = lds + (ch & 1) * SC_BUF + p * 16;
            const LAS unsigned char* vb = lds + (ch & 1) * SC_BUF + 1280 + rl * 4;
            LAS unsigned char* yb = lds + SC_YOFF + (ch & 1) * SC_YBUF + (rl * 4 + (p & 3)) * 4;
            ScanVec cur; scan_ld(cur, base, vb, 0);
#pragma unroll
            for (int t = 0; t < SC_T; ++t) {
                ScanVec nxt; scan_ld(nxt, base, vb, t + 1 < SC_T ? t + 1 : t);
                f32x2 a = S0 * cur.kk0; a = S1 * cur.kk1 + a;
                const float sa = -allsum16(a.x + a.y);
                const f32x2 sa2 = (f32x2){sa, sa}, v2 = (f32x2){cur.v, cur.v};
                f32x2 u0 = cur.b0 * sa2, u1 = cur.b1 * sa2;
                u0 = S0 * cur.d0 + u0; u1 = S1 * cur.d1 + u1;
                S0 = cur.k0 * v2 + u0; S1 = cur.k1 * v2 + u1;
                f32x2 q = S0 * cur.r0; q = S1 * cur.r1 + q;
                float y = q.x + q.y; y += dpp_f<0x128>(y); y += dpp_f<0x124>(y);
                *(LAS float*)(yb + t * 256) = y;
                cur = nxt;
            }
            __syncthreads();
        }
        __builtin_amdgcn_s_setprio(0);
        *(f32x4*)(F.out + O_WP + ((size_t)(b * RWH + h) * HD + row) * HD + 4 * p) = (f32x4){S0.x, S0.y, S1.x, S1.y};
    }
}
__device__ __forceinline__ void dec_rwkv_unit(Frame& F, const Args& A, int du) {
    const int lane = F.lane, wave = F.wave; unsigned char* ws = F.ws;
    const int idx = du * 8 + wave, b = idx >> 4, h = idx & 15, m = MP + b;
    LAS float* vec = (LAS float*)(F.lds + wave * 1280);
    const size_t o = (size_t)m * RWW + 64 * h + lane;
    const float* dv = (const float*)(ws + WS_DEC) + (size_t)b * RWW + 64 * h + lane;
    vec[lane] = dv[0]; vec[64 + lane] = dv[(size_t)1 * NDEC * RWW]; vec[128 + lane] = dv[(size_t)2 * NDEC * RWW];
    vec[192 + lane] = dv[(size_t)3 * NDEC * RWW]; vec[256 + lane] = dv[(size_t)4 * NDEC * RWW];
    const float vi = dv[(size_t)5 * NDEC * RWW];
    const size_t so = ((size_t)(b * RWH + h) * HD + lane) * HD;
    const float* Sp = A.in[4] + so; f32x4 S[16];
#pragma unroll
    for (int j = 0; j < 16; ++j) S[j] = *(const f32x4*)(Sp + 4 * j);
    LDS_WAIT(); asm volatile("" ::: "memory");
    float sa = 0.f;
#pragma unroll
    for (int j = 0; j < 16; ++j) { const f32x4 kk = *(const LAS f32x4*)(vec + 4 * j); sa += (S[j].x * kk.x + S[j].y * kk.y) + (S[j].z * kk.z + S[j].w * kk.w); asm volatile("" ::: "memory"); }
    sa = -sa; float y = 0.f; float* So = F.out + O_WS + so;
#pragma unroll
    for (int j = 0; j < 16; ++j) { const f32x4 dd = *(const LAS f32x4*)(vec + 64 + 4 * j), bb = *(const LAS f32x4*)(vec + 128 + 4 * j), kp = *(const LAS f32x4*)(vec + 192 + 4 * j), rr = *(const LAS f32x4*)(vec + 256 + 4 * j);
        S[j] = S[j] * dd + bb * sa + kp * vi; y += (S[j].x * rr.x + S[j].y * rr.y) + (S[j].z * rr.z + S[j].w * rr.w);
        *(f32x4*)(So + 4 * j) = S[j]; asm volatile("" ::: "memory"); }
    ((float*)(ws + WS_ACT))[o] = y;
    LDS_WAIT(); asm volatile("" ::: "memory");
}


constexpr int SC2_NS = 8, SC2_D = SC2_NS - 1;
static_assert(SC2_NS * CB_STRIDE <= RING_BYTES, "scan ring");
__device__ __forceinline__ void scan2_unit(Frame& F, int c) {
    const int b = c >> 4, h = c & 15, lane = F.lane, wave = F.wave;
    unsigned char* ws = F.ws; LAS unsigned char* lds = F.lds;
    const int mb = b * SEQ, g0 = (b * RWH + h) * NCHUNK;
#define SC2_BAR() do { asm volatile("" ::: "memory"); __builtin_amdgcn_s_barrier(); asm volatile("" ::: "memory"); } while (0)
    if (wave >= 4) {
        const int lw = wave - 4;
#define SC2_ISSUE(cc) do { const unsigned char* blk_ = chunk_block(ws, g0 + (cc)); LAS unsigned char* sl_ = lds + ((cc) & (SC2_NS - 1)) * CB_STRIDE; \
            for (int p_ = lw; p_ < 13; p_ += 4) __builtin_amdgcn_global_load_lds((const unsigned*)(blk_ + p_ * 1024 + lane * 16), (LAS unsigned*)(sl_ + p_ * 1024), 16, 0, 0); } while (0)
#define SC2_WAIT() do { if (lw == 0) asm volatile("s_waitcnt vmcnt(20)" ::: "memory"); else asm volatile("s_waitcnt vmcnt(15)" ::: "memory"); } while (0)
        for (int cc = 0; cc < SC2_D; ++cc) SC2_ISSUE(cc);
        SC2_WAIT(); SC2_BAR();
        for (int cc = 0; cc < NCHUNK; ++cc) {
            if (cc + SC2_D < NCHUNK) { SC2_ISSUE(cc + SC2_D); SC2_WAIT(); } else asm volatile("s_waitcnt vmcnt(0)" ::: "memory");
            SC2_BAR();
        }
#undef SC2_ISSUE
#undef SC2_WAIT
    } else {
        const int it = wave, x = lane & 15, q = lane >> 4;
        f32x4 S[4];
#pragma unroll
        for (int jt = 0; jt < 4; ++jt) S[jt] = (f32x4){0.f, 0.f, 0.f, 0.f};
        float* YS = (float*)(ws + WS_ACT) + (size_t)mb * RWW + 64 * h + 16 * it + x;
        bf16x8 fa[2], fr[2]; s16x4 fnk, ft, fmb, fmk, fv, fbg[4], fkg[4]; f32x4 gc[4];
#define SC2_LOAD(cc) do { const LAS unsigned char* sl = lds + ((cc) & (SC2_NS - 1)) * CB_STRIDE; \
            _Pragma("unroll") for (int k2 = 0; k2 < 2; ++k2) { fa[k2] = *(const LAS bf16x8*)(sl + CB_FA + (k2 * 64 + lane) * 16); fr[k2] = *(const LAS bf16x8*)(sl + CB_FR + (k2 * 64 + lane) * 16); } \
            fnk = *(const LAS s16x4*)(sl + CB_FNK + lane * 8); ft = *(const LAS s16x4*)(sl + CB_FT + lane * 8); fmb = *(const LAS s16x4*)(sl + CB_FMB + lane * 8); fmk = *(const LAS s16x4*)(sl + CB_FMK + lane * 8); \
            fv = *(const LAS s16x4*)(sl + CB_FV + (it * 64 + lane) * 8); \
            _Pragma("unroll") for (int jt = 0; jt < 4; ++jt) { fbg[jt] = *(const LAS s16x4*)(sl + CB_FBG + (jt * 64 + lane) * 8); fkg[jt] = *(const LAS s16x4*)(sl + CB_FKG + (jt * 64 + lane) * 8); \
                gc[jt] = *(const LAS f32x4*)(sl + CB_GC + (16 * jt + 4 * q) * 4); } } while (0)
        SC2_BAR();
        SC2_LOAD(0);
        for (int cc = 0; cc < NCHUNK; ++cc) {
            bf16x8 sb[2];
#pragma unroll
            for (int k2 = 0; k2 < 2; ++k2) { const unsigned long long lo = pack4bf(S[2 * k2]), hi = pack4bf(S[2 * k2 + 1]);
                v4u w_; w_.x = (unsigned)lo; w_.y = (unsigned)(lo >> 32); w_.z = (unsigned)hi; w_.w = (unsigned)(hi >> 32); sb[k2] = __builtin_bit_cast(bf16x8, w_); }
            f32x4 X = (f32x4){0.f, 0.f, 0.f, 0.f};
            X = __builtin_amdgcn_mfma_f32_16x16x32_bf16(fa[0], sb[0], X, 0, 0, 0); X = __builtin_amdgcn_mfma_f32_16x16x32_bf16(fa[1], sb[1], X, 0, 0, 0);
            X = __builtin_amdgcn_mfma_f32_16x16x16bf16_1k(fnk, fv, X, 0, 0, 0);
            f32x4 Y = (f32x4){0.f, 0.f, 0.f, 0.f};
            Y = __builtin_amdgcn_mfma_f32_16x16x32_bf16(fr[0], sb[0], Y, 0, 0, 0); Y = __builtin_amdgcn_mfma_f32_16x16x32_bf16(fr[1], sb[1], Y, 0, 0, 0);
            Y = __builtin_amdgcn_mfma_f32_16x16x16bf16_1k(fmk, fv, Y, 0, 0, 0);
            f32x4 Sn[4];
#pragma unroll
            for (int jt = 0; jt < 4; ++jt) Sn[jt] = __builtin_amdgcn_mfma_f32_16x16x16bf16_1k(fkg[jt], fv, S[jt] * gc[jt], 0, 0, 0);
            const s16x4 xb = __builtin_bit_cast(s16x4, pack4bf(X));
            const f32x4 U = __builtin_amdgcn_mfma_f32_16x16x16bf16_1k(ft, xb, (f32x4){0.f, 0.f, 0.f, 0.f}, 0, 0, 0);
            const s16x4 ub = __builtin_bit_cast(s16x4, pack4bf(U));
            Y = __builtin_amdgcn_mfma_f32_16x16x16bf16_1k(fmb, ub, Y, 0, 0, 0);
#pragma unroll
            for (int jt = 0; jt < 4; ++jt) S[jt] = __builtin_amdgcn_mfma_f32_16x16x16bf16_1k(fbg[jt], ub, Sn[jt], 0, 0, 0);
            if (cc + 1 < NCHUNK) SC2_LOAD(cc + 1);
#pragma unroll
            for (int r = 0; r < 4; ++r) YS[(size_t)(16 * cc + 4 * q + r) * RWW] = Y[r];
            asm volatile("s_waitcnt lgkmcnt(0)" ::: "memory");
            SC2_BAR();
        }
#undef SC2_LOAD
#pragma unroll
        for (int jt = 0; jt < 4; ++jt) *(f32x4*)(F.out + O_WP + ((size_t)(b * RWH + h) * HD + 16 * it + x) * HD + 16 * jt + 4 * q) = S[jt];
    }
#undef SC2_BAR
}

constexpr int SK_S = 4;
__device__ __forceinline__ void skinny_units(Frame& F, const bf16* Arows, int lda, const bf16* Bt, int K, unsigned* cnt, float* slabs,
                                             const float* xi_s, float* xo_s, bf16* XBd, float* ssq, float alpha) {
    const int tid = F.tid, lane = F.lane, wave = F.wave, ln = lane & 15, q4 = lane >> 4, ksteps = K / 32;
    LAS unsigned char* lds = F.lds;
    for (int u = blockIdx.x; u < 32 * SK_S; u += F.G) {
        const int nb = u & 31, sl = u >> 5, n0 = 64 * nb, ks0 = sl * ksteps / SK_S, ks1 = (sl + 1) * ksteps / SK_S;
        f32x4 acc[2][4];
#pragma unroll
        for (int mt = 0; mt < 2; ++mt)
#pragma unroll
            for (int nt = 0; nt < 4; ++nt) acc[mt][nt] = (f32x4){0.f, 0.f, 0.f, 0.f};
        const bf16* ap = Arows + (size_t)ln * lda + 8 * q4; const bf16* bp = Bt + (size_t)(n0 + ln) * K + 8 * q4;
#pragma unroll 2
        for (int ks = ks0 + wave; ks < ks1; ks += 8) { const int k = 32 * ks;
            bf16x8 a[2], b[4];
#pragma unroll
            for (int mt = 0; mt < 2; ++mt) a[mt] = *(const GAS bf16x8*)(ap + (size_t)(16 * mt) * lda + k);
#pragma unroll
            for (int nt = 0; nt < 4; ++nt) b[nt] = *(const GAS bf16x8*)(bp + (size_t)(16 * nt) * K + k);
#pragma unroll
            for (int mt = 0; mt < 2; ++mt)
#pragma unroll
                for (int nt = 0; nt < 4; ++nt) acc[mt][nt] = __builtin_amdgcn_mfma_f32_16x16x32_bf16(a[mt], b[nt], acc[mt][nt], 0, 0, 0); }
#pragma unroll
        for (int mt = 0; mt < 2; ++mt)
#pragma unroll
            for (int nt = 0; nt < 4; ++nt) *(LAS f32x4*)(lds + ((wave * 8 + mt * 4 + nt) * 64 + lane) * 16) = acc[mt][nt];
        __syncthreads();
        { const int tile = tid >> 6, l = tid & 63; f32x4 sum = (f32x4){0.f, 0.f, 0.f, 0.f};
#pragma unroll
          for (int w = 0; w < 8; ++w) sum += *(const LAS f32x4*)(lds + ((w * 8 + tile) * 64 + l) * 16);
          float* sp = slabs + (size_t)sl * 32 * DM + (size_t)(16 * (tile >> 2) + 4 * (l >> 4)) * DM + n0 + 16 * (tile & 3) + (l & 15);
          sp[0] = sum.x; sp[DM] = sum.y; sp[2 * DM] = sum.z; sp[3 * DM] = sum.w; }
        VM_WAIT(); __syncthreads();
        if (tid == 0) { __builtin_amdgcn_fence(__ATOMIC_RELEASE, "agent"); VM_WAIT();
            const unsigned t = __hip_atomic_fetch_add(cnt + nb, 1u, __ATOMIC_RELAXED, __HIP_MEMORY_SCOPE_AGENT);
            const unsigned last = (t == (unsigned)(SK_S - 1)) ? 1u : 0u;
            if (last) { __builtin_amdgcn_fence(__ATOMIC_ACQUIRE, "agent"); VM_WAIT(); }
            *(LAS unsigned*)(lds + 65536) = last; }
        __syncthreads();
        const unsigned last = *(const LAS unsigned*)(lds + 65536);
        if (last) {
            const int row = tid >> 4, c4 = (tid & 15) * 4, col = n0 + c4;
            f32x4 a4 = (f32x4){0.f, 0.f, 0.f, 0.f};
#pragma unroll
            for (int s2 = 0; s2 < SK_S; ++s2) a4 += *(const GAS f32x4*)(slabs + (size_t)s2 * 32 * DM + (size_t)row * DM + col);
            const f32x4 x0 = *(const f32x4*)(xi_s + (size_t)row * DM + col);
            const f32x4 y = x0 + a4 * alpha;
            *(f32x4*)(xo_s + (size_t)row * DM + col) = y;
            if (XBd) *(GAS unsigned long long*)(XBd + (size_t)(MP + row) * DM + col) = (unsigned long long)pk2(y.x, y.y) | ((unsigned long long)pk2(y.z, y.w) << 32);
            float sq = (y.x * y.x + y.y * y.y) + (y.z * y.z + y.w * y.w);
            sq += __shfl_xor(sq, 1); sq += __shfl_xor(sq, 2); sq += __shfl_xor(sq, 4); sq += __shfl_xor(sq, 8);
            if ((tid & 15) == 0) atomicAdd(ssq + MP + row, sq);
        }
        __syncthreads();
    }
}
__global__ void __launch_bounds__(NWAVES * 64, 2) hymba_fwd(Args args) {
    extern __shared__ __attribute__((aligned(16))) unsigned char lds_raw[];
    { const int t0_ = threadIdx.x;
      for (int u = t0_; u < (LDS_BYTES - LDSCTL_OFF) / 4; u += NWAVES * 64) ((LAS unsigned*)((LAS unsigned char*)lds_raw + LDSCTL_OFF))[u] = 0u; }
    __syncthreads();
    XcdBarrier bar; bar.bar = (unsigned*)((gu32*)(args.ws + WS_CTL) + CW_BAR); bar.x = 0; bar.st = nullptr;
    if (MK_N_LAUNCHES == 1) bar = xcd_barrier_post((unsigned*)((gu32*)(args.ws + WS_CTL) + CW_BAR), (volatile LAS unsigned*)((LAS unsigned char*)lds_raw + MISC_OFF) + 8);
    const int lo = args.ph_lo, hi = args.ph_hi;
#ifndef PH_MASK
#define PH_MASK 0x7ff
#endif
#define IN(k) (((PH_MASK >> (k)) & 1) && lo <= (k) && (k) < hi)
#define SEAM(k) do { if (IN(k) && IN((k) + 1)) xcd_barrier(bar); } while (0)
#ifndef PROBE_REP
#define PROBE_REP 0
#endif
#define NREP(k) (1 + ((PROBE_REP >> (k)) & 1))
#define PHASE_FRAME() Frame F; { int t_ = threadIdx.x; asm volatile("" : "+v"(t_)); F.lds = (LAS unsigned char*)lds_raw; F.MISC = (volatile LAS unsigned*)(F.lds + MISC_OFF); F.tid = t_; F.lane = t_ & 63; \
        F.wave = __builtin_amdgcn_readfirstlane(t_ >> 6); F.G = gridDim.x; F.out = args.out; F.ws = args.ws; F.ctl = (gu32*)(args.ws + WS_CTL); } \
    unsigned char* ws = F.ws; const int gw = blockIdx.x * NWAVES + F.wave, NGW = F.G * NWAVES; (void)gw; (void)NGW; \
    bf16* XB = (bf16*)(ws + WS_XB); bf16* ACT = (bf16*)(ws + WS_ACT); bf16* X2B = (bf16*)(ws + WS_X2B); (void)XB; (void)ACT; (void)X2B; \
    float* ssq0 = (float*)(F.ctl + CW_SSQ0); float* ssq1 = (float*)(F.ctl + CW_SSQ1); float* ssq2 = (float*)(F.ctl + CW_SSQ2); float* ssq3 = (float*)(F.ctl + CW_SSQ3); float* ssqd = (float*)(F.ctl + CW_SSQD); (void)ssqd; (void)ssq0; (void)ssq1; (void)ssq2; (void)ssq3; \
    float* yp = args.out + O_YP; float* ys = args.out + O_YS; (void)yp; (void)ys;

    if (IN(0)) for (int rep = 0; rep < NREP(0); ++rep) { PHASE_FRAME(); p0_prologue(F, args); if (rep + 1 < NREP(0)) xcd_barrier(bar); else SEAM(0); }
    if (IN(1)) for (int rep = 0; rep < NREP(1); ++rep) { PHASE_FRAME(); pg8::Gemm g{XB, (const bf16*)(ws + WS_WGU1), MPAD, 2 * DFF, DM}; pg8::StaticOrder S; S.init(MPAD, 2 * DFF, F.G, (int)blockIdx.x);
        pg8::EpiSwiglu E{ACT, ssq0};
        pg8::gemm_phase<pg8::EpiSwiglu, pg8::StaticOrder, true, true>(F.lds + RING_OFF, g, S, E);
#ifndef CV_ALL_IN_P0
        { const int nfull = S.nwg % F.G; if (rep == 0 && nfull != 0 && (int)blockIdx.x >= nfull) convert_items(F, args, CV_EARLY, CV_LATE1, (int)blockIdx.x - nfull, F.G - nfull);
          else if (rep == 0 && nfull == 0) convert_items(F, args, CV_EARLY, CV_LATE1, blockIdx.x, F.G); }
#endif
        if (rep + 1 < NREP(1)) xcd_barrier(bar); else SEAM(1); }
    if (IN(2)) for (int rep = 0; rep < NREP(2); ++rep) { PHASE_FRAME(); pg8::Gemm g{ACT, (const bf16*)(ws + WS_WD1), MP, DM, DFF}; pg8::StaticOrder S; S.init(MP, DM, F.G, (int)blockIdx.x);
        pg8::EpiResid E{args.in[0], args.in[1], yp, ys, XB, rep ? ssqd : ssq1, 0.5f};
        pg8::gemm_phase<pg8::EpiResid, pg8::StaticOrder, true, true>(F.lds + RING_OFF, g, S, E);
        skinny_units(F, ACT + (size_t)MP * DFF, DFF, (const bf16*)(ws + WS_WD1), DFF, (unsigned*)(F.ctl + CW_SKC + 64 * rep), (float*)(ws + WS_SLAB), args.in[1], ys, XB, rep ? ssqd : ssq1, 0.5f);
        if (rep + 1 < NREP(2)) xcd_barrier(bar); else SEAM(2); }
    if (IN(3)) for (int rep = 0; rep < NREP(3); ++rep) { PHASE_FRAME(); pg8::Gemm g{XB, (const bf16*)(ws + WS_WINB), MPAD, INC, DM}; pg8::StaticOrder S; S.init(MPAD, INC, F.G, (int)blockIdx.x);
        pg8::EpiWin E{ssq1, (bf16*)(ws + WS_QB), (bf16*)(ws + WS_KB), (bf16*)(ws + WS_VB), (bf16*)(ws + WS_ACT), args.out};
        pg8::gemm_phase<pg8::EpiWin, pg8::StaticOrder, true, true>(F.lds + RING_OFF, g, S, E);
#ifndef CV_ALL_IN_P0
        { const int nfull = S.nwg % F.G; if (rep == 0 && nfull != 0 && (int)blockIdx.x >= nfull) convert_items(F, args, CV_EARLY + CV_LATE1, CV_LATE2, (int)blockIdx.x - nfull, F.G - nfull);
          else if (rep == 0 && nfull == 0) convert_items(F, args, CV_EARLY + CV_LATE1, CV_LATE2, blockIdx.x, F.G); }
#endif
        if (rep + 1 < NREP(3)) xcd_barrier(bar); else SEAM(3); }
    if (IN(4)) for (int rep = 0; rep < NREP(4); ++rep) { PHASE_FRAME();
        for (int r2 = 0; r2 < 1 + ((PROBE_REP >> 12) & 1); ++r2) { __syncthreads(); prep_phase(F, args); }
        if (rep + 1 < NREP(4)) xcd_barrier(bar); else SEAM(4); }
    if (IN(5)) for (int rep = 0; rep < NREP(5); ++rep) { PHASE_FRAME();
        if ((int)blockIdx.x < NB * RWH) scan2_unit(F, blockIdx.x);
        else { const int oc = (int)blockIdx.x - NB * RWH, on = (int)F.G - NB * RWH;
            for (int r2 = 0; r2 < 1 + ((PROBE_REP >> 11) & 1); ++r2)
            for (int u = oc; u < NB * 16 * NKVH; u += on) attn_unit(F, args, u >> 6, (u >> 2) & 15, u & 3);
            __syncthreads();
            for (int u = on - 1 - oc; u < NDEC * NQH / 8; u += on) dec_attn_unit(F, args, u);
            __syncthreads();
            for (int u = on - 1 - oc; u < NDEC * RWH / 8; u += on) dec_rwkv_unit(F, args, u);
            { const int n4 = NDEC * (WIN - 1) * KVW / 4;
              for (int i = oc * (NWAVES * 64) + F.tid; i < 2 * n4; i += on * NWAVES * 64) { const int t = i >= n4, j = t ? i - n4 : i; const int bb = j / ((WIN - 1) * KVW / 4), r = j % ((WIN - 1) * KVW / 4);
                  const f32x4 v = *((const f32x4*)(args.in[2 + t] + (size_t)bb * WIN * KVW + KVW) + r);
                  *((f32x4*)(args.out + (t ? O_VS : O_KS) + (size_t)bb * WIN * KVW) + r) = v; } } }
        if (rep + 1 < NREP(5)) xcd_barrier(bar); else SEAM(5); }
    if (IN(6)) for (int rep = 0; rep < NREP(6); ++rep) { PHASE_FRAME(); const float* YS = (const float*)(ws + WS_ACT); const bf16* LG = (const bf16*)(ws + WS_LG); const bf16* EE = (const bf16*)(ws + WS_EE);
        for (int u = gw; u < MV * RWH; u += NGW) { const size_t o = (size_t)(u >> 4) * RWW + 64 * (u & 15) + F.lane;
            const float y = YS[o], mean = wave_sum(y) * (1.0f / 64.0f), dl = y - mean, var = wave_sum(dl * dl) * (1.0f / 64.0f);
            const float r = dl * __builtin_amdgcn_rsqf(var + GN_EPS) * bf2f(LG[o]) + bf2f(EE[o]);
            XB[(size_t)(u >> 4) * DM + ATTW + 64 * (u & 15) + F.lane] = f2bfs(r); }
        if (rep + 1 < NREP(6)) xcd_barrier(bar); else SEAM(6); }
    if (IN(7)) for (int rep = 0; rep < NREP(7); ++rep) { PHASE_FRAME(); pg8::Gemm g{XB, (const bf16*)(ws + WS_WOUT), MP, DM, DM}; pg8::StaticOrder S; S.init(MP, DM, F.G, (int)blockIdx.x);
        pg8::EpiResid E{yp, ys, yp, ys, rep ? nullptr : X2B, rep ? ssqd : ssq2, rep ? 0.0f : 1.0f};
        pg8::gemm_phase<pg8::EpiResid, pg8::StaticOrder, true, true>(F.lds + RING_OFF, g, S, E);
        skinny_units(F, XB + (size_t)MP * DM, DM, (const bf16*)(ws + WS_WOUT), DM, (unsigned*)(F.ctl + CW_SKC + 128 + 64 * rep), (float*)(ws + WS_SLAB), ys, ys, rep ? nullptr : X2B, rep ? ssqd : ssq2, rep ? 0.0f : 1.0f);
        if (rep + 1 < NREP(7)) xcd_barrier(bar); else SEAM(7); }
    if (IN(8)) for (int rep = 0; rep < NREP(8); ++rep) { PHASE_FRAME(); pg8::Gemm g{X2B, (const bf16*)(ws + WS_WGU2), MPAD, 2 * DFF, DM}; pg8::StaticOrder S; S.init(MPAD, 2 * DFF, F.G, (int)blockIdx.x);
        pg8::EpiSwiglu E{ACT, ssq2};
        pg8::gemm_phase<pg8::EpiSwiglu, pg8::StaticOrder, true, true>(F.lds + RING_OFF, g, S, E); if (rep + 1 < NREP(8)) xcd_barrier(bar); else SEAM(8); }
    if (IN(9)) for (int rep = 0; rep < NREP(9); ++rep) { PHASE_FRAME(); pg8::Gemm g{ACT, (const bf16*)(ws + WS_WD2), MP, DM, DFF}; pg8::StaticOrder S; S.init(MP, DM, F.G, (int)blockIdx.x);
        pg8::EpiResid E{yp, ys, yp, ys, nullptr, rep ? ssqd : ssq3, rep ? 0.0f : 0.5f};
        pg8::gemm_phase<pg8::EpiResid, pg8::StaticOrder, true, true>(F.lds + RING_OFF, g, S, E);
        skinny_units(F, ACT + (size_t)MP * DFF, DFF, (const bf16*)(ws + WS_WD2), DFF, (unsigned*)(F.ctl + CW_SKC + 256 + 64 * rep), (float*)(ws + WS_SLAB), ys, ys, nullptr, rep ? ssqd : ssq3, rep ? 0.0f : 0.5f);
        if (rep + 1 < NREP(9)) xcd_barrier(bar); else SEAM(9); }
    if (IN(10)) for (int rep = 0; rep < NREP(10); ++rep) { PHASE_FRAME(); const float* fn = args.in[30];
        for (int m = gw; m < MV; m += NGW) { float* xr = m < MP ? yp + (size_t)m * DM : ys + (size_t)(m - MP) * DM;
            const float s = rep ? 1.0f : __builtin_amdgcn_rsqf(ssq3[m] * (1.0f / DM) + RMS_EPS);
            GAS f32x4* x4 = (GAS f32x4*)xr + F.lane; const GAS f32x4* f4 = (const GAS f32x4*)fn + F.lane;
#pragma unroll
            for (int j = 0; j < 8; ++j) x4[64 * j] = rep ? x4[64 * j] * s : x4[64 * j] * s * f4[64 * j]; } if (NREP(10) > 1 && rep == 0) xcd_barrier(bar); }
#undef IN
#undef SEAM
}

extern "C" void kernel_launch(void* const* d_in, const int* in_sizes, int n_in, void* d_out, int out_size, void* d_ws, size_t ws_size, hipStream_t stream) {
    static int grid = 0;
    if (grid == 0) {
        if (n_in != 31 || in_sizes[0] != MP * DM || (size_t)out_size != O_END || ws_size < WS_END2) {
            fprintf(stderr, "kernel_launch: unexpected shapes: n_in %d in0 %d out %d (want %zu) ws %zu (want >= %zu); nothing launched\n", n_in, n_in > 0 ? in_sizes[0] : -1, out_size, (size_t)O_END, ws_size, (size_t)WS_END2);
            grid = -1; return; }
        int dev = 0, cus = 0, per_cu = 0;
        if (hipGetDevice(&dev) != hipSuccess || hipDeviceGetAttribute(&cus, hipDeviceAttributeMultiprocessorCount, dev) != hipSuccess) { fprintf(stderr, "kernel_launch: device query failed\n"); grid = -1; return; }
        if (hipFuncSetAttribute((const void*)hymba_fwd, hipFuncAttributeMaxDynamicSharedMemorySize, LDS_BYTES) != hipSuccess) { fprintf(stderr, "kernel_launch: hipFuncSetAttribute failed\n"); grid = -1; return; }
        if (hipOccupancyMaxActiveBlocksPerMultiprocessor(&per_cu, (const void*)hymba_fwd, NWAVES * 64, LDS_BYTES) != hipSuccess || per_cu < 1)
            fprintf(stderr, "kernel_launch: note: occupancy query reports %d workgroups per CU\n", per_cu);
        (void)hipGetLastError();
        grid = cus;
    }
    if (grid < 0) return;
    if (hipMemsetAsync((char*)d_ws + WS_CTL, 0, CTL_ZERO_BYTES, stream) != hipSuccess) { fprintf(stderr, "kernel_launch: hipMemsetAsync failed\n"); return; }
    Args a{};
    for (int i = 0; i < 31; ++i) a.in[i] = (const float*)d_in[i];
    a.out = (float*)d_out; a.ws = (unsigned char*)d_ws;
    for (int li = 0; li < MK_N_LAUNCHES; ++li) {
        a.ph_lo = (MK_N_LAUNCHES == 1) ? 0 : li; a.ph_hi = (MK_N_LAUNCHES == 1) ? NPHASES : li + 1; a.li = li;
        hipLaunchKernelGGL(hymba_fwd, dim3(grid), dim3(NWAVES * 64), LDS_BYTES, stream, a);
        const hipError_t le = hipPeekAtLastError();
        if (le != hipSuccess) { fprintf(stderr, "kernel_launch: launch %d failed: %s\n", li, hipGetErrorName(le)); break; }
    }
}
```

```cpp
#include <hip/hip_runtime.h>
#include <cstdio>
#include <cstdint>
#define MK_N_LAUNCHES 1
constexpr int DM = 2048, SEQ = 2048, NB = 4, MP = NB * SEQ  , NDEC = 32, MV = MP + NDEC  , MPAD = 8448  ;
constexpr int DFF = 5504, ATTW = 1024, KVW = 256, RWW = 1024, NQH = 16, NKVH = 4, HD = 64, RWH = 16, WIN = 128;
constexpr int ATT_COLS = ATTW + 2 * KVW  , SHC = 3 * RWW + 64 + 64 + 128  , INC = ATT_COLS + SHC  ;
constexpr float RMS_EPS = 1e-5f, GN_EPS = 64e-5f, LOG2E = 1.4426950408889634f;
constexpr float QSCALE = 0.125f * LOG2E;
constexpr size_t O_YP = 0, O_YS = O_YP + (size_t)MP * DM, O_KP = O_YS + (size_t)NDEC * DM, O_VP = O_KP + (size_t)NB * WIN * KVW, O_WP = O_VP + (size_t)NB * WIN * KVW,
                 O_SP = O_WP + (size_t)NB * RWH * HD * HD, O_KS = O_SP + (size_t)NB * SHC, O_VS = O_KS + (size_t)NDEC * WIN * KVW, O_WS = O_VS + (size_t)NDEC * WIN * KVW,
                 O_SS = O_WS + (size_t)NDEC * RWH * HD * HD, O_END = O_SS + (size_t)NDEC * SHC;
namespace pg8 {
#define PG8_LAS __attribute__((address_space(3)))
typedef unsigned short bf16_t;
typedef short bf16x8 __attribute__((ext_vector_type(8)));
typedef float f32x4 __attribute__((ext_vector_type(4)));
typedef unsigned u32x4 __attribute__((ext_vector_type(4)));
constexpr int BM = 256, BK = 64, HALF = 128, HTB = HALF * BK * 2  , STAGE_BYTES = 8 * HTB, NXCD = 8, WGM = 8;

__host__ __device__ __forceinline__ int lds_byte(int r, int c) { const int st = (r >> 4) * 2 + (c >> 5), rr = r & 15, cc = c & 31, ob = rr * 64 + cc * 2; return st * 1024 + (ob ^ (((ob >> 9) & 1) << 5)); }
__host__ __device__ __forceinline__ void stage_rc(int b, int& R, int& C) { const int st = b / 1024, sb = b % 1024, swz = sb ^ (((sb >> 9) & 1) << 5); R = (st >> 1) * 16 + swz / 64; C = (st & 1) * 32 + (swz % 64) / 2; }
__host__ __device__ __forceinline__ int perm32(int rho) { const int n = rho >> 4, i = rho & 15; return 8 * (i >> 2) + 4 * n + (i & 3); }

struct Unit { int pm, pn; };
struct Gemm { const bf16_t* A; const bf16_t* Bt; int M, N, K; };

struct StaticOrder {
    int nM, nN, nwg, G, c;
    __host__ __device__ void init(int M, int N, int G_, int c_) { nM = M / BM; nN = N / BM; nwg = nM * nN; G = G_; c = c_; }
    __host__ __device__ bool next(int i, Unit& u) const {
        const long L = (long)i * G + c; if (L >= nwg) return false;
        int wgid = (int)L; { const int q = nwg / NXCD, r = nwg % NXCD, xcd = wgid % NXCD, off = wgid / NXCD; wgid = (xcd < r ? xcd * (q + 1) : r * (q + 1) + (xcd - r) * q) + off; }
        const int nig = WGM * nN, gid = wgid / nig, fm = gid * WGM, gsz = (nM - fm) < WGM ? (nM - fm) : WGM;
        u.pm = fm + ((wgid % nig) % gsz); u.pn = (wgid % nig) / gsz; return true;
    }
    __device__ __forceinline__ void a_ready(const Unit&) const {}
    __device__ __forceinline__ void done(const Unit&) const {}
};

__device__ __forceinline__ unsigned cvt_pk_bf16(float lo, float hi) { unsigned r; asm volatile("v_cvt_pk_bf16_f32 %0, %1, %2" : "=v"(r) : "v"(lo), "v"(hi)); return r; }
__device__ __forceinline__ float silu_mul(float g, float u) { return g * u * __builtin_amdgcn_rcpf(1.0f + __builtin_amdgcn_exp2f(-g * LOG2E)); }

struct EpiSwiglu {
    static constexpr bool PERM = true, AFTER_DRAIN = false;
    bf16_t* O; const float* ssq;
    __device__ __forceinline__ void operator()(const f32x4 (&acc)[2][2][4][2], const Unit& u, int wr, int wc, int fr, int fq) const {
        const int row0 = u.pm * BM + wr * 64 + fr, col0 = u.pn * HALF + wc * 32 + 8 * fq;
#pragma unroll
        for (int ai = 0; ai < 2; ++ai)
#pragma unroll
            for (int m = 0; m < 4; ++m) { const int row = row0 + ai * HALF + m * 16;
                const float s = __builtin_amdgcn_rsqf(ssq[row] * (1.0f / DM) + RMS_EPS);
                const f32x4 g0 = acc[ai][0][m][0] * s, g1 = acc[ai][0][m][1] * s, u0 = acc[ai][1][m][0] * s, u1 = acc[ai][1][m][1] * s;
                u32x4 w; w.x = cvt_pk_bf16(silu_mul(g0[0], u0[0]), silu_mul(g0[1], u0[1])); w.y = cvt_pk_bf16(silu_mul(g0[2], u0[2]), silu_mul(g0[3], u0[3]));
                w.z = cvt_pk_bf16(silu_mul(g1[0], u1[0]), silu_mul(g1[1], u1[1])); w.w = cvt_pk_bf16(silu_mul(g1[2], u1[2]), silu_mul(g1[3], u1[3]));
                *(u32x4*)(O + (size_t)row * DFF + col0) = w; }
    }
};

struct EpiResid {
    static constexpr bool PERM = true, AFTER_DRAIN = false;
    const float* xi_p; const float* xi_s; const bf16_t* xb_in; float* xo_p; float* xo_s; bf16_t* XB; float* ssq; float alpha;
    __device__ __forceinline__ void operator()(const f32x4 (&acc)[2][2][4][2], const Unit& u, int wr, int wc, int fr, int fq) const {
        const int row0 = u.pm * BM + wr * 64 + fr, col0 = u.pn * BM + wc * 32 + 8 * fq;
#pragma unroll
        for (int ai = 0; ai < 2; ++ai)
#pragma unroll
            for (int m = 0; m < 4; ++m) { const int row = row0 + ai * HALF + m * 16; const bool valid = row < MV;
                const size_t ro = row < MP ? (size_t)row * DM : (size_t)(row - MP) * DM;
                float sq = 0.f;
#pragma unroll
                for (int bj = 0; bj < 2; ++bj) { const int col = col0 + bj * HALF;
                    f32x4 x0 = (f32x4){0.f, 0.f, 0.f, 0.f}, x1 = x0;
                    if (xb_in) { const u32x4 w = *(const u32x4*)(xb_in + (size_t)row * DM + col);
                        x0 = (f32x4){__builtin_bit_cast(float, w.x << 16), __builtin_bit_cast(float, w.x & 0xffff0000u), __builtin_bit_cast(float, w.y << 16), __builtin_bit_cast(float, w.y & 0xffff0000u)};
                        x1 = (f32x4){__builtin_bit_cast(float, w.z << 16), __builtin_bit_cast(float, w.z & 0xffff0000u), __builtin_bit_cast(float, w.w << 16), __builtin_bit_cast(float, w.w & 0xffff0000u)}; }
                    else if (valid) { const float* src = (row < MP ? xi_p : xi_s) + ro; x0 = *(const f32x4*)(src + col); x1 = *(const f32x4*)(src + col + 4); }
                    const f32x4 y0 = x0 + acc[ai][bj][m][0] * alpha, y1 = x1 + acc[ai][bj][m][1] * alpha;
                    if (xo_p && valid) { float* dst = (row < MP ? xo_p : xo_s) + ro; *(f32x4*)(dst + col) = y0; *(f32x4*)(dst + col + 4) = y1; }
                    sq += (y0[0] * y0[0] + y0[1] * y0[1]) + (y0[2] * y0[2] + y0[3] * y0[3]) + (y1[0] * y1[0] + y1[1] * y1[1]) + (y1[2] * y1[2] + y1[3] * y1[3]);
                    if (XB) { u32x4 w; w.x = cvt_pk_bf16(y0[0], y0[1]); w.y = cvt_pk_bf16(y0[2], y0[3]); w.z = cvt_pk_bf16(y1[0], y1[1]); w.w = cvt_pk_bf16(y1[2], y1[3]);
                        *(u32x4*)(XB + (size_t)row * DM + col) = w; } }
                sq += __shfl_xor(sq, 16); sq += __shfl_xor(sq, 32);
                if (fq == 0 && valid) atomicAdd(ssq + row, sq); }
    }
};

struct EpiWin {
    static constexpr bool PERM = true, AFTER_DRAIN = false;
    const float* ssq; bf16_t* QB; bf16_t* KB; bf16_t* VB; bf16_t* PR; float* out;
    __device__ __forceinline__ void operator()(const f32x4 (&acc)[2][2][4][2], const Unit& u, int wr, int wc, int fr, int fq) const {
        const int row0 = u.pm * BM + wr * 64 + fr, cl0 = wc * 32 + 8 * fq;
        const int pn = u.pn;
#pragma unroll
        for (int ai = 0; ai < 2; ++ai)
#pragma unroll
            for (int m = 0; m < 4; ++m) { const int row = row0 + ai * HALF + m * 16; const bool valid = row < MV;
                float s = __builtin_amdgcn_rsqf(ssq[row] * (1.0f / DM) + RMS_EPS);
                if (pn < 4) s *= QSCALE;
#pragma unroll
                for (int bj = 0; bj < 2; ++bj) { const int cl = cl0 + bj * HALF;
                    const f32x4 y0 = acc[ai][bj][m][0] * s, y1 = acc[ai][bj][m][1] * s;
                    if (pn < 6) { u32x4 w; w.x = cvt_pk_bf16(y0[0], y0[1]); w.y = cvt_pk_bf16(y0[2], y0[3]); w.z = cvt_pk_bf16(y1[0], y1[1]); w.w = cvt_pk_bf16(y1[2], y1[3]);
                        if (pn < 4) *(u32x4*)(QB + (size_t)row * ATTW + pn * BM + cl) = w;
                        else { *(u32x4*)((pn == 4 ? KB : VB) + (size_t)row * KVW + cl) = w;
                            if (valid) { float* o = nullptr;
                                if (row >= MP) o = out + (pn == 4 ? O_KS : O_VS) + ((size_t)(row - MP) * WIN + (WIN - 1)) * KVW + cl;
                                else if ((row & (SEQ - 1)) >= SEQ - WIN) o = out + (pn == 4 ? O_KP : O_VP) + ((size_t)(row >> 11) * WIN + ((row & (SEQ - 1)) - (SEQ - WIN))) * KVW + cl;
                                if (o) { *(f32x4*)o = y0; *(f32x4*)(o + 4) = y1; } } }
                    } else { const int cs = (pn - 6) * BM + cl;
                        { u32x4 w; w.x = cvt_pk_bf16(y0[0], y0[1]); w.y = cvt_pk_bf16(y0[2], y0[3]); w.z = cvt_pk_bf16(y1[0], y1[1]); w.w = cvt_pk_bf16(y1[2], y1[3]); *(u32x4*)(PR + (size_t)row * SHC + cs) = w; }
                        if (valid) { float* o = nullptr;
                            if (row >= MP) o = out + O_SS + (size_t)(row - MP) * SHC + cs;
                            else if ((row & (SEQ - 1)) == SEQ - 1) o = out + O_SP + (size_t)(row >> 11) * SHC + cs;
                            if (o) { *(f32x4*)o = y0; *(f32x4*)(o + 4) = y1; } } } }
            }
    }
};
template <class Epi, class Sched, bool ALIGN_EPI = false, bool SP2 = false>
__device__ __forceinline__ void gemm_phase(PG8_LAS unsigned char* lds, const Gemm g, const Sched& S, const Epi& E) {
    int tid_ = threadIdx.x; asm volatile("" : "+v"(tid_)); const int tid = tid_, wid = __builtin_amdgcn_readfirstlane(tid >> 6), lane = tid & 63, wr = wid >> 2, wc = wid & 3, fr = lane & 15, fq = lane >> 4;
    const int K = g.K, nt = K / BK;
    unsigned voffA[2], voffB[2];
#pragma unroll
    for (int i = 0; i < 2; ++i) { int R, C; stage_rc(tid * 16 + i * 8192, R, C); const int Rb = Epi::PERM ? ((R & ~31) + perm32(R & 31)) : R;
        voffA[i] = (unsigned)(R * K + C) * 2u; voffB[i] = (unsigned)(Rb * K + C) * 2u; }
    const size_t kstep = (size_t)(BK * 2);
    const size_t hstep = (size_t)HALF * K * 2;
    const size_t tstep = 2 * hstep;
    const unsigned ldsw = (unsigned)wid * 1024u;
    const int aoff = lds_byte(wr * 64 + fr, fq * 8), boff = lds_byte(wc * 32 + fr, fq * 8);
#define PG8_SA(b, h) (((b) * 2 + (h)) * HTB)
#define PG8_SB(b, h) ((4 + (b) * 2 + (h)) * HTB)
#define PG8_STAGE(bufoff, gbase, voff) do { _Pragma("unroll") for (int _i = 0; _i < 2; ++_i) \
        __builtin_amdgcn_global_load_lds((const unsigned*)((const char*)(gbase) + (voff)[_i]), (PG8_LAS unsigned*)(lds + (bufoff) + ldsw + _i * 8192), 16, 0, 0); } while (0)
#define PG8_LDA(dst, b, h) do { _Pragma("unroll") for (int m = 0; m < 4; ++m) _Pragma("unroll") for (int k = 0; k < 2; ++k) dst[m][k] = *(const PG8_LAS bf16x8*)(lds + PG8_SA(b, h) + aoff + m * 2048 + k * 1024); } while (0)
#define PG8_LDB(dst, b, h) do { _Pragma("unroll") for (int n = 0; n < 2; ++n) _Pragma("unroll") for (int k = 0; k < 2; ++k) dst[n][k] = *(const PG8_LAS bf16x8*)(lds + PG8_SB(b, h) + boff + n * 2048 + k * 1024); } while (0)
#define PG8_MMA(ai, bj, At, Bt) do { __builtin_amdgcn_s_setprio(1); _Pragma("unroll") for (int m = 0; m < 4; ++m) _Pragma("unroll") for (int n = 0; n < 2; ++n) _Pragma("unroll") for (int k = 0; k < 2; ++k) \
        acc[ai][bj][m][n] = __builtin_amdgcn_mfma_f32_16x16x32_bf16(Bt[n][k], At[m][k], acc[ai][bj][m][n], 0, 0, 0); __builtin_amdgcn_s_setprio(0); } while (0)
#define PG8_WAIT_V(n) asm volatile("s_waitcnt vmcnt(" #n ")" ::: "memory")
#define PG8_WAIT_L(n) asm volatile("s_waitcnt lgkmcnt(" #n ")" ::: "memory")
#define PG8_BAR __builtin_amdgcn_s_barrier()
#define PG8_SCHED __builtin_amdgcn_sched_barrier(0)
    Unit cur, nxt; int ui = 0;
    if (!S.next(0, cur)) return;
    f32x4 acc[2][2][4][2];
#pragma unroll
    for (int a = 0; a < 2; ++a)
#pragma unroll
        for (int b = 0; b < 2; ++b)
#pragma unroll
            for (int m = 0; m < 4; ++m)
#pragma unroll
                for (int n = 0; n < 2; ++n) acc[a][b][m][n] = (f32x4){0.f, 0.f, 0.f, 0.f};
    bf16x8 At[4][2], B0[2][2], B1[2][2];
    const char* cA = (const char*)g.A + (size_t)cur.pm * tstep; const char* cB = (const char*)g.Bt + (size_t)cur.pn * tstep;
    S.a_ready(cur);
    if constexpr (SP2) {
        PG8_STAGE(PG8_SB(0, 0), cB, voffB); PG8_STAGE(PG8_SB(0, 1), cB + hstep, voffB); PG8_STAGE(PG8_SA(0, 0), cA, voffA); PG8_STAGE(PG8_SA(0, 1), cA + hstep, voffA);
        if (wr == 1) PG8_BAR;
        PG8_WAIT_V(2); PG8_BAR;
        PG8_STAGE(PG8_SB(1, 0), cB + kstep, voffB); PG8_STAGE(PG8_SA(1, 0), cA + kstep, voffA); PG8_STAGE(PG8_SB(1, 1), cB + hstep + kstep, voffB);
        PG8_WAIT_V(6); PG8_BAR;
    } else {
        PG8_STAGE(PG8_SB(0, 0), cB, voffB); PG8_STAGE(PG8_SA(0, 0), cA, voffA); PG8_STAGE(PG8_SB(0, 1), cB + hstep, voffB); PG8_STAGE(PG8_SA(0, 1), cA + hstep, voffA);
        if (wr == 1) PG8_BAR;
        PG8_WAIT_V(4); PG8_BAR;
        PG8_STAGE(PG8_SB(1, 0), cB + kstep, voffB); PG8_STAGE(PG8_SA(1, 0), cA + kstep, voffA); PG8_STAGE(PG8_SB(1, 1), cB + hstep + kstep, voffB);
        PG8_WAIT_V(6); PG8_BAR;
    }
    for (;;) {
        const bool has_next = S.next(ui + 1, nxt);
        const char* nA = has_next ? (const char*)g.A + (size_t)nxt.pm * tstep : cA; const char* nB = has_next ? (const char*)g.Bt + (size_t)nxt.pn * tstep : cB;
        for (int t = 0; t < nt; t += 2) {
            const bool last = (t == nt - 2);
            const char* a1 = cA + (size_t)(t + 1) * kstep;
            const char* a2 = last ? nA : cA + (size_t)(t + 2) * kstep; const char* b2 = last ? nB : cB + (size_t)(t + 2) * kstep;
            const char* a3 = a2 + kstep; const char* b3 = b2 + kstep;
            if (last && has_next) S.a_ready(nxt);
            if constexpr (SP2) {
            PG8_LDB(B0, 0, 0); PG8_LDB(B1, 0, 1); PG8_SCHED; PG8_LDA(At, 0, 0); PG8_STAGE(PG8_SA(1, 1), a1 + hstep, voffA);
            PG8_WAIT_V(8); PG8_WAIT_L(0); PG8_BAR; PG8_MMA(0, 0, At, B0); PG8_MMA(0, 1, At, B1); PG8_BAR; PG8_SCHED;
            PG8_LDA(At, 0, 1); PG8_STAGE(PG8_SB(0, 0), b2, voffB); PG8_STAGE(PG8_SB(0, 1), b2 + hstep, voffB); PG8_STAGE(PG8_SA(0, 0), a2, voffA);
            PG8_WAIT_V(8); PG8_WAIT_L(0); PG8_BAR; PG8_MMA(1, 0, At, B0); PG8_MMA(1, 1, At, B1); PG8_BAR; PG8_SCHED;
            PG8_LDB(B0, 1, 0); PG8_LDB(B1, 1, 1); PG8_SCHED; PG8_LDA(At, 1, 0); PG8_STAGE(PG8_SA(0, 1), a2 + hstep, voffA);
            PG8_WAIT_V(8); PG8_WAIT_L(0); PG8_BAR; PG8_MMA(0, 0, At, B0); PG8_MMA(0, 1, At, B1); PG8_BAR; PG8_SCHED;
            PG8_LDA(At, 1, 1); PG8_STAGE(PG8_SB(1, 0), b3, voffB); PG8_STAGE(PG8_SB(1, 1), b3 + hstep, voffB); PG8_STAGE(PG8_SA(1, 0), a3, voffA);
            PG8_WAIT_V(8); PG8_WAIT_L(0); PG8_BAR; PG8_MMA(1, 0, At, B0); PG8_MMA(1, 1, At, B1); PG8_BAR; PG8_SCHED;
            } else {
            PG8_LDB(B0, 0, 0); PG8_SCHED; PG8_LDA(At, 0, 0); PG8_STAGE(PG8_SA(1, 1), a1 + hstep, voffA);
            PG8_WAIT_L(8); PG8_BAR; PG8_WAIT_L(0); PG8_MMA(0, 0, At, B0); PG8_BAR; PG8_SCHED;
            PG8_LDB(B1, 0, 1); PG8_STAGE(PG8_SB(0, 0), b2, voffB);
            PG8_BAR; PG8_WAIT_L(0); PG8_MMA(0, 1, At, B1); PG8_BAR;
            PG8_LDA(At, 0, 1); PG8_STAGE(PG8_SA(0, 0), a2, voffA);
            PG8_BAR; PG8_WAIT_L(0); PG8_MMA(1, 0, At, B0); PG8_BAR; PG8_SCHED;
            PG8_STAGE(PG8_SB(0, 1), b2 + hstep, voffB);
            PG8_WAIT_V(6); PG8_BAR; PG8_MMA(1, 1, At, B1); PG8_BAR;
            PG8_LDB(B0, 1, 0); PG8_SCHED; PG8_LDA(At, 1, 0); PG8_STAGE(PG8_SA(0, 1), a2 + hstep, voffA);
            PG8_WAIT_L(8); PG8_BAR; PG8_WAIT_L(0); PG8_MMA(0, 0, At, B0); PG8_BAR; PG8_SCHED;
            PG8_LDB(B1, 1, 1); PG8_STAGE(PG8_SB(1, 0), b3, voffB);
            PG8_BAR; PG8_WAIT_L(0); PG8_MMA(0, 1, At, B1); PG8_BAR;
            PG8_LDA(At, 1, 1); PG8_STAGE(PG8_SA(1, 0), a3, voffA);
            PG8_BAR; PG8_WAIT_L(0); PG8_MMA(1, 0, At, B0); PG8_BAR; PG8_SCHED;
            PG8_STAGE(PG8_SB(1, 1), b3 + hstep, voffB);
            PG8_WAIT_V(6); PG8_BAR; PG8_MMA(1, 1, At, B1); PG8_BAR;
            }
        }
        if constexpr (ALIGN_EPI) { if (wr == 0) PG8_BAR; }
        if constexpr (!Epi::AFTER_DRAIN) { E(acc, cur, wr, wc, fr, fq); S.done(cur); }
        if (!has_next) break;
#pragma unroll
        for (int a = 0; a < 2; ++a)
#pragma unroll
            for (int b = 0; b < 2; ++b)
#pragma unroll
                for (int m = 0; m < 4; ++m)
#pragma unroll
                    for (int n = 0; n < 2; ++n) acc[a][b][m][n] = (f32x4){0.f, 0.f, 0.f, 0.f};
        cur = nxt; cA = nA; cB = nB; ++ui;
        if constexpr (ALIGN_EPI) { if (wr == 1) PG8_BAR; }
    }
    PG8_WAIT_V(0);
    if constexpr (!ALIGN_EPI) { if (wr == 0) PG8_BAR; }
    PG8_BAR;
    if constexpr (Epi::AFTER_DRAIN) { E.fused(acc, cur, wr, wc, fr, fq, lds, wid, lane); S.done(cur); }
#undef PG8_SA
#undef PG8_SB
#undef PG8_STAGE
#undef PG8_LDA
#undef PG8_LDB
#undef PG8_MMA
#undef PG8_WAIT_V
#undef PG8_WAIT_L
#undef PG8_BAR
#undef PG8_SCHED
}
}
#define GAS __attribute__((address_space(1)))
#define LAS __attribute__((address_space(3)))
typedef unsigned short bf16;
typedef unsigned v4u __attribute__((ext_vector_type(4)));
typedef float f32x4 __attribute__((ext_vector_type(4)));
typedef short bf16x8 __attribute__((ext_vector_type(8)));
typedef GAS unsigned gu32;
typedef GAS unsigned long long gu64;
#define RLX_AGENT __ATOMIC_RELAXED, __HIP_MEMORY_SCOPE_AGENT
#define LDS_WAIT() asm volatile("s_waitcnt lgkmcnt(0)" ::: "memory")
#define VM_WAIT() asm volatile("s_waitcnt vmcnt(0)" ::: "memory")
__device__ __forceinline__ unsigned long long rt() { return __builtin_amdgcn_s_memrealtime(); }
__device__ __forceinline__ unsigned f2bf(float f) { unsigned u = __builtin_bit_cast(unsigned, f); return (u + 0x7fffu + ((u >> 16) & 1u)) >> 16; }
__device__ __forceinline__ unsigned pk2(float lo, float hi) { return f2bf(lo) | (f2bf(hi) << 16); }

#define XB_TMO      128
#define XB_XCNT(j)  (256  + 64 * (j))
#define XB_XSUB(j)  (1280 + 64 * (j))
#define XB_XGEN(j)  (2304 + 64 * (j))
#define XB_TOP      3328
#define XB_TOPGEN   3392
#define XCD_BAR_WORDS 3456
#define XB_SPIN_CAP (1u << 18)

__device__ __forceinline__ unsigned xb_ld(unsigned* p)              { return __hip_atomic_load(p, __ATOMIC_RELAXED, __HIP_MEMORY_SCOPE_AGENT); }
__device__ __forceinline__ unsigned xb_add(unsigned* p, unsigned v) { return __hip_atomic_fetch_add(p, v, __ATOMIC_RELAXED, __HIP_MEMORY_SCOPE_AGENT); }
__device__ __forceinline__ unsigned xb_xcc_id() { return (unsigned)__builtin_amdgcn_s_getreg((3 << 11) | 20) & 0xFu; }
#define XB_SPIN(cond, bar) do { unsigned _sp = 0; while (cond) { __builtin_amdgcn_s_sleep(1); \
    if ((++_sp & 255u) == 0u) { if (xb_ld(&(bar)[XB_TMO])) break; if (_sp > XB_SPIN_CAP) { atomicAdd(&(bar)[XB_TMO], 1u); break; } } } } while (0)

struct XcdBarrier {
    unsigned* bar; unsigned x;
    volatile LAS unsigned* st;
};

__device__ __forceinline__ XcdBarrier xcd_barrier_post(unsigned* bar, volatile LAS unsigned* st) {
    XcdBarrier b; b.bar = bar; b.x = xb_xcc_id(); b.st = st;
    if (threadIdx.x == 0) (void)xb_add(&bar[XB_XCNT(b.x)], 1u);
    return b;
}
__device__ __forceinline__ void xcd_barrier_complete(unsigned* bar, unsigned x, unsigned& nloc, unsigned& nx) {
    const unsigned G = gridDim.x * gridDim.y * gridDim.z;
    unsigned sum, cnt, mine, sp = 0u;
    for (;;) {
        sum = 0u; cnt = 0u; mine = 0u;
#pragma unroll
        for (unsigned j = 0; j < 16; ++j) { const unsigned c = xb_ld(&bar[XB_XCNT(j)]); sum += c; cnt += (c > 0u) ? 1u : 0u; mine = (j == x) ? c : mine; }
        if (sum == G) break;
        __builtin_amdgcn_s_sleep(1);
        if ((++sp & 255u) == 0u) { if (xb_ld(&bar[XB_TMO])) break; if (sp > XB_SPIN_CAP) { atomicAdd(&bar[XB_TMO], 1u); break; } }
    }
    nloc = mine > 0u ? mine : 1u; nx = cnt > 0u ? cnt : 1u;
}

__device__ __forceinline__ void xcd_barrier(const XcdBarrier& b) {
    asm volatile("s_waitcnt vmcnt(0)" ::: "memory");
    __syncthreads();
    if (threadIdx.x == 0) {
        unsigned* bar = b.bar;
        __builtin_amdgcn_s_waitcnt(0);
        unsigned nloc = b.st[0], nx = b.st[1];
        if (nloc == 0u) { xcd_barrier_complete(bar, b.x, nloc, nx); b.st[0] = nloc; b.st[1] = nx; }
        const unsigned old = xb_add(&bar[XB_XSUB(b.x)], 1u);
        const unsigned gen = old / nloc;
        if (old + 1u == (gen + 1u) * nloc) {
            __builtin_amdgcn_fence(__ATOMIC_RELEASE, "agent");
            asm volatile("s_waitcnt vmcnt(0)" ::: "memory");
            const unsigned og = xb_add(&bar[XB_TOP], 1u);
            const unsigned tg = og / nx;
            if (og + 1u == (tg + 1u) * nx) xb_add(&bar[XB_TOPGEN], 1u);
            else XB_SPIN(xb_ld(&bar[XB_TOPGEN]) == tg, bar);
            __builtin_amdgcn_fence(__ATOMIC_ACQUIRE, "agent");
            xb_add(&bar[XB_XGEN(b.x)], 1u);
            asm volatile("s_waitcnt vmcnt(0)" ::: "memory");
        } else {
            XB_SPIN(xb_ld(&bar[XB_XGEN(b.x)]) == gen, bar);
            __builtin_amdgcn_fence(__ATOMIC_ACQUIRE, "agent");
            asm volatile("s_waitcnt vmcnt(0)" ::: "memory");
        }
    }
    __syncthreads();
}
constexpr size_t MiB = 1u << 20;
constexpr size_t WS_CTL = 0, CTL_ZERO_BYTES = 1 * MiB;
constexpr size_t WS_BIAS = 1 * MiB, WS_W2T = WS_BIAS + 16384, WS_A2T = WS_W2T + 131072, WS_G2T = WS_A2T + 131072;
constexpr size_t WS_WGU1 = 2 * MiB, WS_WD1 = WS_WGU1 + 43 * MiB, WS_WINB = WS_WD1 + 21 * MiB + MiB / 2;
constexpr size_t WS_WOUT = 86 * MiB, WS_WGU2 = 94 * MiB, WS_WD2 = 137 * MiB;
constexpr size_t WS_XB = 159 * MiB;
constexpr size_t WS_ACT = 192 * MiB;
constexpr size_t WS_MIX = 246 * MiB;
constexpr size_t WS_QB = 300 * MiB, WS_KB = WS_QB + 16 * MiB + MiB / 2, WS_VB = WS_KB + 4 * MiB + MiB / 8;
constexpr size_t WS_DD = 325 * MiB, WS_LG = 358 * MiB, WS_EE = WS_LG + 16 * MiB + MiB / 2, WS_END = WS_EE + 16 * MiB + MiB / 2;
constexpr size_t WS_SLAB = WS_END, WS_DEC = WS_SLAB + 1 * MiB, WS_END2 = WS_DEC + 6 * (size_t)NDEC * RWW * 4;
constexpr size_t VEC16 = 16 * MiB + MiB / 2;
constexpr size_t WS_KK = WS_WGU1, WS_BB = WS_KK + VEC16, WS_KP = WS_BB + VEC16, WS_RR = WS_KP + VEC16, WS_VV = WS_RR + VEC16;
constexpr size_t WS_X2B = WS_WGU1;
static_assert(WS_VV + VEC16 <= WS_WOUT && WS_WINB + 19 * MiB <= WS_WOUT && WS_WD2 + 22 * MiB <= WS_XB && WS_XB + 33 * MiB <= WS_ACT && WS_VB + 4 * MiB + MiB / 8 <= WS_DD && WS_DD + 33 * MiB <= WS_LG, "d_ws map");
constexpr int CW_BAR = 4096;
constexpr int CW_SSQ0 = 16384, CW_SSQ1 = CW_SSQ0 + MPAD, CW_SSQ2 = CW_SSQ1 + MPAD, CW_SSQ3 = CW_SSQ2 + MPAD;
constexpr int CW_SKC = 8192;
constexpr int CW_SSQD = CW_SSQ3 + MPAD;
static_assert((CW_SSQD + MPAD) * 4 <= (int)CTL_ZERO_BYTES, "CTL");
constexpr int RING_OFF = 0, RING_BYTES = 131072;
constexpr int LDSCTL_OFF = RING_BYTES, MISC_OFF = LDSCTL_OFF + 320;
constexpr int LDS_BYTES = 147456;
constexpr int NWAVES = 8;
constexpr int NPHASES = 11;
#ifndef MK_N_LAUNCHES
#define MK_N_LAUNCHES 1
#endif

__constant__ unsigned char T5B[129] = {0, 1, 2, 3, 4, 5, 6, 7, 8, 9, 10, 11, 12, 13, 14, 15, 16, 16, 16, 17, 17, 18, 18, 18, 19, 19, 19, 20, 20, 20, 20, 21, 21, 21, 21, 22, 22, 22, 22, 22, 23, 23, 23, 23, 23, 23, 24, 24, 24, 24, 24, 24, 25, 25, 25, 25, 25, 25, 25, 26, 26, 26, 26, 26, 26, 26, 26, 27, 27, 27, 27, 27, 27, 27, 27, 27, 27, 28, 28, 28, 28, 28, 28, 28, 28, 28, 28, 29, 29, 29, 29, 29, 29, 29, 29, 29, 29, 29, 29, 30, 30, 30, 30, 30, 30, 30, 30, 30, 30, 30, 30, 30, 30, 31, 31, 31, 31, 31, 31, 31, 31, 31, 31, 31, 31, 31, 31, 31, 31};

struct Args { const float* in[31]; float* out; unsigned char* ws; int ph_lo, ph_hi, li, pad; };

struct Frame {
    LAS unsigned char* lds;
    volatile LAS unsigned* MISC;
    gu32* ctl;
    int tid, lane, wave, G;
    float* out; unsigned char* ws;
};
typedef float f32x2 __attribute__((ext_vector_type(2)));
__device__ __forceinline__ float bf2f(unsigned short u) { return __builtin_bit_cast(float, (unsigned)u << 16); }
__device__ __forceinline__ unsigned short f2bfs(float f) { return (unsigned short)f2bf(f); }
__device__ __forceinline__ float wave_sum(float v) {
#pragma unroll
    for (int o = 1; o < 64; o <<= 1) v += __shfl_xor(v, o);
    return v;
}
__device__ __forceinline__ float wave_max(float v) {
#pragma unroll
    for (int o = 1; o < 64; o <<= 1) v = fmaxf(v, __shfl_xor(v, o));
    return v;
}
template <int CTRL> __device__ __forceinline__ float dpp_f(float x) { return __builtin_bit_cast(float, __builtin_amdgcn_update_dpp(0, __builtin_bit_cast(int, x), CTRL, 0xf, 0xf, true)); }
__device__ __forceinline__ float allsum16(float x) { x += dpp_f<0x128>(x); x += dpp_f<0x124>(x); x += dpp_f<0x122>(x); x += dpp_f<0x121>(x); return x; }
__device__ __forceinline__ float sigmoidf_(float x) { return __builtin_amdgcn_rcpf(1.0f + __builtin_amdgcn_exp2f(-x * LOG2E)); }
__device__ __forceinline__ float tanhf_(float x) { return 1.0f - 2.0f * __builtin_amdgcn_rcpf(1.0f + __builtin_amdgcn_exp2f(2.0f * LOG2E * x)); }

constexpr int TP_PITCH = 136;
__device__ __forceinline__ void p0_transpose_item(const float* W, int K, int N, bf16* WT, int kb, int nb, int drow, const float* kscale, LAS unsigned char* scr, int lane) {
    const int k0 = 64 * kb, n0 = 64 * nb, g = lane >> 4, c = lane & 15;
    f32x4 v[16];
#pragma unroll
    for (int j = 0; j < 4; ++j)
#pragma unroll
        for (int r = 0; r < 4; ++r) v[4 * j + r] = *(const GAS f32x4*)(W + (size_t)(k0 + 16 * j + 4 * g + r) * N + n0 + 4 * c);
    if (kscale) {
#pragma unroll
        for (int j = 0; j < 4; ++j) { const f32x4 s4 = *(const GAS f32x4*)(kscale + k0 + 16 * j + 4 * g);
            v[4 * j + 0] *= s4.x; v[4 * j + 1] *= s4.y; v[4 * j + 2] *= s4.z; v[4 * j + 3] *= s4.w; } }
#pragma unroll
    for (int j = 0; j < 4; ++j)
#pragma unroll
        for (int e = 0; e < 4; ++e)
            *(LAS unsigned long long*)(scr + (4 * c + e) * TP_PITCH + (16 * j + 4 * g) * 2) = (unsigned long long)pk2(v[4 * j + 0][e], v[4 * j + 1][e]) | ((unsigned long long)pk2(v[4 * j + 2][e], v[4 * j + 3][e]) << 32);
    LDS_WAIT(); asm volatile("" ::: "memory");
#pragma unroll
    for (int i = 0; i < 8; ++i) { const int n = 8 * i + (lane >> 3), kc = lane & 7;
        const LAS unsigned char* s = scr + n * TP_PITCH + kc * 16;
        v4u o; o.x = *(const LAS unsigned*)(s); o.y = *(const LAS unsigned*)(s + 4); o.z = *(const LAS unsigned*)(s + 8); o.w = *(const LAS unsigned*)(s + 12);
        *(GAS v4u*)(WT + (size_t)(drow + n) * K + k0 + 8 * kc) = o; }
    LDS_WAIT(); asm volatile("" ::: "memory");
}
__device__ __forceinline__ int gu_row(int n0, int up) { return 256 * (n0 >> 7) + (n0 & 127) + 128 * up; }

constexpr int I_GU = (DM / 64) * (DFF / 64), I_D = (DFF / 64) * (DM / 64), I_IN = (DM / 64) * (INC / 64), I_OUT = (DM / 64) * (DM / 64), I_L64 = RWW / 64, I_L128 = 2 * (RWW / 64);
constexpr int CV_EARLY = 2 * I_GU + I_D + I_IN + 2 * I_L64 + I_L128, CV_LATE1 = I_OUT + I_GU, CV_LATE2 = I_GU + I_D, CV_ALL = CV_EARLY + CV_LATE1 + CV_LATE2;
__device__ __forceinline__ void convert_items(Frame& F, const Args& A, int first, int count, int rank, int nranks) {
    LAS unsigned char* scr = F.lds + RING_OFF + F.wave * 16384;
    const int lane = F.lane; unsigned char* ws = F.ws;
    for (int it = first + rank * NWAVES + F.wave; it < first + count; it += nranks * NWAVES) {
        int r = it;
        if (r < I_GU) { const int kb = r / (DFF / 64), nb = r % (DFF / 64); p0_transpose_item(A.in[8], DM, DFF, (bf16*)(ws + WS_WGU1), kb, nb, gu_row(64 * nb, 0), A.in[7], scr, lane); continue; } r -= I_GU;
        if (r < I_GU) { const int kb = r / (DFF / 64), nb = r % (DFF / 64); p0_transpose_item(A.in[9], DM, DFF, (bf16*)(ws + WS_WGU1), kb, nb, gu_row(64 * nb, 1), A.in[7], scr, lane); continue; } r -= I_GU;
        if (r < I_D)  { const int kb = r / (DM / 64), nb = r % (DM / 64); p0_transpose_item(A.in[10], DFF, DM, (bf16*)(ws + WS_WD1), kb, nb, 64 * nb, nullptr, scr, lane); continue; } r -= I_D;
        if (r < I_IN) { const int kb = r / (INC / 64), nb = r % (INC / 64); p0_transpose_item(A.in[12], DM, INC, (bf16*)(ws + WS_WINB), kb, nb, 64 * nb, A.in[11], scr, lane); continue; } r -= I_IN;
        if (r < I_L64) { p0_transpose_item(A.in[16], 64, RWW, (bf16*)(ws + WS_W2T), 0, r, 64 * r, nullptr, scr, lane); continue; } r -= I_L64;
        if (r < I_L64) { p0_transpose_item(A.in[18], 64, RWW, (bf16*)(ws + WS_A2T), 0, r, 64 * r, nullptr, scr, lane); continue; } r -= I_L64;
        if (r < I_L128) { const int kb = r / (RWW / 64), nb = r % (RWW / 64); p0_transpose_item(A.in[19], 128, RWW, (bf16*)(ws + WS_G2T), kb, nb, 64 * nb, nullptr, scr, lane); continue; } r -= I_L128;
        if (r < I_OUT) { const int kb = r / (DM / 64), nb = r % (DM / 64); p0_transpose_item(A.in[25], DM, DM, (bf16*)(ws + WS_WOUT), kb, nb, 64 * nb, nullptr, scr, lane); continue; } r -= I_OUT;
        if (r < I_GU) { const int kb = r / (DFF / 64), nb = r % (DFF / 64); p0_transpose_item(A.in[27], DM, DFF, (bf16*)(ws + WS_WGU2), kb, nb, gu_row(64 * nb, 0), A.in[26], scr, lane); continue; } r -= I_GU;
        if (r < I_GU) { const int kb = r / (DFF / 64), nb = r % (DFF / 64); p0_transpose_item(A.in[28], DM, DFF, (bf16*)(ws + WS_WGU2), kb, nb, gu_row(64 * nb, 1), A.in[26], scr, lane); continue; } r -= I_GU;
        { const int kb = r / (DM / 64), nb = r % (DM / 64); p0_transpose_item(A.in[29], DFF, DM, (bf16*)(ws + WS_WD2), kb, nb, 64 * nb, nullptr, scr, lane); }
    }
}
__device__ __forceinline__ void p0_prologue(Frame& F, const Args& A) {
    const int gw = blockIdx.x * NWAVES + F.wave, NGW = F.G * NWAVES, lane = F.lane;
    unsigned char* ws = F.ws;
#ifdef CV_ALL_IN_P0
    convert_items(F, A, 0, CV_ALL, blockIdx.x, F.G);
#else
    convert_items(F, A, 0, CV_EARLY, blockIdx.x, F.G);
#endif
    bf16* XB = (bf16*)(ws + WS_XB); float* ssq0 = (float*)(F.ctl + CW_SSQ0);
    for (int m = gw; m < MPAD; m += NGW) {
        GAS unsigned long long* o8 = (GAS unsigned long long*)(XB + (size_t)m * DM) + lane;
        if (m < MV) {
            const float* xrow = m < MP ? A.in[0] + (size_t)m * DM : A.in[1] + (size_t)(m - MP) * DM;
            const GAS f32x4* xr = (const GAS f32x4*)xrow + lane; f32x4 v[8]; float s = 0.f;
#pragma unroll
            for (int j = 0; j < 8; ++j) { v[j] = xr[64 * j]; s += (v[j].x * v[j].x + v[j].y * v[j].y) + (v[j].z * v[j].z + v[j].w * v[j].w); }
            s = wave_sum(s);
#pragma unroll
            for (int j = 0; j < 8; ++j) o8[64 * j] = (unsigned long long)pk2(v[j].x, v[j].y) | ((unsigned long long)pk2(v[j].z, v[j].w) << 32);
            if (lane == 0) ssq0[m] = s;
        } else {
#pragma unroll
            for (int j = 0; j < 8; ++j) o8[64 * j] = 0ull;
        }
    }
    float* bt = (float*)(ws + WS_BIAS);
    for (int i = blockIdx.x * (NWAVES * 64) + F.tid; i < 129 * NQH; i += F.G * NWAVES * 64) bt[i] = A.in[6][(int)T5B[i >> 4] * NQH + (i & 15)] * LOG2E;
}
constexpr int PREP_TILES = (MV + 63) / 64  , PREP_UNITS = PREP_TILES * RWH;
constexpr int PA_PITCH = 528;
constexpr int PW_LD = 68;
constexpr int PA_OFF = 0, PW_OFF = 64 * PA_PITCH  , PMAT = 64 * PW_LD * 4  , PC_OFF = 114688;
constexpr int CB_FA = 0, CB_FR = 2048, CB_FNK = 4096, CB_FT = 4608, CB_FMB = 5120, CB_FMK = 5632, CB_FBG = 6144, CB_FKG = 8192, CB_FV = 10240, CB_GC = 12288, CB_BYTES = 12544, CB_STRIDE = 13312;
constexpr int NCHUNK = SEQ / 16;
constexpr size_t CH_NA = (WS_WOUT - WS_WGU1) / CB_STRIDE, CH_NB = (WS_LG - WS_DD) / CB_STRIDE;
static_assert(CH_NA + CH_NB >= (size_t)NB * RWH * NCHUNK, "chunk blocks");
__device__ __forceinline__ unsigned char* chunk_block(unsigned char* ws, int g) { return (size_t)g < CH_NA ? ws + WS_WGU1 + (size_t)g * CB_STRIDE : ws + WS_DD + ((size_t)g - CH_NA) * CB_STRIDE; }
constexpr int LW_OFF = 0, CS2_OFF = 16384;
static_assert(PW_OFF + 3 * PMAT <= PC_OFF && CS2_OFF + 4 * 16384 <= PC_OFF && PC_OFF + 2560 <= RING_BYTES, "prep LDS");
constexpr int SC_FA = 0, SC_FR = 2048, SC_FBH = 4096, SC_FKH = 6144, SC_FBG = 8192, SC_FKG = 10240, SC_FV = 12288, SC_NB = 14336, SC_TT = 15360;
typedef short s16x4 __attribute__((ext_vector_type(4)));
typedef __bf16 bf16x2_t __attribute__((ext_vector_type(2)));
__device__ __forceinline__ unsigned cvtpk_c(float lo, float hi) { const f32x2 v = {lo, hi}; return __builtin_bit_cast(unsigned, __builtin_convertvector(v, bf16x2_t)); }
__device__ __forceinline__ unsigned long long pack4bf(f32x4 v) { return (unsigned long long)cvtpk_c(v.x, v.y) | ((unsigned long long)cvtpk_c(v.z, v.w) << 32); }
__device__ __forceinline__ void chunk_mm(LAS unsigned char* lds, int c, unsigned char* blk, int lane) {
    asm volatile("" : "+v"(lane));
    LAS unsigned char* sc = lds + CS2_OFF + c * 16384;
    const int x = lane & 15, q = lane >> 4;
    bf16x8 aB[2], aK[2], bA[2], bR[2];
#pragma unroll
    for (int k2 = 0; k2 < 2; ++k2) { aB[k2] = *(const LAS bf16x8*)(sc + SC_FBH + (k2 * 64 + lane) * 16); aK[k2] = *(const LAS bf16x8*)(sc + SC_FKH + (k2 * 64 + lane) * 16);
        bA[k2] = *(const LAS bf16x8*)(sc + SC_FA + (k2 * 64 + lane) * 16); bR[k2] = *(const LAS bf16x8*)(sc + SC_FR + (k2 * 64 + lane) * 16); }
    f32x4 nb = (f32x4){0.f, 0.f, 0.f, 0.f}, nk = nb, mb_ = nb, mk = nb;
#pragma unroll
    for (int k2 = 0; k2 < 2; ++k2) { nb = __builtin_amdgcn_mfma_f32_16x16x32_bf16(aB[k2], bA[k2], nb, 0, 0, 0); nk = __builtin_amdgcn_mfma_f32_16x16x32_bf16(aK[k2], bA[k2], nk, 0, 0, 0);
        mb_ = __builtin_amdgcn_mfma_f32_16x16x32_bf16(aB[k2], bR[k2], mb_, 0, 0, 0); mk = __builtin_amdgcn_mfma_f32_16x16x32_bf16(aK[k2], bR[k2], mk, 0, 0, 0); }
#pragma unroll
    for (int r = 0; r < 4; ++r) { const int s_ = 4 * q + r; if (!(s_ < x)) { nb[r] = 0.f; nk[r] = 0.f; } if (!(s_ <= x)) { mb_[r] = 0.f; mk[r] = 0.f; } }
    *(GAS unsigned long long*)(blk + CB_FNK + lane * 8) = pack4bf(nk); *(GAS unsigned long long*)(blk + CB_FMB + lane * 8) = pack4bf(mb_); *(GAS unsigned long long*)(blk + CB_FMK + lane * 8) = pack4bf(mk);
    LAS float* nbs = (LAS float*)(sc + SC_NB);
#pragma unroll
    for (int r = 0; r < 4; ++r) nbs[(4 * q + r) * 16 + x] = nb[r];
    float Tc[16];
#pragma unroll
    for (int t = 0; t < 16; ++t) { float a_ = (x == t) ? 1.f : 0.f;
#pragma unroll
        for (int s_ = 0; s_ < t; ++s_) a_ -= Tc[s_] * nbs[s_ * 16 + t];
        Tc[t] = a_; if ((t & 3) == 3) asm volatile("" ::: "memory"); }
    LAS float* tts = (LAS float*)(sc + SC_TT);
#pragma unroll
    for (int t = 0; t < 16; ++t) tts[x * 16 + t] = Tc[t];
    { f32x4 tv;
#pragma unroll
      for (int e = 0; e < 4; ++e) tv[e] = -tts[(4 * q + e) * 16 + x];
      *(GAS unsigned long long*)(blk + CB_FT + lane * 8) = pack4bf(tv); }
}
__device__ __forceinline__ void chunk_copy(LAS unsigned char* lds, int c, unsigned char* blk, int lane) {
    const LAS unsigned char* sc = lds + CS2_OFF + c * 16384;
#pragma unroll
    for (int i = 0; i < 4; ++i) *(GAS v4u*)(blk + CB_FA + (i * 64 + lane) * 16) = *(const LAS v4u*)(sc + SC_FA + (i * 64 + lane) * 16);
#pragma unroll
    for (int i = 0; i < 6; ++i) *(GAS v4u*)(blk + CB_FBG + (i * 64 + lane) * 16) = *(const LAS v4u*)(sc + SC_FBG + (i * 64 + lane) * 16);
}
__device__ __forceinline__ float qsum8(float x) {
    x += dpp_f<0xB1>(x); x += dpp_f<0x4E>(x); x += dpp_f<0x141>(x); return x; }
__device__ __forceinline__ void prep_phase(Frame& F, const Args& A) {
    const int tid = F.tid, lane = F.lane, wave = F.wave;
    unsigned char* ws = F.ws; LAS unsigned char* lds = F.lds;
    const bf16* PR = (const bf16*)(ws + WS_ACT);
    const float* mu = A.in[14];
    int hcur = -1;
    const int mtile = wave & 3, nh = wave >> 2, ln = lane & 15, q4 = lane >> 4;
    for (int u = blockIdx.x; u < PREP_UNITS; u += F.G) {
        const int mt = u >> 4, h = u & 15, m0 = mt * 64;
        if (h != hcur) {
            __syncthreads();
            hcur = h;
            { LAS float* cst = (LAS float*)(lds + PC_OFF);
              for (int i = tid; i < 10 * 64; i += NWAVES * 64) { const int a = i >> 6, c = i & 63, hc = 64 * h + c; float v;
                  if (a < 3) v = mu[a * RWW + hc]; else v = A.in[a == 3 ? 15 : (a == 4 ? 17 : (a == 5 ? 20 : (a == 6 ? 21 : (a == 7 ? 22 : (a == 8 ? 23 : 24)))))][hc];
                  cst[i] = v; } }
            __syncthreads();
        }
        const int row1 = tid >> 3, cc = tid & 7, m1 = m0 + row1, c01 = 3 * RWW + 32 * cc;
        const bool valid1 = m1 < MV;
        f32x4 xa[8], xb[8];
        { const bf16* p = PR + (size_t)(valid1 ? m1 : MV - 1) * SHC + c01;
          v4u ua[4], ub[4]; const v4u z4 = (v4u){0u, 0u, 0u, 0u};
#pragma unroll
          for (int q = 0; q < 4; ++q) { ua[q] = *(const GAS v4u*)(p + 8 * q); ub[q] = z4; }
          if (valid1 && m1 >= MP) { const float* pv = A.in[5] + (size_t)(m1 - MP) * SHC + c01;
#pragma unroll
              for (int q = 0; q < 8; ++q) xb[q] = *(const GAS f32x4*)(pv + 4 * q); }
          else { if (valid1 && (m1 & (SEQ - 1)) != 0) {
#pragma unroll
                  for (int q = 0; q < 4; ++q) ub[q] = *(const GAS v4u*)(p - SHC + 8 * q); }
#pragma unroll
              for (int q = 0; q < 4; ++q) { xb[2 * q] = (f32x4){__builtin_bit_cast(float, ub[q].x << 16), __builtin_bit_cast(float, ub[q].x & 0xffff0000u), __builtin_bit_cast(float, ub[q].y << 16), __builtin_bit_cast(float, ub[q].y & 0xffff0000u)};
                  xb[2 * q + 1] = (f32x4){__builtin_bit_cast(float, ub[q].z << 16), __builtin_bit_cast(float, ub[q].z & 0xffff0000u), __builtin_bit_cast(float, ub[q].w << 16), __builtin_bit_cast(float, ub[q].w & 0xffff0000u)}; } }
#pragma unroll
          for (int q = 0; q < 4; ++q) { xa[2 * q] = (f32x4){__builtin_bit_cast(float, ua[q].x << 16), __builtin_bit_cast(float, ua[q].x & 0xffff0000u), __builtin_bit_cast(float, ua[q].y << 16), __builtin_bit_cast(float, ua[q].y & 0xffff0000u)};
              xa[2 * q + 1] = (f32x4){__builtin_bit_cast(float, ua[q].z << 16), __builtin_bit_cast(float, ua[q].z & 0xffff0000u), __builtin_bit_cast(float, ua[q].w << 16), __builtin_bit_cast(float, ua[q].w & 0xffff0000u)}; } }
        const int t3 = lane >> 3, cq = lane & 7, tok3 = 8 * wave + t3, m3 = m0 + tok3, hc0 = 64 * h + 8 * cq;
        const bool valid3 = m3 < MV;
        f32x4 cr[2], ck[2], cv[2], pr[2], pk[2], pv3[2];
        { const bf16* p = PR + (size_t)(valid3 ? m3 : MV - 1) * SHC + hc0;
#define UNP(u, lo, hi) { lo = (f32x4){__builtin_bit_cast(float, u.x << 16), __builtin_bit_cast(float, u.x & 0xffff0000u), __builtin_bit_cast(float, u.y << 16), __builtin_bit_cast(float, u.y & 0xffff0000u)}; \
                         hi = (f32x4){__builtin_bit_cast(float, u.z << 16), __builtin_bit_cast(float, u.z & 0xffff0000u), __builtin_bit_cast(float, u.w << 16), __builtin_bit_cast(float, u.w & 0xffff0000u)}; }
          const v4u z4 = (v4u){0u, 0u, 0u, 0u};
          const v4u u0 = *(const GAS v4u*)p, u1 = *(const GAS v4u*)(p + RWW), u2 = *(const GAS v4u*)(p + 2 * RWW);
          v4u w0_ = z4, w1_ = z4, w2_ = z4;
          if (valid3 && m3 >= MP) { const float* q = A.in[5] + (size_t)(m3 - MP) * SHC + hc0;
#pragma unroll
              for (int e = 0; e < 2; ++e) { pr[e] = *(const GAS f32x4*)(q + 4 * e); pk[e] = *(const GAS f32x4*)(q + RWW + 4 * e); pv3[e] = *(const GAS f32x4*)(q + 2 * RWW + 4 * e); } }
          else { if (valid3 && (m3 & (SEQ - 1)) != 0) { w0_ = *(const GAS v4u*)(p - SHC); w1_ = *(const GAS v4u*)(p - SHC + RWW); w2_ = *(const GAS v4u*)(p - SHC + 2 * RWW); }
              UNP(w0_, pr[0], pr[1]) UNP(w1_, pk[0], pk[1]) UNP(w2_, pv3[0], pv3[1]) }
          UNP(u0, cr[0], cr[1]) UNP(u1, ck[0], ck[1]) UNP(u2, cv[0], cv[1])
#undef UNP
        }
#pragma unroll
        for (int q = 0; q < 8; ++q) {
            const f32x4 m4 = *(const GAS f32x4*)(mu + c01 + 4 * q);
            f32x4 x = xa[q] + m4 * (xb[q] - xa[q]);
            if (cc < 2) { x.x = tanhf_(x.x); x.y = tanhf_(x.y); x.z = tanhf_(x.z); x.w = tanhf_(x.w); }
            else if (cc >= 4) { x.x = sigmoidf_(x.x); x.y = sigmoidf_(x.y); x.z = sigmoidf_(x.z); x.w = sigmoidf_(x.w); }
            if (!valid1) x = (f32x4){0.f, 0.f, 0.f, 0.f};
            *(LAS unsigned long long*)(lds + PA_OFF + row1 * PA_PITCH + (32 * cc + 4 * q) * 2) = (unsigned long long)pk2(x.x, x.y) | ((unsigned long long)pk2(x.z, x.w) << 32);
        }
        __syncthreads();
#pragma unroll
        for (int mat = 0; mat < 3; ++mat) { const int kbase = mat == 0 ? 0 : (mat == 1 ? 64 : 128), KM = mat == 2 ? 128 : 64;
#pragma unroll
            for (int n2 = 0; n2 < 2; ++n2) { const int nt = 2 * nh + n2; f32x4 acc = (f32x4){0.f, 0.f, 0.f, 0.f};
#pragma unroll
                for (int ks = 0; ks < KM / 32; ++ks) {
                    const bf16x8 a = *(const LAS bf16x8*)(lds + PA_OFF + (16 * mtile + ln) * PA_PITCH + (kbase + 32 * ks + 8 * q4) * 2);
                    const bf16x8 bq = *(const GAS bf16x8*)((const bf16*)(ws + (mat == 0 ? WS_W2T : (mat == 1 ? WS_A2T : WS_G2T))) + (size_t)(64 * h + 16 * nt + ln) * KM + 32 * ks + 8 * q4);
                    acc = __builtin_amdgcn_mfma_f32_16x16x32_bf16(a, bq, acc, 0, 0, 0); }
                LAS float* o = (LAS float*)(lds + PW_OFF + mat * PMAT);
#pragma unroll
                for (int r = 0; r < 4; ++r) o[(16 * mtile + 4 * q4 + r) * PW_LD + 16 * nt + ln] = acc[r]; } }
        __syncthreads();
        { const LAS float* cst = (const LAS float*)(lds + PC_OFF) + 8 * cq;
          const LAS float* Wp = (const LAS float*)(lds + PW_OFF) + tok3 * PW_LD + 8 * cq; const LAS float* Ap = Wp + PMAT / 4; const LAS float* Gp = Ap + PMAT / 4;
          float xr[8], xk[8], xv[8], kkr[8], kp[8], aa[8], gg[8], dec[8], lw2[8]; float n2 = 0.f, bon = 0.f;
#pragma unroll
          for (int e = 0; e < 2; ++e) {
              const f32x4 mur = *(const LAS f32x4*)(cst + 0 * 64 + 4 * e), muk = *(const LAS f32x4*)(cst + 1 * 64 + 4 * e), muv = *(const LAS f32x4*)(cst + 2 * 64 + 4 * e);
              const f32x4 w0 = *(const LAS f32x4*)(cst + 3 * 64 + 4 * e), a0 = *(const LAS f32x4*)(cst + 4 * 64 + 4 * e), k_k = *(const LAS f32x4*)(cst + 5 * 64 + 4 * e);
              const f32x4 k_a = *(const LAS f32x4*)(cst + 6 * 64 + 4 * e), r_k = *(const LAS f32x4*)(cst + 7 * 64 + 4 * e);
              const f32x4 wl = *(const LAS f32x4*)(Wp + 4 * e), al = *(const LAS f32x4*)(Ap + 4 * e), gl = *(const LAS f32x4*)(Gp + 4 * e);
              const f32x4 r4 = cr[e] + mur * (pr[e] - cr[e]), k4 = ck[e] + muk * (pk[e] - ck[e]), v4 = cv[e] + muv * (pv3[e] - cv[e]);
#pragma unroll
              for (int j = 0; j < 4; ++j) { const int i = 4 * e + j;
                  xr[i] = r4[j]; xk[i] = k4[j]; xv[i] = v4[j];
                  lw2[i] = -0.6065306597126334f * LOG2E * sigmoidf_(w0[j] + wl[j]); dec[i] = __builtin_amdgcn_exp2f(lw2[i]);
                  aa[i] = sigmoidf_(a0[j] + al[j]); gg[i] = gl[j];
                  kkr[i] = xk[i] * k_k[j]; n2 += kkr[i] * kkr[i];
                  kp[i] = xk[i] * (1.0f + (aa[i] - 1.0f) * k_a[j]);
                  bon += xr[i] * kp[i] * r_k[j]; } }
          n2 = qsum8(n2); bon = qsum8(bon);
          const float inv = 1.0f / fmaxf(sqrtf(n2), 1e-12f);
          float lgv[8], eev[8], bbv[8];
          { const f32x4 lw0 = *(const LAS f32x4*)(cst + 8 * 64), lw1 = *(const LAS f32x4*)(cst + 8 * 64 + 4), lb0 = *(const LAS f32x4*)(cst + 9 * 64), lb1 = *(const LAS f32x4*)(cst + 9 * 64 + 4);
#pragma unroll
            for (int i = 0; i < 8; ++i) { kkr[i] *= inv; bbv[i] = kkr[i] * aa[i]; const float lw = i < 4 ? lw0[i & 3] : lw1[i & 3], lb = i < 4 ? lb0[i & 3] : lb1[i & 3]; lgv[i] = lw * gg[i]; eev[i] = (lb + bon * xv[i]) * gg[i]; } }
#define PK8(a) (v4u){pk2(a[0], a[1]), pk2(a[2], a[3]), pk2(a[4], a[5]), pk2(a[6], a[7])}
          if (valid3) { const size_t o = (size_t)m3 * RWW + hc0;
              *(GAS v4u*)((bf16*)(ws + WS_LG) + o) = PK8(lgv); *(GAS v4u*)((bf16*)(ws + WS_EE) + o) = PK8(eev); }
          if (m0 >= MP) {
              if (valid3) { float* dv = (float*)(ws + WS_DEC) + (size_t)(m3 - MP) * RWW + hc0;
#define ST8(arr, a) { *(GAS f32x4*)(dv + (size_t)(arr) * NDEC * RWW) = (f32x4){a[0], a[1], a[2], a[3]}; *(GAS f32x4*)(dv + (size_t)(arr) * NDEC * RWW + 4) = (f32x4){a[4], a[5], a[6], a[7]}; }
                  ST8(0, kkr) ST8(1, dec) ST8(2, bbv) ST8(3, kp) ST8(4, xr) ST8(5, xv)
#undef ST8
              }
          } else {
              *(LAS f32x4*)(lds + LW_OFF + (tok3 * 64 + 8 * cq) * 4) = (f32x4){lw2[0], lw2[1], lw2[2], lw2[3]}; *(LAS f32x4*)(lds + LW_OFF + (tok3 * 64 + 8 * cq) * 4 + 16) = (f32x4){lw2[4], lw2[5], lw2[6], lw2[7]};
              __syncthreads();
              const int cch = tok3 >> 4, t_ = tok3 & 15;
              float Lall[8], Lt[8];
#pragma unroll
              for (int i = 0; i < 8; ++i) { Lall[i] = 0.f; Lt[i] = 0.f; }
#pragma unroll
              for (int s_ = 0; s_ < 16; ++s_) { const LAS float* rp = (const LAS float*)(lds + LW_OFF + ((16 * cch + s_) * 64 + 8 * cq) * 4); const f32x4 a_ = *(const LAS f32x4*)rp, b_ = *(const LAS f32x4*)(rp + 4);
                  const bool in_ = s_ <= t_;
#pragma unroll
                  for (int i = 0; i < 4; ++i) { Lall[i] += a_[i]; Lall[4 + i] += b_[i]; Lt[i] += in_ ? a_[i] : 0.f; Lt[4 + i] += in_ ? b_[i] : 0.f; } }
              unsigned char* blk = chunk_block(ws, ((m0 >> 11) * RWH + h) * NCHUNK + ((m0 & (SEQ - 1)) >> 4) + cch);
              float ah[8], rh[8], bh[8], kh[8], bg[8], kg[8], gcv[8];
#pragma unroll
              for (int i = 0; i < 8; ++i) { const float gt = __builtin_amdgcn_exp2f(Lt[i]), gp = __builtin_amdgcn_exp2f(Lt[i] - lw2[i]), ig = __builtin_amdgcn_exp2f(-Lt[i]), gr = __builtin_amdgcn_exp2f(Lall[i] - Lt[i]);
                  ah[i] = gp * kkr[i]; rh[i] = gt * xr[i]; bh[i] = bbv[i] * ig; kh[i] = kp[i] * ig; bg[i] = bbv[i] * gr; kg[i] = kp[i] * gr; gcv[i] = __builtin_amdgcn_exp2f(Lall[i]); }
              if (t_ == 15) { *(GAS f32x4*)(blk + CB_GC + 32 * cq) = (f32x4){gcv[0], gcv[1], gcv[2], gcv[3]}; *(GAS f32x4*)(blk + CB_GC + 32 * cq + 16) = (f32x4){gcv[4], gcv[5], gcv[6], gcv[7]}; }
              { LAS unsigned char* sc = lds + CS2_OFF + cch * 16384;
                const int ks_ = cq >> 2, qa = 2 * (cq & 1), e0 = 4 * ((cq & 3) >> 1);
                const int a0_ = ((ks_ * 64 + qa * 16 + t_) * 8 + e0) * 2, a1_ = a0_ + 16 * 16;
#define W8(off, a) { *(LAS unsigned long long*)(sc + (off) + a0_) = (unsigned long long)cvtpk_c(a[0], a[1]) | ((unsigned long long)cvtpk_c(a[2], a[3]) << 32); \
                     *(LAS unsigned long long*)(sc + (off) + a1_) = (unsigned long long)cvtpk_c(a[4], a[5]) | ((unsigned long long)cvtpk_c(a[6], a[7]) << 32); }
                W8(SC_FA, ah) W8(SC_FR, rh) W8(SC_FBH, bh) W8(SC_FKH, kh)
#undef W8
#pragma unroll
                for (int i = 0; i < 8; ++i) { const int j_ = 8 * cq + i, off = (((j_ >> 4) * 64 + (t_ >> 2) * 16 + (j_ & 15)) * 4 + (t_ & 3)) * 2;
                    *(LAS unsigned short*)(sc + SC_FBG + off) = (unsigned short)cvtpk_c(bg[i], 0.f); *(LAS unsigned short*)(sc + SC_FKG + off) = (unsigned short)cvtpk_c(kg[i], 0.f);
                    *(LAS unsigned short*)(sc + SC_FV + off) = (unsigned short)cvtpk_c(xv[i], 0.f); } }
              __syncthreads();
              { unsigned char* blkw = chunk_block(ws, ((m0 >> 11) * RWH + h) * NCHUNK + ((m0 & (SEQ - 1)) >> 4) + (wave & 3));
                if (wave < 4) chunk_mm(lds, wave, blkw, lane); else chunk_copy(lds, wave - 4, blkw, lane); }
              __syncthreads();
          }
#undef PK8
        }
    }
}

constexpr int AK_PITCH = 144, AV_PITCH = 592, AP_PITCH = 336;
constexpr int AK_OFF = 0, AV_OFF = 272 * AK_PITCH  , AP_OFF = AV_OFF + 64 * AV_PITCH  , AB_OFF = AP_OFF + 8 * 16 * AP_PITCH  ;
static_assert(AB_OFF + 129 * 4 * 4 <= RING_BYTES, "attention LDS");
__device__ __forceinline__ void attn_unit(Frame& F, const Args& A, int b, int blk, int hk) {
    const int tid = F.tid, lane = F.lane, wave = F.wave;
    unsigned char* ws = F.ws; LAS unsigned char* lds = F.lds;
    const bf16* QB = (const bf16*)(ws + WS_QB); const bf16* KB = (const bf16*)(ws + WS_KB); const bf16* VB = (const bf16*)(ws + WS_VB); bf16* MX = (bf16*)(ws + WS_MIX);
    const int mq0 = b * SEQ + blk * 128, mk0 = mq0 - 128;
    for (int i = tid; i < 16 * AK_PITCH / 4; i += NWAVES * 64) ((LAS unsigned*)(lds + AK_OFF + 256 * AK_PITCH))[i] = 0u;
    for (int i = tid; i < 64 * 16; i += NWAVES * 64) ((LAS unsigned*)(lds + AV_OFF + (i >> 4) * AV_PITCH + 512))[i & 15] = 0u;
#pragma unroll
    for (int it = 0; it < 4; ++it) { const int idx = it * 512 + tid, row = idx >> 3, ch = idx & 7;
        v4u kv = (v4u){0u, 0u, 0u, 0u}, vv = kv;
        if (blk > 0 || row >= 128) { kv = *(const GAS v4u*)(KB + (size_t)(mk0 + row) * KVW + hk * 64 + ch * 8); vv = *(const GAS v4u*)(VB + (size_t)(mk0 + row) * KVW + hk * 64 + ch * 8); }
        *(LAS v4u*)(lds + AK_OFF + row * AK_PITCH + ch * 16) = kv;
        LAS unsigned short* vt = (LAS unsigned short*)(lds + AV_OFF + (8 * ch) * AV_PITCH + row * 2);
        vt[0 * (AV_PITCH / 2)] = (unsigned short)(vv.x & 0xffffu); vt[1 * (AV_PITCH / 2)] = (unsigned short)(vv.x >> 16);
        vt[2 * (AV_PITCH / 2)] = (unsigned short)(vv.y & 0xffffu); vt[3 * (AV_PITCH / 2)] = (unsigned short)(vv.y >> 16);
        vt[4 * (AV_PITCH / 2)] = (unsigned short)(vv.z & 0xffffu); vt[5 * (AV_PITCH / 2)] = (unsigned short)(vv.z >> 16);
        vt[6 * (AV_PITCH / 2)] = (unsigned short)(vv.w & 0xffffu); vt[7 * (AV_PITCH / 2)] = (unsigned short)(vv.w >> 16); }
    { const float* bt = (const float*)(ws + WS_BIAS); LAS float* bl = (LAS float*)(lds + AB_OFF);
      for (int i = tid; i < 129 * 4; i += NWAVES * 64) bl[i] = bt[(i >> 2) * NQH + 4 * hk + (i & 3)]; }
    __syncthreads();
    const int g = wave >> 1, half = wave & 1, head = 4 * hk + g, ln = lane & 15, q4 = lane >> 4;
    const float sink2 = A.in[13][head] * LOG2E;
    const LAS float* bl = (const LAS float*)(lds + AB_OFF);
    LAS unsigned char* Pw = lds + AP_OFF + wave * (16 * AP_PITCH);
    bf16x8 qfa[4][2];
#pragma unroll
    for (int rb = 0; rb < 4; ++rb)
#pragma unroll
        for (int ks = 0; ks < 2; ++ks) qfa[rb][ks] = *(const GAS bf16x8*)(QB + (size_t)(mq0 + 64 * half + 16 * rb + ln) * ATTW + head * 64 + 32 * ks + 8 * q4);
#pragma unroll
    for (int rb = 0; rb < 4; ++rb) {
        const int i0 = 64 * half + 16 * rb, kt0 = i0 >> 4;
        bf16x8 qf[2]; qf[0] = qfa[rb][0]; qf[1] = qfa[rb][1];
        f32x4 s[10];
#pragma unroll
        for (int j = 0; j < 10; ++j) { f32x4 acc = (f32x4){0.f, 0.f, 0.f, 0.f};
#pragma unroll
            for (int ks = 0; ks < 2; ++ks) { const bf16x8 kf = *(const LAS bf16x8*)(lds + AK_OFF + (16 * (kt0 + j) + ln) * AK_PITCH + (32 * ks + 8 * q4) * 2);
                acc = __builtin_amdgcn_mfma_f32_16x16x32_bf16(qf[ks], kf, acc, 0, 0, 0); }
            s[j] = acc; }
        float mx[4] = {-INFINITY, -INFINITY, -INFINITY, -INFINITY};
#pragma unroll
        for (int j = 0; j < 10; ++j) { const int kj = 16 * (kt0 + j) + ln;
#pragma unroll
            for (int r = 0; r < 4; ++r) { const int dist = 128 + i0 + 4 * q4 + r - kj; const bool ok = dist >= 0 && dist <= 128 && (blk > 0 || kj >= 128);
                const int dc = dist < 0 ? 0 : (dist > 128 ? 128 : dist);
                const float v = ok ? s[j][r] + bl[dc * 4 + g] : -INFINITY; s[j][r] = v; mx[r] = fmaxf(mx[r], v); } }
        float l[4];
#pragma unroll
        for (int r = 0; r < 4; ++r) { float m_ = mx[r]; m_ = fmaxf(m_, __shfl_xor(m_, 1)); m_ = fmaxf(m_, __shfl_xor(m_, 2)); m_ = fmaxf(m_, __shfl_xor(m_, 4)); m_ = fmaxf(m_, __shfl_xor(m_, 8));
            mx[r] = fmaxf(m_, sink2); l[r] = 0.f; }
#pragma unroll
        for (int j = 0; j < 10; ++j)
#pragma unroll
            for (int r = 0; r < 4; ++r) { const float p = __builtin_amdgcn_exp2f(s[j][r] - mx[r]); l[r] += p;
                *(LAS unsigned short*)(Pw + (4 * q4 + r) * AP_PITCH + (16 * j + ln) * 2) = f2bfs(p); }
#pragma unroll
        for (int r = 0; r < 4; ++r) { float t = l[r]; t += __shfl_xor(t, 1); t += __shfl_xor(t, 2); t += __shfl_xor(t, 4); t += __shfl_xor(t, 8);
            l[r] = __builtin_amdgcn_rcpf(t + __builtin_amdgcn_exp2f(sink2 - mx[r])); }
        f32x4 o[4];
#pragma unroll
        for (int dt = 0; dt < 4; ++dt) o[dt] = (f32x4){0.f, 0.f, 0.f, 0.f};
#pragma unroll
        for (int st = 0; st < 5; ++st) { const bf16x8 pf = *(const LAS bf16x8*)(Pw + ln * AP_PITCH + (32 * st + 8 * q4) * 2);
#pragma unroll
            for (int dt = 0; dt < 4; ++dt) { const bf16x8 vf = *(const LAS bf16x8*)(lds + AV_OFF + (16 * dt + ln) * AV_PITCH + (16 * kt0 + 32 * st + 8 * q4) * 2);
                o[dt] = __builtin_amdgcn_mfma_f32_16x16x32_bf16(pf, vf, o[dt], 0, 0, 0); } }
#pragma unroll
        for (int dt = 0; dt < 4; ++dt)
#pragma unroll
            for (int r = 0; r < 4; ++r) *(LAS unsigned short*)(Pw + (4 * q4 + r) * AP_PITCH + (16 * dt + ln) * 2) = f2bfs(o[dt][r] * l[r]);
#pragma unroll
        for (int i = 0; i < 2; ++i) { const int qrow = 8 * i + (lane >> 3), ch = lane & 7;
            const v4u ov = *(const LAS v4u*)(Pw + qrow * AP_PITCH + ch * 16);
            *(GAS v4u*)(MX + (size_t)(mq0 + i0 + qrow) * DM + head * 64 + ch * 8) = ov; }
    }
    __syncthreads();
}

__device__ __forceinline__ void dec_attn_unit(Frame& F, const Args& A, int du) {
    const int lane = F.lane, wave = F.wave; unsigned char* ws = F.ws;
    const int idx = du * 8 + wave, b = idx >> 4, head = idx & 15, hk = head >> 2, m = MP + b;
    LAS float* qs = (LAS float*)(F.lds + wave * 1024); LAS float* ps = qs + 64;
    const bf16* QB = (const bf16*)(ws + WS_QB); bf16* MX = (bf16*)(ws + WS_MIX);
    const float* bt = (const float*)(ws + WS_BIAS);
    const float sink2 = A.in[13][head] * LOG2E;
    const float qv = bf2f(QB[(size_t)m * ATTW + head * 64 + lane]);
    qs[lane] = qv;
    LDS_WAIT(); asm volatile("" ::: "memory");
    float sc[2];
#pragma unroll
    for (int pi = 0; pi < 2; ++pi) { const int pos = lane + 64 * pi; const float* kr = A.in[2] + ((size_t)(b * WIN + pos) * NKVH + hk) * HD; float d = 0.f;
#pragma unroll
        for (int j = 0; j < 16; ++j) { const f32x4 k4 = *(const f32x4*)(kr + 4 * j); const f32x4 q4v = *(const LAS f32x4*)(qs + 4 * j); d += (k4.x * q4v.x + k4.y * q4v.y) + (k4.z * q4v.z + k4.w * q4v.w); }
        sc[pi] = d + bt[(WIN - pos) * NQH + head]; }
    const float* kn = F.out + O_KS + ((size_t)b * WIN + (WIN - 1)) * KVW + hk * HD; const float* vn = F.out + O_VS + ((size_t)b * WIN + (WIN - 1)) * KVW + hk * HD;
    const float snew = wave_sum(qv * kn[lane]) + bt[head];
    const float mx = fmaxf(fmaxf(wave_max(fmaxf(sc[0], sc[1])), snew), sink2);
    const float p0 = __builtin_amdgcn_exp2f(sc[0] - mx), p1 = __builtin_amdgcn_exp2f(sc[1] - mx), pn = __builtin_amdgcn_exp2f(snew - mx);
    const float linv = __builtin_amdgcn_rcpf(wave_sum(p0 + p1) + pn + __builtin_amdgcn_exp2f(sink2 - mx));
    ps[lane] = p0; ps[lane + 64] = p1;
    LDS_WAIT(); asm volatile("" ::: "memory");
    const float* vr = A.in[3] + ((size_t)(b * WIN) * NKVH + hk) * HD + lane; float o = pn * vn[lane];
#pragma unroll 8
    for (int pos = 0; pos < WIN; ++pos) o += ps[pos] * vr[(size_t)pos * NKVH * HD];
    MX[(size_t)m * DM + head * 64 + lane] = f2bfs(o * linv);
    LDS_WAIT(); asm volatile("" ::: "memory");
}

constexpr int SC_T = 32, SC_REC = 1344  , SC_BUF = SC_T * SC_REC  ;
struct ScanRegs { v4u kk, bb, kp, rr, vv; f32x4 d0, d1; };
__device__ __forceinline__ void scan_load(ScanRegs& R, const unsigned char* ws, int m, int h, int rq, int part) {
    const size_t o = (size_t)m * RWW + 64 * h + 8 * part;
    R.kk = *(const GAS v4u*)((const bf16*)(ws + WS_KK) + o); R.bb = *(const GAS v4u*)((const bf16*)(ws + WS_BB) + o);
    R.kp = *(const GAS v4u*)((const bf16*)(ws + WS_KP) + o); R.rr = *(const GAS v4u*)((const bf16*)(ws + WS_RR) + o);
    R.d0 = *(const GAS f32x4*)((const float*)(ws + WS_DD) + o); R.d1 = *(const GAS f32x4*)((const float*)(ws + WS_DD) + o + 4);
    R.vv = (v4u){0u, 0u, 0u, 0u};
    if (part < 2) R.vv = *(const GAS v4u*)((const bf16*)(ws + WS_VV) + (size_t)m * RWW + 64 * h + 16 * rq + 8 * part);
}
__device__ __forceinline__ void st8(LAS unsigned char* p, v4u u) {
    *(LAS f32x4*)p = (f32x4){__builtin_bit_cast(float, u.x << 16), __builtin_bit_cast(float, u.x & 0xffff0000u), __builtin_bit_cast(float, u.y << 16), __builtin_bit_cast(float, u.y & 0xffff0000u)};
    *(LAS f32x4*)(p + 16) = (f32x4){__builtin_bit_cast(float, u.z << 16), __builtin_bit_cast(float, u.z & 0xffff0000u), __builtin_bit_cast(float, u.w << 16), __builtin_bit_cast(float, u.w & 0xffff0000u)};
}
__device__ __forceinline__ void scan_store(const ScanRegs& R, LAS unsigned char* rec, int part) {
    st8(rec + 0 + 32 * part, R.kk); *(LAS f32x4*)(rec + 256 + 32 * part) = R.d0; *(LAS f32x4*)(rec + 256 + 32 * part + 16) = R.d1;
    st8(rec + 512 + 32 * part, R.bb); st8(rec + 768 + 32 * part, R.kp); st8(rec + 1024 + 32 * part, R.rr);
    if (part < 2) st8(rec + 1280 + 32 * part, R.vv);
}
constexpr int SC_YOFF = 2 * SC_BUF, SC_YBUF = SC_T * 16 * 4 * 4  ;
static_assert(SC_YOFF + 2 * SC_YBUF <= RING_BYTES, "scan LDS");
struct ScanVec { f32x2 kk0, kk1, d0, d1, b0, b1, k0, k1, r0, r1; float v; };
__device__ __forceinline__ void scan_ld(ScanVec& x, const LAS unsigned char* base, const LAS unsigned char* vb, int t) {
    const f32x4 kk = *(const LAS f32x4*)(base + t * SC_REC), dd = *(const LAS f32x4*)(base + t * SC_REC + 256), bb = *(const LAS f32x4*)(base + t * SC_REC + 512),
                kp = *(const LAS f32x4*)(base + t * SC_REC + 768), rr = *(const LAS f32x4*)(base + t * SC_REC + 1024);
    x.kk0 = (f32x2){kk.x, kk.y}; x.kk1 = (f32x2){kk.z, kk.w}; x.d0 = (f32x2){dd.x, dd.y}; x.d1 = (f32x2){dd.z, dd.w}; x.b0 = (f32x2){bb.x, bb.y}; x.b1 = (f32x2){bb.z, bb.w};
    x.k0 = (f32x2){kp.x, kp.y}; x.k1 = (f32x2){kp.z, kp.w}; x.r0 = (f32x2){rr.x, rr.y}; x.r1 = (f32x2){rr.z, rr.w};
    x.v = *(const LAS float*)(vb + t * SC_REC);
}
__device__ __forceinline__ void scan_yflush(const LAS unsigned char* yb, float* YS, int ptid) {
#pragma unroll
    for (int i = 0; i < 2; ++i) { const int o = ptid + 256 * i, t = o >> 4, r = o & 15; const f32x4 q = *(const LAS f32x4*)(yb + o * 16);
        YS[(size_t)t * RWW + r] = (q.x + q.y) + (q.z + q.w); }
}
__device__ __forceinline__ void scan_unit(Frame& F, int c) {
    const int b = c >> 6, h = (c >> 2) & 15, rq = c & 3, lane = F.lane, wave = F.wave;
    unsigned char* ws = F.ws; LAS unsigned char* lds = F.lds;
    const int mb = b * SEQ; constexpr int NCH = SEQ / SC_T;
    if (wave >= 4) {
        const int ptid = F.tid - 256, tok = ptid >> 3, part = ptid & 7;
        float* YS = (float*)(ws + WS_ACT) + (size_t)mb * RWW + 64 * h + 16 * rq;
        ScanRegs cur, nxt;
        scan_load(cur, ws, mb + tok, h, rq, part);
        scan_load(nxt, ws, mb + SC_T + tok, h, rq, part);
        scan_store(cur, lds + tok * SC_REC, part);
        __syncthreads();
        for (int ch = 0; ch < NCH; ++ch) {
            cur = nxt;
            if (ch + 2 < NCH) scan_load(nxt, ws, mb + (ch + 2) * SC_T + tok, h, rq, part);
            if (ch + 1 < NCH) scan_store(cur, lds + ((ch + 1) & 1) * SC_BUF + tok * SC_REC, part);
            if (ch > 0) scan_yflush(lds + SC_YOFF + ((ch - 1) & 1) * SC_YBUF, YS + (size_t)(ch - 1) * SC_T * RWW, ptid);
            __syncthreads();
        }
        scan_yflush(lds + SC_YOFF + ((NCH - 1) & 1) * SC_YBUF, YS + (size_t)(NCH - 1) * SC_T * RWW, ptid);
    } else {
        const int rl = 4 * wave + (lane >> 4), p = lane & 15, row = 16 * rq + rl;
        f32x2 S0 = (f32x2){0.f, 0.f}, S1 = S0;
        __builtin_amdgcn_s_setprio(2);
        __syncthreads();
        for (int ch = 0; ch < NCH; ++ch) {
            const LAS unsigned char* base = lds + (ch & 1) * SC_BUF + p * 16;
            const LAS unsigned char* vb = lds + (ch & 1) * SC_BUF + 1280 + rl * 4;
            LAS unsigned char* yb = lds + SC_YOFF + (ch & 1) * SC_YBUF + (rl * 4 + (p & 3)) * 4;
            ScanVec cur; scan_ld(cur, base, vb, 0);
#pragma unroll
            for (int t = 0; t < SC_T; ++t) {
                ScanVec nxt; scan_ld(nxt, base, vb, t + 1 < SC_T ? t + 1 : t);
                f32x2 a = S0 * cur.kk0; a = S1 * cur.kk1 + a;
                const float sa = -allsum16(a.x + a.y);
                const f32x2 sa2 = (f32x2){sa, sa}, v2 = (f32x2){cur.v, cur.v};
                f32x2 u0 = cur.b0 * sa2, u1 = cur.b1 * sa2;
                u0 = S0 * cur.d0 + u0; u1 = S1 * cur.d1 + u1;
                S0 = cur.k0 * v2 + u0; S1 = cur.k1 * v2 + u1;
                f32x2 q = S0 * cur.r0; q = S1 * cur.r1 + q;
                float y = q.x + q.y; y += dpp_f<0x128>(y); y += dpp_f<0x124>(y);
                *(LAS float*)(yb + t * 256) = y;
                cur = nxt;
            }
            __syncthreads();
        }
        __builtin_amdgcn_s_setprio(0);
        *(f32x4*)(F.out + O_WP + ((size_t)(b * RWH + h) * HD + row) * HD + 4 * p) = (f32x4){S0.x, S0.y, S1.x, S1.y};
    }
}
__device__ __forceinline__ void dec_rwkv_unit(Frame& F, const Args& A, int du) {
    const int lane = F.lane, wave = F.wave; unsigned char* ws = F.ws;
    const int idx = du * 8 + wave, b = idx >> 4, h = idx & 15, m = MP + b;
    LAS float* vec = (LAS float*)(F.lds + wave * 1280);
    const size_t o = (size_t)m * RWW + 64 * h + lane;
    const float* dv = (const float*)(ws + WS_DEC) + (size_t)b * RWW + 64 * h + lane;
    vec[lane] = dv[0]; vec[64 + lane] = dv[(size_t)1 * NDEC * RWW]; vec[128 + lane] = dv[(size_t)2 * NDEC * RWW];
    vec[192 + lane] = dv[(size_t)3 * NDEC * RWW]; vec[256 + lane] = dv[(size_t)4 * NDEC * RWW];
    const float vi = dv[(size_t)5 * NDEC * RWW];
    const size_t so = ((size_t)(b * RWH + h) * HD + lane) * HD;
    const float* Sp = A.in[4] + so; f32x4 S[16];
#pragma unroll
    for (int j = 0; j < 16; ++j) S[j] = *(const f32x4*)(Sp + 4 * j);
    LDS_WAIT(); asm volatile("" ::: "memory");
    float sa = 0.f;
#pragma unroll
    for (int j = 0; j < 16; ++j) { const f32x4 kk = *(const LAS f32x4*)(vec + 4 * j); sa += (S[j].x * kk.x + S[j].y * kk.y) + (S[j].z * kk.z + S[j].w * kk.w); asm volatile("" ::: "memory"); }
    sa = -sa; float y = 0.f; float* So = F.out + O_WS + so;
#pragma unroll
    for (int j = 0; j < 16; ++j) { const f32x4 dd = *(const LAS f32x4*)(vec + 64 + 4 * j), bb = *(const LAS f32x4*)(vec + 128 + 4 * j), kp = *(const LAS f32x4*)(vec + 192 + 4 * j), rr = *(const LAS f32x4*)(vec + 256 + 4 * j);
        S[j] = S[j] * dd + bb * sa + kp * vi; y += (S[j].x * rr.x + S[j].y * rr.y) + (S[j].z * rr.z + S[j].w * rr.w);
        *(f32x4*)(So + 4 * j) = S[j]; asm volatile("" ::: "memory"); }
    ((float*)(ws + WS_ACT))[o] = y;
    LDS_WAIT(); asm volatile("" ::: "memory");
}


constexpr int SC2_NS = 8, SC2_D = SC2_NS - 1;
static_assert(SC2_NS * CB_STRIDE <= RING_BYTES, "scan ring");
__device__ __forceinline__ void scan2_unit(Frame& F, int c) {
    const int b = c >> 4, h = c & 15, lane = F.lane, wave = F.wave;
    unsigned char* ws = F.ws; LAS unsigned char* lds = F.lds;
    const int mb = b * SEQ, g0 = (b * RWH + h) * NCHUNK;
#define SC2_BAR() do { asm volatile("" ::: "memory"); __builtin_amdgcn_s_barrier(); asm volatile("" ::: "memory"); } while (0)
    if (wave >= 4) {
        const int lw = wave - 4;
#define SC2_ISSUE(cc) do { const unsigned char* blk_ = chunk_block(ws, g0 + (cc)); LAS unsigned char* sl_ = lds + ((cc) & (SC2_NS - 1)) * CB_STRIDE; \
            for (int p_ = lw; p_ < 13; p_ += 4) __builtin_amdgcn_global_load_lds((const unsigned*)(blk_ + p_ * 1024 + lane * 16), (LAS unsigned*)(sl_ + p_ * 1024), 16, 0, 0); } while (0)
#define SC2_WAIT() do { if (lw == 0) asm volatile("s_waitcnt vmcnt(20)" ::: "memory"); else asm volatile("s_waitcnt vmcnt(15)" ::: "memory"); } while (0)
        for (int cc = 0; cc < SC2_D; ++cc) SC2_ISSUE(cc);
        SC2_WAIT(); SC2_BAR();
        for (int cc = 0; cc < NCHUNK; ++cc) {
            if (cc + SC2_D < NCHUNK) { SC2_ISSUE(cc + SC2_D); SC2_WAIT(); } else asm volatile("s_waitcnt vmcnt(0)" ::: "memory");
            SC2_BAR();
        }
#undef SC2_ISSUE
#undef SC2_WAIT
    } else {
        const int it = wave, x = lane & 15, q = lane >> 4;
        f32x4 S[4];
#pragma unroll
        for (int jt = 0; jt < 4; ++jt) S[jt] = (f32x4){0.f, 0.f, 0.f, 0.f};
        float* YS = (float*)(ws + WS_ACT) + (size_t)mb * RWW + 64 * h + 16 * it + x;
        bf16x8 fa[2], fr[2]; s16x4 fnk, ft, fmb, fmk, fv, fbg[4], fkg[4]; f32x4 gc[4];
#define SC2_LOAD(cc) do { const LAS unsigned char* sl = lds + ((cc) & (SC2_NS - 1)) * CB_STRIDE; \
            _Pragma("unroll") for (int k2 = 0; k2 < 2; ++k2) { fa[k2] = *(const LAS bf16x8*)(sl + CB_FA + (k2 * 64 + lane) * 16); fr[k2] = *(const LAS bf16x8*)(sl + CB_FR + (k2 * 64 + lane) * 16); } \
            fnk = *(const LAS s16x4*)(sl + CB_FNK + lane * 8); ft = *(const LAS s16x4*)(sl + CB_FT + lane * 8); fmb = *(const LAS s16x4*)(sl + CB_FMB + lane * 8); fmk = *(const LAS s16x4*)(sl + CB_FMK + lane * 8); \
            fv = *(const LAS s16x4*)(sl + CB_FV + (it * 64 + lane) * 8); \
            _Pragma("unroll") for (int jt = 0; jt < 4; ++jt) { fbg[jt] = *(const LAS s16x4*)(sl + CB_FBG + (jt * 64 + lane) * 8); fkg[jt] = *(const LAS s16x4*)(sl + CB_FKG + (jt * 64 + lane) * 8); \
                gc[jt] = *(const LAS f32x4*)(sl + CB_GC + (16 * jt + 4 * q) * 4); } } while (0)
        SC2_BAR();
        SC2_LOAD(0);
        for (int cc = 0; cc < NCHUNK; ++cc) {
            bf16x8 sb[2];
#pragma unroll
            for (int k2 = 0; k2 < 2; ++k2) { const unsigned long long lo = pack4bf(S[2 * k2]), hi = pack4bf(S[2 * k2 + 1]);
                v4u w_; w_.x = (unsigned)lo; w_.y = (unsigned)(lo >> 32); w_.z = (unsigned)hi; w_.w = (unsigned)(hi >> 32); sb[k2] = __builtin_bit_cast(bf16x8, w_); }
            f32x4 X = (f32x4){0.f, 0.f, 0.f, 0.f};
            X = __builtin_amdgcn_mfma_f32_16x16x32_bf16(fa[0], sb[0], X, 0, 0, 0); X = __builtin_amdgcn_mfma_f32_16x16x32_bf16(fa[1], sb[1], X, 0, 0, 0);
            X = __builtin_amdgcn_mfma_f32_16x16x16bf16_1k(fnk, fv, X, 0, 0, 0);
            f32x4 Y = (f32x4){0.f, 0.f, 0.f, 0.f};
            Y = __builtin_amdgcn_mfma_f32_16x16x32_bf16(fr[0], sb[0], Y, 0, 0, 0); Y = __builtin_amdgcn_mfma_f32_16x16x32_bf16(fr[1], sb[1], Y, 0, 0, 0);
            Y = __builtin_amdgcn_mfma_f32_16x16x16bf16_1k(fmk, fv, Y, 0, 0, 0);
            f32x4 Sn[4];
#pragma unroll
            for (int jt = 0; jt < 4; ++jt) Sn[jt] = __builtin_amdgcn_mfma_f32_16x16x16bf16_1k(fkg[jt], fv, S[jt] * gc[jt], 0, 0, 0);
            const s16x4 xb = __builtin_bit_cast(s16x4, pack4bf(X));
            const f32x4 U = __builtin_amdgcn_mfma_f32_16x16x16bf16_1k(ft, xb, (f32x4){0.f, 0.f, 0.f, 0.f}, 0, 0, 0);
            const s16x4 ub = __builtin_bit_cast(s16x4, pack4bf(U));
            Y = __builtin_amdgcn_mfma_f32_16x16x16bf16_1k(fmb, ub, Y, 0, 0, 0);
#pragma unroll
            for (int jt = 0; jt < 4; ++jt) S[jt] = __builtin_amdgcn_mfma_f32_16x16x16bf16_1k(fbg[jt], ub, Sn[jt], 0, 0, 0);
            if (cc + 1 < NCHUNK) SC2_LOAD(cc + 1);
#pragma unroll
            for (int r = 0; r < 4; ++r) YS[(size_t)(16 * cc + 4 * q + r) * RWW] = Y[r];
            asm volatile("s_waitcnt lgkmcnt(0)" ::: "memory");
            SC2_BAR();
        }
#undef SC2_LOAD
#pragma unroll
        for (int jt = 0; jt < 4; ++jt) *(f32x4*)(F.out + O_WP + ((size_t)(b * RWH + h) * HD + 16 * it + x) * HD + 16 * jt + 4 * q) = S[jt];
    }
#undef SC2_BAR
}

constexpr int SK_S = 4;
__device__ __forceinline__ void skinny_units(Frame& F, const bf16* Arows, int lda, const bf16* Bt, int K, unsigned* cnt, float* slabs,
                                             const float* xi_s, const bf16* xb_in, float* xo_s, bf16* XBd, float* ssq, float alpha) {
    const int tid = F.tid, lane = F.lane, wave = F.wave, ln = lane & 15, q4 = lane >> 4, ksteps = K / 32;
    LAS unsigned char* lds = F.lds;
    for (int u = blockIdx.x; u < 32 * SK_S; u += F.G) {
        const int nb = u & 31, sl = u >> 5, n0 = 64 * nb, ks0 = sl * ksteps / SK_S, ks1 = (sl + 1) * ksteps / SK_S;
        f32x4 acc[2][4];
#pragma unroll
        for (int mt = 0; mt < 2; ++mt)
#pragma unroll
            for (int nt = 0; nt < 4; ++nt) acc[mt][nt] = (f32x4){0.f, 0.f, 0.f, 0.f};
        const bf16* ap = Arows + (size_t)ln * lda + 8 * q4; const bf16* bp = Bt + (size_t)(n0 + ln) * K + 8 * q4;
#pragma unroll 2
        for (int ks = ks0 + wave; ks < ks1; ks += 8) { const int k = 32 * ks;
            bf16x8 a[2], b[4];
#pragma unroll
            for (int mt = 0; mt < 2; ++mt) a[mt] = *(const GAS bf16x8*)(ap + (size_t)(16 * mt) * lda + k);
#pragma unroll
            for (int nt = 0; nt < 4; ++nt) b[nt] = *(const GAS bf16x8*)(bp + (size_t)(16 * nt) * K + k);
#pragma unroll
            for (int mt = 0; mt < 2; ++mt)
#pragma unroll
                for (int nt = 0; nt < 4; ++nt) acc[mt][nt] = __builtin_amdgcn_mfma_f32_16x16x32_bf16(a[mt], b[nt], acc[mt][nt], 0, 0, 0); }
#pragma unroll
        for (int mt = 0; mt < 2; ++mt)
#pragma unroll
            for (int nt = 0; nt < 4; ++nt) *(LAS f32x4*)(lds + ((wave * 8 + mt * 4 + nt) * 64 + lane) * 16) = acc[mt][nt];
        __syncthreads();
        { const int tile = tid >> 6, l = tid & 63; f32x4 sum = (f32x4){0.f, 0.f, 0.f, 0.f};
#pragma unroll
          for (int w = 0; w < 8; ++w) sum += *(const LAS f32x4*)(lds + ((w * 8 + tile) * 64 + l) * 16);
          float* sp = slabs + (size_t)sl * 32 * DM + (size_t)(16 * (tile >> 2) + 4 * (l >> 4)) * DM + n0 + 16 * (tile & 3) + (l & 15);
          sp[0] = sum.x; sp[DM] = sum.y; sp[2 * DM] = sum.z; sp[3 * DM] = sum.w; }
        VM_WAIT(); __syncthreads();
        if (tid == 0) { __builtin_amdgcn_fence(__ATOMIC_RELEASE, "agent"); VM_WAIT();
            const unsigned t = __hip_atomic_fetch_add(cnt + nb, 1u, __ATOMIC_RELAXED, __HIP_MEMORY_SCOPE_AGENT);
            const unsigned last = (t == (unsigned)(SK_S - 1)) ? 1u : 0u;
            if (last) { __builtin_amdgcn_fence(__ATOMIC_ACQUIRE, "agent"); VM_WAIT(); }
            *(LAS unsigned*)(lds + 65536) = last; }
        __syncthreads();
        const unsigned last = *(const LAS unsigned*)(lds + 65536);
        if (last) {
            const int row = tid >> 4, c4 = (tid & 15) * 4, col = n0 + c4;
            f32x4 a4 = (f32x4){0.f, 0.f, 0.f, 0.f};
#pragma unroll
            for (int s2 = 0; s2 < SK_S; ++s2) a4 += *(const GAS f32x4*)(slabs + (size_t)s2 * 32 * DM + (size_t)row * DM + col);
            f32x4 x0;
            if (xb_in) { const unsigned long long w = *(const GAS unsigned long long*)(xb_in + (size_t)(MP + row) * DM + col);
                x0 = (f32x4){__builtin_bit_cast(float, (unsigned)w << 16), __builtin_bit_cast(float, (unsigned)w & 0xffff0000u), __builtin_bit_cast(float, (unsigned)(w >> 32) << 16), __builtin_bit_cast(float, (unsigned)(w >> 32) & 0xffff0000u)}; }
            else x0 = *(const f32x4*)(xi_s + (size_t)row * DM + col);
            const f32x4 y = x0 + a4 * alpha;
            if (xo_s) *(f32x4*)(xo_s + (size_t)row * DM + col) = y;
            if (XBd) *(GAS unsigned long long*)(XBd + (size_t)(MP + row) * DM + col) = (unsigned long long)pk2(y.x, y.y) | ((unsigned long long)pk2(y.z, y.w) << 32);
            float sq = (y.x * y.x + y.y * y.y) + (y.z * y.z + y.w * y.w);
            sq += __shfl_xor(sq, 1); sq += __shfl_xor(sq, 2); sq += __shfl_xor(sq, 4); sq += __shfl_xor(sq, 8);
            if ((tid & 15) == 0) atomicAdd(ssq + MP + row, sq);
        }
        __syncthreads();
    }
}
__global__ void __launch_bounds__(NWAVES * 64, 2) hymba_fwd(Args args) {
    extern __shared__ __attribute__((aligned(16))) unsigned char lds_raw[];
    { const int t0_ = threadIdx.x;
      for (int u = t0_; u < (LDS_BYTES - LDSCTL_OFF) / 4; u += NWAVES * 64) ((LAS unsigned*)((LAS unsigned char*)lds_raw + LDSCTL_OFF))[u] = 0u; }
    __syncthreads();
    XcdBarrier bar; bar.bar = (unsigned*)((gu32*)(args.ws + WS_CTL) + CW_BAR); bar.x = 0; bar.st = nullptr;
    if (MK_N_LAUNCHES == 1) bar = xcd_barrier_post((unsigned*)((gu32*)(args.ws + WS_CTL) + CW_BAR), (volatile LAS unsigned*)((LAS unsigned char*)lds_raw + MISC_OFF) + 8);
    const int lo = args.ph_lo, hi = args.ph_hi;
#ifndef PH_MASK
#define PH_MASK 0x7ff
#endif
#define IN(k) (((PH_MASK >> (k)) & 1) && lo <= (k) && (k) < hi)
#define SEAM(k) do { if (IN(k) && IN((k) + 1)) xcd_barrier(bar); } while (0)
#ifndef PROBE_REP
#define PROBE_REP 0
#endif
#define NREP(k) (1 + ((PROBE_REP >> (k)) & 1))
#define PHASE_FRAME() Frame F; { int t_ = threadIdx.x; asm volatile("" : "+v"(t_)); F.lds = (LAS unsigned char*)lds_raw; F.MISC = (volatile LAS unsigned*)(F.lds + MISC_OFF); F.tid = t_; F.lane = t_ & 63; \
        F.wave = __builtin_amdgcn_readfirstlane(t_ >> 6); F.G = gridDim.x; F.out = args.out; F.ws = args.ws; F.ctl = (gu32*)(args.ws + WS_CTL); } \
    unsigned char* ws = F.ws; const int gw = blockIdx.x * NWAVES + F.wave, NGW = F.G * NWAVES; (void)gw; (void)NGW; \
    bf16* XB = (bf16*)(ws + WS_XB); bf16* ACT = (bf16*)(ws + WS_ACT); bf16* X2B = (bf16*)(ws + WS_X2B); bf16* MIXB = (bf16*)(ws + WS_MIX); (void)XB; (void)ACT; (void)X2B; (void)MIXB; \
    float* ssq0 = (float*)(F.ctl + CW_SSQ0); float* ssq1 = (float*)(F.ctl + CW_SSQ1); float* ssq2 = (float*)(F.ctl + CW_SSQ2); float* ssq3 = (float*)(F.ctl + CW_SSQ3); float* ssqd = (float*)(F.ctl + CW_SSQD); (void)ssqd; (void)ssq0; (void)ssq1; (void)ssq2; (void)ssq3; \
    float* yp = args.out + O_YP; float* ys = args.out + O_YS; (void)yp; (void)ys;

    if (IN(0)) for (int rep = 0; rep < NREP(0); ++rep) { PHASE_FRAME(); p0_prologue(F, args); if (rep + 1 < NREP(0)) xcd_barrier(bar); else SEAM(0); }
    if (IN(1)) for (int rep = 0; rep < NREP(1); ++rep) { PHASE_FRAME(); pg8::Gemm g{XB, (const bf16*)(ws + WS_WGU1), MPAD, 2 * DFF, DM}; pg8::StaticOrder S; S.init(MPAD, 2 * DFF, F.G, (int)blockIdx.x);
        pg8::EpiSwiglu E{ACT, ssq0};
        pg8::gemm_phase<pg8::EpiSwiglu, pg8::StaticOrder, true, true>(F.lds + RING_OFF, g, S, E);
#ifndef CV_ALL_IN_P0
        { const int nfull = S.nwg % F.G; if (rep == 0 && nfull != 0 && (int)blockIdx.x >= nfull) convert_items(F, args, CV_EARLY, CV_LATE1, (int)blockIdx.x - nfull, F.G - nfull);
          else if (rep == 0 && nfull == 0) convert_items(F, args, CV_EARLY, CV_LATE1, blockIdx.x, F.G); }
#endif
        if (rep + 1 < NREP(1)) xcd_barrier(bar); else SEAM(1); }
    if (IN(2)) for (int rep = 0; rep < NREP(2); ++rep) { PHASE_FRAME(); pg8::Gemm g{ACT, (const bf16*)(ws + WS_WD1), MP, DM, DFF}; pg8::StaticOrder S; S.init(MP, DM, F.G, (int)blockIdx.x);
        pg8::EpiResid E{args.in[0], args.in[1], nullptr, nullptr, nullptr, XB, rep ? ssqd : ssq1, 0.5f};
        pg8::gemm_phase<pg8::EpiResid, pg8::StaticOrder, true, true>(F.lds + RING_OFF, g, S, E);
        skinny_units(F, ACT + (size_t)MP * DFF, DFF, (const bf16*)(ws + WS_WD1), DFF, (unsigned*)(F.ctl + CW_SKC + 64 * rep), (float*)(ws + WS_SLAB), args.in[1], nullptr, nullptr, XB, rep ? ssqd : ssq1, 0.5f);
        if (rep + 1 < NREP(2)) xcd_barrier(bar); else SEAM(2); }
    if (IN(3)) for (int rep = 0; rep < NREP(3); ++rep) { PHASE_FRAME(); pg8::Gemm g{XB, (const bf16*)(ws + WS_WINB), MPAD, INC, DM}; pg8::StaticOrder S; S.init(MPAD, INC, F.G, (int)blockIdx.x);
        pg8::EpiWin E{ssq1, (bf16*)(ws + WS_QB), (bf16*)(ws + WS_KB), (bf16*)(ws + WS_VB), (bf16*)(ws + WS_ACT), args.out};
        pg8::gemm_phase<pg8::EpiWin, pg8::StaticOrder, true, true>(F.lds + RING_OFF, g, S, E);
#ifndef CV_ALL_IN_P0
        { const int nfull = S.nwg % F.G; if (rep == 0 && nfull != 0 && (int)blockIdx.x >= nfull) convert_items(F, args, CV_EARLY + CV_LATE1, CV_LATE2, (int)blockIdx.x - nfull, F.G - nfull);
          else if (rep == 0 && nfull == 0) convert_items(F, args, CV_EARLY + CV_LATE1, CV_LATE2, blockIdx.x, F.G); }
#endif
        if (rep + 1 < NREP(3)) xcd_barrier(bar); else SEAM(3); }
    if (IN(4)) for (int rep = 0; rep < NREP(4); ++rep) { PHASE_FRAME();
        for (int r2 = 0; r2 < 1 + ((PROBE_REP >> 12) & 1); ++r2) { __syncthreads(); prep_phase(F, args); }
        if (rep + 1 < NREP(4)) xcd_barrier(bar); else SEAM(4); }
    if (IN(5)) for (int rep = 0; rep < NREP(5); ++rep) { PHASE_FRAME();
        if ((int)blockIdx.x < NB * RWH) scan2_unit(F, blockIdx.x);
        else { const int oc = (int)blockIdx.x - NB * RWH, on = (int)F.G - NB * RWH;
            for (int r2 = 0; r2 < 1 + ((PROBE_REP >> 11) & 1); ++r2)
            for (int u = oc; u < NB * 16 * NKVH; u += on) attn_unit(F, args, u >> 6, (u >> 2) & 15, u & 3);
            __syncthreads();
            for (int u = on - 1 - oc; u < NDEC * NQH / 8; u += on) dec_attn_unit(F, args, u);
            __syncthreads();
            for (int u = on - 1 - oc; u < NDEC * RWH / 8; u += on) dec_rwkv_unit(F, args, u);
            { const int n4 = NDEC * (WIN - 1) * KVW / 4;
              for (int i = oc * (NWAVES * 64) + F.tid; i < 2 * n4; i += on * NWAVES * 64) { const int t = i >= n4, j = t ? i - n4 : i; const int bb = j / ((WIN - 1) * KVW / 4), r = j % ((WIN - 1) * KVW / 4);
                  const f32x4 v = *((const f32x4*)(args.in[2 + t] + (size_t)bb * WIN * KVW + KVW) + r);
                  *((f32x4*)(args.out + (t ? O_VS : O_KS) + (size_t)bb * WIN * KVW) + r) = v; } } }
        if (rep + 1 < NREP(5)) xcd_barrier(bar); else SEAM(5); }
    if (IN(6)) for (int rep = 0; rep < NREP(6); ++rep) { PHASE_FRAME(); const float* YS = (const float*)(ws + WS_ACT); const bf16* LG = (const bf16*)(ws + WS_LG); const bf16* EE = (const bf16*)(ws + WS_EE);
        for (int u = gw; u < MV * RWH; u += NGW) { const size_t o = (size_t)(u >> 4) * RWW + 64 * (u & 15) + F.lane;
            const float y = YS[o], mean = wave_sum(y) * (1.0f / 64.0f), dl = y - mean, var = wave_sum(dl * dl) * (1.0f / 64.0f);
            const float r = dl * __builtin_amdgcn_rsqf(var + GN_EPS) * bf2f(LG[o]) + bf2f(EE[o]);
            MIXB[(size_t)(u >> 4) * DM + ATTW + 64 * (u & 15) + F.lane] = f2bfs(r); }
        if (rep + 1 < NREP(6)) xcd_barrier(bar); else SEAM(6); }
    if (IN(7)) for (int rep = 0; rep < NREP(7); ++rep) { PHASE_FRAME(); pg8::Gemm g{MIXB, (const bf16*)(ws + WS_WOUT), MP, DM, DM}; pg8::StaticOrder S; S.init(MP, DM, F.G, (int)blockIdx.x);
        pg8::EpiResid E{nullptr, nullptr, XB, nullptr, nullptr, X2B, rep ? ssqd : ssq2, 1.0f};
        pg8::gemm_phase<pg8::EpiResid, pg8::StaticOrder, true, true>(F.lds + RING_OFF, g, S, E);
        skinny_units(F, MIXB + (size_t)MP * DM, DM, (const bf16*)(ws + WS_WOUT), DM, (unsigned*)(F.ctl + CW_SKC + 128 + 64 * rep), (float*)(ws + WS_SLAB), nullptr, XB, nullptr, X2B, rep ? ssqd : ssq2, 1.0f);
        if (rep + 1 < NREP(7)) xcd_barrier(bar); else SEAM(7); }
    if (IN(8)) for (int rep = 0; rep < NREP(8); ++rep) { PHASE_FRAME(); pg8::Gemm g{X2B, (const bf16*)(ws + WS_WGU2), MPAD, 2 * DFF, DM}; pg8::StaticOrder S; S.init(MPAD, 2 * DFF, F.G, (int)blockIdx.x);
        pg8::EpiSwiglu E{ACT, ssq2};
        pg8::gemm_phase<pg8::EpiSwiglu, pg8::StaticOrder, true, true>(F.lds + RING_OFF, g, S, E); if (rep + 1 < NREP(8)) xcd_barrier(bar); else SEAM(8); }
    if (IN(9)) for (int rep = 0; rep < NREP(9); ++rep) { PHASE_FRAME(); pg8::Gemm g{ACT, (const bf16*)(ws + WS_WD2), MP, DM, DFF}; pg8::StaticOrder S; S.init(MP, DM, F.G, (int)blockIdx.x);
        pg8::EpiResid E{nullptr, nullptr, X2B, yp, ys, nullptr, rep ? ssqd : ssq3, 0.5f};
        pg8::gemm_phase<pg8::EpiResid, pg8::StaticOrder, true, true>(F.lds + RING_OFF, g, S, E);
        skinny_units(F, ACT + (size_t)MP * DFF, DFF, (const bf16*)(ws + WS_WD2), DFF, (unsigned*)(F.ctl + CW_SKC + 256 + 64 * rep), (float*)(ws + WS_SLAB), nullptr, X2B, ys, nullptr, rep ? ssqd : ssq3, 0.5f);
        if (rep + 1 < NREP(9)) xcd_barrier(bar); else SEAM(9); }
    if (IN(10)) for (int rep = 0; rep < NREP(10); ++rep) { PHASE_FRAME(); const float* fn = args.in[30];
        for (int m = gw; m < MV; m += NGW) { float* xr = m < MP ? yp + (size_t)m * DM : ys + (size_t)(m - MP) * DM;
            const float s = rep ? 1.0f : __builtin_amdgcn_rsqf(ssq3[m] * (1.0f / DM) + RMS_EPS);
            GAS f32x4* x4 = (GAS f32x4*)xr + F.lane; const GAS f32x4* f4 = (const GAS f32x4*)fn + F.lane;
#pragma unroll
            for (int j = 0; j < 8; ++j) x4[64 * j] = rep ? x4[64 * j] * s : x4[64 * j] * s * f4[64 * j]; } if (NREP(10) > 1 && rep == 0) xcd_barrier(bar); }
#undef IN
#undef SEAM
}

extern "C" void kernel_launch(void* const* d_in, const int* in_sizes, int n_in, void* d_out, int out_size, void* d_ws, size_t ws_size, hipStream_t stream) {
    static int grid = 0;
    if (grid == 0) {
        if (n_in != 31 || in_sizes[0] != MP * DM || (size_t)out_size != O_END || ws_size < WS_END2) {
            fprintf(stderr, "kernel_launch: unexpected shapes: n_in %d in0 %d out %d (want %zu) ws %zu (want >= %zu); nothing launched\n", n_in, n_in > 0 ? in_sizes[0] : -1, out_size, (size_t)O_END, ws_size, (size_t)WS_END2);
            grid = -1; return; }
        int dev = 0, cus = 0, per_cu = 0;
        if (hipGetDevice(&dev) != hipSuccess || hipDeviceGetAttribute(&cus, hipDeviceAttributeMultiprocessorCount, dev) != hipSuccess) { fprintf(stderr, "kernel_launch: device query failed\n"); grid = -1; return; }
        if (hipFuncSetAttribute((const void*)hymba_fwd, hipFuncAttributeMaxDynamicSharedMemorySize, LDS_BYTES) != hipSuccess) { fprintf(stderr, "kernel_launch: hipFuncSetAttribute failed\n"); grid = -1; return; }
        if (hipOccupancyMaxActiveBlocksPerMultiprocessor(&per_cu, (const void*)hymba_fwd, NWAVES * 64, LDS_BYTES) != hipSuccess || per_cu < 1)
            fprintf(stderr, "kernel_launch: note: occupancy query reports %d workgroups per CU\n", per_cu);
        (void)hipGetLastError();
        grid = cus;
    }
    if (grid < 0) return;
    if (hipMemsetAsync((char*)d_ws + WS_CTL, 0, CTL_ZERO_BYTES, stream) != hipSuccess) { fprintf(stderr, "kernel_launch: hipMemsetAsync failed\n"); return; }
    Args a{};
    for (int i = 0; i < 31; ++i) a.in[i] = (const float*)d_in[i];
    a.out = (float*)d_out; a.ws = (unsigned char*)d_ws;
    for (int li = 0; li < MK_N_LAUNCHES; ++li) {
        a.ph_lo = (MK_N_LAUNCHES == 1) ? 0 : li; a.ph_hi = (MK_N_LAUNCHES == 1) ? NPHASES : li + 1; a.li = li;
        hipLaunchKernelGGL(hymba_fwd, dim3(grid), dim3(NWAVES * 64), LDS_BYTES, stream, a);
        const hipError_t le = hipPeekAtLastError();
        if (le != hipSuccess) { fprintf(stderr, "kernel_launch: launch %d failed: %s\n", li, hipGetErrorName(le)); break; }
    }
}
```

```cpp
#include <hip/hip_runtime.h>
#include <cstdio>
#include <cstdint>
#define MK_N_LAUNCHES 1
constexpr int DM = 2048, SEQ = 2048, NB = 4, MP = NB * SEQ  , NDEC = 32, MV = MP + NDEC  , MPAD = 8448  ;
constexpr int DFF = 5504, ATTW = 1024, KVW = 256, RWW = 1024, NQH = 16, NKVH = 4, HD = 64, RWH = 16, WIN = 128;
constexpr int ATT_COLS = ATTW + 2 * KVW  , SHC = 3 * RWW + 64 + 64 + 128  , INC = ATT_COLS + SHC  ;
constexpr float RMS_EPS = 1e-5f, GN_EPS = 64e-5f, LOG2E = 1.4426950408889634f;
constexpr float QSCALE = 0.125f * LOG2E;
constexpr size_t O_YP = 0, O_YS = O_YP + (size_t)MP * DM, O_KP = O_YS + (size_t)NDEC * DM, O_VP = O_KP + (size_t)NB * WIN * KVW, O_WP = O_VP + (size_t)NB * WIN * KVW,
                 O_SP = O_WP + (size_t)NB * RWH * HD * HD, O_KS = O_SP + (size_t)NB * SHC, O_VS = O_KS + (size_t)NDEC * WIN * KVW, O_WS = O_VS + (size_t)NDEC * WIN * KVW,
                 O_SS = O_WS + (size_t)NDEC * RWH * HD * HD, O_END = O_SS + (size_t)NDEC * SHC;
namespace pg8 {
#define PG8_LAS __attribute__((address_space(3)))
typedef unsigned short bf16_t;
typedef short bf16x8 __attribute__((ext_vector_type(8)));
typedef float f32x4 __attribute__((ext_vector_type(4)));
typedef unsigned u32x4 __attribute__((ext_vector_type(4)));
constexpr int BM = 256, BK = 64, HALF = 128, HTB = HALF * BK * 2  , STAGE_BYTES = 8 * HTB, NXCD = 8, WGM = 8;

__host__ __device__ __forceinline__ int lds_byte(int r, int c) { const int st = (r >> 4) * 2 + (c >> 5), rr = r & 15, cc = c & 31, ob = rr * 64 + cc * 2; return st * 1024 + (ob ^ (((ob >> 9) & 1) << 5)); }
__host__ __device__ __forceinline__ void stage_rc(int b, int& R, int& C) { const int st = b / 1024, sb = b % 1024, swz = sb ^ (((sb >> 9) & 1) << 5); R = (st >> 1) * 16 + swz / 64; C = (st & 1) * 32 + (swz % 64) / 2; }
__host__ __device__ __forceinline__ int perm32(int rho) { const int n = rho >> 4, i = rho & 15; return 8 * (i >> 2) + 4 * n + (i & 3); }

struct Unit { int pm, pn; };
struct Gemm { const bf16_t* A; const bf16_t* Bt; int M, N, K; };

struct StaticOrder {
    int nM, nN, nwg, G, c;
    __host__ __device__ void init(int M, int N, int G_, int c_) { nM = M / BM; nN = N / BM; nwg = nM * nN; G = G_; c = c_; }
    __host__ __device__ bool next(int i, Unit& u) const {
        const long L = (long)i * G + c; if (L >= nwg) return false;
        int wgid = (int)L; { const int q = nwg / NXCD, r = nwg % NXCD, xcd = wgid % NXCD, off = wgid / NXCD; wgid = (xcd < r ? xcd * (q + 1) : r * (q + 1) + (xcd - r) * q) + off; }
        const int nig = WGM * nN, gid = wgid / nig, fm = gid * WGM, gsz = (nM - fm) < WGM ? (nM - fm) : WGM;
        u.pm = fm + ((wgid % nig) % gsz); u.pn = (wgid % nig) / gsz; return true;
    }
    __device__ __forceinline__ void a_ready(const Unit&) const {}
    __device__ __forceinline__ void done(const Unit&) const {}
};

__device__ __forceinline__ unsigned cvt_pk_bf16(float lo, float hi) { unsigned r; asm volatile("v_cvt_pk_bf16_f32 %0, %1, %2" : "=v"(r) : "v"(lo), "v"(hi)); return r; }
__device__ __forceinline__ float silu_mul(float g, float u) { return g * u * __builtin_amdgcn_rcpf(1.0f + __builtin_amdgcn_exp2f(-g * LOG2E)); }

struct EpiSwiglu {
    static constexpr bool PERM = true, AFTER_DRAIN = false;
    bf16_t* O; const float* ssq;
    __device__ __forceinline__ void operator()(const f32x4 (&acc)[2][2][4][2], const Unit& u, int wr, int wc, int fr, int fq) const {
        const int row0 = u.pm * BM + wr * 64 + fr, col0 = u.pn * HALF + wc * 32 + 8 * fq;
#pragma unroll
        for (int ai = 0; ai < 2; ++ai)
#pragma unroll
            for (int m = 0; m < 4; ++m) { const int row = row0 + ai * HALF + m * 16;
                const float s = __builtin_amdgcn_rsqf(ssq[row] * (1.0f / DM) + RMS_EPS);
                const f32x4 g0 = acc[ai][0][m][0] * s, g1 = acc[ai][0][m][1] * s, u0 = acc[ai][1][m][0] * s, u1 = acc[ai][1][m][1] * s;
                u32x4 w; w.x = cvt_pk_bf16(silu_mul(g0[0], u0[0]), silu_mul(g0[1], u0[1])); w.y = cvt_pk_bf16(silu_mul(g0[2], u0[2]), silu_mul(g0[3], u0[3]));
                w.z = cvt_pk_bf16(silu_mul(g1[0], u1[0]), silu_mul(g1[1], u1[1])); w.w = cvt_pk_bf16(silu_mul(g1[2], u1[2]), silu_mul(g1[3], u1[3]));
                *(u32x4*)(O + (size_t)row * DFF + col0) = w; }
    }
};

struct EpiResid {
    static constexpr bool PERM = true, AFTER_DRAIN = false;
    const float* xi_p; const float* xi_s; const bf16_t* xb_in; float* xo_p; float* xo_s; bf16_t* XB; float* ssq; float alpha;
    __device__ __forceinline__ void operator()(const f32x4 (&acc)[2][2][4][2], const Unit& u, int wr, int wc, int fr, int fq) const {
        const int row0 = u.pm * BM + wr * 64 + fr, col0 = u.pn * BM + wc * 32 + 8 * fq;
#pragma unroll
        for (int ai = 0; ai < 2; ++ai)
#pragma unroll
            for (int m = 0; m < 4; ++m) { const int row = row0 + ai * HALF + m * 16; const bool valid = row < MV;
                const size_t ro = row < MP ? (size_t)row * DM : (size_t)(row - MP) * DM;
                float sq = 0.f;
#pragma unroll
                for (int bj = 0; bj < 2; ++bj) { const int col = col0 + bj * HALF;
                    f32x4 x0 = (f32x4){0.f, 0.f, 0.f, 0.f}, x1 = x0;
                    if (xb_in) { const u32x4 w = *(const u32x4*)(xb_in + (size_t)row * DM + col);
                        x0 = (f32x4){__builtin_bit_cast(float, w.x << 16), __builtin_bit_cast(float, w.x & 0xffff0000u), __builtin_bit_cast(float, w.y << 16), __builtin_bit_cast(float, w.y & 0xffff0000u)};
                        x1 = (f32x4){__builtin_bit_cast(float, w.z << 16), __builtin_bit_cast(float, w.z & 0xffff0000u), __builtin_bit_cast(float, w.w << 16), __builtin_bit_cast(float, w.w & 0xffff0000u)}; }
                    else if (valid) { const float* src = (row < MP ? xi_p : xi_s) + ro; x0 = *(const f32x4*)(src + col); x1 = *(const f32x4*)(src + col + 4); }
                    const f32x4 y0 = x0 + acc[ai][bj][m][0] * alpha, y1 = x1 + acc[ai][bj][m][1] * alpha;
                    if (xo_p && valid) { float* dst = (row < MP ? xo_p : xo_s) + ro; *(f32x4*)(dst + col) = y0; *(f32x4*)(dst + col + 4) = y1; }
                    sq += (y0[0] * y0[0] + y0[1] * y0[1]) + (y0[2] * y0[2] + y0[3] * y0[3]) + (y1[0] * y1[0] + y1[1] * y1[1]) + (y1[2] * y1[2] + y1[3] * y1[3]);
                    if (XB) { u32x4 w; w.x = cvt_pk_bf16(y0[0], y0[1]); w.y = cvt_pk_bf16(y0[2], y0[3]); w.z = cvt_pk_bf16(y1[0], y1[1]); w.w = cvt_pk_bf16(y1[2], y1[3]);
                        *(u32x4*)(XB + (size_t)row * DM + col) = w; } }
                sq += __shfl_xor(sq, 16); sq += __shfl_xor(sq, 32);
                if (fq == 0 && valid) atomicAdd(ssq + row, sq); }
    }
};

struct EpiWin {
    static constexpr bool PERM = true, AFTER_DRAIN = false;
    const float* ssq; bf16_t* QB; bf16_t* KB; bf16_t* VB; bf16_t* PR; float* out;
    __device__ __forceinline__ void operator()(const f32x4 (&acc)[2][2][4][2], const Unit& u, int wr, int wc, int fr, int fq) const {
        const int row0 = u.pm * BM + wr * 64 + fr, cl0 = wc * 32 + 8 * fq;
        const int pn = u.pn;
#pragma unroll
        for (int ai = 0; ai < 2; ++ai)
#pragma unroll
            for (int m = 0; m < 4; ++m) { const int row = row0 + ai * HALF + m * 16; const bool valid = row < MV;
                float s = __builtin_amdgcn_rsqf(ssq[row] * (1.0f / DM) + RMS_EPS);
                if (pn < 4) s *= QSCALE;
#pragma unroll
                for (int bj = 0; bj < 2; ++bj) { const int cl = cl0 + bj * HALF;
                    const f32x4 y0 = acc[ai][bj][m][0] * s, y1 = acc[ai][bj][m][1] * s;
                    if (pn < 6) { u32x4 w; w.x = cvt_pk_bf16(y0[0], y0[1]); w.y = cvt_pk_bf16(y0[2], y0[3]); w.z = cvt_pk_bf16(y1[0], y1[1]); w.w = cvt_pk_bf16(y1[2], y1[3]);
                        if (pn < 4) *(u32x4*)(QB + (size_t)row * ATTW + pn * BM + cl) = w;
                        else { *(u32x4*)((pn == 4 ? KB : VB) + (size_t)row * KVW + cl) = w;
                            if (valid) { float* o = nullptr;
                                if (row >= MP) o = out + (pn == 4 ? O_KS : O_VS) + ((size_t)(row - MP) * WIN + (WIN - 1)) * KVW + cl;
                                else if ((row & (SEQ - 1)) >= SEQ - WIN) o = out + (pn == 4 ? O_KP : O_VP) + ((size_t)(row >> 11) * WIN + ((row & (SEQ - 1)) - (SEQ - WIN))) * KVW + cl;
                                if (o) { *(f32x4*)o = y0; *(f32x4*)(o + 4) = y1; } } }
                    } else { const int cs = (pn - 6) * BM + cl;
                        { u32x4 w; w.x = cvt_pk_bf16(y0[0], y0[1]); w.y = cvt_pk_bf16(y0[2], y0[3]); w.z = cvt_pk_bf16(y1[0], y1[1]); w.w = cvt_pk_bf16(y1[2], y1[3]); *(u32x4*)(PR + (size_t)row * SHC + cs) = w; }
                        if (valid) { float* o = nullptr;
                            if (row >= MP) o = out + O_SS + (size_t)(row - MP) * SHC + cs;
                            else if ((row & (SEQ - 1)) == SEQ - 1) o = out + O_SP + (size_t)(row >> 11) * SHC + cs;
                            if (o) { *(f32x4*)o = y0; *(f32x4*)(o + 4) = y1; } } } }
            }
    }
};
template <class Epi, class Sched, bool ALIGN_EPI = false, bool SP2 = false>
__device__ __forceinline__ void gemm_phase(PG8_LAS unsigned char* lds, const Gemm g, const Sched& S, const Epi& E) {
    int tid_ = threadIdx.x; asm volatile("" : "+v"(tid_)); const int tid = tid_, wid = __builtin_amdgcn_readfirstlane(tid >> 6), lane = tid & 63, wr = wid >> 2, wc = wid & 3, fr = lane & 15, fq = lane >> 4;
    const int K = g.K, nt = K / BK;
    unsigned voffA[2], voffB[2];
#pragma unroll
    for (int i = 0; i < 2; ++i) { int R, C; stage_rc(tid * 16 + i * 8192, R, C); const int Rb = Epi::PERM ? ((R & ~31) + perm32(R & 31)) : R;
        voffA[i] = (unsigned)(R * K + C) * 2u; voffB[i] = (unsigned)(Rb * K + C) * 2u; }
    const size_t kstep = (size_t)(BK * 2);
    const size_t hstep = (size_t)HALF * K * 2;
    const size_t tstep = 2 * hstep;
    const unsigned ldsw = (unsigned)wid * 1024u;
    const int aoff = lds_byte(wr * 64 + fr, fq * 8), boff = lds_byte(wc * 32 + fr, fq * 8);
#define PG8_SA(b, h) (((b) * 2 + (h)) * HTB)
#define PG8_SB(b, h) ((4 + (b) * 2 + (h)) * HTB)
#define PG8_STAGE(bufoff, gbase, voff) do { _Pragma("unroll") for (int _i = 0; _i < 2; ++_i) \
        __builtin_amdgcn_global_load_lds((const unsigned*)((const char*)(gbase) + (voff)[_i]), (PG8_LAS unsigned*)(lds + (bufoff) + ldsw + _i * 8192), 16, 0, 0); } while (0)
#define PG8_LDA(dst, b, h) do { _Pragma("unroll") for (int m = 0; m < 4; ++m) _Pragma("unroll") for (int k = 0; k < 2; ++k) dst[m][k] = *(const PG8_LAS bf16x8*)(lds + PG8_SA(b, h) + aoff + m * 2048 + k * 1024); } while (0)
#define PG8_LDB(dst, b, h) do { _Pragma("unroll") for (int n = 0; n < 2; ++n) _Pragma("unroll") for (int k = 0; k < 2; ++k) dst[n][k] = *(const PG8_LAS bf16x8*)(lds + PG8_SB(b, h) + boff + n * 2048 + k * 1024); } while (0)
#define PG8_MMA(ai, bj, At, Bt) do { __builtin_amdgcn_s_setprio(1); _Pragma("unroll") for (int m = 0; m < 4; ++m) _Pragma("unroll") for (int n = 0; n < 2; ++n) _Pragma("unroll") for (int k = 0; k < 2; ++k) \
        acc[ai][bj][m][n] = __builtin_amdgcn_mfma_f32_16x16x32_bf16(Bt[n][k], At[m][k], acc[ai][bj][m][n], 0, 0, 0); __builtin_amdgcn_s_setprio(0); } while (0)
#define PG8_WAIT_V(n) asm volatile("s_waitcnt vmcnt(" #n ")" ::: "memory")
#define PG8_WAIT_L(n) asm volatile("s_waitcnt lgkmcnt(" #n ")" ::: "memory")
#define PG8_BAR __builtin_amdgcn_s_barrier()
#define PG8_SCHED __builtin_amdgcn_sched_barrier(0)
    Unit cur, nxt; int ui = 0;
    if (!S.next(0, cur)) return;
    f32x4 acc[2][2][4][2];
#pragma unroll
    for (int a = 0; a < 2; ++a)
#pragma unroll
        for (int b = 0; b < 2; ++b)
#pragma unroll
            for (int m = 0; m < 4; ++m)
#pragma unroll
                for (int n = 0; n < 2; ++n) acc[a][b][m][n] = (f32x4){0.f, 0.f, 0.f, 0.f};
    bf16x8 At[4][2], B0[2][2], B1[2][2];
    const char* cA = (const char*)g.A + (size_t)cur.pm * tstep; const char* cB = (const char*)g.Bt + (size_t)cur.pn * tstep;
    S.a_ready(cur);
    if constexpr (SP2) {
        PG8_STAGE(PG8_SB(0, 0), cB, voffB); PG8_STAGE(PG8_SB(0, 1), cB + hstep, voffB); PG8_STAGE(PG8_SA(0, 0), cA, voffA); PG8_STAGE(PG8_SA(0, 1), cA + hstep, voffA);
        if (wr == 1) PG8_BAR;
        PG8_WAIT_V(2); PG8_BAR;
        PG8_STAGE(PG8_SB(1, 0), cB + kstep, voffB); PG8_STAGE(PG8_SA(1, 0), cA + kstep, voffA); PG8_STAGE(PG8_SB(1, 1), cB + hstep + kstep, voffB);
        PG8_WAIT_V(6); PG8_BAR;
    } else {
        PG8_STAGE(PG8_SB(0, 0), cB, voffB); PG8_STAGE(PG8_SA(0, 0), cA, voffA); PG8_STAGE(PG8_SB(0, 1), cB + hstep, voffB); PG8_STAGE(PG8_SA(0, 1), cA + hstep, voffA);
        if (wr == 1) PG8_BAR;
        PG8_WAIT_V(4); PG8_BAR;
        PG8_STAGE(PG8_SB(1, 0), cB + kstep, voffB); PG8_STAGE(PG8_SA(1, 0), cA + kstep, voffA); PG8_STAGE(PG8_SB(1, 1), cB + hstep + kstep, voffB);
        PG8_WAIT_V(6); PG8_BAR;
    }
    for (;;) {
        const bool has_next = S.next(ui + 1, nxt);
        const char* nA = has_next ? (const char*)g.A + (size_t)nxt.pm * tstep : cA; const char* nB = has_next ? (const char*)g.Bt + (size_t)nxt.pn * tstep : cB;
        for (int t = 0; t < nt; t += 2) {
            const bool last = (t == nt - 2);
            const char* a1 = cA + (size_t)(t + 1) * kstep;
            const char* a2 = last ? nA : cA + (size_t)(t + 2) * kstep; const char* b2 = last ? nB : cB + (size_t)(t + 2) * kstep;
            const char* a3 = a2 + kstep; const char* b3 = b2 + kstep;
            if (last && has_next) S.a_ready(nxt);
            if constexpr (SP2) {
            PG8_LDB(B0, 0, 0); PG8_LDB(B1, 0, 1); PG8_SCHED; PG8_LDA(At, 0, 0); PG8_STAGE(PG8_SA(1, 1), a1 + hstep, voffA);
            PG8_WAIT_V(8); PG8_WAIT_L(0); PG8_BAR; PG8_MMA(0, 0, At, B0); PG8_MMA(0, 1, At, B1); PG8_BAR; PG8_SCHED;
            PG8_LDA(At, 0, 1); PG8_STAGE(PG8_SB(0, 0), b2, voffB); PG8_STAGE(PG8_SB(0, 1), b2 + hstep, voffB); PG8_STAGE(PG8_SA(0, 0), a2, voffA);
            PG8_WAIT_V(8); PG8_WAIT_L(0); PG8_BAR; PG8_MMA(1, 0, At, B0); PG8_MMA(1, 1, At, B1); PG8_BAR; PG8_SCHED;
            PG8_LDB(B0, 1, 0); PG8_LDB(B1, 1, 1); PG8_SCHED; PG8_LDA(At, 1, 0); PG8_STAGE(PG8_SA(0, 1), a2 + hstep, voffA);
            PG8_WAIT_V(8); PG8_WAIT_L(0); PG8_BAR; PG8_MMA(0, 0, At, B0); PG8_MMA(0, 1, At, B1); PG8_BAR; PG8_SCHED;
            PG8_LDA(At, 1, 1); PG8_STAGE(PG8_SB(1, 0), b3, voffB); PG8_STAGE(PG8_SB(1, 1), b3 + hstep, voffB); PG8_STAGE(PG8_SA(1, 0), a3, voffA);
            PG8_WAIT_V(8); PG8_WAIT_L(0); PG8_BAR; PG8_MMA(1, 0, At, B0); PG8_MMA(1, 1, At, B1); PG8_BAR; PG8_SCHED;
            } else {
            PG8_LDB(B0, 0, 0); PG8_SCHED; PG8_LDA(At, 0, 0); PG8_STAGE(PG8_SA(1, 1), a1 + hstep, voffA);
            PG8_WAIT_L(8); PG8_BAR; PG8_WAIT_L(0); PG8_MMA(0, 0, At, B0); PG8_BAR; PG8_SCHED;
            PG8_LDB(B1, 0, 1); PG8_STAGE(PG8_SB(0, 0), b2, voffB);
            PG8_BAR; PG8_WAIT_L(0); PG8_MMA(0, 1, At, B1); PG8_BAR;
            PG8_LDA(At, 0, 1); PG8_STAGE(PG8_SA(0, 0), a2, voffA);
            PG8_BAR; PG8_WAIT_L(0); PG8_MMA(1, 0, At, B0); PG8_BAR; PG8_SCHED;
            PG8_STAGE(PG8_SB(0, 1), b2 + hstep, voffB);
            PG8_WAIT_V(6); PG8_BAR; PG8_MMA(1, 1, At, B1); PG8_BAR;
            PG8_LDB(B0, 1, 0); PG8_SCHED; PG8_LDA(At, 1, 0); PG8_STAGE(PG8_SA(0, 1), a2 + hstep, voffA);
            PG8_WAIT_L(8); PG8_BAR; PG8_WAIT_L(0); PG8_MMA(0, 0, At, B0); PG8_BAR; PG8_SCHED;
            PG8_LDB(B1, 1, 1); PG8_STAGE(PG8_SB(1, 0), b3, voffB);
            PG8_BAR; PG8_WAIT_L(0); PG8_MMA(0, 1, At, B1); PG8_BAR;
            PG8_LDA(At, 1, 1); PG8_STAGE(PG8_SA(1, 0), a3, voffA);
            PG8_BAR; PG8_WAIT_L(0); PG8_MMA(1, 0, At, B0); PG8_BAR; PG8_SCHED;
            PG8_STAGE(PG8_SB(1, 1), b3 + hstep, voffB);
            PG8_WAIT_V(6); PG8_BAR; PG8_MMA(1, 1, At, B1); PG8_BAR;
            }
        }
        if constexpr (ALIGN_EPI) { if (wr == 0) PG8_BAR; }
        if constexpr (!Epi::AFTER_DRAIN) { E(acc, cur, wr, wc, fr, fq); S.done(cur); }
        if (!has_next) break;
#pragma unroll
        for (int a = 0; a < 2; ++a)
#pragma unroll
            for (int b = 0; b < 2; ++b)
#pragma unroll
                for (int m = 0; m < 4; ++m)
#pragma unroll
                    for (int n = 0; n < 2; ++n) acc[a][b][m][n] = (f32x4){0.f, 0.f, 0.f, 0.f};
        cur = nxt; cA = nA; cB = nB; ++ui;
        if constexpr (ALIGN_EPI) { if (wr == 1) PG8_BAR; }
    }
    PG8_WAIT_V(0);
    if constexpr (!ALIGN_EPI) { if (wr == 0) PG8_BAR; }
    PG8_BAR;
    if constexpr (Epi::AFTER_DRAIN) { E.fused(acc, cur, wr, wc, fr, fq, lds, wid, lane); S.done(cur); }
#undef PG8_SA
#undef PG8_SB
#undef PG8_STAGE
#undef PG8_LDA
#undef PG8_LDB
#undef PG8_MMA
#undef PG8_WAIT_V
#undef PG8_WAIT_L
#undef PG8_BAR
#undef PG8_SCHED
}
}
#define GAS __attribute__((address_space(1)))
#define LAS __attribute__((address_space(3)))
typedef unsigned short bf16;
typedef unsigned v4u __attribute__((ext_vector_type(4)));
typedef float f32x4 __attribute__((ext_vector_type(4)));
typedef short bf16x8 __attribute__((ext_vector_type(8)));
typedef GAS unsigned gu32;
typedef GAS unsigned long long gu64;
#define RLX_AGENT __ATOMIC_RELAXED, __HIP_MEMORY_SCOPE_AGENT
#define LDS_WAIT() asm volatile("s_waitcnt lgkmcnt(0)" ::: "memory")
#define VM_WAIT() asm volatile("s_waitcnt vmcnt(0)" ::: "memory")
__device__ __forceinline__ unsigned long long rt() { return __builtin_amdgcn_s_memrealtime(); }
__device__ __forceinline__ unsigned f2bf(float f) { unsigned u = __builtin_bit_cast(unsigned, f); return (u + 0x7fffu + ((u >> 16) & 1u)) >> 16; }
__device__ __forceinline__ unsigned pk2(float lo, float hi) { return f2bf(lo) | (f2bf(hi) << 16); }

#define XB_TMO      128
#define XB_XCNT(j)  (256  + 64 * (j))
#define XB_XSUB(j)  (1280 + 64 * (j))
#define XB_XGEN(j)  (2304 + 64 * (j))
#define XB_TOP      3328
#define XB_TOPGEN   3392
#define XCD_BAR_WORDS 3456
#define XB_SPIN_CAP (1u << 18)

__device__ __forceinline__ unsigned xb_ld(unsigned* p)              { return __hip_atomic_load(p, __ATOMIC_RELAXED, __HIP_MEMORY_SCOPE_AGENT); }
__device__ __forceinline__ unsigned xb_add(unsigned* p, unsigned v) { return __hip_atomic_fetch_add(p, v, __ATOMIC_RELAXED, __HIP_MEMORY_SCOPE_AGENT); }
__device__ __forceinline__ unsigned xb_xcc_id() { return (unsigned)__builtin_amdgcn_s_getreg((3 << 11) | 20) & 0xFu; }
#define XB_SPIN(cond, bar) do { unsigned _sp = 0; while (cond) { __builtin_amdgcn_s_sleep(1); \
    if ((++_sp & 255u) == 0u) { if (xb_ld(&(bar)[XB_TMO])) break; if (_sp > XB_SPIN_CAP) { atomicAdd(&(bar)[XB_TMO], 1u); break; } } } } while (0)

struct XcdBarrier {
    unsigned* bar; unsigned x;
    volatile LAS unsigned* st;
};

__device__ __forceinline__ XcdBarrier xcd_barrier_post(unsigned* bar, volatile LAS unsigned* st) {
    XcdBarrier b; b.bar = bar; b.x = xb_xcc_id(); b.st = st;
    if (threadIdx.x == 0) (void)xb_add(&bar[XB_XCNT(b.x)], 1u);
    return b;
}
__device__ __forceinline__ void xcd_barrier_complete(unsigned* bar, unsigned x, unsigned& nloc, unsigned& nx) {
    const unsigned G = gridDim.x * gridDim.y * gridDim.z;
    unsigned sum, cnt, mine, sp = 0u;
    for (;;) {
        sum = 0u; cnt = 0u; mine = 0u;
#pragma unroll
        for (unsigned j = 0; j < 16; ++j) { const unsigned c = xb_ld(&bar[XB_XCNT(j)]); sum += c; cnt += (c > 0u) ? 1u : 0u; mine = (j == x) ? c : mine; }
        if (sum == G) break;
        __builtin_amdgcn_s_sleep(1);
        if ((++sp & 255u) == 0u) { if (xb_ld(&bar[XB_TMO])) break; if (sp > XB_SPIN_CAP) { atomicAdd(&bar[XB_TMO], 1u); break; } }
    }
    nloc = mine > 0u ? mine : 1u; nx = cnt > 0u ? cnt : 1u;
}

__device__ __forceinline__ void xcd_barrier(const XcdBarrier& b) {
    asm volatile("s_waitcnt vmcnt(0)" ::: "memory");
    __syncthreads();
    if (threadIdx.x == 0) {
        unsigned* bar = b.bar;
        __builtin_amdgcn_s_waitcnt(0);
        unsigned nloc = b.st[0], nx = b.st[1];
        if (nloc == 0u) { xcd_barrier_complete(bar, b.x, nloc, nx); b.st[0] = nloc; b.st[1] = nx; }
        const unsigned old = xb_add(&bar[XB_XSUB(b.x)], 1u);
        const unsigned gen = old / nloc;
        if (old + 1u == (gen + 1u) * nloc) {
            __builtin_amdgcn_fence(__ATOMIC_RELEASE, "agent");
            asm volatile("s_waitcnt vmcnt(0)" ::: "memory");
            const unsigned og = xb_add(&bar[XB_TOP], 1u);
            const unsigned tg = og / nx;
            if (og + 1u == (tg + 1u) * nx) xb_add(&bar[XB_TOPGEN], 1u);
            else XB_SPIN(xb_ld(&bar[XB_TOPGEN]) == tg, bar);
            __builtin_amdgcn_fence(__ATOMIC_ACQUIRE, "agent");
            xb_add(&bar[XB_XGEN(b.x)], 1u);
            asm volatile("s_waitcnt vmcnt(0)" ::: "memory");
        } else {
            XB_SPIN(xb_ld(&bar[XB_XGEN(b.x)]) == gen, bar);
            __builtin_amdgcn_fence(__ATOMIC_ACQUIRE, "agent");
            asm volatile("s_waitcnt vmcnt(0)" ::: "memory");
        }
    }
    __syncthreads();
}
constexpr size_t MiB = 1u << 20;
constexpr size_t WS_CTL = 0, CTL_ZERO_BYTES = 1 * MiB;
constexpr size_t WS_BIAS = 1 * MiB, WS_W2T = WS_BIAS + 16384, WS_A2T = WS_W2T + 131072, WS_G2T = WS_A2T + 131072;
constexpr size_t WS_WGU1 = 2 * MiB, WS_WD1 = WS_WGU1 + 43 * MiB, WS_WINB = WS_WD1 + 21 * MiB + MiB / 2;
constexpr size_t WS_WOUT = 86 * MiB, WS_WGU2 = 94 * MiB, WS_WD2 = 137 * MiB;
constexpr size_t WS_XB = 159 * MiB;
constexpr size_t WS_ACT = 192 * MiB;
constexpr size_t WS_MIX = 246 * MiB;
constexpr size_t WS_QB = 300 * MiB, WS_KB = WS_QB + 16 * MiB + MiB / 2, WS_VB = WS_KB + 4 * MiB + MiB / 8;
constexpr size_t WS_DD = 325 * MiB, WS_LG = 358 * MiB, WS_EE = WS_LG + 16 * MiB + MiB / 2, WS_END = WS_EE + 16 * MiB + MiB / 2;
constexpr size_t WS_SLAB = WS_END, WS_DEC = WS_SLAB + 1 * MiB, WS_END2 = WS_DEC + 6 * (size_t)NDEC * RWW * 4;
constexpr size_t VEC16 = 16 * MiB + MiB / 2;
constexpr size_t WS_KK = WS_WGU1, WS_BB = WS_KK + VEC16, WS_KP = WS_BB + VEC16, WS_RR = WS_KP + VEC16, WS_VV = WS_RR + VEC16;
constexpr size_t WS_X2B = WS_WGU1;
static_assert(WS_VV + VEC16 <= WS_WOUT && WS_WINB + 19 * MiB <= WS_WOUT && WS_WD2 + 22 * MiB <= WS_XB && WS_XB + 33 * MiB <= WS_ACT && WS_VB + 4 * MiB + MiB / 8 <= WS_DD && WS_DD + 33 * MiB <= WS_LG, "d_ws map");
constexpr int CW_BAR = 4096;
constexpr int CW_SSQ0 = 16384, CW_SSQ1 = CW_SSQ0 + MPAD, CW_SSQ2 = CW_SSQ1 + MPAD, CW_SSQ3 = CW_SSQ2 + MPAD;
constexpr int CW_SKC = 8192;
constexpr int CW_SSQD = CW_SSQ3 + MPAD;
static_assert((CW_SSQD + MPAD) * 4 <= (int)CTL_ZERO_BYTES, "CTL");
constexpr int RING_OFF = 0, RING_BYTES = 131072;
constexpr int LDSCTL_OFF = RING_BYTES, MISC_OFF = LDSCTL_OFF + 320;
constexpr int LDS_BYTES = 147456;
constexpr int NWAVES = 8;
constexpr int NPHASES = 11;
#ifndef PROBE_REP
#define PROBE_REP 0
#endif
#ifndef MK_N_LAUNCHES
#define MK_N_LAUNCHES 1
#endif

__constant__ unsigned char T5B[129] = {0, 1, 2, 3, 4, 5, 6, 7, 8, 9, 10, 11, 12, 13, 14, 15, 16, 16, 16, 17, 17, 18, 18, 18, 19, 19, 19, 20, 20, 20, 20, 21, 21, 21, 21, 22, 22, 22, 22, 22, 23, 23, 23, 23, 23, 23, 24, 24, 24, 24, 24, 24, 25, 25, 25, 25, 25, 25, 25, 26, 26, 26, 26, 26, 26, 26, 26, 27, 27, 27, 27, 27, 27, 27, 27, 27, 27, 28, 28, 28, 28, 28, 28, 28, 28, 28, 28, 29, 29, 29, 29, 29, 29, 29, 29, 29, 29, 29, 29, 30, 30, 30, 30, 30, 30, 30, 30, 30, 30, 30, 30, 30, 30, 31, 31, 31, 31, 31, 31, 31, 31, 31, 31, 31, 31, 31, 31, 31, 31};

struct Args { const float* in[31]; float* out; unsigned char* ws; int ph_lo, ph_hi, li, pad; };

struct Frame {
    LAS unsigned char* lds;
    volatile LAS unsigned* MISC;
    gu32* ctl;
    int tid, lane, wave, G;
    float* out; unsigned char* ws;
};
typedef float f32x2 __attribute__((ext_vector_type(2)));
__device__ __forceinline__ float bf2f(unsigned short u) { return __builtin_bit_cast(float, (unsigned)u << 16); }
__device__ __forceinline__ unsigned short f2bfs(float f) { return (unsigned short)f2bf(f); }
__device__ __forceinline__ float wave_sum(float v) {
#pragma unroll
    for (int o = 1; o < 64; o <<= 1) v += __shfl_xor(v, o);
    return v;
}
__device__ __forceinline__ float wave_max(float v) {
#pragma unroll
    for (int o = 1; o < 64; o <<= 1) v = fmaxf(v, __shfl_xor(v, o));
    return v;
}
template <int CTRL> __device__ __forceinline__ float dpp_f(float x) { return __builtin_bit_cast(float, __builtin_amdgcn_update_dpp(0, __builtin_bit_cast(int, x), CTRL, 0xf, 0xf, true)); }
__device__ __forceinline__ float allsum16(float x) { x += dpp_f<0x128>(x); x += dpp_f<0x124>(x); x += dpp_f<0x122>(x); x += dpp_f<0x121>(x); return x; }
__device__ __forceinline__ float sigmoidf_(float x) { return __builtin_amdgcn_rcpf(1.0f + __builtin_amdgcn_exp2f(-x * LOG2E)); }
__device__ __forceinline__ float tanhf_(float x) { return 1.0f - 2.0f * __builtin_amdgcn_rcpf(1.0f + __builtin_amdgcn_exp2f(2.0f * LOG2E * x)); }

constexpr int TP_PITCH = 136;
__device__ __forceinline__ void p0_transpose_item(const float* W, int K, int N, bf16* WT, int kb, int nb, int drow, const float* kscale, LAS unsigned char* scr, int lane) {
    const int k0 = 64 * kb, n0 = 64 * nb, g = lane >> 4, c = lane & 15;
    f32x4 v[16];
#pragma unroll
    for (int j = 0; j < 4; ++j)
#pragma unroll
        for (int r = 0; r < 4; ++r) v[4 * j + r] = *(const GAS f32x4*)(W + (size_t)(k0 + 16 * j + 4 * g + r) * N + n0 + 4 * c);
    if (kscale) {
#pragma unroll
        for (int j = 0; j < 4; ++j) { const f32x4 s4 = *(const GAS f32x4*)(kscale + k0 + 16 * j + 4 * g);
            v[4 * j + 0] *= s4.x; v[4 * j + 1] *= s4.y; v[4 * j + 2] *= s4.z; v[4 * j + 3] *= s4.w; } }
#pragma unroll
    for (int j = 0; j < 4; ++j)
#pragma unroll
        for (int e = 0; e < 4; ++e)
            *(LAS unsigned long long*)(scr + (4 * c + e) * TP_PITCH + (16 * j + 4 * g) * 2) = (unsigned long long)pk2(v[4 * j + 0][e], v[4 * j + 1][e]) | ((unsigned long long)pk2(v[4 * j + 2][e], v[4 * j + 3][e]) << 32);
    LDS_WAIT(); asm volatile("" ::: "memory");
#pragma unroll
    for (int i = 0; i < 8; ++i) { const int n = 8 * i + (lane >> 3), kc = lane & 7;
        const LAS unsigned char* s = scr + n * TP_PITCH + kc * 16;
        v4u o; o.x = *(const LAS unsigned*)(s); o.y = *(const LAS unsigned*)(s + 4); o.z = *(const LAS unsigned*)(s + 8); o.w = *(const LAS unsigned*)(s + 12);
        *(GAS v4u*)(WT + (size_t)(drow + n) * K + k0 + 8 * kc) = o; }
    LDS_WAIT(); asm volatile("" ::: "memory");
}
__device__ __forceinline__ int gu_row(int n0, int up) { return 256 * (n0 >> 7) + (n0 & 127) + 128 * up; }

constexpr int I_GU = (DM / 64) * (DFF / 64), I_D = (DFF / 64) * (DM / 64), I_IN = (DM / 64) * (INC / 64), I_OUT = (DM / 64) * (DM / 64), I_L64 = RWW / 64, I_L128 = 2 * (RWW / 64);
constexpr int CV_G0 = 2 * I_GU + 2 * I_L64 + I_L128, CV_G1 = I_D + I_IN, CV_G2 = I_OUT + 2 * I_GU, CV_G3 = I_D, CV_ALL = CV_G0 + CV_G1 + CV_G2 + CV_G3;
__device__ __forceinline__ void convert_items(Frame& F, const Args& A, int first, int count, int rank, int nranks) {
    LAS unsigned char* scr = F.lds + RING_OFF + F.wave * 16384;
    const int lane = F.lane; unsigned char* ws = F.ws;
    for (int it = first + rank * NWAVES + F.wave; it < first + count; it += nranks * NWAVES) {
        int r = it;
        if (r < I_GU) { const int kb = r / (DFF / 64), nb = r % (DFF / 64); p0_transpose_item(A.in[8], DM, DFF, (bf16*)(ws + WS_WGU1), kb, nb, gu_row(64 * nb, 0), A.in[7], scr, lane); continue; } r -= I_GU;
        if (r < I_GU) { const int kb = r / (DFF / 64), nb = r % (DFF / 64); p0_transpose_item(A.in[9], DM, DFF, (bf16*)(ws + WS_WGU1), kb, nb, gu_row(64 * nb, 1), A.in[7], scr, lane); continue; } r -= I_GU;
        if (r < I_L64) { p0_transpose_item(A.in[16], 64, RWW, (bf16*)(ws + WS_W2T), 0, r, 64 * r, nullptr, scr, lane); continue; } r -= I_L64;
        if (r < I_L64) { p0_transpose_item(A.in[18], 64, RWW, (bf16*)(ws + WS_A2T), 0, r, 64 * r, nullptr, scr, lane); continue; } r -= I_L64;
        if (r < I_L128) { const int kb = r / (RWW / 64), nb = r % (RWW / 64); p0_transpose_item(A.in[19], 128, RWW, (bf16*)(ws + WS_G2T), kb, nb, 64 * nb, nullptr, scr, lane); continue; } r -= I_L128;
        if (r < I_D)  { const int kb = r / (DM / 64), nb = r % (DM / 64); p0_transpose_item(A.in[10], DFF, DM, (bf16*)(ws + WS_WD1), kb, nb, 64 * nb, nullptr, scr, lane); continue; } r -= I_D;
        if (r < I_IN) { const int kb = r / (INC / 64), nb = r % (INC / 64); p0_transpose_item(A.in[12], DM, INC, (bf16*)(ws + WS_WINB), kb, nb, 64 * nb, A.in[11], scr, lane); continue; } r -= I_IN;
        if (r < I_OUT) { const int kb = r / (DM / 64), nb = r % (DM / 64); p0_transpose_item(A.in[25], DM, DM, (bf16*)(ws + WS_WOUT), kb, nb, 64 * nb, nullptr, scr, lane); continue; } r -= I_OUT;
        if (r < I_GU) { const int kb = r / (DFF / 64), nb = r % (DFF / 64); p0_transpose_item(A.in[27], DM, DFF, (bf16*)(ws + WS_WGU2), kb, nb, gu_row(64 * nb, 0), A.in[26], scr, lane); continue; } r -= I_GU;
        if (r < I_GU) { const int kb = r / (DFF / 64), nb = r % (DFF / 64); p0_transpose_item(A.in[28], DM, DFF, (bf16*)(ws + WS_WGU2), kb, nb, gu_row(64 * nb, 1), A.in[26], scr, lane); continue; } r -= I_GU;
        { const int kb = r / (DM / 64), nb = r % (DM / 64); p0_transpose_item(A.in[29], DFF, DM, (bf16*)(ws + WS_WD2), kb, nb, 64 * nb, nullptr, scr, lane); }
    }
}
__device__ __forceinline__ void p0_prologue(Frame& F, const Args& A) {
    const int gw = blockIdx.x * NWAVES + F.wave, NGW = F.G * NWAVES, lane = F.lane;
    unsigned char* ws = F.ws;
#ifdef CV_ALL_IN_P0
    convert_items(F, A, 0, CV_ALL, blockIdx.x, F.G);
#else
    convert_items(F, A, 0, CV_G0, blockIdx.x, F.G);
#endif
    bf16* XB = (bf16*)(ws + WS_XB); float* ssq0 = (float*)(F.ctl + CW_SSQ0);
    for (int m = gw; m < MPAD; m += NGW) {
        GAS unsigned long long* o8 = (GAS unsigned long long*)(XB + (size_t)m * DM) + lane;
        if (m < MV) {
            const float* xrow = m < MP ? A.in[0] + (size_t)m * DM : A.in[1] + (size_t)(m - MP) * DM;
            const GAS f32x4* xr = (const GAS f32x4*)xrow + lane; f32x4 v[8]; float s = 0.f;
#pragma unroll
            for (int j = 0; j < 8; ++j) { v[j] = xr[64 * j]; s += (v[j].x * v[j].x + v[j].y * v[j].y) + (v[j].z * v[j].z + v[j].w * v[j].w); }
            s = wave_sum(s);
#pragma unroll
            for (int j = 0; j < 8; ++j) o8[64 * j] = (unsigned long long)pk2(v[j].x, v[j].y) | ((unsigned long long)pk2(v[j].z, v[j].w) << 32);
            if (lane == 0) ssq0[m] = s;
        } else {
#pragma unroll
            for (int j = 0; j < 8; ++j) o8[64 * j] = 0ull;
        }
    }
    float* bt = (float*)(ws + WS_BIAS);
    for (int i = blockIdx.x * (NWAVES * 64) + F.tid; i < 129 * NQH; i += F.G * NWAVES * 64) bt[i] = A.in[6][(int)T5B[i >> 4] * NQH + (i & 15)] * LOG2E;
}
constexpr int PREP_TILES = (MV + 63) / 64  , PREP_UNITS = PREP_TILES * RWH;
constexpr int PA_PITCH = 528;
constexpr int PW_LD = 68;
constexpr int PA_OFF = 0, PW_OFF = 64 * PA_PITCH  , PMAT = 64 * PW_LD * 4  , PC_OFF = 114688;
constexpr int CB_FA = 0, CB_FR = 2048, CB_FNK = 4096, CB_FT = 4608, CB_FMB = 5120, CB_FMK = 5632, CB_FBG = 6144, CB_FKG = 8192, CB_FV = 10240, CB_GC = 12288, CB_BYTES = 12544, CB_STRIDE = 13312;
constexpr int NCHUNK = SEQ / 16;
constexpr size_t CH_NA = (WS_WOUT - WS_WGU1) / CB_STRIDE, CH_NB = (WS_LG - WS_DD) / CB_STRIDE;
static_assert(CH_NA + CH_NB >= (size_t)NB * RWH * NCHUNK, "chunk blocks");
__device__ __forceinline__ unsigned char* chunk_block(unsigned char* ws, int g) { return (size_t)g < CH_NA ? ws + WS_WGU1 + (size_t)g * CB_STRIDE : ws + WS_DD + ((size_t)g - CH_NA) * CB_STRIDE; }
constexpr int LW_OFF = 0, CS2_OFF = 16384;
static_assert(PW_OFF + 3 * PMAT <= PC_OFF && CS2_OFF + 4 * 16384 <= PC_OFF && PC_OFF + 2560 <= RING_BYTES, "prep LDS");
constexpr int SC_FA = 0, SC_FR = 2048, SC_FBH = 4096, SC_FKH = 6144, SC_FBG = 8192, SC_FKG = 10240, SC_FV = 12288, SC_NB = 14336, SC_TT = 15360;
typedef short s16x4 __attribute__((ext_vector_type(4)));
typedef __bf16 bf16x2_t __attribute__((ext_vector_type(2)));
__device__ __forceinline__ unsigned cvtpk_c(float lo, float hi) { const f32x2 v = {lo, hi}; return __builtin_bit_cast(unsigned, __builtin_convertvector(v, bf16x2_t)); }
__device__ __forceinline__ unsigned long long pack4bf(f32x4 v) { return (unsigned long long)cvtpk_c(v.x, v.y) | ((unsigned long long)cvtpk_c(v.z, v.w) << 32); }
__device__ __forceinline__ void chunk_mm(LAS unsigned char* lds, int c, unsigned char* blk, int lane) {
    asm volatile("" : "+v"(lane));
    LAS unsigned char* sc = lds + CS2_OFF + c * 16384;
    const int x = lane & 15, q = lane >> 4;
    bf16x8 aB[2], aK[2], bA[2], bR[2];
#pragma unroll
    for (int k2 = 0; k2 < 2; ++k2) { aB[k2] = *(const LAS bf16x8*)(sc + SC_FBH + (k2 * 64 + lane) * 16); aK[k2] = *(const LAS bf16x8*)(sc + SC_FKH + (k2 * 64 + lane) * 16);
        bA[k2] = *(const LAS bf16x8*)(sc + SC_FA + (k2 * 64 + lane) * 16); bR[k2] = *(const LAS bf16x8*)(sc + SC_FR + (k2 * 64 + lane) * 16); }
    f32x4 nb = (f32x4){0.f, 0.f, 0.f, 0.f}, nk = nb, mb_ = nb, mk = nb;
#pragma unroll
    for (int k2 = 0; k2 < 2; ++k2) { nb = __builtin_amdgcn_mfma_f32_16x16x32_bf16(aB[k2], bA[k2], nb, 0, 0, 0); nk = __builtin_amdgcn_mfma_f32_16x16x32_bf16(aK[k2], bA[k2], nk, 0, 0, 0);
        mb_ = __builtin_amdgcn_mfma_f32_16x16x32_bf16(aB[k2], bR[k2], mb_, 0, 0, 0); mk = __builtin_amdgcn_mfma_f32_16x16x32_bf16(aK[k2], bR[k2], mk, 0, 0, 0); }
#pragma unroll
    for (int r = 0; r < 4; ++r) { const int s_ = 4 * q + r; if (!(s_ < x)) { nb[r] = 0.f; nk[r] = 0.f; } if (!(s_ <= x)) { mb_[r] = 0.f; mk[r] = 0.f; } }
    *(GAS unsigned long long*)(blk + CB_FNK + lane * 8) = pack4bf(nk); *(GAS unsigned long long*)(blk + CB_FMB + lane * 8) = pack4bf(mb_); *(GAS unsigned long long*)(blk + CB_FMK + lane * 8) = pack4bf(mk);
    LAS float* nbs = (LAS float*)(sc + SC_NB);
#pragma unroll
    for (int r = 0; r < 4; ++r) nbs[(4 * q + r) * 16 + x] = nb[r];
    float Tc[16];
#pragma unroll
    for (int t = 0; t < 16; ++t) { float a_ = (x == t) ? 1.f : 0.f;
#pragma unroll
        for (int s_ = 0; s_ < t; ++s_) a_ -= Tc[s_] * nbs[s_ * 16 + t];
        Tc[t] = a_; if ((t & 3) == 3) asm volatile("" ::: "memory"); }
    LAS float* tts = (LAS float*)(sc + SC_TT);
#pragma unroll
    for (int t = 0; t < 16; ++t) tts[x * 16 + t] = Tc[t];
    { f32x4 tv;
#pragma unroll
      for (int e = 0; e < 4; ++e) tv[e] = -tts[(4 * q + e) * 16 + x];
      *(GAS unsigned long long*)(blk + CB_FT + lane * 8) = pack4bf(tv); }
}
__device__ __forceinline__ void chunk_copy(LAS unsigned char* lds, int c, unsigned char* blk, int lane) {
    const LAS unsigned char* sc = lds + CS2_OFF + c * 16384;
#pragma unroll
    for (int i = 0; i < 4; ++i) *(GAS v4u*)(blk + CB_FA + (i * 64 + lane) * 16) = *(const LAS v4u*)(sc + SC_FA + (i * 64 + lane) * 16);
#pragma unroll
    for (int i = 0; i < 6; ++i) *(GAS v4u*)(blk + CB_FBG + (i * 64 + lane) * 16) = *(const LAS v4u*)(sc + SC_FBG + (i * 64 + lane) * 16);
}
__device__ __forceinline__ float qsum8(float x) {
    x += dpp_f<0xB1>(x); x += dpp_f<0x4E>(x); x += dpp_f<0x141>(x); return x; }
__device__ __forceinline__ void prep_phase(Frame& F, const Args& A) {
    const int tid = F.tid, lane = F.lane, wave = F.wave;
    unsigned char* ws = F.ws; LAS unsigned char* lds = F.lds;
    const bf16* PR = (const bf16*)(ws + WS_ACT);
    const float* mu = A.in[14];
    int hcur = -1;
    const int mtile = wave & 3, nh = wave >> 2;
    v4u ua[4], ub[4], u0, u1, u2, w0_, w1_, w2_;
#define RAW_LOAD1(M0_) do { const int ma_ = (M0_) + row1, mc_ = ma_ < MV ? ma_ : MV - 1, mp_ = (mc_ & (SEQ - 1)) != 0 ? mc_ - 1 : mc_; \
        const bf16* p_ = PR + (size_t)mc_ * SHC + c01; const bf16* pp_ = PR + (size_t)mp_ * SHC + c01; \
        _Pragma("unroll") for (int q_ = 0; q_ < 4; ++q_) { ua[q_] = *(const GAS v4u*)(p_ + 8 * q_); ub[q_] = *(const GAS v4u*)(pp_ + 8 * q_); } } while (0)
#define RAW_LOAD3(M0_, H_) do { const int mb_ = (M0_) + tok3, md_ = mb_ < MV ? mb_ : MV - 1, me_ = (md_ & (SEQ - 1)) != 0 ? md_ - 1 : md_; \
        const bf16* r_ = PR + (size_t)md_ * SHC + 64 * (H_) + 8 * cq; const bf16* rp_ = PR + (size_t)me_ * SHC + 64 * (H_) + 8 * cq; \
        u0 = *(const GAS v4u*)r_; u1 = *(const GAS v4u*)(r_ + RWW); u2 = *(const GAS v4u*)(r_ + 2 * RWW); \
        w0_ = *(const GAS v4u*)rp_; w1_ = *(const GAS v4u*)(rp_ + RWW); w2_ = *(const GAS v4u*)(rp_ + 2 * RWW); } while (0)
    if ((int)blockIdx.x < PREP_UNITS) { const int row1 = tid >> 3, cc = tid & 7, c01 = 3 * RWW + 32 * cc; RAW_LOAD1(((int)blockIdx.x >> 4) * 64); }
    for (int u = blockIdx.x; u < PREP_UNITS; u += F.G) {
        int tl_ = tid; asm volatile("" : "+v"(tl_));
        const int row1 = tl_ >> 3, cc = tl_ & 7, c01 = 3 * RWW + 32 * cc;
        const int ln_ = tl_ & 63, t3 = ln_ >> 3, cq = ln_ & 7, tok3 = 8 * wave + t3, ln = ln_ & 15, q4 = ln_ >> 4;
        const int mt = u >> 4, h = u & 15, m0 = mt * 64, hc0 = 64 * h + 8 * cq;
        if (h != hcur) {
            __syncthreads();
            hcur = h;
            { LAS float* cst = (LAS float*)(lds + PC_OFF);
              for (int i = tid; i < 10 * 64; i += NWAVES * 64) { const int a = i >> 6, c = i & 63, hc = 64 * h + c; float v;
                  if (a < 3) v = mu[a * RWW + hc]; else v = A.in[a == 3 ? 15 : (a == 4 ? 17 : (a == 5 ? 20 : (a == 6 ? 21 : (a == 7 ? 22 : (a == 8 ? 23 : 24)))))][hc];
                  cst[i] = v; } }
            __syncthreads();
        }
        RAW_LOAD3(m0, h);
        const int m1 = m0 + row1; const bool valid1 = m1 < MV;
        f32x4 xa[8], xb[8];
#define UNP(u, lo, hi) { lo = (f32x4){__builtin_bit_cast(float, u.x << 16), __builtin_bit_cast(float, u.x & 0xffff0000u), __builtin_bit_cast(float, u.y << 16), __builtin_bit_cast(float, u.y & 0xffff0000u)}; \
                         hi = (f32x4){__builtin_bit_cast(float, u.z << 16), __builtin_bit_cast(float, u.z & 0xffff0000u), __builtin_bit_cast(float, u.w << 16), __builtin_bit_cast(float, u.w & 0xffff0000u)}; }
        { const bool hp = valid1 && m1 < MP && (m1 & (SEQ - 1)) != 0; const v4u z4 = (v4u){0u, 0u, 0u, 0u};
#pragma unroll
          for (int q = 0; q < 4; ++q) { const v4u b_ = hp ? ub[q] : z4; UNP(ua[q], xa[2 * q], xa[2 * q + 1]) UNP(b_, xb[2 * q], xb[2 * q + 1]) }
          if (valid1 && m1 >= MP) { const float* pv = A.in[5] + (size_t)(m1 - MP) * SHC + c01;
#pragma unroll
              for (int q = 0; q < 8; ++q) xb[q] = *(const GAS f32x4*)(pv + 4 * q); } }
        const int m3 = m0 + tok3; const bool valid3 = m3 < MV;
        f32x4 cr[2], ck[2], cv[2], pr[2], pk[2], pv3[2];
        { const bool hp = valid3 && m3 < MP && (m3 & (SEQ - 1)) != 0; const v4u z4 = (v4u){0u, 0u, 0u, 0u};
          const v4u a_ = hp ? w0_ : z4, b_ = hp ? w1_ : z4, c_ = hp ? w2_ : z4;
          UNP(a_, pr[0], pr[1]) UNP(b_, pk[0], pk[1]) UNP(c_, pv3[0], pv3[1])
          UNP(u0, cr[0], cr[1]) UNP(u1, ck[0], ck[1]) UNP(u2, cv[0], cv[1])
          if (valid3 && m3 >= MP) { const float* q = A.in[5] + (size_t)(m3 - MP) * SHC + hc0;
#pragma unroll
              for (int e = 0; e < 2; ++e) { pr[e] = *(const GAS f32x4*)(q + 4 * e); pk[e] = *(const GAS f32x4*)(q + RWW + 4 * e); pv3[e] = *(const GAS f32x4*)(q + 2 * RWW + 4 * e); } } }
#undef UNP
        for (int rr1_ = 0; rr1_ < 1 + ((PROBE_REP >> 14) & 1); ++rr1_) {
#pragma unroll
        for (int q = 0; q < 8; ++q) {
            const f32x4 m4 = *(const GAS f32x4*)(mu + c01 + 4 * q);
            f32x4 x = xa[q] + m4 * (xb[q] - xa[q]);
            if (cc < 2) { x.x = tanhf_(x.x); x.y = tanhf_(x.y); x.z = tanhf_(x.z); x.w = tanhf_(x.w); }
            else if (cc >= 4) { x.x = sigmoidf_(x.x); x.y = sigmoidf_(x.y); x.z = sigmoidf_(x.z); x.w = sigmoidf_(x.w); }
            if (!valid1) x = (f32x4){0.f, 0.f, 0.f, 0.f};
            *(LAS unsigned long long*)(lds + PA_OFF + row1 * PA_PITCH + (32 * cc + 4 * q) * 2) = (unsigned long long)pk2(x.x, x.y) | ((unsigned long long)pk2(x.z, x.w) << 32);
        }
        __syncthreads();
#pragma unroll
        for (int mat = 0; mat < 3; ++mat) { const int kbase = mat == 0 ? 0 : (mat == 1 ? 64 : 128), KM = mat == 2 ? 128 : 64;
#pragma unroll
            for (int n2 = 0; n2 < 2; ++n2) { const int nt = 2 * nh + n2; f32x4 acc = (f32x4){0.f, 0.f, 0.f, 0.f};
#pragma unroll
                for (int ks = 0; ks < KM / 32; ++ks) {
                    const bf16x8 a = *(const LAS bf16x8*)(lds + PA_OFF + (16 * mtile + ln) * PA_PITCH + (kbase + 32 * ks + 8 * q4) * 2);
                    const bf16x8 bq = *(const GAS bf16x8*)((const bf16*)(ws + (mat == 0 ? WS_W2T : (mat == 1 ? WS_A2T : WS_G2T))) + (size_t)(64 * h + 16 * nt + ln) * KM + 32 * ks + 8 * q4);
                    acc = __builtin_amdgcn_mfma_f32_16x16x32_bf16(a, bq, acc, 0, 0, 0); }
                LAS float* o = (LAS float*)(lds + PW_OFF + mat * PMAT);
#pragma unroll
                for (int r = 0; r < 4; ++r) o[(16 * mtile + 4 * q4 + r) * PW_LD + 16 * nt + ln] = acc[r]; } }
        __syncthreads();
        }
        { const LAS float* cst = (const LAS float*)(lds + PC_OFF) + 8 * cq;
          const LAS float* Wp = (const LAS float*)(lds + PW_OFF) + tok3 * PW_LD + 8 * cq; const LAS float* Ap = Wp + PMAT / 4; const LAS float* Gp = Ap + PMAT / 4;
          float xr[8], xk[8], xv[8], kkr[8], kp[8], aa[8], gg[8], dec[8], lw2[8]; float n2 = 0.f, bon = 0.f;
#pragma unroll
          for (int e = 0; e < 2; ++e) {
              const f32x4 mur = *(const LAS f32x4*)(cst + 0 * 64 + 4 * e), muk = *(const LAS f32x4*)(cst + 1 * 64 + 4 * e), muv = *(const LAS f32x4*)(cst + 2 * 64 + 4 * e);
              const f32x4 w0 = *(const LAS f32x4*)(cst + 3 * 64 + 4 * e), a0 = *(const LAS f32x4*)(cst + 4 * 64 + 4 * e), k_k = *(const LAS f32x4*)(cst + 5 * 64 + 4 * e);
              const f32x4 k_a = *(const LAS f32x4*)(cst + 6 * 64 + 4 * e), r_k = *(const LAS f32x4*)(cst + 7 * 64 + 4 * e);
              const f32x4 wl = *(const LAS f32x4*)(Wp + 4 * e), al = *(const LAS f32x4*)(Ap + 4 * e), gl = *(const LAS f32x4*)(Gp + 4 * e);
              const f32x4 r4 = cr[e] + mur * (pr[e] - cr[e]), k4 = ck[e] + muk * (pk[e] - ck[e]), v4 = cv[e] + muv * (pv3[e] - cv[e]);
#pragma unroll
              for (int j = 0; j < 4; ++j) { const int i = 4 * e + j;
                  xr[i] = r4[j]; xk[i] = k4[j]; xv[i] = v4[j];
                  lw2[i] = -0.6065306597126334f * LOG2E * sigmoidf_(w0[j] + wl[j]); dec[i] = __builtin_amdgcn_exp2f(lw2[i]);
                  aa[i] = sigmoidf_(a0[j] + al[j]); gg[i] = gl[j];
                  kkr[i] = xk[i] * k_k[j]; n2 += kkr[i] * kkr[i];
                  kp[i] = xk[i] * (1.0f + (aa[i] - 1.0f) * k_a[j]);
                  bon += xr[i] * kp[i] * r_k[j]; } }
          n2 = qsum8(n2); bon = qsum8(bon);
          const float inv = 1.0f / fmaxf(sqrtf(n2), 1e-12f);
          float lgv[8], eev[8], bbv[8];
          { const f32x4 lw0 = *(const LAS f32x4*)(cst + 8 * 64), lw1 = *(const LAS f32x4*)(cst + 8 * 64 + 4), lb0 = *(const LAS f32x4*)(cst + 9 * 64), lb1 = *(const LAS f32x4*)(cst + 9 * 64 + 4);
#pragma unroll
            for (int i = 0; i < 8; ++i) { kkr[i] *= inv; bbv[i] = kkr[i] * aa[i]; const float lw = i < 4 ? lw0[i & 3] : lw1[i & 3], lb = i < 4 ? lb0[i & 3] : lb1[i & 3]; lgv[i] = lw * gg[i]; eev[i] = (lb + bon * xv[i]) * gg[i]; } }
#define PK8(a) (v4u){pk2(a[0], a[1]), pk2(a[2], a[3]), pk2(a[4], a[5]), pk2(a[6], a[7])}
          if (valid3) { const size_t o = (size_t)m3 * RWW + hc0;
              *(GAS v4u*)((bf16*)(ws + WS_LG) + o) = PK8(lgv); *(GAS v4u*)((bf16*)(ws + WS_EE) + o) = PK8(eev); }
          if (u + (int)F.G < PREP_UNITS) RAW_LOAD1(((u + (int)F.G) >> 4) * 64);
          if (m0 >= MP) {
              if (valid3) { float* dv = (float*)(ws + WS_DEC) + (size_t)(m3 - MP) * RWW + hc0;
#define ST8(arr, a) { *(GAS f32x4*)(dv + (size_t)(arr) * NDEC * RWW) = (f32x4){a[0], a[1], a[2], a[3]}; *(GAS f32x4*)(dv + (size_t)(arr) * NDEC * RWW + 4) = (f32x4){a[4], a[5], a[6], a[7]}; }
                  ST8(0, kkr) ST8(1, dec) ST8(2, bbv) ST8(3, kp) ST8(4, xr) ST8(5, xv)
#undef ST8
              }
          } else for (int rr3_ = 0; rr3_ < 1 + ((PROBE_REP >> 15) & 1); ++rr3_) {
              *(LAS f32x4*)(lds + LW_OFF + (tok3 * 64 + 8 * cq) * 4) = (f32x4){lw2[0], lw2[1], lw2[2], lw2[3]}; *(LAS f32x4*)(lds + LW_OFF + (tok3 * 64 + 8 * cq) * 4 + 16) = (f32x4){lw2[4], lw2[5], lw2[6], lw2[7]};
              __syncthreads();
              const int cch = tok3 >> 4, t_ = tok3 & 15;
              float Lall[8], Lt[8];
#pragma unroll
              for (int i = 0; i < 8; ++i) { Lall[i] = 0.f; Lt[i] = 0.f; }
#pragma unroll
              for (int s_ = 0; s_ < 16; ++s_) { const LAS float* rp = (const LAS float*)(lds + LW_OFF + ((16 * cch + s_) * 64 + 8 * cq) * 4); const f32x4 a_ = *(const LAS f32x4*)rp, b_ = *(const LAS f32x4*)(rp + 4);
                  const bool in_ = s_ <= t_;
#pragma unroll
                  for (int i = 0; i < 4; ++i) { Lall[i] += a_[i]; Lall[4 + i] += b_[i]; Lt[i] += in_ ? a_[i] : 0.f; Lt[4 + i] += in_ ? b_[i] : 0.f; } }
              unsigned char* blk = chunk_block(ws, ((m0 >> 11) * RWH + h) * NCHUNK + ((m0 & (SEQ - 1)) >> 4) + cch);
              { LAS unsigned char* sc = lds + CS2_OFF + cch * 16384;
                const int ks_ = cq >> 2, qa = 2 * (cq & 1), e0 = 4 * ((cq & 3) >> 1);
                const int a0_ = ((ks_ * 64 + qa * 16 + t_) * 8 + e0) * 2;
#pragma unroll
                for (int hf = 0; hf < 2; ++hf) {
                    float ah[4], rh[4], bh[4], kh[4], bg[4], kg[4], gcv[4];
#pragma unroll
                    for (int i2 = 0; i2 < 4; ++i2) { const int i = 4 * hf + i2;
                        const float gt = __builtin_amdgcn_exp2f(Lt[i]), gp = __builtin_amdgcn_exp2f(Lt[i] - lw2[i]), ig = __builtin_amdgcn_exp2f(-Lt[i]), gr = __builtin_amdgcn_exp2f(Lall[i] - Lt[i]);
                        ah[i2] = gp * kkr[i]; rh[i2] = gt * xr[i]; bh[i2] = bbv[i] * ig; kh[i2] = kp[i] * ig; bg[i2] = bbv[i] * gr; kg[i2] = kp[i] * gr; gcv[i2] = __builtin_amdgcn_exp2f(Lall[i]); }
                    if (t_ == 15) *(GAS f32x4*)(blk + CB_GC + 32 * cq + 16 * hf) = (f32x4){gcv[0], gcv[1], gcv[2], gcv[3]};
#define W4(off, a) *(LAS unsigned long long*)(sc + (off) + a0_ + 256 * hf) = (unsigned long long)cvtpk_c(a[0], a[1]) | ((unsigned long long)cvtpk_c(a[2], a[3]) << 32);
                    W4(SC_FA, ah) W4(SC_FR, rh) W4(SC_FBH, bh) W4(SC_FKH, kh)
#undef W4
#pragma unroll
                    for (int i2 = 0; i2 < 4; ++i2) { const int j_ = 8 * cq + 4 * hf + i2, off = (((j_ >> 4) * 64 + (t_ >> 2) * 16 + (j_ & 15)) * 4 + (t_ & 3)) * 2;
                        *(LAS unsigned short*)(sc + SC_FBG + off) = (unsigned short)cvtpk_c(bg[i2], 0.f); *(LAS unsigned short*)(sc + SC_FKG + off) = (unsigned short)cvtpk_c(kg[i2], 0.f);
                        *(LAS unsigned short*)(sc + SC_FV + off) = (unsigned short)cvtpk_c(xv[4 * hf + i2], 0.f); }
                    asm volatile("" ::: "memory");
                } }
              __syncthreads();
              { unsigned char* blkw = chunk_block(ws, ((m0 >> 11) * RWH + h) * NCHUNK + ((m0 & (SEQ - 1)) >> 4) + (wave & 3));
                if (wave < 4) chunk_mm(lds, wave, blkw, ln_); else chunk_copy(lds, wave - 4, blkw, ln_); }
              __syncthreads();
          }
#undef PK8
        }
    }
#undef RAW_LOAD1
#undef RAW_LOAD3
}

constexpr int AK_PITCH = 144, AV_PITCH = 592, AP_PITCH = 336;
constexpr int AK_OFF = 0, AV_OFF = 272 * AK_PITCH  , AP_OFF = AV_OFF + 64 * AV_PITCH  , AB_OFF = AP_OFF + 8 * 16 * AP_PITCH  ;
static_assert(AB_OFF + 129 * 4 * 4 <= RING_BYTES, "attention LDS");
__device__ __forceinline__ void attn_unit(Frame& F, const Args& A, int b, int blk, int hk) {
    const int tid = F.tid, lane = F.lane, wave = F.wave;
    unsigned char* ws = F.ws; LAS unsigned char* lds = F.lds;
    const bf16* QB = (const bf16*)(ws + WS_QB); const bf16* KB = (const bf16*)(ws + WS_KB); const bf16* VB = (const bf16*)(ws + WS_VB); bf16* MX = (bf16*)(ws + WS_MIX);
    const int mq0 = b * SEQ + blk * 128, mk0 = mq0 - 128;
    for (int i = tid; i < 16 * AK_PITCH / 4; i += NWAVES * 64) ((LAS unsigned*)(lds + AK_OFF + 256 * AK_PITCH))[i] = 0u;
    for (int i = tid; i < 64 * 16; i += NWAVES * 64) ((LAS unsigned*)(lds + AV_OFF + (i >> 4) * AV_PITCH + 512))[i & 15] = 0u;
#pragma unroll
    for (int it = 0; it < 4; ++it) { const int idx = it * 512 + tid, row = idx >> 3, ch = idx & 7;
        v4u kv = (v4u){0u, 0u, 0u, 0u}, vv = kv;
        if (blk > 0 || row >= 128) { kv = *(const GAS v4u*)(KB + (size_t)(mk0 + row) * KVW + hk * 64 + ch * 8); vv = *(const GAS v4u*)(VB + (size_t)(mk0 + row) * KVW + hk * 64 + ch * 8); }
        *(LAS v4u*)(lds + AK_OFF + row * AK_PITCH + ch * 16) = kv;
        LAS unsigned short* vt = (LAS unsigned short*)(lds + AV_OFF + (8 * ch) * AV_PITCH + row * 2);
        vt[0 * (AV_PITCH / 2)] = (unsigned short)(vv.x & 0xffffu); vt[1 * (AV_PITCH / 2)] = (unsigned short)(vv.x >> 16);
        vt[2 * (AV_PITCH / 2)] = (unsigned short)(vv.y & 0xffffu); vt[3 * (AV_PITCH / 2)] = (unsigned short)(vv.y >> 16);
        vt[4 * (AV_PITCH / 2)] = (unsigned short)(vv.z & 0xffffu); vt[5 * (AV_PITCH / 2)] = (unsigned short)(vv.z >> 16);
        vt[6 * (AV_PITCH / 2)] = (unsigned short)(vv.w & 0xffffu); vt[7 * (AV_PITCH / 2)] = (unsigned short)(vv.w >> 16); }
    { const float* bt = (const float*)(ws + WS_BIAS); LAS float* bl = (LAS float*)(lds + AB_OFF);
      for (int i = tid; i < 129 * 4; i += NWAVES * 64) bl[i] = bt[(i >> 2) * NQH + 4 * hk + (i & 3)]; }
    __syncthreads();
    const int g = wave >> 1, half = wave & 1, head = 4 * hk + g, ln = lane & 15, q4 = lane >> 4;
    const float sink2 = A.in[13][head] * LOG2E;
    const LAS float* bl = (const LAS float*)(lds + AB_OFF);
    LAS unsigned char* Pw = lds + AP_OFF + wave * (16 * AP_PITCH);
    bf16x8 qfa[4][2];
#pragma unroll
    for (int rb = 0; rb < 4; ++rb)
#pragma unroll
        for (int ks = 0; ks < 2; ++ks) qfa[rb][ks] = *(const GAS bf16x8*)(QB + (size_t)(mq0 + 64 * half + 16 * rb + ln) * ATTW + head * 64 + 32 * ks + 8 * q4);
#pragma unroll
    for (int rb = 0; rb < 4; ++rb) {
        const int i0 = 64 * half + 16 * rb, kt0 = i0 >> 4;
        bf16x8 qf[2]; qf[0] = qfa[rb][0]; qf[1] = qfa[rb][1];
        f32x4 s[10];
#pragma unroll
        for (int j = 0; j < 10; ++j) { f32x4 acc = (f32x4){0.f, 0.f, 0.f, 0.f};
#pragma unroll
            for (int ks = 0; ks < 2; ++ks) { const bf16x8 kf = *(const LAS bf16x8*)(lds + AK_OFF + (16 * (kt0 + j) + ln) * AK_PITCH + (32 * ks + 8 * q4) * 2);
                acc = __builtin_amdgcn_mfma_f32_16x16x32_bf16(qf[ks], kf, acc, 0, 0, 0); }
            s[j] = acc; }
        float mx[4] = {-INFINITY, -INFINITY, -INFINITY, -INFINITY};
#pragma unroll
        for (int j = 0; j < 10; ++j) { const int kj = 16 * (kt0 + j) + ln;
#pragma unroll
            for (int r = 0; r < 4; ++r) { const int dist = 128 + i0 + 4 * q4 + r - kj; const bool ok = dist >= 0 && dist <= 128 && (blk > 0 || kj >= 128);
                const int dc = dist < 0 ? 0 : (dist > 128 ? 128 : dist);
                const float v = ok ? s[j][r] + bl[dc * 4 + g] : -INFINITY; s[j][r] = v; mx[r] = fmaxf(mx[r], v); } }
        float l[4];
#pragma unroll
        for (int r = 0; r < 4; ++r) { float m_ = mx[r]; m_ = fmaxf(m_, __shfl_xor(m_, 1)); m_ = fmaxf(m_, __shfl_xor(m_, 2)); m_ = fmaxf(m_, __shfl_xor(m_, 4)); m_ = fmaxf(m_, __shfl_xor(m_, 8));
            mx[r] = fmaxf(m_, sink2); l[r] = 0.f; }
#pragma unroll
        for (int j = 0; j < 10; ++j)
#pragma unroll
            for (int r = 0; r < 4; ++r) { const float p = __builtin_amdgcn_exp2f(s[j][r] - mx[r]); l[r] += p;
                *(LAS unsigned short*)(Pw + (4 * q4 + r) * AP_PITCH + (16 * j + ln) * 2) = f2bfs(p); }
#pragma unroll
        for (int r = 0; r < 4; ++r) { float t = l[r]; t += __shfl_xor(t, 1); t += __shfl_xor(t, 2); t += __shfl_xor(t, 4); t += __shfl_xor(t, 8);
            l[r] = __builtin_amdgcn_rcpf(t + __builtin_amdgcn_exp2f(sink2 - mx[r])); }
        f32x4 o[4];
#pragma unroll
        for (int dt = 0; dt < 4; ++dt) o[dt] = (f32x4){0.f, 0.f, 0.f, 0.f};
#pragma unroll
        for (int st = 0; st < 5; ++st) { const bf16x8 pf = *(const LAS bf16x8*)(Pw + ln * AP_PITCH + (32 * st + 8 * q4) * 2);
#pragma unroll
            for (int dt = 0; dt < 4; ++dt) { const bf16x8 vf = *(const LAS bf16x8*)(lds + AV_OFF + (16 * dt + ln) * AV_PITCH + (16 * kt0 + 32 * st + 8 * q4) * 2);
                o[dt] = __builtin_amdgcn_mfma_f32_16x16x32_bf16(pf, vf, o[dt], 0, 0, 0); } }
#pragma unroll
        for (int dt = 0; dt < 4; ++dt)
#pragma unroll
            for (int r = 0; r < 4; ++r) *(LAS unsigned short*)(Pw + (4 * q4 + r) * AP_PITCH + (16 * dt + ln) * 2) = f2bfs(o[dt][r] * l[r]);
#pragma unroll
        for (int i = 0; i < 2; ++i) { const int qrow = 8 * i + (lane >> 3), ch = lane & 7;
            const v4u ov = *(const LAS v4u*)(Pw + qrow * AP_PITCH + ch * 16);
            *(GAS v4u*)(MX + (size_t)(mq0 + i0 + qrow) * DM + head * 64 + ch * 8) = ov; }
    }
    __syncthreads();
}

__device__ __forceinline__ void dec_attn_unit(Frame& F, const Args& A, int du) {
    const int lane = F.lane, wave = F.wave; unsigned char* ws = F.ws;
    const int idx = du * 8 + wave, b = idx >> 4, head = idx & 15, hk = head >> 2, m = MP + b;
    LAS float* qs = (LAS float*)(F.lds + wave * 1024); LAS float* ps = qs + 64;
    const bf16* QB = (const bf16*)(ws + WS_QB); bf16* MX = (bf16*)(ws + WS_MIX);
    const float* bt = (const float*)(ws + WS_BIAS);
    const float sink2 = A.in[13][head] * LOG2E;
    const float qv = bf2f(QB[(size_t)m * ATTW + head * 64 + lane]);
    qs[lane] = qv;
    LDS_WAIT(); asm volatile("" ::: "memory");
    float sc[2];
#pragma unroll
    for (int pi = 0; pi < 2; ++pi) { const int pos = lane + 64 * pi; const float* kr = A.in[2] + ((size_t)(b * WIN + pos) * NKVH + hk) * HD; float d = 0.f;
#pragma unroll
        for (int j = 0; j < 16; ++j) { const f32x4 k4 = *(const f32x4*)(kr + 4 * j); const f32x4 q4v = *(const LAS f32x4*)(qs + 4 * j); d += (k4.x * q4v.x + k4.y * q4v.y) + (k4.z * q4v.z + k4.w * q4v.w); }
        sc[pi] = d + bt[(WIN - pos) * NQH + head]; }
    const float* kn = F.out + O_KS + ((size_t)b * WIN + (WIN - 1)) * KVW + hk * HD; const float* vn = F.out + O_VS + ((size_t)b * WIN + (WIN - 1)) * KVW + hk * HD;
    const float snew = wave_sum(qv * kn[lane]) + bt[head];
    const float mx = fmaxf(fmaxf(wave_max(fmaxf(sc[0], sc[1])), snew), sink2);
    const float p0 = __builtin_amdgcn_exp2f(sc[0] - mx), p1 = __builtin_amdgcn_exp2f(sc[1] - mx), pn = __builtin_amdgcn_exp2f(snew - mx);
    const float linv = __builtin_amdgcn_rcpf(wave_sum(p0 + p1) + pn + __builtin_amdgcn_exp2f(sink2 - mx));
    ps[lane] = p0; ps[lane + 64] = p1;
    LDS_WAIT(); asm volatile("" ::: "memory");
    const float* vr = A.in[3] + ((size_t)(b * WIN) * NKVH + hk) * HD + lane; float o = pn * vn[lane];
#pragma unroll 8
    for (int pos = 0; pos < WIN; ++pos) o += ps[pos] * vr[(size_t)pos * NKVH * HD];
    MX[(size_t)m * DM + head * 64 + lane] = f2bfs(o * linv);
    LDS_WAIT(); asm volatile("" ::: "memory");
}

constexpr int SC_T = 32, SC_REC = 1344  , SC_BUF = SC_T * SC_REC  ;
struct ScanRegs { v4u kk, bb, kp, rr, vv; f32x4 d0, d1; };
__device__ __forceinline__ void scan_load(ScanRegs& R, const unsigned char* ws, int m, int h, int rq, int part) {
    const size_t o = (size_t)m * RWW + 64 * h + 8 * part;
    R.kk = *(const GAS v4u*)((const bf16*)(ws + WS_KK) + o); R.bb = *(const GAS v4u*)((const bf16*)(ws + WS_BB) + o);
    R.kp = *(const GAS v4u*)((const bf16*)(ws + WS_KP) + o); R.rr = *(const GAS v4u*)((const bf16*)(ws + WS_RR) + o);
    R.d0 = *(const GAS f32x4*)((const float*)(ws + WS_DD) + o); R.d1 = *(const GAS f32x4*)((const float*)(ws + WS_DD) + o + 4);
    R.vv = (v4u){0u, 0u, 0u, 0u};
    if (part < 2) R.vv = *(const GAS v4u*)((const bf16*)(ws + WS_VV) + (size_t)m * RWW + 64 * h + 16 * rq + 8 * part);
}
__device__ __forceinline__ void st8(LAS unsigned char* p, v4u u) {
    *(LAS f32x4*)p = (f32x4){__builtin_bit_cast(float, u.x << 16), __builtin_bit_cast(float, u.x & 0xffff0000u), __builtin_bit_cast(float, u.y << 16), __builtin_bit_cast(float, u.y & 0xffff0000u)};
    *(LAS f32x4*)(p + 16) = (f32x4){__builtin_bit_cast(float, u.z << 16), __builtin_bit_cast(float, u.z & 0xffff0000u), __builtin_bit_cast(float, u.w << 16), __builtin_bit_cast(float, u.w & 0xffff0000u)};
}
__device__ __forceinline__ void scan_store(const ScanRegs& R, LAS unsigned char* rec, int part) {
    st8(rec + 0 + 32 * part, R.kk); *(LAS f32x4*)(rec + 256 + 32 * part) = R.d0; *(LAS f32x4*)(rec + 256 + 32 * part + 16) = R.d1;
    st8(rec + 512 + 32 * part, R.bb); st8(rec + 768 + 32 * part, R.kp); st8(rec + 1024 + 32 * part, R.rr);
    if (part < 2) st8(rec + 1280 + 32 * part, R.vv);
}
constexpr int SC_YOFF = 2 * SC_BUF, SC_YBUF = SC_T * 16 * 4 * 4  ;
static_assert(SC_YOFF + 2 * SC_YBUF <= RING_BYTES, "scan LDS");
struct ScanVec { f32x2 kk0, kk1, d0, d1, b0, b1, k0, k1, r0, r1; float v; };
__device__ __forceinline__ void scan_ld(ScanVec& x, const LAS unsigned char* base, const LAS unsigned char* vb, int t) {
    const f32x4 kk = *(const LAS f32x4*)(base + t * SC_REC), dd = *(const LAS f32x4*)(base + t * SC_REC + 256), bb = *(const LAS f32x4*)(base + t * SC_REC + 512),
                kp = *(const LAS f32x4*)(base + t * SC_REC + 768), rr = *(const LAS f32x4*)(base + t * SC_REC + 1024);
    x.kk0 = (f32x2){kk.x, kk.y}; x.kk1 = (f32x2){kk.z, kk.w}; x.d0 = (f32x2){dd.x, dd.y}; x.d1 = (f32x2){dd.z, dd.w}; x.b0 = (f32x2){bb.x, bb.y}; x.b1 = (f32x2){bb.z, bb.w};
    x.k0 = (f32x2){kp.x, kp.y}; x.k1 = (f32x2){kp.z, kp.w}; x.r0 = (f32x2){rr.x, rr.y}; x.r1 = (f32x2){rr.z, rr.w};
    x.v = *(const LAS float*)(vb + t * SC_REC);
}
__device__ __forceinline__ void scan_yflush(const LAS unsigned char* yb, float* YS, int ptid) {
#pragma unroll
    for (int i = 0; i < 2; ++i) { const int o = ptid + 256 * i, t = o >> 4, r = o & 15; const f32x4 q = *(const LAS f32x4*)(yb + o * 16);
        YS[(size_t)t * RWW + r] = (q.x + q.y) + (q.z + q.w); }
}
__device__ __forceinline__ void scan_unit(Frame& F, int c) {
    const int b = c >> 6, h = (c >> 2) & 15, rq = c & 3, lane = F.lane, wave = F.wave;
    unsigned char* ws = F.ws; LAS unsigned char* lds = F.lds;
    const int mb = b * SEQ; constexpr int NCH = SEQ / SC_T;
    if (wave >= 4) {
        const int ptid = F.tid - 256, tok = ptid >> 3, part = ptid & 7;
        float* YS = (float*)(ws + WS_ACT) + (size_t)mb * RWW + 64 * h + 16 * rq;
        ScanRegs cur, nxt;
        scan_load(cur, ws, mb + tok, h, rq, part);
        scan_load(nxt, ws, mb + SC_T + tok, h, rq, part);
        scan_store(cur, lds + tok * SC_REC, part);
        __syncthreads();
        for (int ch = 0; ch < NCH; ++ch) {
            cur = nxt;
            if (ch + 2 < NCH) scan_load(nxt, ws, mb + (ch + 2) * SC_T + tok, h, rq, part);
            if (ch + 1 < NCH) scan_store(cur, lds + ((ch + 1) & 1) * SC_BUF + tok * SC_REC, part);
            if (ch > 0) scan_yflush(lds + SC_YOFF + ((ch - 1) & 1) * SC_YBUF, YS + (size_t)(ch - 1) * SC_T * RWW, ptid);
            __syncthreads();
        }
        scan_yflush(lds + SC_YOFF + ((NCH - 1) & 1) * SC_YBUF, YS + (size_t)(NCH - 1) * SC_T * RWW, ptid);
    } else {
        const int rl = 4 * wave + (lane >> 4), p = lane & 15, row = 16 * rq + rl;
        f32x2 S0 = (f32x2){0.f, 0.f}, S1 = S0;
        __builtin_amdgcn_s_setprio(2);
        __syncthreads();
        for (int ch = 0; ch < NCH; ++ch) {
            const LAS unsigned char* base = lds + (ch & 1) * SC_BUF + p * 16;
            const LAS unsigned char* vb = lds + (ch & 1) * SC_BUF + 1280 + rl * 4;
            LAS unsigned char* yb = lds + SC_YOFF + (ch & 1) * SC_YBUF + (rl * 4 + (p & 3)) * 4;
            ScanVec cur; scan_ld(cur, base, vb, 0);
#pragma unroll
            for (int t = 0; t < SC_T; ++t) {
                ScanVec nxt; scan_ld(nxt, base, vb, t + 1 < SC_T ? t + 1 : t);
                f32x2 a = S0 * cur.kk0; a = S1 * cur.kk1 + a;
                const float sa = -allsum16(a.x + a.y);
                const f32x2 sa2 = (f32x2){sa, sa}, v2 = (f32x2){cur.v, cur.v};
                f32x2 u0 = cur.b0 * sa2, u1 = cur.b1 * sa2;
                u0 = S0 * cur.d0 + u0; u1 = S1 * cur.d1 + u1;
                S0 = cur.k0 * v2 + u0; S1 = cur.k1 * v2 + u1;
                f32x2 q = S0 * cur.r0; q = S1 * cur.r1 + q;
                float y = q.x + q.y; y += dpp_f<0x128>(y); y += dpp_f<0x124>(y);
                *(LAS float*)(yb + t * 256) = y;
                cur = nxt;
            }
            __syncthreads();
        }
        __builtin_amdgcn_s_setprio(0);
        *(f32x4*)(F.out + O_WP + ((size_t)(b * RWH + h) * HD + row) * HD + 4 * p) = (f32x4){S0.x, S0.y, S1.x, S1.y};
    }
}
__device__ __forceinline__ void dec_rwkv_unit(Frame& F, const Args& A, int du) {
    const int lane = F.lane, wave = F.wave; unsigned char* ws = F.ws;
    const int idx = du * 8 + wave, b = idx >> 4, h = idx & 15, m = MP + b;
    LAS float* vec = (LAS float*)(F.lds + wave * 1280);
    const size_t o = (size_t)m * RWW + 64 * h + lane;
    const float* dv = (const float*)(ws + WS_DEC) + (size_t)b * RWW + 64 * h + lane;
    vec[lane] = dv[0]; vec[64 + lane] = dv[(size_t)1 * NDEC * RWW]; vec[128 + lane] = dv[(size_t)2 * NDEC * RWW];
    vec[192 + lane] = dv[(size_t)3 * NDEC * RWW]; vec[256 + lane] = dv[(size_t)4 * NDEC * RWW];
    const float vi = dv[(size_t)5 * NDEC * RWW];
    const size_t so = ((size_t)(b * RWH + h) * HD + lane) * HD;
    const float* Sp = A.in[4] + so; f32x4 S[16];
#pragma unroll
    for (int j = 0; j < 16; ++j) S[j] = *(const f32x4*)(Sp + 4 * j);
    LDS_WAIT(); asm volatile("" ::: "memory");
    float sa = 0.f;
#pragma unroll
    for (int j = 0; j < 16; ++j) { const f32x4 kk = *(const LAS f32x4*)(vec + 4 * j); sa += (S[j].x * kk.x + S[j].y * kk.y) + (S[j].z * kk.z + S[j].w * kk.w); asm volatile("" ::: "memory"); }
    sa = -sa; float y = 0.f; float* So = F.out + O_WS + so;
#pragma unroll
    for (int j = 0; j < 16; ++j) { const f32x4 dd = *(const LAS f32x4*)(vec + 64 + 4 * j), bb = *(const LAS f32x4*)(vec + 128 + 4 * j), kp = *(const LAS f32x4*)(vec + 192 + 4 * j), rr = *(const LAS f32x4*)(vec + 256 + 4 * j);
        S[j] = S[j] * dd + bb * sa + kp * vi; y += (S[j].x * rr.x + S[j].y * rr.y) + (S[j].z * rr.z + S[j].w * rr.w);
        *(f32x4*)(So + 4 * j) = S[j]; asm volatile("" ::: "memory"); }
    ((float*)(ws + WS_ACT))[o] = y;
    LDS_WAIT(); asm volatile("" ::: "memory");
}


constexpr int SC2_NS = 8, SC2_D = SC2_NS - 1;
static_assert(SC2_NS * CB_STRIDE <= RING_BYTES, "scan ring");
__device__ __forceinline__ void scan2_unit(Frame& F, int c) {
    const int b = c >> 4, h = c & 15, lane = F.lane, wave = F.wave;
    unsigned char* ws = F.ws; LAS unsigned char* lds = F.lds;
    const int mb = b * SEQ, g0 = (b * RWH + h) * NCHUNK;
#define SC2_BAR() do { asm volatile("" ::: "memory"); __builtin_amdgcn_s_barrier(); asm volatile("" ::: "memory"); } while (0)
    if (wave >= 4) {
        const int lw = wave - 4;
#define SC2_ISSUE(cc) do { const unsigned char* blk_ = chunk_block(ws, g0 + (cc)); LAS unsigned char* sl_ = lds + ((cc) & (SC2_NS - 1)) * CB_STRIDE; \
            for (int p_ = lw; p_ < 13; p_ += 4) __builtin_amdgcn_global_load_lds((const unsigned*)(blk_ + p_ * 1024 + lane * 16), (LAS unsigned*)(sl_ + p_ * 1024), 16, 0, 0); } while (0)
#define SC2_WAIT() do { if (lw == 0) asm volatile("s_waitcnt vmcnt(20)" ::: "memory"); else asm volatile("s_waitcnt vmcnt(15)" ::: "memory"); } while (0)
        for (int cc = 0; cc < SC2_D; ++cc) SC2_ISSUE(cc);
        SC2_WAIT(); SC2_BAR();
        for (int cc = 0; cc < NCHUNK; ++cc) {
            if (cc + SC2_D < NCHUNK) { SC2_ISSUE(cc + SC2_D); SC2_WAIT(); } else asm volatile("s_waitcnt vmcnt(0)" ::: "memory");
            SC2_BAR();
        }
#undef SC2_ISSUE
#undef SC2_WAIT
    } else {
        const int it = wave, x = lane & 15, q = lane >> 4;
        f32x4 S[4];
#pragma unroll
        for (int jt = 0; jt < 4; ++jt) S[jt] = (f32x4){0.f, 0.f, 0.f, 0.f};
        float* YS = (float*)(ws + WS_ACT) + (size_t)mb * RWW + 64 * h + 16 * it + x;
        bf16x8 fa[2], fr[2]; s16x4 fnk, ft, fmb, fmk, fv, fbg[4], fkg[4]; f32x4 gc[4];
#define SC2_LOAD(cc) do { const LAS unsigned char* sl = lds + ((cc) & (SC2_NS - 1)) * CB_STRIDE; \
            _Pragma("unroll") for (int k2 = 0; k2 < 2; ++k2) { fa[k2] = *(const LAS bf16x8*)(sl + CB_FA + (k2 * 64 + lane) * 16); fr[k2] = *(const LAS bf16x8*)(sl + CB_FR + (k2 * 64 + lane) * 16); } \
            fnk = *(const LAS s16x4*)(sl + CB_FNK + lane * 8); ft = *(const LAS s16x4*)(sl + CB_FT + lane * 8); fmb = *(const LAS s16x4*)(sl + CB_FMB + lane * 8); fmk = *(const LAS s16x4*)(sl + CB_FMK + lane * 8); \
            fv = *(const LAS s16x4*)(sl + CB_FV + (it * 64 + lane) * 8); \
            _Pragma("unroll") for (int jt = 0; jt < 4; ++jt) { fbg[jt] = *(const LAS s16x4*)(sl + CB_FBG + (jt * 64 + lane) * 8); fkg[jt] = *(const LAS s16x4*)(sl + CB_FKG + (jt * 64 + lane) * 8); \
                gc[jt] = *(const LAS f32x4*)(sl + CB_GC + (16 * jt + 4 * q) * 4); } } while (0)
        SC2_BAR();
        SC2_LOAD(0);
        for (int cc = 0; cc < NCHUNK; ++cc) {
            bf16x8 sb[2];
#pragma unroll
            for (int k2 = 0; k2 < 2; ++k2) { const unsigned long long lo = pack4bf(S[2 * k2]), hi = pack4bf(S[2 * k2 + 1]);
                v4u w_; w_.x = (unsigned)lo; w_.y = (unsigned)(lo >> 32); w_.z = (unsigned)hi; w_.w = (unsigned)(hi >> 32); sb[k2] = __builtin_bit_cast(bf16x8, w_); }
            f32x4 X = (f32x4){0.f, 0.f, 0.f, 0.f};
            X = __builtin_amdgcn_mfma_f32_16x16x32_bf16(fa[0], sb[0], X, 0, 0, 0); X = __builtin_amdgcn_mfma_f32_16x16x32_bf16(fa[1], sb[1], X, 0, 0, 0);
            X = __builtin_amdgcn_mfma_f32_16x16x16bf16_1k(fnk, fv, X, 0, 0, 0);
            f32x4 Y = (f32x4){0.f, 0.f, 0.f, 0.f};
            Y = __builtin_amdgcn_mfma_f32_16x16x32_bf16(fr[0], sb[0], Y, 0, 0, 0); Y = __builtin_amdgcn_mfma_f32_16x16x32_bf16(fr[1], sb[1], Y, 0, 0, 0);
            Y = __builtin_amdgcn_mfma_f32_16x16x16bf16_1k(fmk, fv, Y, 0, 0, 0);
            f32x4 Sn[4];
#pragma unroll
            for (int jt = 0; jt < 4; ++jt) Sn[jt] = __builtin_amdgcn_mfma_f32_16x16x16bf16_1k(fkg[jt], fv, S[jt] * gc[jt], 0, 0, 0);
            const s16x4 xb = __builtin_bit_cast(s16x4, pack4bf(X));
            const f32x4 U = __builtin_amdgcn_mfma_f32_16x16x16bf16_1k(ft, xb, (f32x4){0.f, 0.f, 0.f, 0.f}, 0, 0, 0);
            const s16x4 ub = __builtin_bit_cast(s16x4, pack4bf(U));
            Y = __builtin_amdgcn_mfma_f32_16x16x16bf16_1k(fmb, ub, Y, 0, 0, 0);
#pragma unroll
            for (int jt = 0; jt < 4; ++jt) S[jt] = __builtin_amdgcn_mfma_f32_16x16x16bf16_1k(fbg[jt], ub, Sn[jt], 0, 0, 0);
            if (cc + 1 < NCHUNK) SC2_LOAD(cc + 1);
#pragma unroll
            for (int r = 0; r < 4; ++r) YS[(size_t)(16 * cc + 4 * q + r) * RWW] = Y[r];
            asm volatile("s_waitcnt lgkmcnt(0)" ::: "memory");
            SC2_BAR();
        }
#undef SC2_LOAD
#pragma unroll
        for (int jt = 0; jt < 4; ++jt) *(f32x4*)(F.out + O_WP + ((size_t)(b * RWH + h) * HD + 16 * it + x) * HD + 16 * jt + 4 * q) = S[jt];
    }
#undef SC2_BAR
}

constexpr int SK_S = 4;
__device__ __forceinline__ void skinny_units(Frame& F, const bf16* Arows, int lda, const bf16* Bt, int K, unsigned* cnt, float* slabs,
                                             const float* xi_s, const bf16* xb_in, float* xo_s, bf16* XBd, float* ssq, float alpha) {
    const int tid = F.tid, lane = F.lane, wave = F.wave, ln = lane & 15, q4 = lane >> 4, ksteps = K / 32;
    LAS unsigned char* lds = F.lds;
    for (int u = blockIdx.x; u < 32 * SK_S; u += F.G) {
        const int nb = u & 31, sl = u >> 5, n0 = 64 * nb, ks0 = sl * ksteps / SK_S, ks1 = (sl + 1) * ksteps / SK_S;
        f32x4 acc[2][4];
#pragma unroll
        for (int mt = 0; mt < 2; ++mt)
#pragma unroll
            for (int nt = 0; nt < 4; ++nt) acc[mt][nt] = (f32x4){0.f, 0.f, 0.f, 0.f};
        const bf16* ap = Arows + (size_t)ln * lda + 8 * q4; const bf16* bp = Bt + (size_t)(n0 + ln) * K + 8 * q4;
#pragma unroll 2
        for (int ks = ks0 + wave; ks < ks1; ks += 8) { const int k = 32 * ks;
            bf16x8 a[2], b[4];
#pragma unroll
            for (int mt = 0; mt < 2; ++mt) a[mt] = *(const GAS bf16x8*)(ap + (size_t)(16 * mt) * lda + k);
#pragma unroll
            for (int nt = 0; nt < 4; ++nt) b[nt] = *(const GAS bf16x8*)(bp + (size_t)(16 * nt) * K + k);
#pragma unroll
            for (int mt = 0; mt < 2; ++mt)
#pragma unroll
                for (int nt = 0; nt < 4; ++nt) acc[mt][nt] = __builtin_amdgcn_mfma_f32_16x16x32_bf16(a[mt], b[nt], acc[mt][nt], 0, 0, 0); }
#pragma unroll
        for (int mt = 0; mt < 2; ++mt)
#pragma unroll
            for (int nt = 0; nt < 4; ++nt) *(LAS f32x4*)(lds + ((wave * 8 + mt * 4 + nt) * 64 + lane) * 16) = acc[mt][nt];
        __syncthreads();
        { const int tile = tid >> 6, l = tid & 63; f32x4 sum = (f32x4){0.f, 0.f, 0.f, 0.f};
#pragma unroll
          for (int w = 0; w < 8; ++w) sum += *(const LAS f32x4*)(lds + ((w * 8 + tile) * 64 + l) * 16);
          float* sp = slabs + (size_t)sl * 32 * DM + (size_t)(16 * (tile >> 2) + 4 * (l >> 4)) * DM + n0 + 16 * (tile & 3) + (l & 15);
          sp[0] = sum.x; sp[DM] = sum.y; sp[2 * DM] = sum.z; sp[3 * DM] = sum.w; }
        VM_WAIT(); __syncthreads();
        if (tid == 0) { __builtin_amdgcn_fence(__ATOMIC_RELEASE, "agent"); VM_WAIT();
            const unsigned t = __hip_atomic_fetch_add(cnt + nb, 1u, __ATOMIC_RELAXED, __HIP_MEMORY_SCOPE_AGENT);
            const unsigned last = (t == (unsigned)(SK_S - 1)) ? 1u : 0u;
            if (last) { __builtin_amdgcn_fence(__ATOMIC_ACQUIRE, "agent"); VM_WAIT(); }
            *(LAS unsigned*)(lds + 65536) = last; }
        __syncthreads();
        const unsigned last = *(const LAS unsigned*)(lds + 65536);
        if (last) {
            const int row = tid >> 4, c4 = (tid & 15) * 4, col = n0 + c4;
            f32x4 a4 = (f32x4){0.f, 0.f, 0.f, 0.f};
#pragma unroll
            for (int s2 = 0; s2 < SK_S; ++s2) a4 += *(const GAS f32x4*)(slabs + (size_t)s2 * 32 * DM + (size_t)row * DM + col);
            f32x4 x0;
            if (xb_in) { const unsigned long long w = *(const GAS unsigned long long*)(xb_in + (size_t)(MP + row) * DM + col);
                x0 = (f32x4){__builtin_bit_cast(float, (unsigned)w << 16), __builtin_bit_cast(float, (unsigned)w & 0xffff0000u), __builtin_bit_cast(float, (unsigned)(w >> 32) << 16), __builtin_bit_cast(float, (unsigned)(w >> 32) & 0xffff0000u)}; }
            else x0 = *(const f32x4*)(xi_s + (size_t)row * DM + col);
            const f32x4 y = x0 + a4 * alpha;
            if (xo_s) *(f32x4*)(xo_s + (size_t)row * DM + col) = y;
            if (XBd) *(GAS unsigned long long*)(XBd + (size_t)(MP + row) * DM + col) = (unsigned long long)pk2(y.x, y.y) | ((unsigned long long)pk2(y.z, y.w) << 32);
            float sq = (y.x * y.x + y.y * y.y) + (y.z * y.z + y.w * y.w);
            sq += __shfl_xor(sq, 1); sq += __shfl_xor(sq, 2); sq += __shfl_xor(sq, 4); sq += __shfl_xor(sq, 8);
            if ((tid & 15) == 0) atomicAdd(ssq + MP + row, sq);
        }
        __syncthreads();
    }
}
__global__ void __launch_bounds__(NWAVES * 64, 2) hymba_fwd(Args args) {
    extern __shared__ __attribute__((aligned(16))) unsigned char lds_raw[];
    { const int t0_ = threadIdx.x;
      for (int u = t0_; u < (LDS_BYTES - LDSCTL_OFF) / 4; u += NWAVES * 64) ((LAS unsigned*)((LAS unsigned char*)lds_raw + LDSCTL_OFF))[u] = 0u; }
    __syncthreads();
    XcdBarrier bar; bar.bar = (unsigned*)((gu32*)(args.ws + WS_CTL) + CW_BAR); bar.x = 0; bar.st = nullptr;
    if (MK_N_LAUNCHES == 1) bar = xcd_barrier_post((unsigned*)((gu32*)(args.ws + WS_CTL) + CW_BAR), (volatile LAS unsigned*)((LAS unsigned char*)lds_raw + MISC_OFF) + 8);
    const int lo = args.ph_lo, hi = args.ph_hi;
#ifndef PH_MASK
#define PH_MASK 0x7ff
#endif
#define IN(k) (((PH_MASK >> (k)) & 1) && lo <= (k) && (k) < hi)
#define SEAM(k) do { if (IN(k) && IN((k) + 1)) xcd_barrier(bar); } while (0)
#ifndef PROBE_REP
#define PROBE_REP 0
#endif
#define NREP(k) (1 + ((PROBE_REP >> (k)) & 1))
#define PHASE_FRAME() Frame F; { int t_ = threadIdx.x; asm volatile("" : "+v"(t_)); F.lds = (LAS unsigned char*)lds_raw; F.MISC = (volatile LAS unsigned*)(F.lds + MISC_OFF); F.tid = t_; F.lane = t_ & 63; \
        F.wave = __builtin_amdgcn_readfirstlane(t_ >> 6); F.G = gridDim.x; F.out = args.out; F.ws = args.ws; F.ctl = (gu32*)(args.ws + WS_CTL); } \
    unsigned char* ws = F.ws; const int gw = blockIdx.x * NWAVES + F.wave, NGW = F.G * NWAVES; (void)gw; (void)NGW; \
    bf16* XB = (bf16*)(ws + WS_XB); bf16* ACT = (bf16*)(ws + WS_ACT); bf16* X2B = (bf16*)(ws + WS_X2B); bf16* MIXB = (bf16*)(ws + WS_MIX); (void)XB; (void)ACT; (void)X2B; (void)MIXB; \
    float* ssq0 = (float*)(F.ctl + CW_SSQ0); float* ssq1 = (float*)(F.ctl + CW_SSQ1); float* ssq2 = (float*)(F.ctl + CW_SSQ2); float* ssq3 = (float*)(F.ctl + CW_SSQ3); float* ssqd = (float*)(F.ctl + CW_SSQD); (void)ssqd; (void)ssq0; (void)ssq1; (void)ssq2; (void)ssq3; \
    float* yp = args.out + O_YP; float* ys = args.out + O_YS; (void)yp; (void)ys;

    if (IN(0)) for (int rep = 0; rep < NREP(0); ++rep) { PHASE_FRAME(); p0_prologue(F, args); if (rep + 1 < NREP(0)) xcd_barrier(bar); else SEAM(0); }
    if (IN(1)) for (int rep = 0; rep < NREP(1); ++rep) { PHASE_FRAME(); pg8::Gemm g{XB, (const bf16*)(ws + WS_WGU1), MPAD, 2 * DFF, DM}; pg8::StaticOrder S; S.init(MPAD, 2 * DFF, F.G, (int)blockIdx.x);
        pg8::EpiSwiglu E{ACT, ssq0};
        pg8::gemm_phase<pg8::EpiSwiglu, pg8::StaticOrder, true, true>(F.lds + RING_OFF, g, S, E);
#ifndef CV_ALL_IN_P0
        { const int nfull = S.nwg % F.G; if (rep == 0 && nfull != 0 && (int)blockIdx.x >= nfull) convert_items(F, args, CV_G0, CV_G1, (int)blockIdx.x - nfull, F.G - nfull);
          else if (rep == 0 && nfull == 0) convert_items(F, args, CV_G0, CV_G1, blockIdx.x, F.G); }
#endif
        if (rep + 1 < NREP(1)) xcd_barrier(bar); else SEAM(1); }
    if (IN(2)) for (int rep = 0; rep < NREP(2); ++rep) { PHASE_FRAME(); pg8::Gemm g{ACT, (const bf16*)(ws + WS_WD1), MP, DM, DFF}; pg8::StaticOrder S; S.init(MP, DM, F.G, (int)blockIdx.x);
        pg8::EpiResid E{args.in[0], args.in[1], nullptr, nullptr, nullptr, XB, rep ? ssqd : ssq1, 0.5f};
        pg8::gemm_phase<pg8::EpiResid, pg8::StaticOrder, true, true>(F.lds + RING_OFF, g, S, E);
        skinny_units(F, ACT + (size_t)MP * DFF, DFF, (const bf16*)(ws + WS_WD1), DFF, (unsigned*)(F.ctl + CW_SKC + 64 * rep), (float*)(ws + WS_SLAB), args.in[1], nullptr, nullptr, XB, rep ? ssqd : ssq1, 0.5f);
        if (rep + 1 < NREP(2)) xcd_barrier(bar); else SEAM(2); }
    if (IN(3)) for (int rep = 0; rep < NREP(3); ++rep) { PHASE_FRAME(); pg8::Gemm g{XB, (const bf16*)(ws + WS_WINB), MPAD, INC, DM}; pg8::StaticOrder S; S.init(MPAD, INC, F.G, (int)blockIdx.x);
        pg8::EpiWin E{ssq1, (bf16*)(ws + WS_QB), (bf16*)(ws + WS_KB), (bf16*)(ws + WS_VB), (bf16*)(ws + WS_ACT), args.out};
        pg8::gemm_phase<pg8::EpiWin, pg8::StaticOrder, true, true>(F.lds + RING_OFF, g, S, E);
#ifndef CV_ALL_IN_P0
        { const int nfull = S.nwg % F.G; if (rep == 0 && nfull != 0 && (int)blockIdx.x >= nfull) convert_items(F, args, CV_G0 + CV_G1, CV_G2, (int)blockIdx.x - nfull, F.G - nfull);
          else if (rep == 0 && nfull == 0) convert_items(F, args, CV_G0 + CV_G1, CV_G2, blockIdx.x, F.G); }
#endif
        if (rep + 1 < NREP(3)) xcd_barrier(bar); else SEAM(3); }
    if (IN(4)) for (int rep = 0; rep < NREP(4); ++rep) { PHASE_FRAME();
        for (int r2 = 0; r2 < 1 + ((PROBE_REP >> 12) & 1); ++r2) { __syncthreads(); prep_phase(F, args); }
        if (rep + 1 < NREP(4)) xcd_barrier(bar); else SEAM(4); }
    if (IN(5)) for (int rep = 0; rep < NREP(5); ++rep) { PHASE_FRAME();
        if ((int)blockIdx.x < NB * RWH) scan2_unit(F, blockIdx.x);
        else { const int oc = (int)blockIdx.x - NB * RWH, on = (int)F.G - NB * RWH;
            for (int r2 = 0; r2 < 1 + ((PROBE_REP >> 11) & 1); ++r2)
            for (int u = oc; u < NB * 16 * NKVH; u += on) attn_unit(F, args, u >> 6, (u >> 2) & 15, u & 3);
            __syncthreads();
            for (int u = on - 1 - oc; u < NDEC * NQH / 8; u += on) dec_attn_unit(F, args, u);
            __syncthreads();
            for (int u = on - 1 - oc; u < NDEC * RWH / 8; u += on) dec_rwkv_unit(F, args, u);
            { const int n4 = NDEC * (WIN - 1) * KVW / 4;
              for (int i = oc * (NWAVES * 64) + F.tid; i < 2 * n4; i += on * NWAVES * 64) { const int t = i >= n4, j = t ? i - n4 : i; const int bb = j / ((WIN - 1) * KVW / 4), r = j % ((WIN - 1) * KVW / 4);
                  const f32x4 v = *((const f32x4*)(args.in[2 + t] + (size_t)bb * WIN * KVW + KVW) + r);
                  *((f32x4*)(args.out + (t ? O_VS : O_KS) + (size_t)bb * WIN * KVW) + r) = v; } }
#ifndef CV_ALL_IN_P0
            __syncthreads();
            if (rep == 0) convert_items(F, args, CV_G0 + CV_G1 + CV_G2, CV_G3, oc, on);
#endif
        }
        if (rep + 1 < NREP(5)) xcd_barrier(bar); else SEAM(5); }
    if (IN(6)) for (int rep = 0; rep < NREP(6); ++rep) { PHASE_FRAME(); const float* YS = (const float*)(ws + WS_ACT); const bf16* LG = (const bf16*)(ws + WS_LG); const bf16* EE = (const bf16*)(ws + WS_EE);
        for (int u8 = gw; u8 < (MV * RWH + 7) / 8; u8 += NGW) { const int u = 8 * u8 + (F.lane >> 3), cq = F.lane & 7; const bool ok = u < MV * RWH;
            const size_t o = (size_t)((ok ? u : 0) >> 4) * RWW + 64 * ((ok ? u : 0) & 15) + 8 * cq;
            const f32x4 y0 = *(const GAS f32x4*)(YS + o), y1 = *(const GAS f32x4*)(YS + o + 4);
            const v4u lg = *(const GAS v4u*)(LG + o), ee = *(const GAS v4u*)(EE + o);
            const float mean = qsum8((y0.x + y0.y) + (y0.z + y0.w) + (y1.x + y1.y) + (y1.z + y1.w)) * (1.0f / 64.0f);
            const f32x4 d0 = y0 - mean, d1 = y1 - mean;
            const float var = qsum8((d0.x * d0.x + d0.y * d0.y) + (d0.z * d0.z + d0.w * d0.w) + (d1.x * d1.x + d1.y * d1.y) + (d1.z * d1.z + d1.w * d1.w)) * (1.0f / 64.0f);
            const float rs = __builtin_amdgcn_rsqf(var + GN_EPS);
#define BFL(w) __builtin_bit_cast(float, (w) << 16)
#define BFH(w) __builtin_bit_cast(float, (w) & 0xffff0000u)
            v4u r;
            r.x = pk2(d0.x * rs * BFL(lg.x) + BFL(ee.x), d0.y * rs * BFH(lg.x) + BFH(ee.x)); r.y = pk2(d0.z * rs * BFL(lg.y) + BFL(ee.y), d0.w * rs * BFH(lg.y) + BFH(ee.y));
            r.z = pk2(d1.x * rs * BFL(lg.z) + BFL(ee.z), d1.y * rs * BFH(lg.z) + BFH(ee.z)); r.w = pk2(d1.z * rs * BFL(lg.w) + BFL(ee.w), d1.w * rs * BFH(lg.w) + BFH(ee.w));
#undef BFL
#undef BFH
            if (ok) *(GAS v4u*)(MIXB + (size_t)(u >> 4) * DM + ATTW + 64 * (u & 15) + 8 * cq) = r; }
        if (rep + 1 < NREP(6)) xcd_barrier(bar); else SEAM(6); }
    if (IN(7)) for (int rep = 0; rep < NREP(7); ++rep) { PHASE_FRAME(); pg8::Gemm g{MIXB, (const bf16*)(ws + WS_WOUT), MP, DM, DM}; pg8::StaticOrder S; S.init(MP, DM, F.G, (int)blockIdx.x);
        pg8::EpiResid E{nullptr, nullptr, XB, nullptr, nullptr, X2B, rep ? ssqd : ssq2, 1.0f};
        pg8::gemm_phase<pg8::EpiResid, pg8::StaticOrder, true, true>(F.lds + RING_OFF, g, S, E);
        skinny_units(F, MIXB + (size_t)MP * DM, DM, (const bf16*)(ws + WS_WOUT), DM, (unsigned*)(F.ctl + CW_SKC + 128 + 64 * rep), (float*)(ws + WS_SLAB), nullptr, XB, nullptr, X2B, rep ? ssqd : ssq2, 1.0f);
        if (rep + 1 < NREP(7)) xcd_barrier(bar); else SEAM(7); }
    if (IN(8)) for (int rep = 0; rep < NREP(8); ++rep) { PHASE_FRAME(); pg8::Gemm g{X2B, (const bf16*)(ws + WS_WGU2), MPAD, 2 * DFF, DM}; pg8::StaticOrder S; S.init(MPAD, 2 * DFF, F.G, (int)blockIdx.x);
        pg8::EpiSwiglu E{ACT, ssq2};
        pg8::gemm_phase<pg8::EpiSwiglu, pg8::StaticOrder, true, true>(F.lds + RING_OFF, g, S, E); if (rep + 1 < NREP(8)) xcd_barrier(bar); else SEAM(8); }
    if (IN(9)) for (int rep = 0; rep < NREP(9); ++rep) { PHASE_FRAME(); pg8::Gemm g{ACT, (const bf16*)(ws + WS_WD2), MP, DM, DFF}; pg8::StaticOrder S; S.init(MP, DM, F.G, (int)blockIdx.x);
        pg8::EpiResid E{nullptr, nullptr, X2B, yp, ys, nullptr, rep ? ssqd : ssq3, 0.5f};
        pg8::gemm_phase<pg8::EpiResid, pg8::StaticOrder, true, true>(F.lds + RING_OFF, g, S, E);
        skinny_units(F, ACT + (size_t)MP * DFF, DFF, (const bf16*)(ws + WS_WD2), DFF, (unsigned*)(F.ctl + CW_SKC + 256 + 64 * rep), (float*)(ws + WS_SLAB), nullptr, X2B, ys, nullptr, rep ? ssqd : ssq3, 0.5f);
        if (rep + 1 < NREP(9)) xcd_barrier(bar); else SEAM(9); }
    if (IN(10)) for (int rep = 0; rep < NREP(10); ++rep) { PHASE_FRAME(); const float* fn = args.in[30];
        for (int m = gw; m < MV; m += NGW) { float* xr = m < MP ? yp + (size_t)m * DM : ys + (size_t)(m - MP) * DM;
            const float s = rep ? 1.0f : __builtin_amdgcn_rsqf(ssq3[m] * (1.0f / DM) + RMS_EPS);
            GAS f32x4* x4 = (GAS f32x4*)xr + F.lane; const GAS f32x4* f4 = (const GAS f32x4*)fn + F.lane;
#pragma unroll
            for (int j = 0; j < 8; ++j) x4[64 * j] = rep ? x4[64 * j] * s : x4[64 * j] * s * f4[64 * j]; } if (NREP(10) > 1 && rep == 0) xcd_barrier(bar); }
#undef IN
#undef SEAM
}

extern "C" void kernel_launch(void* const* d_in, const int* in_sizes, int n_in, void* d_out, int out_size, void* d_ws, size_t ws_size, hipStream_t stream) {
    static int grid = 0;
    if (grid == 0) {
        if (n_in != 31 || in_sizes[0] != MP * DM || (size_t)out_size != O_END || ws_size < WS_END2) {
            fprintf(stderr, "kernel_launch: unexpected shapes: n_in %d in0 %d out %d (want %zu) ws %zu (want >= %zu); nothing launched\n", n_in, n_in > 0 ? in_sizes[0] : -1, out_size, (size_t)O_END, ws_size, (size_t)WS_END2);
            grid = -1; return; }
        int dev = 0, cus = 0, per_cu = 0;
        if (hipGetDevice(&dev) != hipSuccess || hipDeviceGetAttribute(&cus, hipDeviceAttributeMultiprocessorCount, dev) != hipSuccess) { fprintf(stderr, "kernel_launch: device query failed\n"); grid = -1; return; }
        if (hipFuncSetAttribute((const void*)hymba_fwd, hipFuncAttributeMaxDynamicSharedMemorySize, LDS_BYTES) != hipSuccess) { fprintf(stderr, "kernel_launch: hipFuncSetAttribute failed\n"); grid = -1; return; }
        if (hipOccupancyMaxActiveBlocksPerMultiprocessor(&per_cu, (const void*)hymba_fwd, NWAVES * 64, LDS_BYTES) != hipSuccess || per_cu < 1)
            fprintf(stderr, "kernel_launch: note: occupancy query reports %d workgroups per CU\n", per_cu);
        (void)hipGetLastError();
        grid = cus;
    }
    if (grid < 0) return;
    if (hipMemsetAsync((char*)d_ws + WS_CTL, 0, CTL_ZERO_BYTES, stream) != hipSuccess) { fprintf(stderr, "kernel_launch: hipMemsetAsync failed\n"); return; }
    Args a{};
    for (int i = 0; i < 31; ++i) a.in[i] = (const float*)d_in[i];
    a.out = (float*)d_out; a.ws = (unsigned char*)d_ws;
    for (int li = 0; li < MK_N_LAUNCHES; ++li) {
        a.ph_lo = (MK_N_LAUNCHES == 1) ? 0 : li; a.ph_hi = (MK_N_LAUNCHES == 1) ? NPHASES : li + 1; a.li = li;
        hipLaunchKernelGGL(hymba_fwd, dim3(grid), dim3(NWAVES * 64), LDS_BYTES, stream, a);
        const hipError_t le = hipPeekAtLastError();
        if (le != hipSuccess) { fprintf(stderr, "kernel_launch: launch %d failed: %s\n", li, hipGetErrorName(le)); break; }
    }
}
```

```cpp
#include <hip/hip_runtime.h>
#include <cstdio>
#include <cstdint>
#define MK_N_LAUNCHES 1
constexpr int DM = 2048, SEQ = 2048, NB = 4, MP = NB * SEQ  , NDEC = 32, MV = MP + NDEC  , MPAD = 8448  ;
constexpr int DFF = 5504, ATTW = 1024, KVW = 256, RWW = 1024, NQH = 16, NKVH = 4, HD = 64, RWH = 16, WIN = 128;
constexpr int ATT_COLS = ATTW + 2 * KVW  , SHC = 3 * RWW + 64 + 64 + 128  , INC = ATT_COLS + SHC  ;
constexpr float RMS_EPS = 1e-5f, GN_EPS = 64e-5f, LOG2E = 1.4426950408889634f;
constexpr float QSCALE = 0.125f * LOG2E;
constexpr size_t O_YP = 0, O_YS = O_YP + (size_t)MP * DM, O_KP = O_YS + (size_t)NDEC * DM, O_VP = O_KP + (size_t)NB * WIN * KVW, O_WP = O_VP + (size_t)NB * WIN * KVW,
                 O_SP = O_WP + (size_t)NB * RWH * HD * HD, O_KS = O_SP + (size_t)NB * SHC, O_VS = O_KS + (size_t)NDEC * WIN * KVW, O_WS = O_VS + (size_t)NDEC * WIN * KVW,
                 O_SS = O_WS + (size_t)NDEC * RWH * HD * HD, O_END = O_SS + (size_t)NDEC * SHC;
namespace pg8 {
#define PG8_LAS __attribute__((address_space(3)))
typedef unsigned short bf16_t;
typedef short bf16x8 __attribute__((ext_vector_type(8)));
typedef float f32x4 __attribute__((ext_vector_type(4)));
typedef unsigned u32x4 __attribute__((ext_vector_type(4)));
constexpr int BM = 256, BK = 64, HALF = 128, HTB = HALF * BK * 2  , STAGE_BYTES = 8 * HTB, NXCD = 8, WGM = 8;

__host__ __device__ __forceinline__ int lds_byte(int r, int c) { const int st = (r >> 4) * 2 + (c >> 5), rr = r & 15, cc = c & 31, ob = rr * 64 + cc * 2; return st * 1024 + (ob ^ (((ob >> 9) & 1) << 5)); }
__host__ __device__ __forceinline__ void stage_rc(int b, int& R, int& C) { const int st = b / 1024, sb = b % 1024, swz = sb ^ (((sb >> 9) & 1) << 5); R = (st >> 1) * 16 + swz / 64; C = (st & 1) * 32 + (swz % 64) / 2; }
__host__ __device__ __forceinline__ int perm32(int rho) { const int n = rho >> 4, i = rho & 15; return 8 * (i >> 2) + 4 * n + (i & 3); }

struct Unit { int pm, pn; };
struct Gemm { const bf16_t* A; const bf16_t* Bt; int M, N, K; };

struct StaticOrder {
    int nM, nN, nwg, G, c;
    __host__ __device__ void init(int M, int N, int G_, int c_) { nM = M / BM; nN = N / BM; nwg = nM * nN; G = G_; c = c_; }
    __host__ __device__ bool next(int i, Unit& u) const {
        const long L = (long)i * G + c; if (L >= nwg) return false;
        int wgid = (int)L; { const int q = nwg / NXCD, r = nwg % NXCD, xcd = wgid % NXCD, off = wgid / NXCD; wgid = (xcd < r ? xcd * (q + 1) : r * (q + 1) + (xcd - r) * q) + off; }
        const int nig = WGM * nN, gid = wgid / nig, fm = gid * WGM, gsz = (nM - fm) < WGM ? (nM - fm) : WGM;
        u.pm = fm + ((wgid % nig) % gsz); u.pn = (wgid % nig) / gsz; return true;
    }
    __device__ __forceinline__ void a_ready(const Unit&) const {}
    __device__ __forceinline__ void done(const Unit&) const {}
};

__device__ __forceinline__ unsigned cvt_pk_bf16(float lo, float hi) { unsigned r; asm volatile("v_cvt_pk_bf16_f32 %0, %1, %2" : "=v"(r) : "v"(lo), "v"(hi)); return r; }
__device__ __forceinline__ float silu_mul(float g, float u) { return g * u * __builtin_amdgcn_rcpf(1.0f + __builtin_amdgcn_exp2f(-g * LOG2E)); }

struct EpiSwiglu {
    static constexpr bool PERM = true, AFTER_DRAIN = false;
    bf16_t* O; const float* ssq;
    __device__ __forceinline__ void operator()(const f32x4 (&acc)[2][2][4][2], const Unit& u, int wr, int wc, int fr, int fq) const {
        const int row0 = u.pm * BM + wr * 64 + fr, col0 = u.pn * HALF + wc * 32 + 8 * fq;
#pragma unroll
        for (int ai = 0; ai < 2; ++ai)
#pragma unroll
            for (int m = 0; m < 4; ++m) { const int row = row0 + ai * HALF + m * 16;
                const float s = __builtin_amdgcn_rsqf(ssq[row] * (1.0f / DM) + RMS_EPS);
                const f32x4 g0 = acc[ai][0][m][0] * s, g1 = acc[ai][0][m][1] * s, u0 = acc[ai][1][m][0] * s, u1 = acc[ai][1][m][1] * s;
                u32x4 w; w.x = cvt_pk_bf16(silu_mul(g0[0], u0[0]), silu_mul(g0[1], u0[1])); w.y = cvt_pk_bf16(silu_mul(g0[2], u0[2]), silu_mul(g0[3], u0[3]));
                w.z = cvt_pk_bf16(silu_mul(g1[0], u1[0]), silu_mul(g1[1], u1[1])); w.w = cvt_pk_bf16(silu_mul(g1[2], u1[2]), silu_mul(g1[3], u1[3]));
                *(u32x4*)(O + (size_t)row * DFF + col0) = w; }
    }
};

struct EpiResid {
    static constexpr bool PERM = true, AFTER_DRAIN = false;
    const float* xi_p; const float* xi_s; const bf16_t* xb_in; float* xo_p; float* xo_s; bf16_t* XB; float* ssq; float alpha;
    __device__ __forceinline__ void operator()(const f32x4 (&acc)[2][2][4][2], const Unit& u, int wr, int wc, int fr, int fq) const {
        const int row0 = u.pm * BM + wr * 64 + fr, col0 = u.pn * BM + wc * 32 + 8 * fq;
#pragma unroll
        for (int ai = 0; ai < 2; ++ai)
#pragma unroll
            for (int m = 0; m < 4; ++m) { const int row = row0 + ai * HALF + m * 16; const bool valid = row < MV;
                const size_t ro = row < MP ? (size_t)row * DM : (size_t)(row - MP) * DM;
                float sq = 0.f;
#pragma unroll
                for (int bj = 0; bj < 2; ++bj) { const int col = col0 + bj * HALF;
                    f32x4 x0 = (f32x4){0.f, 0.f, 0.f, 0.f}, x1 = x0;
                    if (xb_in) { const u32x4 w = *(const u32x4*)(xb_in + (size_t)row * DM + col);
                        x0 = (f32x4){__builtin_bit_cast(float, w.x << 16), __builtin_bit_cast(float, w.x & 0xffff0000u), __builtin_bit_cast(float, w.y << 16), __builtin_bit_cast(float, w.y & 0xffff0000u)};
                        x1 = (f32x4){__builtin_bit_cast(float, w.z << 16), __builtin_bit_cast(float, w.z & 0xffff0000u), __builtin_bit_cast(float, w.w << 16), __builtin_bit_cast(float, w.w & 0xffff0000u)}; }
                    else if (valid) { const float* src = (row < MP ? xi_p : xi_s) + ro; x0 = *(const f32x4*)(src + col); x1 = *(const f32x4*)(src + col + 4); }
                    const f32x4 y0 = x0 + acc[ai][bj][m][0] * alpha, y1 = x1 + acc[ai][bj][m][1] * alpha;
                    if (xo_p && valid) { float* dst = (row < MP ? xo_p : xo_s) + ro; *(f32x4*)(dst + col) = y0; *(f32x4*)(dst + col + 4) = y1; }
                    sq += (y0[0] * y0[0] + y0[1] * y0[1]) + (y0[2] * y0[2] + y0[3] * y0[3]) + (y1[0] * y1[0] + y1[1] * y1[1]) + (y1[2] * y1[2] + y1[3] * y1[3]);
                    if (XB) { u32x4 w; w.x = cvt_pk_bf16(y0[0], y0[1]); w.y = cvt_pk_bf16(y0[2], y0[3]); w.z = cvt_pk_bf16(y1[0], y1[1]); w.w = cvt_pk_bf16(y1[2], y1[3]);
                        *(u32x4*)(XB + (size_t)row * DM + col) = w; } }
                sq += __shfl_xor(sq, 16); sq += __shfl_xor(sq, 32);
                if (fq == 0 && valid) atomicAdd(ssq + row, sq); }
    }
};

struct EpiWin {
    static constexpr bool PERM = true, AFTER_DRAIN = false;
    const float* ssq; bf16_t* QB; bf16_t* KB; bf16_t* VB; bf16_t* PR; float* out;
    __device__ __forceinline__ void operator()(const f32x4 (&acc)[2][2][4][2], const Unit& u, int wr, int wc, int fr, int fq) const {
        const int row0 = u.pm * BM + wr * 64 + fr, cl0 = wc * 32 + 8 * fq;
        const int pn = u.pn;
#pragma unroll
        for (int ai = 0; ai < 2; ++ai)
#pragma unroll
            for (int m = 0; m < 4; ++m) { const int row = row0 + ai * HALF + m * 16; const bool valid = row < MV;
                float s = __builtin_amdgcn_rsqf(ssq[row] * (1.0f / DM) + RMS_EPS);
                if (pn < 4) s *= QSCALE;
#pragma unroll
                for (int bj = 0; bj < 2; ++bj) { const int cl = cl0 + bj * HALF;
                    const f32x4 y0 = acc[ai][bj][m][0] * s, y1 = acc[ai][bj][m][1] * s;
                    if (pn < 6) { u32x4 w; w.x = cvt_pk_bf16(y0[0], y0[1]); w.y = cvt_pk_bf16(y0[2], y0[3]); w.z = cvt_pk_bf16(y1[0], y1[1]); w.w = cvt_pk_bf16(y1[2], y1[3]);
                        if (pn < 4) *(u32x4*)(QB + (size_t)row * ATTW + pn * BM + cl) = w;
                        else { *(u32x4*)((pn == 4 ? KB : VB) + (size_t)row * KVW + cl) = w;
                            if (valid) { float* o = nullptr;
                                if (row >= MP) o = out + (pn == 4 ? O_KS : O_VS) + ((size_t)(row - MP) * WIN + (WIN - 1)) * KVW + cl;
                                else if ((row & (SEQ - 1)) >= SEQ - WIN) o = out + (pn == 4 ? O_KP : O_VP) + ((size_t)(row >> 11) * WIN + ((row & (SEQ - 1)) - (SEQ - WIN))) * KVW + cl;
                                if (o) { *(f32x4*)o = y0; *(f32x4*)(o + 4) = y1; } } }
                    } else { const int cs = (pn - 6) * BM + cl;
                        { u32x4 w; w.x = cvt_pk_bf16(y0[0], y0[1]); w.y = cvt_pk_bf16(y0[2], y0[3]); w.z = cvt_pk_bf16(y1[0], y1[1]); w.w = cvt_pk_bf16(y1[2], y1[3]); *(u32x4*)(PR + (size_t)row * SHC + cs) = w; }
                        if (valid) { float* o = nullptr;
                            if (row >= MP) o = out + O_SS + (size_t)(row - MP) * SHC + cs;
                            else if ((row & (SEQ - 1)) == SEQ - 1) o = out + O_SP + (size_t)(row >> 11) * SHC + cs;
                            if (o) { *(f32x4*)o = y0; *(f32x4*)(o + 4) = y1; } } } }
            }
    }
};
template <class Epi, class Sched, bool ALIGN_EPI = false, bool SP2 = false>
__device__ __forceinline__ void gemm_phase(PG8_LAS unsigned char* lds, const Gemm g, const Sched& S, const Epi& E) {
    int tid_ = threadIdx.x; asm volatile("" : "+v"(tid_)); const int tid = tid_, wid = __builtin_amdgcn_readfirstlane(tid >> 6), lane = tid & 63, wr = wid >> 2, wc = wid & 3, fr = lane & 15, fq = lane >> 4;
    const int K = g.K, nt = K / BK;
    unsigned voffA[2], voffB[2];
#pragma unroll
    for (int i = 0; i < 2; ++i) { int R, C; stage_rc(tid * 16 + i * 8192, R, C); const int Rb = Epi::PERM ? ((R & ~31) + perm32(R & 31)) : R;
        voffA[i] = (unsigned)(R * K + C) * 2u; voffB[i] = (unsigned)(Rb * K + C) * 2u; }
    const size_t kstep = (size_t)(BK * 2);
    const size_t hstep = (size_t)HALF * K * 2;
    const size_t tstep = 2 * hstep;
    const unsigned ldsw = (unsigned)wid * 1024u;
    const int aoff = lds_byte(wr * 64 + fr, fq * 8), boff = lds_byte(wc * 32 + fr, fq * 8);
#define PG8_SA(b, h) (((b) * 2 + (h)) * HTB)
#define PG8_SB(b, h) ((4 + (b) * 2 + (h)) * HTB)
#define PG8_STAGE(bufoff, gbase, voff) do { _Pragma("unroll") for (int _i = 0; _i < 2; ++_i) \
        __builtin_amdgcn_global_load_lds((const unsigned*)((const char*)(gbase) + (voff)[_i]), (PG8_LAS unsigned*)(lds + (bufoff) + ldsw + _i * 8192), 16, 0, 0); } while (0)
#define PG8_LDA(dst, b, h) do { _Pragma("unroll") for (int m = 0; m < 4; ++m) _Pragma("unroll") for (int k = 0; k < 2; ++k) dst[m][k] = *(const PG8_LAS bf16x8*)(lds + PG8_SA(b, h) + aoff + m * 2048 + k * 1024); } while (0)
#define PG8_LDB(dst, b, h) do { _Pragma("unroll") for (int n = 0; n < 2; ++n) _Pragma("unroll") for (int k = 0; k < 2; ++k) dst[n][k] = *(const PG8_LAS bf16x8*)(lds + PG8_SB(b, h) + boff + n * 2048 + k * 1024); } while (0)
#define PG8_MMA(ai, bj, At, Bt) do { __builtin_amdgcn_s_setprio(1); _Pragma("unroll") for (int m = 0; m < 4; ++m) _Pragma("unroll") for (int n = 0; n < 2; ++n) _Pragma("unroll") for (int k = 0; k < 2; ++k) \
        acc[ai][bj][m][n] = __builtin_amdgcn_mfma_f32_16x16x32_bf16(Bt[n][k], At[m][k], acc[ai][bj][m][n], 0, 0, 0); __builtin_amdgcn_s_setprio(0); } while (0)
#define PG8_WAIT_V(n) asm volatile("s_waitcnt vmcnt(" #n ")" ::: "memory")
#define PG8_WAIT_L(n) asm volatile("s_waitcnt lgkmcnt(" #n ")" ::: "memory")
#define PG8_BAR __builtin_amdgcn_s_barrier()
#define PG8_SCHED __builtin_amdgcn_sched_barrier(0)
    Unit cur, nxt; int ui = 0;
    if (!S.next(0, cur)) return;
    f32x4 acc[2][2][4][2];
#pragma unroll
    for (int a = 0; a < 2; ++a)
#pragma unroll
        for (int b = 0; b < 2; ++b)
#pragma unroll
            for (int m = 0; m < 4; ++m)
#pragma unroll
                for (int n = 0; n < 2; ++n) acc[a][b][m][n] = (f32x4){0.f, 0.f, 0.f, 0.f};
    bf16x8 At[4][2], B0[2][2], B1[2][2];
    const char* cA = (const char*)g.A + (size_t)cur.pm * tstep; const char* cB = (const char*)g.Bt + (size_t)cur.pn * tstep;
    S.a_ready(cur);
    if constexpr (SP2) {
        PG8_STAGE(PG8_SB(0, 0), cB, voffB); PG8_STAGE(PG8_SB(0, 1), cB + hstep, voffB); PG8_STAGE(PG8_SA(0, 0), cA, voffA); PG8_STAGE(PG8_SA(0, 1), cA + hstep, voffA);
        if (wr == 1) PG8_BAR;
        PG8_WAIT_V(2); PG8_BAR;
        PG8_STAGE(PG8_SB(1, 0), cB + kstep, voffB); PG8_STAGE(PG8_SA(1, 0), cA + kstep, voffA); PG8_STAGE(PG8_SB(1, 1), cB + hstep + kstep, voffB);
        PG8_WAIT_V(6); PG8_BAR;
    } else {
        PG8_STAGE(PG8_SB(0, 0), cB, voffB); PG8_STAGE(PG8_SA(0, 0), cA, voffA); PG8_STAGE(PG8_SB(0, 1), cB + hstep, voffB); PG8_STAGE(PG8_SA(0, 1), cA + hstep, voffA);
        if (wr == 1) PG8_BAR;
        PG8_WAIT_V(4); PG8_BAR;
        PG8_STAGE(PG8_SB(1, 0), cB + kstep, voffB); PG8_STAGE(PG8_SA(1, 0), cA + kstep, voffA); PG8_STAGE(PG8_SB(1, 1), cB + hstep + kstep, voffB);
        PG8_WAIT_V(6); PG8_BAR;
    }
    for (;;) {
        const bool has_next = S.next(ui + 1, nxt);
        const char* nA = has_next ? (const char*)g.A + (size_t)nxt.pm * tstep : cA; const char* nB = has_next ? (const char*)g.Bt + (size_t)nxt.pn * tstep : cB;
        for (int t = 0; t < nt; t += 2) {
            const bool last = (t == nt - 2);
            const char* a1 = cA + (size_t)(t + 1) * kstep;
            const char* a2 = last ? nA : cA + (size_t)(t + 2) * kstep; const char* b2 = last ? nB : cB + (size_t)(t + 2) * kstep;
            const char* a3 = a2 + kstep; const char* b3 = b2 + kstep;
            if (last && has_next) S.a_ready(nxt);
            if constexpr (SP2) {
            PG8_LDB(B0, 0, 0); PG8_LDB(B1, 0, 1); PG8_SCHED; PG8_LDA(At, 0, 0); PG8_STAGE(PG8_SA(1, 1), a1 + hstep, voffA);
            PG8_WAIT_V(8); PG8_WAIT_L(0); PG8_BAR; PG8_MMA(0, 0, At, B0); PG8_MMA(0, 1, At, B1); PG8_BAR; PG8_SCHED;
            PG8_LDA(At, 0, 1); PG8_STAGE(PG8_SB(0, 0), b2, voffB); PG8_STAGE(PG8_SB(0, 1), b2 + hstep, voffB); PG8_STAGE(PG8_SA(0, 0), a2, voffA);
            PG8_WAIT_V(8); PG8_WAIT_L(0); PG8_BAR; PG8_MMA(1, 0, At, B0); PG8_MMA(1, 1, At, B1); PG8_BAR; PG8_SCHED;
            PG8_LDB(B0, 1, 0); PG8_LDB(B1, 1, 1); PG8_SCHED; PG8_LDA(At, 1, 0); PG8_STAGE(PG8_SA(0, 1), a2 + hstep, voffA);
            PG8_WAIT_V(8); PG8_WAIT_L(0); PG8_BAR; PG8_MMA(0, 0, At, B0); PG8_MMA(0, 1, At, B1); PG8_BAR; PG8_SCHED;
            PG8_LDA(At, 1, 1); PG8_STAGE(PG8_SB(1, 0), b3, voffB); PG8_STAGE(PG8_SB(1, 1), b3 + hstep, voffB); PG8_STAGE(PG8_SA(1, 0), a3, voffA);
            PG8_WAIT_V(8); PG8_WAIT_L(0); PG8_BAR; PG8_MMA(1, 0, At, B0); PG8_MMA(1, 1, At, B1); PG8_BAR; PG8_SCHED;
            } else {
            PG8_LDB(B0, 0, 0); PG8_SCHED; PG8_LDA(At, 0, 0); PG8_STAGE(PG8_SA(1, 1), a1 + hstep, voffA);
            PG8_WAIT_L(8); PG8_BAR; PG8_WAIT_L(0); PG8_MMA(0, 0, At, B0); PG8_BAR; PG8_SCHED;
            PG8_LDB(B1, 0, 1); PG8_STAGE(PG8_SB(0, 0), b2, voffB);
            PG8_BAR; PG8_WAIT_L(0); PG8_MMA(0, 1, At, B1); PG8_BAR;
            PG8_LDA(At, 0, 1); PG8_STAGE(PG8_SA(0, 0), a2, voffA);
            PG8_BAR; PG8_WAIT_L(0); PG8_MMA(1, 0, At, B0); PG8_BAR; PG8_SCHED;
            PG8_STAGE(PG8_SB(0, 1), b2 + hstep, voffB);
            PG8_WAIT_V(6); PG8_BAR; PG8_MMA(1, 1, At, B1); PG8_BAR;
            PG8_LDB(B0, 1, 0); PG8_SCHED; PG8_LDA(At, 1, 0); PG8_STAGE(PG8_SA(0, 1), a2 + hstep, voffA);
            PG8_WAIT_L(8); PG8_BAR; PG8_WAIT_L(0); PG8_MMA(0, 0, At, B0); PG8_BAR; PG8_SCHED;
            PG8_LDB(B1, 1, 1); PG8_STAGE(PG8_SB(1, 0), b3, voffB);
            PG8_BAR; PG8_WAIT_L(0); PG8_MMA(0, 1, At, B1); PG8_BAR;
            PG8_LDA(At, 1, 1); PG8_STAGE(PG8_SA(1, 0), a3, voffA);
            PG8_BAR; PG8_WAIT_L(0); PG8_MMA(1, 0, At, B0); PG8_BAR; PG8_SCHED;
            PG8_STAGE(PG8_SB(1, 1), b3 + hstep, voffB);
            PG8_WAIT_V(6); PG8_BAR; PG8_MMA(1, 1, At, B1); PG8_BAR;
            }
        }
        if constexpr (ALIGN_EPI) { if (wr == 0) PG8_BAR; }
        if constexpr (!Epi::AFTER_DRAIN) { E(acc, cur, wr, wc, fr, fq); S.done(cur); }
        if (!has_next) break;
#pragma unroll
        for (int a = 0; a < 2; ++a)
#pragma unroll
            for (int b = 0; b < 2; ++b)
#pragma unroll
                for (int m = 0; m < 4; ++m)
#pragma unroll
                    for (int n = 0; n < 2; ++n) acc[a][b][m][n] = (f32x4){0.f, 0.f, 0.f, 0.f};
        cur = nxt; cA = nA; cB = nB; ++ui;
        if constexpr (ALIGN_EPI) { if (wr == 1) PG8_BAR; }
    }
    PG8_WAIT_V(0);
    if constexpr (!ALIGN_EPI) { if (wr == 0) PG8_BAR; }
    PG8_BAR;
    if constexpr (Epi::AFTER_DRAIN) { E.fused(acc, cur, wr, wc, fr, fq, lds, wid, lane); S.done(cur); }
#undef PG8_SA
#undef PG8_SB
#undef PG8_STAGE
#undef PG8_LDA
#undef PG8_LDB
#undef PG8_MMA
#undef PG8_WAIT_V
#undef PG8_WAIT_L
#undef PG8_BAR
#undef PG8_SCHED
}
}
#define GAS __attribute__((address_space(1)))
#define LAS __attribute__((address_space(3)))
typedef unsigned short bf16;
typedef unsigned v4u __attribute__((ext_vector_type(4)));
typedef float f32x4 __attribute__((ext_vector_type(4)));
typedef short bf16x8 __attribute__((ext_vector_type(8)));
typedef GAS unsigned gu32;
typedef GAS unsigned long long gu64;
#define RLX_AGENT __ATOMIC_RELAXED, __HIP_MEMORY_SCOPE_AGENT
#define LDS_WAIT() asm volatile("s_waitcnt lgkmcnt(0)" ::: "memory")
#define VM_WAIT() asm volatile("s_waitcnt vmcnt(0)" ::: "memory")
__device__ __forceinline__ unsigned long long rt() { return __builtin_amdgcn_s_memrealtime(); }
__device__ __forceinline__ unsigned f2bf(float f) { unsigned u = __builtin_bit_cast(unsigned, f); return (u + 0x7fffu + ((u >> 16) & 1u)) >> 16; }
__device__ __forceinline__ unsigned pk2(float lo, float hi) { return f2bf(lo) | (f2bf(hi) << 16); }

#define XB_TMO      128
#define XB_XCNT(j)  (256  + 64 * (j))
#define XB_XSUB(j)  (1280 + 64 * (j))
#define XB_XGEN(j)  (2304 + 64 * (j))
#define XB_TOP      3328
#define XB_TOPGEN   3392
#define XCD_BAR_WORDS 3456
#define XB_SPIN_CAP (1u << 18)

__device__ __forceinline__ unsigned xb_ld(unsigned* p)              { return __hip_atomic_load(p, __ATOMIC_RELAXED, __HIP_MEMORY_SCOPE_AGENT); }
__device__ __forceinline__ unsigned xb_add(unsigned* p, unsigned v) { return __hip_atomic_fetch_add(p, v, __ATOMIC_RELAXED, __HIP_MEMORY_SCOPE_AGENT); }
__device__ __forceinline__ unsigned xb_xcc_id() { return (unsigned)__builtin_amdgcn_s_getreg((3 << 11) | 20) & 0xFu; }
#define XB_SPIN(cond, bar) do { unsigned _sp = 0; while (cond) { __builtin_amdgcn_s_sleep(1); \
    if ((++_sp & 255u) == 0u) { if (xb_ld(&(bar)[XB_TMO])) break; if (_sp > XB_SPIN_CAP) { atomicAdd(&(bar)[XB_TMO], 1u); break; } } } } while (0)

struct XcdBarrier {
    unsigned* bar; unsigned x;
    volatile LAS unsigned* st;
};

__device__ __forceinline__ XcdBarrier xcd_barrier_post(unsigned* bar, volatile LAS unsigned* st) {
    XcdBarrier b; b.bar = bar; b.x = xb_xcc_id(); b.st = st;
    if (threadIdx.x == 0) (void)xb_add(&bar[XB_XCNT(b.x)], 1u);
    return b;
}
__device__ __forceinline__ void xcd_barrier_complete(unsigned* bar, unsigned x, unsigned& nloc, unsigned& nx) {
    const unsigned G = gridDim.x * gridDim.y * gridDim.z;
    unsigned sum, cnt, mine, sp = 0u;
    for (;;) {
        sum = 0u; cnt = 0u; mine = 0u;
#pragma unroll
        for (unsigned j = 0; j < 16; ++j) { const unsigned c = xb_ld(&bar[XB_XCNT(j)]); sum += c; cnt += (c > 0u) ? 1u : 0u; mine = (j == x) ? c : mine; }
        if (sum == G) break;
        __builtin_amdgcn_s_sleep(1);
        if ((++sp & 255u) == 0u) { if (xb_ld(&bar[XB_TMO])) break; if (sp > XB_SPIN_CAP) { atomicAdd(&bar[XB_TMO], 1u); break; } }
    }
    nloc = mine > 0u ? mine : 1u; nx = cnt > 0u ? cnt : 1u;
}

__device__ __forceinline__ void xcd_barrier(const XcdBarrier& b) {
    asm volatile("s_waitcnt vmcnt(0)" ::: "memory");
    __syncthreads();
    if (threadIdx.x == 0) {
        unsigned* bar = b.bar;
        __builtin_amdgcn_s_waitcnt(0);
        unsigned nloc = b.st[0], nx = b.st[1];
        if (nloc == 0u) { xcd_barrier_complete(bar, b.x, nloc, nx); b.st[0] = nloc; b.st[1] = nx; }
        const unsigned old = xb_add(&bar[XB_XSUB(b.x)], 1u);
        const unsigned gen = old / nloc;
        if (old + 1u == (gen + 1u) * nloc) {
            __builtin_amdgcn_fence(__ATOMIC_RELEASE, "agent");
            asm volatile("s_waitcnt vmcnt(0)" ::: "memory");
            const unsigned og = xb_add(&bar[XB_TOP], 1u);
            const unsigned tg = og / nx;
            if (og + 1u == (tg + 1u) * nx) xb_add(&bar[XB_TOPGEN], 1u);
            else XB_SPIN(xb_ld(&bar[XB_TOPGEN]) == tg, bar);
            __builtin_amdgcn_fence(__ATOMIC_ACQUIRE, "agent");
            xb_add(&bar[XB_XGEN(b.x)], 1u);
            asm volatile("s_waitcnt vmcnt(0)" ::: "memory");
        } else {
            XB_SPIN(xb_ld(&bar[XB_XGEN(b.x)]) == gen, bar);
            __builtin_amdgcn_fence(__ATOMIC_ACQUIRE, "agent");
            asm volatile("s_waitcnt vmcnt(0)" ::: "memory");
        }
    }
    __syncthreads();
}
constexpr size_t MiB = 1u << 20;
constexpr size_t WS_CTL = 0, CTL_ZERO_BYTES = 1 * MiB;
constexpr size_t WS_BIAS = 1 * MiB, WS_W2T = WS_BIAS + 16384, WS_A2T = WS_W2T + 131072, WS_G2T = WS_A2T + 131072;
constexpr size_t WS_WGU1 = 2 * MiB, WS_WD1 = WS_WGU1 + 43 * MiB, WS_WINB = WS_WD1 + 21 * MiB + MiB / 2;
constexpr size_t WS_WOUT = 86 * MiB, WS_WGU2 = 94 * MiB, WS_WD2 = 137 * MiB;
constexpr size_t WS_XB = 159 * MiB;
constexpr size_t WS_ACT = 192 * MiB;
constexpr size_t WS_MIX = 246 * MiB;
constexpr size_t WS_LACT = 280 * MiB;
constexpr size_t WS_QB = 300 * MiB, WS_KB = WS_QB + 16 * MiB + MiB / 2, WS_VB = WS_KB + 4 * MiB + MiB / 8;
constexpr size_t WS_DD = 325 * MiB, WS_LG = 358 * MiB, WS_EE = WS_LG + 16 * MiB + MiB / 2, WS_END = WS_EE + 16 * MiB + MiB / 2;
constexpr size_t WS_SLAB = WS_END, WS_DEC = WS_SLAB + 1 * MiB, WS_END2 = WS_DEC + 6 * (size_t)NDEC * RWW * 4;
constexpr size_t VEC16 = 16 * MiB + MiB / 2;
constexpr size_t WS_KK = WS_WGU1, WS_BB = WS_KK + VEC16, WS_KP = WS_BB + VEC16, WS_RR = WS_KP + VEC16, WS_VV = WS_RR + VEC16;
constexpr size_t WS_X2B = WS_WGU1;
static_assert(WS_VV + VEC16 <= WS_WOUT && WS_WINB + 19 * MiB <= WS_WOUT && WS_WD2 + 22 * MiB <= WS_XB && WS_XB + 33 * MiB <= WS_ACT && WS_VB + 4 * MiB + MiB / 8 <= WS_DD && WS_DD + 33 * MiB <= WS_LG, "d_ws map");
constexpr int CW_BAR = 4096;
constexpr int CW_SSQ0 = 16384, CW_SSQ1 = CW_SSQ0 + MPAD, CW_SSQ2 = CW_SSQ1 + MPAD, CW_SSQ3 = CW_SSQ2 + MPAD;
constexpr int CW_SKC = 8192;
constexpr int CW_SSQD = CW_SSQ3 + MPAD;
static_assert((CW_SSQD + MPAD) * 4 <= (int)CTL_ZERO_BYTES, "CTL");
constexpr int RING_OFF = 0, RING_BYTES = 131072;
constexpr int LDSCTL_OFF = RING_BYTES, MISC_OFF = LDSCTL_OFF + 320;
constexpr int LDS_BYTES = 147456;
constexpr int NWAVES = 8;
constexpr int NPHASES = 11;
#ifndef PROBE_REP
#define PROBE_REP 0
#endif
#ifndef MK_N_LAUNCHES
#define MK_N_LAUNCHES 1
#endif

__constant__ unsigned char T5B[129] = {0, 1, 2, 3, 4, 5, 6, 7, 8, 9, 10, 11, 12, 13, 14, 15, 16, 16, 16, 17, 17, 18, 18, 18, 19, 19, 19, 20, 20, 20, 20, 21, 21, 21, 21, 22, 22, 22, 22, 22, 23, 23, 23, 23, 23, 23, 24, 24, 24, 24, 24, 24, 25, 25, 25, 25, 25, 25, 25, 26, 26, 26, 26, 26, 26, 26, 26, 27, 27, 27, 27, 27, 27, 27, 27, 27, 27, 28, 28, 28, 28, 28, 28, 28, 28, 28, 28, 29, 29, 29, 29, 29, 29, 29, 29, 29, 29, 29, 29, 30, 30, 30, 30, 30, 30, 30, 30, 30, 30, 30, 30, 30, 30, 31, 31, 31, 31, 31, 31, 31, 31, 31, 31, 31, 31, 31, 31, 31, 31};

struct Args { const float* in[31]; float* out; unsigned char* ws; int ph_lo, ph_hi, li, pad; };

struct Frame {
    LAS unsigned char* lds;
    volatile LAS unsigned* MISC;
    gu32* ctl;
    int tid, lane, wave, G;
    float* out; unsigned char* ws;
};
typedef float f32x2 __attribute__((ext_vector_type(2)));
__device__ __forceinline__ float bf2f(unsigned short u) { return __builtin_bit_cast(float, (unsigned)u << 16); }
__device__ __forceinline__ unsigned short f2bfs(float f) { return (unsigned short)f2bf(f); }
__device__ __forceinline__ float wave_sum(float v) {
#pragma unroll
    for (int o = 1; o < 64; o <<= 1) v += __shfl_xor(v, o);
    return v;
}
__device__ __forceinline__ float wave_max(float v) {
#pragma unroll
    for (int o = 1; o < 64; o <<= 1) v = fmaxf(v, __shfl_xor(v, o));
    return v;
}
template <int CTRL> __device__ __forceinline__ float dpp_f(float x) { return __builtin_bit_cast(float, __builtin_amdgcn_update_dpp(0, __builtin_bit_cast(int, x), CTRL, 0xf, 0xf, true)); }
__device__ __forceinline__ float allsum16(float x) { x += dpp_f<0x128>(x); x += dpp_f<0x124>(x); x += dpp_f<0x122>(x); x += dpp_f<0x121>(x); return x; }
__device__ __forceinline__ float sigmoidf_(float x) { return __builtin_amdgcn_rcpf(1.0f + __builtin_amdgcn_exp2f(-x * LOG2E)); }
__device__ __forceinline__ float tanhf_(float x) { return 1.0f - 2.0f * __builtin_amdgcn_rcpf(1.0f + __builtin_amdgcn_exp2f(2.0f * LOG2E * x)); }

constexpr int TP_PITCH = 136;
__device__ __forceinline__ void p0_transpose_item(const float* W, int K, int N, bf16* WT, int kb, int nb, int drow, const float* kscale, LAS unsigned char* scr, int lane) {
    const int k0 = 64 * kb, n0 = 64 * nb, g = lane >> 4, c = lane & 15;
    f32x4 v[16];
#pragma unroll
    for (int j = 0; j < 4; ++j)
#pragma unroll
        for (int r = 0; r < 4; ++r) v[4 * j + r] = *(const GAS f32x4*)(W + (size_t)(k0 + 16 * j + 4 * g + r) * N + n0 + 4 * c);
    if (kscale) {
#pragma unroll
        for (int j = 0; j < 4; ++j) { const f32x4 s4 = *(const GAS f32x4*)(kscale + k0 + 16 * j + 4 * g);
            v[4 * j + 0] *= s4.x; v[4 * j + 1] *= s4.y; v[4 * j + 2] *= s4.z; v[4 * j + 3] *= s4.w; } }
#pragma unroll
    for (int j = 0; j < 4; ++j)
#pragma unroll
        for (int e = 0; e < 4; ++e)
            *(LAS unsigned long long*)(scr + (4 * c + e) * TP_PITCH + (16 * j + 4 * g) * 2) = (unsigned long long)pk2(v[4 * j + 0][e], v[4 * j + 1][e]) | ((unsigned long long)pk2(v[4 * j + 2][e], v[4 * j + 3][e]) << 32);
    LDS_WAIT(); asm volatile("" ::: "memory");
#pragma unroll
    for (int i = 0; i < 8; ++i) { const int n = 8 * i + (lane >> 3), kc = lane & 7;
        const LAS unsigned char* s = scr + n * TP_PITCH + kc * 16;
        v4u o; o.x = *(const LAS unsigned*)(s); o.y = *(const LAS unsigned*)(s + 4); o.z = *(const LAS unsigned*)(s + 8); o.w = *(const LAS unsigned*)(s + 12);
        *(GAS v4u*)(WT + (size_t)(drow + n) * K + k0 + 8 * kc) = o; }
    LDS_WAIT(); asm volatile("" ::: "memory");
}
__device__ __forceinline__ int gu_row(int n0, int up) { return 256 * (n0 >> 7) + (n0 & 127) + 128 * up; }

constexpr int I_GU = (DM / 64) * (DFF / 64), I_D = (DFF / 64) * (DM / 64), I_IN = (DM / 64) * (INC / 64), I_OUT = (DM / 64) * (DM / 64), I_L64 = RWW / 64, I_L128 = 2 * (RWW / 64);
constexpr int CV_G0 = 2 * I_GU + 2 * I_L64 + I_L128, CV_G1 = I_D + I_IN, CV_G2 = I_OUT + 2 * I_GU, CV_G3 = I_D, CV_ALL = CV_G0 + CV_G1 + CV_G2 + CV_G3;
__device__ __forceinline__ void convert_items(Frame& F, const Args& A, int first, int count, int rank, int nranks) {
    LAS unsigned char* scr = F.lds + RING_OFF + F.wave * 16384;
    const int lane = F.lane; unsigned char* ws = F.ws;
    for (int it = first + rank * NWAVES + F.wave; it < first + count; it += nranks * NWAVES) {
        int r = it;
        if (r < I_GU) { const int kb = r / (DFF / 64), nb = r % (DFF / 64); p0_transpose_item(A.in[8], DM, DFF, (bf16*)(ws + WS_WGU1), kb, nb, gu_row(64 * nb, 0), A.in[7], scr, lane); continue; } r -= I_GU;
        if (r < I_GU) { const int kb = r / (DFF / 64), nb = r % (DFF / 64); p0_transpose_item(A.in[9], DM, DFF, (bf16*)(ws + WS_WGU1), kb, nb, gu_row(64 * nb, 1), A.in[7], scr, lane); continue; } r -= I_GU;
        if (r < I_L64) { p0_transpose_item(A.in[16], 64, RWW, (bf16*)(ws + WS_W2T), 0, r, 64 * r, nullptr, scr, lane); continue; } r -= I_L64;
        if (r < I_L64) { p0_transpose_item(A.in[18], 64, RWW, (bf16*)(ws + WS_A2T), 0, r, 64 * r, nullptr, scr, lane); continue; } r -= I_L64;
        if (r < I_L128) { const int kb = r / (RWW / 64), nb = r % (RWW / 64); p0_transpose_item(A.in[19], 128, RWW, (bf16*)(ws + WS_G2T), kb, nb, 64 * nb, nullptr, scr, lane); continue; } r -= I_L128;
        if (r < I_D)  { const int kb = r / (DM / 64), nb = r % (DM / 64); p0_transpose_item(A.in[10], DFF, DM, (bf16*)(ws + WS_WD1), kb, nb, 64 * nb, nullptr, scr, lane); continue; } r -= I_D;
        if (r < I_IN) { const int kb = r / (INC / 64), nb = r % (INC / 64); p0_transpose_item(A.in[12], DM, INC, (bf16*)(ws + WS_WINB), kb, nb, 64 * nb, A.in[11], scr, lane); continue; } r -= I_IN;
        if (r < I_OUT) { const int kb = r / (DM / 64), nb = r % (DM / 64); p0_transpose_item(A.in[25], DM, DM, (bf16*)(ws + WS_WOUT), kb, nb, 64 * nb, nullptr, scr, lane); continue; } r -= I_OUT;
        if (r < I_GU) { const int kb = r / (DFF / 64), nb = r % (DFF / 64); p0_transpose_item(A.in[27], DM, DFF, (bf16*)(ws + WS_WGU2), kb, nb, gu_row(64 * nb, 0), A.in[26], scr, lane); continue; } r -= I_GU;
        if (r < I_GU) { const int kb = r / (DFF / 64), nb = r % (DFF / 64); p0_transpose_item(A.in[28], DM, DFF, (bf16*)(ws + WS_WGU2), kb, nb, gu_row(64 * nb, 1), A.in[26], scr, lane); continue; } r -= I_GU;
        { const int kb = r / (DM / 64), nb = r % (DM / 64); p0_transpose_item(A.in[29], DFF, DM, (bf16*)(ws + WS_WD2), kb, nb, 64 * nb, nullptr, scr, lane); }
    }
}
__device__ __forceinline__ void p0_prologue(Frame& F, const Args& A) {
    const int gw = blockIdx.x * NWAVES + F.wave, NGW = F.G * NWAVES, lane = F.lane;
    unsigned char* ws = F.ws;
#ifdef CV_ALL_IN_P0
    convert_items(F, A, 0, CV_ALL, blockIdx.x, F.G);
#else
    convert_items(F, A, 0, CV_G0, blockIdx.x, F.G);
#endif
    bf16* XB = (bf16*)(ws + WS_XB); float* ssq0 = (float*)(F.ctl + CW_SSQ0);
    for (int m = gw; m < MPAD; m += NGW) {
        GAS unsigned long long* o8 = (GAS unsigned long long*)(XB + (size_t)m * DM) + lane;
        if (m < MV) {
            const float* xrow = m < MP ? A.in[0] + (size_t)m * DM : A.in[1] + (size_t)(m - MP) * DM;
            const GAS f32x4* xr = (const GAS f32x4*)xrow + lane; f32x4 v[8]; float s = 0.f;
#pragma unroll
            for (int j = 0; j < 8; ++j) { v[j] = xr[64 * j]; s += (v[j].x * v[j].x + v[j].y * v[j].y) + (v[j].z * v[j].z + v[j].w * v[j].w); }
            s = wave_sum(s);
#pragma unroll
            for (int j = 0; j < 8; ++j) o8[64 * j] = (unsigned long long)pk2(v[j].x, v[j].y) | ((unsigned long long)pk2(v[j].z, v[j].w) << 32);
            if (lane == 0) ssq0[m] = s;
        } else {
#pragma unroll
            for (int j = 0; j < 8; ++j) o8[64 * j] = 0ull;
        }
    }
    float* bt = (float*)(ws + WS_BIAS);
    for (int i = blockIdx.x * (NWAVES * 64) + F.tid; i < 129 * NQH; i += F.G * NWAVES * 64) bt[i] = A.in[6][(int)T5B[i >> 4] * NQH + (i & 15)] * LOG2E;
}
constexpr int PREP_TILES = (MV + 63) / 64  , PREP_UNITS = PREP_TILES * RWH;
constexpr int PA_PITCH = 528;
constexpr int PW_LD = 68;
constexpr int PA_OFF = 0, PW_OFF = 64 * PA_PITCH  , PMAT = 64 * PW_LD * 4  , PC_OFF = 114688;
constexpr int CB_FA = 0, CB_FR = 2048, CB_FNK = 4096, CB_FT = 4608, CB_FMB = 5120, CB_FMK = 5632, CB_FBG = 6144, CB_FKG = 8192, CB_FV = 10240, CB_GC = 12288, CB_BYTES = 12544, CB_STRIDE = 13312;
constexpr int NCHUNK = SEQ / 16;
constexpr size_t CH_NA = (WS_WOUT - WS_WGU1) / CB_STRIDE, CH_NB = (WS_LG - WS_DD) / CB_STRIDE;
static_assert(CH_NA + CH_NB >= (size_t)NB * RWH * NCHUNK, "chunk blocks");
__device__ __forceinline__ unsigned char* chunk_block(unsigned char* ws, int g) { return (size_t)g < CH_NA ? ws + WS_WGU1 + (size_t)g * CB_STRIDE : ws + WS_DD + ((size_t)g - CH_NA) * CB_STRIDE; }
constexpr int LW_OFF = 0, CS2_OFF = 16384;
static_assert(PW_OFF + 3 * PMAT <= PC_OFF && CS2_OFF + 4 * 16384 <= PC_OFF && PC_OFF + 2560 <= RING_BYTES, "prep LDS");
constexpr int SC_FA = 0, SC_FR = 2048, SC_FBH = 4096, SC_FKH = 6144, SC_FBG = 8192, SC_FKG = 10240, SC_FV = 12288, SC_NB = 14336, SC_TT = 15360;
typedef short s16x4 __attribute__((ext_vector_type(4)));
typedef __bf16 bf16x2_t __attribute__((ext_vector_type(2)));
__device__ __forceinline__ unsigned cvtpk_c(float lo, float hi) { const f32x2 v = {lo, hi}; return __builtin_bit_cast(unsigned, __builtin_convertvector(v, bf16x2_t)); }
__device__ __forceinline__ unsigned long long pack4bf(f32x4 v) { return (unsigned long long)cvtpk_c(v.x, v.y) | ((unsigned long long)cvtpk_c(v.z, v.w) << 32); }
__device__ __forceinline__ void chunk_mm(LAS unsigned char* lds, int c, unsigned char* blk, int lane) {
    asm volatile("" : "+v"(lane));
    LAS unsigned char* sc = lds + CS2_OFF + c * 16384;
    const int x = lane & 15, q = lane >> 4;
    bf16x8 aB[2], aK[2], bA[2], bR[2];
#pragma unroll
    for (int k2 = 0; k2 < 2; ++k2) { aB[k2] = *(const LAS bf16x8*)(sc + SC_FBH + (k2 * 64 + lane) * 16); aK[k2] = *(const LAS bf16x8*)(sc + SC_FKH + (k2 * 64 + lane) * 16);
        bA[k2] = *(const LAS bf16x8*)(sc + SC_FA + (k2 * 64 + lane) * 16); bR[k2] = *(const LAS bf16x8*)(sc + SC_FR + (k2 * 64 + lane) * 16); }
    f32x4 nb = (f32x4){0.f, 0.f, 0.f, 0.f}, nk = nb, mb_ = nb, mk = nb;
#pragma unroll
    for (int k2 = 0; k2 < 2; ++k2) { nb = __builtin_amdgcn_mfma_f32_16x16x32_bf16(aB[k2], bA[k2], nb, 0, 0, 0); nk = __builtin_amdgcn_mfma_f32_16x16x32_bf16(aK[k2], bA[k2], nk, 0, 0, 0);
        mb_ = __builtin_amdgcn_mfma_f32_16x16x32_bf16(aB[k2], bR[k2], mb_, 0, 0, 0); mk = __builtin_amdgcn_mfma_f32_16x16x32_bf16(aK[k2], bR[k2], mk, 0, 0, 0); }
#pragma unroll
    for (int r = 0; r < 4; ++r) { const int s_ = 4 * q + r; if (!(s_ < x)) { nb[r] = 0.f; nk[r] = 0.f; } if (!(s_ <= x)) { mb_[r] = 0.f; mk[r] = 0.f; } }
    *(GAS unsigned long long*)(blk + CB_FNK + lane * 8) = pack4bf(nk); *(GAS unsigned long long*)(blk + CB_FMB + lane * 8) = pack4bf(mb_); *(GAS unsigned long long*)(blk + CB_FMK + lane * 8) = pack4bf(mk);
    LAS float* nbs = (LAS float*)(sc + SC_NB);
#pragma unroll
    for (int r = 0; r < 4; ++r) nbs[(4 * q + r) * 16 + x] = nb[r];
    float Tc[16];
#pragma unroll
    for (int t = 0; t < 16; ++t) { float a_ = (x == t) ? 1.f : 0.f;
#pragma unroll
        for (int s_ = 0; s_ < t; ++s_) a_ -= Tc[s_] * nbs[s_ * 16 + t];
        Tc[t] = a_; if ((t & 3) == 3) asm volatile("" ::: "memory"); }
    LAS float* tts = (LAS float*)(sc + SC_TT);
#pragma unroll
    for (int t = 0; t < 16; ++t) tts[x * 16 + t] = Tc[t];
    { f32x4 tv;
#pragma unroll
      for (int e = 0; e < 4; ++e) tv[e] = -tts[(4 * q + e) * 16 + x];
      *(GAS unsigned long long*)(blk + CB_FT + lane * 8) = pack4bf(tv); }
}
__device__ __forceinline__ void chunk_copy(LAS unsigned char* lds, int c, unsigned char* blk, int lane) {
    const LAS unsigned char* sc = lds + CS2_OFF + c * 16384;
#pragma unroll
    for (int i = 0; i < 4; ++i) *(GAS v4u*)(blk + CB_FA + (i * 64 + lane) * 16) = *(const LAS v4u*)(sc + SC_FA + (i * 64 + lane) * 16);
#pragma unroll
    for (int i = 0; i < 6; ++i) *(GAS v4u*)(blk + CB_FBG + (i * 64 + lane) * 16) = *(const LAS v4u*)(sc + SC_FBG + (i * 64 + lane) * 16);
}
__device__ __forceinline__ float qsum8(float x) {
    x += dpp_f<0xB1>(x); x += dpp_f<0x4E>(x); x += dpp_f<0x141>(x); return x; }
__device__ __forceinline__ void lact_phase(Frame& F, const Args& A) {
    unsigned char* ws = F.ws; const bf16* PR = (const bf16*)(ws + WS_ACT); bf16* LA = (bf16*)(ws + WS_LACT); const float* mu = A.in[14];
    for (int i = blockIdx.x * (NWAVES * 64) + F.tid; i < MV * 32; i += F.G * NWAVES * 64) { const int m = i >> 5, c8 = i & 31, c0 = 3 * RWW + 8 * c8;
        const bf16* p = PR + (size_t)m * SHC + c0;
        const v4u ua = *(const GAS v4u*)p;
        f32x4 a0, a1, b0 = (f32x4){0.f, 0.f, 0.f, 0.f}, b1 = b0;
#define UNP(u, lo, hi) { lo = (f32x4){__builtin_bit_cast(float, u.x << 16), __builtin_bit_cast(float, u.x & 0xffff0000u), __builtin_bit_cast(float, u.y << 16), __builtin_bit_cast(float, u.y & 0xffff0000u)}; \
                         hi = (f32x4){__builtin_bit_cast(float, u.z << 16), __builtin_bit_cast(float, u.z & 0xffff0000u), __builtin_bit_cast(float, u.w << 16), __builtin_bit_cast(float, u.w & 0xffff0000u)}; }
        UNP(ua, a0, a1)
        if (m >= MP) { const float* pv = A.in[5] + (size_t)(m - MP) * SHC + c0; b0 = *(const GAS f32x4*)pv; b1 = *(const GAS f32x4*)(pv + 4); }
        else if ((m & (SEQ - 1)) != 0) { const v4u ub = *(const GAS v4u*)(p - SHC); UNP(ub, b0, b1) }
#undef UNP
        const f32x4 m0_ = *(const GAS f32x4*)(mu + c0), m1_ = *(const GAS f32x4*)(mu + c0 + 4);
        f32x4 x0 = a0 + m0_ * (b0 - a0), x1 = a1 + m1_ * (b1 - a1);
        if (c8 < 8) { x0.x = tanhf_(x0.x); x0.y = tanhf_(x0.y); x0.z = tanhf_(x0.z); x0.w = tanhf_(x0.w); x1.x = tanhf_(x1.x); x1.y = tanhf_(x1.y); x1.z = tanhf_(x1.z); x1.w = tanhf_(x1.w); }
        else if (c8 >= 16) { x0.x = sigmoidf_(x0.x); x0.y = sigmoidf_(x0.y); x0.z = sigmoidf_(x0.z); x0.w = sigmoidf_(x0.w); x1.x = sigmoidf_(x1.x); x1.y = sigmoidf_(x1.y); x1.z = sigmoidf_(x1.z); x1.w = sigmoidf_(x1.w); }
        *(GAS v4u*)(LA + (size_t)m * 256 + 8 * c8) = (v4u){pk2(x0.x, x0.y), pk2(x0.z, x0.w), pk2(x1.x, x1.y), pk2(x1.z, x1.w)}; }
}
__device__ __forceinline__ void prep_phase(Frame& F, const Args& A) {
    const int tid = F.tid, lane = F.lane, wave = F.wave;
    unsigned char* ws = F.ws; LAS unsigned char* lds = F.lds;
    const bf16* PR = (const bf16*)(ws + WS_ACT);
    const float* mu = A.in[14];
    int hcur = -1;
    const int mtile = wave & 3, nh = wave >> 2;
    v4u ua[4], u0, u1, u2, w0_, w1_, w2_;
#define RAW_LOAD1(M0_) do { const int ma_ = (M0_) + row1, mc_ = ma_ < MV ? ma_ : MV - 1; const bf16* p_ = (const bf16*)(ws + WS_LACT) + (size_t)mc_ * 256 + 32 * cc; \
        _Pragma("unroll") for (int q_ = 0; q_ < 4; ++q_) ua[q_] = *(const GAS v4u*)(p_ + 8 * q_); } while (0)
#define RAW_LOAD3(M0_, H_) do { const int mb_ = (M0_) + tok3, md_ = mb_ < MV ? mb_ : MV - 1, me_ = (md_ & (SEQ - 1)) != 0 ? md_ - 1 : md_; \
        const bf16* r_ = PR + (size_t)md_ * SHC + 64 * (H_) + 8 * cq; const bf16* rp_ = PR + (size_t)me_ * SHC + 64 * (H_) + 8 * cq; \
        u0 = *(const GAS v4u*)r_; u1 = *(const GAS v4u*)(r_ + RWW); u2 = *(const GAS v4u*)(r_ + 2 * RWW); \
        w0_ = *(const GAS v4u*)rp_; w1_ = *(const GAS v4u*)(rp_ + RWW); w2_ = *(const GAS v4u*)(rp_ + 2 * RWW); } while (0)
    if ((int)blockIdx.x < PREP_UNITS) { const int row1 = tid >> 3, cc = tid & 7, c01 = 3 * RWW + 32 * cc; RAW_LOAD1(((int)blockIdx.x >> 4) * 64); }
    for (int u = blockIdx.x; u < PREP_UNITS; u += F.G) {
        int tl_ = tid; asm volatile("" : "+v"(tl_));
        const int row1 = tl_ >> 3, cc = tl_ & 7, c01 = 3 * RWW + 32 * cc;
        const int ln_ = tl_ & 63, t3 = ln_ >> 3, cq = ln_ & 7, tok3 = 8 * wave + t3, ln = ln_ & 15, q4 = ln_ >> 4;
        const int mt = u >> 4, h = u & 15, m0 = mt * 64, hc0 = 64 * h + 8 * cq;
        if (h != hcur) {
            __syncthreads();
            hcur = h;
            { LAS float* cst = (LAS float*)(lds + PC_OFF);
              for (int i = tid; i < 10 * 64; i += NWAVES * 64) { const int a = i >> 6, c = i & 63, hc = 64 * h + c; float v;
                  if (a < 3) v = mu[a * RWW + hc]; else v = A.in[a == 3 ? 15 : (a == 4 ? 17 : (a == 5 ? 20 : (a == 6 ? 21 : (a == 7 ? 22 : (a == 8 ? 23 : 24)))))][hc];
                  cst[i] = v; } }
            __syncthreads();
        }
        RAW_LOAD3(m0, h);
        const int m1 = m0 + row1; const bool valid1 = m1 < MV;
#define UNP(u, lo, hi) { lo = (f32x4){__builtin_bit_cast(float, u.x << 16), __builtin_bit_cast(float, u.x & 0xffff0000u), __builtin_bit_cast(float, u.y << 16), __builtin_bit_cast(float, u.y & 0xffff0000u)}; \
                         hi = (f32x4){__builtin_bit_cast(float, u.z << 16), __builtin_bit_cast(float, u.z & 0xffff0000u), __builtin_bit_cast(float, u.w << 16), __builtin_bit_cast(float, u.w & 0xffff0000u)}; }
        const int m3 = m0 + tok3; const bool valid3 = m3 < MV;
        f32x4 cr[2], ck[2], cv[2], pr[2], pk[2], pv3[2];
        { const bool hp = valid3 && m3 < MP && (m3 & (SEQ - 1)) != 0; const v4u z4 = (v4u){0u, 0u, 0u, 0u};
          const v4u a_ = hp ? w0_ : z4, b_ = hp ? w1_ : z4, c_ = hp ? w2_ : z4;
          UNP(a_, pr[0], pr[1]) UNP(b_, pk[0], pk[1]) UNP(c_, pv3[0], pv3[1])
          UNP(u0, cr[0], cr[1]) UNP(u1, ck[0], ck[1]) UNP(u2, cv[0], cv[1])
          if (valid3 && m3 >= MP) { const float* q = A.in[5] + (size_t)(m3 - MP) * SHC + hc0;
#pragma unroll
              for (int e = 0; e < 2; ++e) { pr[e] = *(const GAS f32x4*)(q + 4 * e); pk[e] = *(const GAS f32x4*)(q + RWW + 4 * e); pv3[e] = *(const GAS f32x4*)(q + 2 * RWW + 4 * e); } } }
#undef UNP
        for (int rr1_ = 0; rr1_ < 1 + ((PROBE_REP >> 14) & 1); ++rr1_) {
#pragma unroll
        for (int q = 0; q < 4; ++q) *(LAS v4u*)(lds + PA_OFF + row1 * PA_PITCH + (32 * cc + 8 * q) * 2) = valid1 ? ua[q] : (v4u){0u, 0u, 0u, 0u};
        __syncthreads();
#pragma unroll
        for (int mat = 0; mat < 3; ++mat) { const int kbase = mat == 0 ? 0 : (mat == 1 ? 64 : 128), KM = mat == 2 ? 128 : 64;
#pragma unroll
            for (int n2 = 0; n2 < 2; ++n2) { const int nt = 2 * nh + n2; f32x4 acc = (f32x4){0.f, 0.f, 0.f, 0.f};
#pragma unroll
                for (int ks = 0; ks < KM / 32; ++ks) {
                    const bf16x8 a = *(const LAS bf16x8*)(lds + PA_OFF + (16 * mtile + ln) * PA_PITCH + (kbase + 32 * ks + 8 * q4) * 2);
                    const bf16x8 bq = *(const GAS bf16x8*)((const bf16*)(ws + (mat == 0 ? WS_W2T : (mat == 1 ? WS_A2T : WS_G2T))) + (size_t)(64 * h + 16 * nt + ln) * KM + 32 * ks + 8 * q4);
                    acc = __builtin_amdgcn_mfma_f32_16x16x32_bf16(a, bq, acc, 0, 0, 0); }
                LAS float* o = (LAS float*)(lds + PW_OFF + mat * PMAT);
#pragma unroll
                for (int r = 0; r < 4; ++r) o[(16 * mtile + 4 * q4 + r) * PW_LD + 16 * nt + ln] = acc[r]; } }
        __syncthreads();
        }
        { const LAS float* cst = (const LAS float*)(lds + PC_OFF) + 8 * cq;
          const LAS float* Wp = (const LAS float*)(lds + PW_OFF) + tok3 * PW_LD + 8 * cq; const LAS float* Ap = Wp + PMAT / 4; const LAS float* Gp = Ap + PMAT / 4;
          float xr[8], xk[8], xv[8], kkr[8], kp[8], aa[8], gg[8], dec[8], lw2[8]; float n2 = 0.f, bon = 0.f;
#pragma unroll
          for (int e = 0; e < 2; ++e) {
              const f32x4 mur = *(const LAS f32x4*)(cst + 0 * 64 + 4 * e), muk = *(const LAS f32x4*)(cst + 1 * 64 + 4 * e), muv = *(const LAS f32x4*)(cst + 2 * 64 + 4 * e);
              const f32x4 w0 = *(const LAS f32x4*)(cst + 3 * 64 + 4 * e), a0 = *(const LAS f32x4*)(cst + 4 * 64 + 4 * e), k_k = *(const LAS f32x4*)(cst + 5 * 64 + 4 * e);
              const f32x4 k_a = *(const LAS f32x4*)(cst + 6 * 64 + 4 * e), r_k = *(const LAS f32x4*)(cst + 7 * 64 + 4 * e);
              const f32x4 wl = *(const LAS f32x4*)(Wp + 4 * e), al = *(const LAS f32x4*)(Ap + 4 * e), gl = *(const LAS f32x4*)(Gp + 4 * e);
              const f32x4 r4 = cr[e] + mur * (pr[e] - cr[e]), k4 = ck[e] + muk * (pk[e] - ck[e]), v4 = cv[e] + muv * (pv3[e] - cv[e]);
#pragma unroll
              for (int j = 0; j < 4; ++j) { const int i = 4 * e + j;
                  xr[i] = r4[j]; xk[i] = k4[j]; xv[i] = v4[j];
                  lw2[i] = -0.6065306597126334f * LOG2E * sigmoidf_(w0[j] + wl[j]); dec[i] = __builtin_amdgcn_exp2f(lw2[i]);
                  aa[i] = sigmoidf_(a0[j] + al[j]); gg[i] = gl[j];
                  kkr[i] = xk[i] * k_k[j]; n2 += kkr[i] * kkr[i];
                  kp[i] = xk[i] * (1.0f + (aa[i] - 1.0f) * k_a[j]);
                  bon += xr[i] * kp[i] * r_k[j]; } }
          n2 = qsum8(n2); bon = qsum8(bon);
          const float inv = 1.0f / fmaxf(sqrtf(n2), 1e-12f);
          float lgv[8], eev[8], bbv[8];
          { const f32x4 lw0 = *(const LAS f32x4*)(cst + 8 * 64), lw1 = *(const LAS f32x4*)(cst + 8 * 64 + 4), lb0 = *(const LAS f32x4*)(cst + 9 * 64), lb1 = *(const LAS f32x4*)(cst + 9 * 64 + 4);
#pragma unroll
            for (int i = 0; i < 8; ++i) { kkr[i] *= inv; bbv[i] = kkr[i] * aa[i]; const float lw = i < 4 ? lw0[i & 3] : lw1[i & 3], lb = i < 4 ? lb0[i & 3] : lb1[i & 3]; lgv[i] = lw * gg[i]; eev[i] = (lb + bon * xv[i]) * gg[i]; } }
#define PK8(a) (v4u){pk2(a[0], a[1]), pk2(a[2], a[3]), pk2(a[4], a[5]), pk2(a[6], a[7])}
          if (valid3) { const size_t o = (size_t)m3 * RWW + hc0;
              *(GAS v4u*)((bf16*)(ws + WS_LG) + o) = PK8(lgv); *(GAS v4u*)((bf16*)(ws + WS_EE) + o) = PK8(eev); }
          if (u + (int)F.G < PREP_UNITS) RAW_LOAD1(((u + (int)F.G) >> 4) * 64);
          if (m0 >= MP) {
              if (valid3) { float* dv = (float*)(ws + WS_DEC) + (size_t)(m3 - MP) * RWW + hc0;
#define ST8(arr, a) { *(GAS f32x4*)(dv + (size_t)(arr) * NDEC * RWW) = (f32x4){a[0], a[1], a[2], a[3]}; *(GAS f32x4*)(dv + (size_t)(arr) * NDEC * RWW + 4) = (f32x4){a[4], a[5], a[6], a[7]}; }
                  ST8(0, kkr) ST8(1, dec) ST8(2, bbv) ST8(3, kp) ST8(4, xr) ST8(5, xv)
#undef ST8
              }
          } else for (int rr3_ = 0; rr3_ < 1 + ((PROBE_REP >> 15) & 1); ++rr3_) {
              *(LAS f32x4*)(lds + LW_OFF + (tok3 * 64 + 8 * cq) * 4) = (f32x4){lw2[0], lw2[1], lw2[2], lw2[3]}; *(LAS f32x4*)(lds + LW_OFF + (tok3 * 64 + 8 * cq) * 4 + 16) = (f32x4){lw2[4], lw2[5], lw2[6], lw2[7]};
              __syncthreads();
              const int cch = tok3 >> 4, t_ = tok3 & 15;
              float Lall[8], Lt[8];
#pragma unroll
              for (int i = 0; i < 8; ++i) { Lall[i] = 0.f; Lt[i] = 0.f; }
#pragma unroll
              for (int s_ = 0; s_ < 16; ++s_) { const LAS float* rp = (const LAS float*)(lds + LW_OFF + ((16 * cch + s_) * 64 + 8 * cq) * 4); const f32x4 a_ = *(const LAS f32x4*)rp, b_ = *(const LAS f32x4*)(rp + 4);
                  const bool in_ = s_ <= t_;
#pragma unroll
                  for (int i = 0; i < 4; ++i) { Lall[i] += a_[i]; Lall[4 + i] += b_[i]; Lt[i] += in_ ? a_[i] : 0.f; Lt[4 + i] += in_ ? b_[i] : 0.f; } }
              unsigned char* blk = chunk_block(ws, ((m0 >> 11) * RWH + h) * NCHUNK + ((m0 & (SEQ - 1)) >> 4) + cch);
              { LAS unsigned char* sc = lds + CS2_OFF + cch * 16384;
                const int ks_ = cq >> 2, qa = 2 * (cq & 1), e0 = 4 * ((cq & 3) >> 1);
                const int a0_ = ((ks_ * 64 + qa * 16 + t_) * 8 + e0) * 2;
#pragma unroll
                for (int hf = 0; hf < 2; ++hf) {
                    float ah[4], rh[4], bh[4], kh[4], bg[4], kg[4], gcv[4];
#pragma unroll
                    for (int i2 = 0; i2 < 4; ++i2) { const int i = 4 * hf + i2;
                        const float gt = __builtin_amdgcn_exp2f(Lt[i]), gp = __builtin_amdgcn_exp2f(Lt[i] - lw2[i]), ig = __builtin_amdgcn_exp2f(-Lt[i]), gr = __builtin_amdgcn_exp2f(Lall[i] - Lt[i]);
                        ah[i2] = gp * kkr[i]; rh[i2] = gt * xr[i]; bh[i2] = bbv[i] * ig; kh[i2] = kp[i] * ig; bg[i2] = bbv[i] * gr; kg[i2] = kp[i] * gr; gcv[i2] = __builtin_amdgcn_exp2f(Lall[i]); }
                    if (t_ == 15) *(GAS f32x4*)(blk + CB_GC + 32 * cq + 16 * hf) = (f32x4){gcv[0], gcv[1], gcv[2], gcv[3]};
#define W4(off, a) *(LAS unsigned long long*)(sc + (off) + a0_ + 256 * hf) = (unsigned long long)cvtpk_c(a[0], a[1]) | ((unsigned long long)cvtpk_c(a[2], a[3]) << 32);
                    W4(SC_FA, ah) W4(SC_FR, rh) W4(SC_FBH, bh) W4(SC_FKH, kh)
#undef W4
#pragma unroll
                    for (int i2 = 0; i2 < 4; ++i2) { const int j_ = 8 * cq + 4 * hf + i2, off = (((j_ >> 4) * 64 + (t_ >> 2) * 16 + (j_ & 15)) * 4 + (t_ & 3)) * 2;
                        *(LAS unsigned short*)(sc + SC_FBG + off) = (unsigned short)cvtpk_c(bg[i2], 0.f); *(LAS unsigned short*)(sc + SC_FKG + off) = (unsigned short)cvtpk_c(kg[i2], 0.f);
                        *(LAS unsigned short*)(sc + SC_FV + off) = (unsigned short)cvtpk_c(xv[4 * hf + i2], 0.f); }
                    asm volatile("" ::: "memory");
                } }
              __syncthreads();
              { unsigned char* blkw = chunk_block(ws, ((m0 >> 11) * RWH + h) * NCHUNK + ((m0 & (SEQ - 1)) >> 4) + (wave & 3));
                if (wave < 4) chunk_mm(lds, wave, blkw, ln_); else chunk_copy(lds, wave - 4, blkw, ln_); }
              __syncthreads();
          }
#undef PK8
        }
    }
#undef RAW_LOAD1
#undef RAW_LOAD3
}

constexpr int AK_PITCH = 144, AV_PITCH = 592, AP_PITCH = 336;
constexpr int AK_OFF = 0, AV_OFF = 272 * AK_PITCH  , AP_OFF = AV_OFF + 64 * AV_PITCH  , AB_OFF = AP_OFF + 8 * 16 * AP_PITCH  ;
static_assert(AB_OFF + 129 * 4 * 4 <= RING_BYTES, "attention LDS");
__device__ __forceinline__ void attn_unit(Frame& F, const Args& A, int b, int blk, int hk) {
    const int tid = F.tid, lane = F.lane, wave = F.wave;
    unsigned char* ws = F.ws; LAS unsigned char* lds = F.lds;
    const bf16* QB = (const bf16*)(ws + WS_QB); const bf16* KB = (const bf16*)(ws + WS_KB); const bf16* VB = (const bf16*)(ws + WS_VB); bf16* MX = (bf16*)(ws + WS_MIX);
    const int mq0 = b * SEQ + blk * 128, mk0 = mq0 - 128;
    for (int i = tid; i < 16 * AK_PITCH / 4; i += NWAVES * 64) ((LAS unsigned*)(lds + AK_OFF + 256 * AK_PITCH))[i] = 0u;
    for (int i = tid; i < 64 * 16; i += NWAVES * 64) ((LAS unsigned*)(lds + AV_OFF + (i >> 4) * AV_PITCH + 512))[i & 15] = 0u;
#pragma unroll
    for (int it = 0; it < 4; ++it) { const int idx = it * 512 + tid, row = idx >> 3, ch = idx & 7;
        v4u kv = (v4u){0u, 0u, 0u, 0u}, vv = kv;
        if (blk > 0 || row >= 128) { kv = *(const GAS v4u*)(KB + (size_t)(mk0 + row) * KVW + hk * 64 + ch * 8); vv = *(const GAS v4u*)(VB + (size_t)(mk0 + row) * KVW + hk * 64 + ch * 8); }
        *(LAS v4u*)(lds + AK_OFF + row * AK_PITCH + ch * 16) = kv;
        LAS unsigned short* vt = (LAS unsigned short*)(lds + AV_OFF + (8 * ch) * AV_PITCH + row * 2);
        vt[0 * (AV_PITCH / 2)] = (unsigned short)(vv.x & 0xffffu); vt[1 * (AV_PITCH / 2)] = (unsigned short)(vv.x >> 16);
        vt[2 * (AV_PITCH / 2)] = (unsigned short)(vv.y & 0xffffu); vt[3 * (AV_PITCH / 2)] = (unsigned short)(vv.y >> 16);
        vt[4 * (AV_PITCH / 2)] = (unsigned short)(vv.z & 0xffffu); vt[5 * (AV_PITCH / 2)] = (unsigned short)(vv.z >> 16);
        vt[6 * (AV_PITCH / 2)] = (unsigned short)(vv.w & 0xffffu); vt[7 * (AV_PITCH / 2)] = (unsigned short)(vv.w >> 16); }
    { const float* bt = (const float*)(ws + WS_BIAS); LAS float* bl = (LAS float*)(lds + AB_OFF);
      for (int i = tid; i < 129 * 4; i += NWAVES * 64) bl[i] = bt[(i >> 2) * NQH + 4 * hk + (i & 3)]; }
    __syncthreads();
    const int g = wave >> 1, half = wave & 1, head = 4 * hk + g, ln = lane & 15, q4 = lane >> 4;
    const float sink2 = A.in[13][head] * LOG2E;
    const LAS float* bl = (const LAS float*)(lds + AB_OFF);
    LAS unsigned char* Pw = lds + AP_OFF + wave * (16 * AP_PITCH);
    bf16x8 qfa[4][2];
#pragma unroll
    for (int rb = 0; rb < 4; ++rb)
#pragma unroll
        for (int ks = 0; ks < 2; ++ks) qfa[rb][ks] = *(const GAS bf16x8*)(QB + (size_t)(mq0 + 64 * half + 16 * rb + ln) * ATTW + head * 64 + 32 * ks + 8 * q4);
#pragma unroll
    for (int rb = 0; rb < 4; ++rb) {
        const int i0 = 64 * half + 16 * rb, kt0 = i0 >> 4;
        bf16x8 qf[2]; qf[0] = qfa[rb][0]; qf[1] = qfa[rb][1];
        f32x4 s[10];
#pragma unroll
        for (int j = 0; j < 10; ++j) { f32x4 acc = (f32x4){0.f, 0.f, 0.f, 0.f};
#pragma unroll
            for (int ks = 0; ks < 2; ++ks) { const bf16x8 kf = *(const LAS bf16x8*)(lds + AK_OFF + (16 * (kt0 + j) + ln) * AK_PITCH + (32 * ks + 8 * q4) * 2);
                acc = __builtin_amdgcn_mfma_f32_16x16x32_bf16(qf[ks], kf, acc, 0, 0, 0); }
            s[j] = acc; }
        float mx[4] = {-INFINITY, -INFINITY, -INFINITY, -INFINITY};
#pragma unroll
        for (int j = 0; j < 10; ++j) { const int kj = 16 * (kt0 + j) + ln;
#pragma unroll
            for (int r = 0; r < 4; ++r) { const int dist = 128 + i0 + 4 * q4 + r - kj; const bool ok = dist >= 0 && dist <= 128 && (blk > 0 || kj >= 128);
                const int dc = dist < 0 ? 0 : (dist > 128 ? 128 : dist);
                const float v = ok ? s[j][r] + bl[dc * 4 + g] : -INFINITY; s[j][r] = v; mx[r] = fmaxf(mx[r], v); } }
        float l[4];
#pragma unroll
        for (int r = 0; r < 4; ++r) { float m_ = mx[r]; m_ = fmaxf(m_, dpp_f<0x128>(m_)); m_ = fmaxf(m_, dpp_f<0x124>(m_)); m_ = fmaxf(m_, dpp_f<0x122>(m_)); m_ = fmaxf(m_, dpp_f<0x121>(m_));
            mx[r] = fmaxf(m_, sink2); l[r] = 0.f; }
#pragma unroll
        for (int j = 0; j < 10; ++j)
#pragma unroll
            for (int r = 0; r < 4; ++r) { const float p = __builtin_amdgcn_exp2f(s[j][r] - mx[r]); l[r] += p;
                *(LAS unsigned short*)(Pw + (4 * q4 + r) * AP_PITCH + (16 * j + ln) * 2) = (unsigned short)cvtpk_c(p, 0.f); }
#pragma unroll
        for (int r = 0; r < 4; ++r) { const float t = allsum16(l[r]);
            l[r] = __builtin_amdgcn_rcpf(t + __builtin_amdgcn_exp2f(sink2 - mx[r])); }
        f32x4 o[4];
#pragma unroll
        for (int dt = 0; dt < 4; ++dt) o[dt] = (f32x4){0.f, 0.f, 0.f, 0.f};
#pragma unroll
        for (int st = 0; st < 5; ++st) { const bf16x8 pf = *(const LAS bf16x8*)(Pw + ln * AP_PITCH + (32 * st + 8 * q4) * 2);
#pragma unroll
            for (int dt = 0; dt < 4; ++dt) { const bf16x8 vf = *(const LAS bf16x8*)(lds + AV_OFF + (16 * dt + ln) * AV_PITCH + (16 * kt0 + 32 * st + 8 * q4) * 2);
                o[dt] = __builtin_amdgcn_mfma_f32_16x16x32_bf16(pf, vf, o[dt], 0, 0, 0); } }
#pragma unroll
        for (int dt = 0; dt < 4; ++dt)
#pragma unroll
            for (int r = 0; r < 4; ++r) *(LAS unsigned short*)(Pw + (4 * q4 + r) * AP_PITCH + (16 * dt + ln) * 2) = (unsigned short)cvtpk_c(o[dt][r] * l[r], 0.f);
#pragma unroll
        for (int i = 0; i < 2; ++i) { const int qrow = 8 * i + (lane >> 3), ch = lane & 7;
            const v4u ov = *(const LAS v4u*)(Pw + qrow * AP_PITCH + ch * 16);
            *(GAS v4u*)(MX + (size_t)(mq0 + i0 + qrow) * DM + head * 64 + ch * 8) = ov; }
    }
    __syncthreads();
}

__device__ __forceinline__ void dec_attn_unit(Frame& F, const Args& A, int du) {
    const int lane = F.lane, wave = F.wave; unsigned char* ws = F.ws;
    const int idx = du * 8 + wave, b = idx >> 4, head = idx & 15, hk = head >> 2, m = MP + b;
    LAS float* qs = (LAS float*)(F.lds + wave * 1024); LAS float* ps = qs + 64;
    const bf16* QB = (const bf16*)(ws + WS_QB); bf16* MX = (bf16*)(ws + WS_MIX);
    const float* bt = (const float*)(ws + WS_BIAS);
    const float sink2 = A.in[13][head] * LOG2E;
    const float qv = bf2f(QB[(size_t)m * ATTW + head * 64 + lane]);
    qs[lane] = qv;
    LDS_WAIT(); asm volatile("" ::: "memory");
    float sc[2];
#pragma unroll
    for (int pi = 0; pi < 2; ++pi) { const int pos = lane + 64 * pi; const float* kr = A.in[2] + ((size_t)(b * WIN + pos) * NKVH + hk) * HD; float d = 0.f;
#pragma unroll
        for (int j = 0; j < 16; ++j) { const f32x4 k4 = *(const f32x4*)(kr + 4 * j); const f32x4 q4v = *(const LAS f32x4*)(qs + 4 * j); d += (k4.x * q4v.x + k4.y * q4v.y) + (k4.z * q4v.z + k4.w * q4v.w); }
        sc[pi] = d + bt[(WIN - pos) * NQH + head]; }
    const float* kn = F.out + O_KS + ((size_t)b * WIN + (WIN - 1)) * KVW + hk * HD; const float* vn = F.out + O_VS + ((size_t)b * WIN + (WIN - 1)) * KVW + hk * HD;
    const float snew = wave_sum(qv * kn[lane]) + bt[head];
    const float mx = fmaxf(fmaxf(wave_max(fmaxf(sc[0], sc[1])), snew), sink2);
    const float p0 = __builtin_amdgcn_exp2f(sc[0] - mx), p1 = __builtin_amdgcn_exp2f(sc[1] - mx), pn = __builtin_amdgcn_exp2f(snew - mx);
    const float linv = __builtin_amdgcn_rcpf(wave_sum(p0 + p1) + pn + __builtin_amdgcn_exp2f(sink2 - mx));
    ps[lane] = p0; ps[lane + 64] = p1;
    LDS_WAIT(); asm volatile("" ::: "memory");
    const float* vr = A.in[3] + ((size_t)(b * WIN) * NKVH + hk) * HD + lane; float o = pn * vn[lane];
#pragma unroll 8
    for (int pos = 0; pos < WIN; ++pos) o += ps[pos] * vr[(size_t)pos * NKVH * HD];
    MX[(size_t)m * DM + head * 64 + lane] = f2bfs(o * linv);
    LDS_WAIT(); asm volatile("" ::: "memory");
}

constexpr int SC_T = 32, SC_REC = 1344  , SC_BUF = SC_T * SC_REC  ;
struct ScanRegs { v4u kk, bb, kp, rr, vv; f32x4 d0, d1; };
__device__ __forceinline__ void scan_load(ScanRegs& R, const unsigned char* ws, int m, int h, int rq, int part) {
    const size_t o = (size_t)m * RWW + 64 * h + 8 * part;
    R.kk = *(const GAS v4u*)((const bf16*)(ws + WS_KK) + o); R.bb = *(const GAS v4u*)((const bf16*)(ws + WS_BB) + o);
    R.kp = *(const GAS v4u*)((const bf16*)(ws + WS_KP) + o); R.rr = *(const GAS v4u*)((const bf16*)(ws + WS_RR) + o);
    R.d0 = *(const GAS f32x4*)((const float*)(ws + WS_DD) + o); R.d1 = *(const GAS f32x4*)((const float*)(ws + WS_DD) + o + 4);
    R.vv = (v4u){0u, 0u, 0u, 0u};
    if (part < 2) R.vv = *(const GAS v4u*)((const bf16*)(ws + WS_VV) + (size_t)m * RWW + 64 * h + 16 * rq + 8 * part);
}
__device__ __forceinline__ void st8(LAS unsigned char* p, v4u u) {
    *(LAS f32x4*)p = (f32x4){__builtin_bit_cast(float, u.x << 16), __builtin_bit_cast(float, u.x & 0xffff0000u), __builtin_bit_cast(float, u.y << 16), __builtin_bit_cast(float, u.y & 0xffff0000u)};
    *(LAS f32x4*)(p + 16) = (f32x4){__builtin_bit_cast(float, u.z << 16), __builtin_bit_cast(float, u.z & 0xffff0000u), __builtin_bit_cast(float, u.w << 16), __builtin_bit_cast(float, u.w & 0xffff0000u)};
}
__device__ __forceinline__ void scan_store(const ScanRegs& R, LAS unsigned char* rec, int part) {
    st8(rec + 0 + 32 * part, R.kk); *(LAS f32x4*)(rec + 256 + 32 * part) = R.d0; *(LAS f32x4*)(rec + 256 + 32 * part + 16) = R.d1;
    st8(rec + 512 + 32 * part, R.bb); st8(rec + 768 + 32 * part, R.kp); st8(rec + 1024 + 32 * part, R.rr);
    if (part < 2) st8(rec + 1280 + 32 * part, R.vv);
}
constexpr int SC_YOFF = 2 * SC_BUF, SC_YBUF = SC_T * 16 * 4 * 4  ;
static_assert(SC_YOFF + 2 * SC_YBUF <= RING_BYTES, "scan LDS");
struct ScanVec { f32x2 kk0, kk1, d0, d1, b0, b1, k0, k1, r0, r1; float v; };
__device__ __forceinline__ void scan_ld(ScanVec& x, const LAS unsigned char* base, const LAS unsigned char* vb, int t) {
    const f32x4 kk = *(const LAS f32x4*)(base + t * SC_REC), dd = *(const LAS f32x4*)(base + t * SC_REC + 256), bb = *(const LAS f32x4*)(base + t * SC_REC + 512),
                kp = *(const LAS f32x4*)(base + t * SC_REC + 768), rr = *(const LAS f32x4*)(base + t * SC_REC + 1024);
    x.kk0 = (f32x2){kk.x, kk.y}; x.kk1 = (f32x2){kk.z, kk.w}; x.d0 = (f32x2){dd.x, dd.y}; x.d1 = (f32x2){dd.z, dd.w}; x.b0 = (f32x2){bb.x, bb.y}; x.b1 = (f32x2){bb.z, bb.w};
    x.k0 = (f32x2){kp.x, kp.y}; x.k1 = (f32x2){kp.z, kp.w}; x.r0 = (f32x2){rr.x, rr.y}; x.r1 = (f32x2){rr.z, rr.w};
    x.v = *(const LAS float*)(vb + t * SC_REC);
}
__device__ __forceinline__ void scan_yflush(const LAS unsigned char* yb, float* YS, int ptid) {
#pragma unroll
    for (int i = 0; i < 2; ++i) { const int o = ptid + 256 * i, t = o >> 4, r = o & 15; const f32x4 q = *(const LAS f32x4*)(yb + o * 16);
        YS[(size_t)t * RWW + r] = (q.x + q.y) + (q.z + q.w); }
}
__device__ __forceinline__ void scan_unit(Frame& F, int c) {
    const int b = c >> 6, h = (c >> 2) & 15, rq = c & 3, lane = F.lane, wave = F.wave;
    unsigned char* ws = F.ws; LAS unsigned char* lds = F.lds;
    const int mb = b * SEQ; constexpr int NCH = SEQ / SC_T;
    if (wave >= 4) {
        const int ptid = F.tid - 256, tok = ptid >> 3, part = ptid & 7;
        float* YS = (float*)(ws + WS_ACT) + (size_t)mb * RWW + 64 * h + 16 * rq;
        ScanRegs cur, nxt;
        scan_load(cur, ws, mb + tok, h, rq, part);
        scan_load(nxt, ws, mb + SC_T + tok, h, rq, part);
        scan_store(cur, lds + tok * SC_REC, part);
        __syncthreads();
        for (int ch = 0; ch < NCH; ++ch) {
            cur = nxt;
            if (ch + 2 < NCH) scan_load(nxt, ws, mb + (ch + 2) * SC_T + tok, h, rq, part);
            if (ch + 1 < NCH) scan_store(cur, lds + ((ch + 1) & 1) * SC_BUF + tok * SC_REC, part);
            if (ch > 0) scan_yflush(lds + SC_YOFF + ((ch - 1) & 1) * SC_YBUF, YS + (size_t)(ch - 1) * SC_T * RWW, ptid);
            __syncthreads();
        }
        scan_yflush(lds + SC_YOFF + ((NCH - 1) & 1) * SC_YBUF, YS + (size_t)(NCH - 1) * SC_T * RWW, ptid);
    } else {
        const int rl = 4 * wave + (lane >> 4), p = lane & 15, row = 16 * rq + rl;
        f32x2 S0 = (f32x2){0.f, 0.f}, S1 = S0;
        __builtin_amdgcn_s_setprio(2);
        __syncthreads();
        for (int ch = 0; ch < NCH; ++ch) {
            const LAS unsigned char* base = lds + (ch & 1) * SC_BUF + p * 16;
            const LAS unsigned char* vb = lds + (ch & 1) * SC_BUF + 1280 + rl * 4;
            LAS unsigned char* yb = lds + SC_YOFF + (ch & 1) * SC_YBUF + (rl * 4 + (p & 3)) * 4;
            ScanVec cur; scan_ld(cur, base, vb, 0);
#pragma unroll
            for (int t = 0; t < SC_T; ++t) {
                ScanVec nxt; scan_ld(nxt, base, vb, t + 1 < SC_T ? t + 1 : t);
                f32x2 a = S0 * cur.kk0; a = S1 * cur.kk1 + a;
                const float sa = -allsum16(a.x + a.y);
                const f32x2 sa2 = (f32x2){sa, sa}, v2 = (f32x2){cur.v, cur.v};
                f32x2 u0 = cur.b0 * sa2, u1 = cur.b1 * sa2;
                u0 = S0 * cur.d0 + u0; u1 = S1 * cur.d1 + u1;
                S0 = cur.k0 * v2 + u0; S1 = cur.k1 * v2 + u1;
                f32x2 q = S0 * cur.r0; q = S1 * cur.r1 + q;
                float y = q.x + q.y; y += dpp_f<0x128>(y); y += dpp_f<0x124>(y);
                *(LAS float*)(yb + t * 256) = y;
                cur = nxt;
            }
            __syncthreads();
        }
        __builtin_amdgcn_s_setprio(0);
        *(f32x4*)(F.out + O_WP + ((size_t)(b * RWH + h) * HD + row) * HD + 4 * p) = (f32x4){S0.x, S0.y, S1.x, S1.y};
    }
}
__device__ __forceinline__ void dec_rwkv_unit(Frame& F, const Args& A, int du) {
    const int lane = F.lane, wave = F.wave; unsigned char* ws = F.ws;
    const int idx = du * 8 + wave, b = idx >> 4, h = idx & 15, m = MP + b;
    LAS float* vec = (LAS float*)(F.lds + wave * 1280);
    const size_t o = (size_t)m * RWW + 64 * h + lane;
    const float* dv = (const float*)(ws + WS_DEC) + (size_t)b * RWW + 64 * h + lane;
    vec[lane] = dv[0]; vec[64 + lane] = dv[(size_t)1 * NDEC * RWW]; vec[128 + lane] = dv[(size_t)2 * NDEC * RWW];
    vec[192 + lane] = dv[(size_t)3 * NDEC * RWW]; vec[256 + lane] = dv[(size_t)4 * NDEC * RWW];
    const float vi = dv[(size_t)5 * NDEC * RWW];
    const size_t so = ((size_t)(b * RWH + h) * HD + lane) * HD;
    const float* Sp = A.in[4] + so; f32x4 S[16];
#pragma unroll
    for (int j = 0; j < 16; ++j) S[j] = *(const f32x4*)(Sp + 4 * j);
    LDS_WAIT(); asm volatile("" ::: "memory");
    float sa = 0.f;
#pragma unroll
    for (int j = 0; j < 16; ++j) { const f32x4 kk = *(const LAS f32x4*)(vec + 4 * j); sa += (S[j].x * kk.x + S[j].y * kk.y) + (S[j].z * kk.z + S[j].w * kk.w); asm volatile("" ::: "memory"); }
    sa = -sa; float y = 0.f; float* So = F.out + O_WS + so;
#pragma unroll
    for (int j = 0; j < 16; ++j) { const f32x4 dd = *(const LAS f32x4*)(vec + 64 + 4 * j), bb = *(const LAS f32x4*)(vec + 128 + 4 * j), kp = *(const LAS f32x4*)(vec + 192 + 4 * j), rr = *(const LAS f32x4*)(vec + 256 + 4 * j);
        S[j] = S[j] * dd + bb * sa + kp * vi; y += (S[j].x * rr.x + S[j].y * rr.y) + (S[j].z * rr.z + S[j].w * rr.w);
        *(f32x4*)(So + 4 * j) = S[j]; asm volatile("" ::: "memory"); }
    { const float mean = wave_sum(y) * (1.0f / 64.0f), dl = y - mean, var = wave_sum(dl * dl) * (1.0f / 64.0f);
      const float r_ = dl * __builtin_amdgcn_rsqf(var + GN_EPS) * bf2f(((const bf16*)(ws + WS_LG))[o]) + bf2f(((const bf16*)(ws + WS_EE))[o]);
      ((bf16*)(ws + WS_MIX))[(size_t)m * DM + ATTW + 64 * h + lane] = f2bfs(r_); }
    LDS_WAIT(); asm volatile("" ::: "memory");
}


__device__ __forceinline__ void post_rows8(unsigned char* ws, int m, int h, int cq, bool ok) {
    const float* YS = (const float*)(ws + WS_ACT); const bf16* LG = (const bf16*)(ws + WS_LG); const bf16* EE = (const bf16*)(ws + WS_EE); bf16* MIXB = (bf16*)(ws + WS_MIX);
    const size_t o = (size_t)(ok ? m : 0) * RWW + 64 * h + 8 * cq;
    const f32x4 y0 = *(const GAS f32x4*)(YS + o), y1 = *(const GAS f32x4*)(YS + o + 4);
    const v4u lg = *(const GAS v4u*)(LG + o), ee = *(const GAS v4u*)(EE + o);
    const float mean = qsum8((y0.x + y0.y) + (y0.z + y0.w) + (y1.x + y1.y) + (y1.z + y1.w)) * (1.0f / 64.0f);
    const f32x4 d0 = y0 - mean, d1 = y1 - mean;
    const float var = qsum8((d0.x * d0.x + d0.y * d0.y) + (d0.z * d0.z + d0.w * d0.w) + (d1.x * d1.x + d1.y * d1.y) + (d1.z * d1.z + d1.w * d1.w)) * (1.0f / 64.0f);
    const float rs = __builtin_amdgcn_rsqf(var + GN_EPS);
#define BFL(w) __builtin_bit_cast(float, (w) << 16)
#define BFH(w) __builtin_bit_cast(float, (w) & 0xffff0000u)
    v4u r;
    r.x = cvtpk_c(d0.x * rs * BFL(lg.x) + BFL(ee.x), d0.y * rs * BFH(lg.x) + BFH(ee.x)); r.y = cvtpk_c(d0.z * rs * BFL(lg.y) + BFL(ee.y), d0.w * rs * BFH(lg.y) + BFH(ee.y));
    r.z = cvtpk_c(d1.x * rs * BFL(lg.z) + BFL(ee.z), d1.y * rs * BFH(lg.z) + BFH(ee.z)); r.w = cvtpk_c(d1.z * rs * BFL(lg.w) + BFL(ee.w), d1.w * rs * BFH(lg.w) + BFH(ee.w));
#undef BFL
#undef BFH
    if (ok) *(GAS v4u*)(MIXB + (size_t)m * DM + ATTW + 64 * h + 8 * cq) = r;
}
constexpr int SC2_NS = 8, SC2_D = SC2_NS - 1;
static_assert(SC2_NS * CB_STRIDE <= RING_BYTES, "scan ring");
__device__ __forceinline__ void scan2_unit(Frame& F, int c) {
    const int b = c >> 4, h = c & 15, lane = F.lane, wave = F.wave;
    unsigned char* ws = F.ws; LAS unsigned char* lds = F.lds;
    const int mb = b * SEQ, g0 = (b * RWH + h) * NCHUNK;
#define SC2_BAR() do { asm volatile("" ::: "memory"); __builtin_amdgcn_s_barrier(); asm volatile("" ::: "memory"); } while (0)
    if (wave >= 4) {
        const int lw = wave - 4;
#define SC2_ISSUE(cc) do { const unsigned char* blk_ = chunk_block(ws, g0 + (cc)); LAS unsigned char* sl_ = lds + ((cc) & (SC2_NS - 1)) * CB_STRIDE; \
            for (int p_ = lw; p_ < 13; p_ += 4) __builtin_amdgcn_global_load_lds((const unsigned*)(blk_ + p_ * 1024 + lane * 16), (LAS unsigned*)(sl_ + p_ * 1024), 16, 0, 0); } while (0)
#define SC2_WAIT() do { if (lw == 0) asm volatile("s_waitcnt vmcnt(20)" ::: "memory"); else asm volatile("s_waitcnt vmcnt(15)" ::: "memory"); } while (0)
        for (int cc = 0; cc < SC2_D; ++cc) SC2_ISSUE(cc);
        SC2_WAIT(); SC2_BAR();
        for (int cc = 0; cc < NCHUNK; ++cc) {
            if (cc + SC2_D < NCHUNK) { SC2_ISSUE(cc + SC2_D); SC2_WAIT(); } else asm volatile("s_waitcnt vmcnt(0)" ::: "memory");
            SC2_BAR();
        }
#undef SC2_ISSUE
#undef SC2_WAIT
    } else {
        const int it = wave, x = lane & 15, q = lane >> 4;
        f32x4 S[4];
#pragma unroll
        for (int jt = 0; jt < 4; ++jt) S[jt] = (f32x4){0.f, 0.f, 0.f, 0.f};
        float* YS = (float*)(ws + WS_ACT) + (size_t)mb * RWW + 64 * h + 16 * it + x;
        struct CkOps { bf16x8 fa[2], fr[2]; s16x4 fnk, ft, fmb, fmk, fv, fbg[4], fkg[4]; f32x4 gc[4]; };
#define SC2_LOAD(O, cc) do { const LAS unsigned char* sl = lds + ((cc) & (SC2_NS - 1)) * CB_STRIDE; \
            _Pragma("unroll") for (int k2 = 0; k2 < 2; ++k2) { O.fa[k2] = *(const LAS bf16x8*)(sl + CB_FA + (k2 * 64 + lane) * 16); O.fr[k2] = *(const LAS bf16x8*)(sl + CB_FR + (k2 * 64 + lane) * 16); } \
            O.fnk = *(const LAS s16x4*)(sl + CB_FNK + lane * 8); O.ft = *(const LAS s16x4*)(sl + CB_FT + lane * 8); O.fmb = *(const LAS s16x4*)(sl + CB_FMB + lane * 8); O.fmk = *(const LAS s16x4*)(sl + CB_FMK + lane * 8); \
            O.fv = *(const LAS s16x4*)(sl + CB_FV + (it * 64 + lane) * 8); \
            _Pragma("unroll") for (int jt = 0; jt < 4; ++jt) { O.fbg[jt] = *(const LAS s16x4*)(sl + CB_FBG + (jt * 64 + lane) * 8); O.fkg[jt] = *(const LAS s16x4*)(sl + CB_FKG + (jt * 64 + lane) * 8); \
                O.gc[jt] = *(const LAS f32x4*)(sl + CB_GC + (16 * jt + 4 * q) * 4); } } while (0)
#define SC2_STEP(O, N, cc) do { \
            bf16x8 sb[2]; \
            _Pragma("unroll") for (int k2 = 0; k2 < 2; ++k2) { const unsigned long long lo = pack4bf(S[2 * k2]), hi = pack4bf(S[2 * k2 + 1]); \
                v4u w_; w_.x = (unsigned)lo; w_.y = (unsigned)(lo >> 32); w_.z = (unsigned)hi; w_.w = (unsigned)(hi >> 32); sb[k2] = __builtin_bit_cast(bf16x8, w_); } \
            f32x4 X = (f32x4){0.f, 0.f, 0.f, 0.f}; \
            X = __builtin_amdgcn_mfma_f32_16x16x32_bf16(O.fa[0], sb[0], X, 0, 0, 0); X = __builtin_amdgcn_mfma_f32_16x16x32_bf16(O.fa[1], sb[1], X, 0, 0, 0); \
            X = __builtin_amdgcn_mfma_f32_16x16x16bf16_1k(O.fnk, O.fv, X, 0, 0, 0); \
            f32x4 Y = (f32x4){0.f, 0.f, 0.f, 0.f}; \
            Y = __builtin_amdgcn_mfma_f32_16x16x32_bf16(O.fr[0], sb[0], Y, 0, 0, 0); Y = __builtin_amdgcn_mfma_f32_16x16x32_bf16(O.fr[1], sb[1], Y, 0, 0, 0); \
            Y = __builtin_amdgcn_mfma_f32_16x16x16bf16_1k(O.fmk, O.fv, Y, 0, 0, 0); \
            f32x4 Sn[4]; \
            _Pragma("unroll") for (int jt = 0; jt < 4; ++jt) Sn[jt] = __builtin_amdgcn_mfma_f32_16x16x16bf16_1k(O.fkg[jt], O.fv, S[jt] * O.gc[jt], 0, 0, 0); \
            const s16x4 xb = __builtin_bit_cast(s16x4, pack4bf(X)); \
            const f32x4 U = __builtin_amdgcn_mfma_f32_16x16x16bf16_1k(O.ft, xb, (f32x4){0.f, 0.f, 0.f, 0.f}, 0, 0, 0);         \
            const s16x4 ub = __builtin_bit_cast(s16x4, pack4bf(U)); \
            Y = __builtin_amdgcn_mfma_f32_16x16x16bf16_1k(O.fmb, ub, Y, 0, 0, 0); \
            _Pragma("unroll") for (int jt = 0; jt < 4; ++jt) S[jt] = __builtin_amdgcn_mfma_f32_16x16x16bf16_1k(O.fbg[jt], ub, Sn[jt], 0, 0, 0); \
            if ((cc) + 1 < NCHUNK) SC2_LOAD(N, (cc) + 1); \
            _Pragma("unroll") for (int r = 0; r < 4; ++r) YS[(size_t)(16 * (cc) + 4 * q + r) * RWW] = Y[r];                           \
            asm volatile("s_waitcnt lgkmcnt(0)" ::: "memory"); \
            SC2_BAR(); } while (0)
        CkOps Oa, Ob;
        SC2_BAR();
        SC2_LOAD(Oa, 0);
        for (int cc = 0; cc < NCHUNK; cc += 2) { SC2_STEP(Oa, Ob, cc); SC2_STEP(Ob, Oa, cc + 1); }
#undef SC2_STEP
#undef SC2_LOAD
#pragma unroll
        for (int jt = 0; jt < 4; ++jt) *(f32x4*)(F.out + O_WP + ((size_t)(b * RWH + h) * HD + 16 * it + x) * HD + 16 * jt + 4 * q) = S[jt];
    }
    asm volatile("s_waitcnt vmcnt(0)" ::: "memory"); SC2_BAR();
#pragma unroll 4
    for (int t8 = wave; t8 < SEQ / 8; t8 += NWAVES) post_rows8(ws, mb + 8 * t8 + (lane >> 3), h, lane & 7, true);
#undef SC2_BAR
}

constexpr int SK_S = 8;
__device__ __forceinline__ void skinny_units(Frame& F, const bf16* Arows, int lda, const bf16* Bt, int K, unsigned* cnt, float* slabs,
                                             const float* xi_s, const bf16* xb_in, float* xo_s, bf16* XBd, float* ssq, float alpha) {
    const int tid = F.tid, lane = F.lane, wave = F.wave, ln = lane & 15, q4 = lane >> 4, ksteps = K / 32;
    LAS unsigned char* lds = F.lds;
    for (int u = blockIdx.x; u < 32 * SK_S; u += F.G) {
        const int nb = u & 31, sl = u >> 5, n0 = 64 * nb, ks0 = sl * ksteps / SK_S, ks1 = (sl + 1) * ksteps / SK_S;
        f32x4 acc[2][4];
#pragma unroll
        for (int mt = 0; mt < 2; ++mt)
#pragma unroll
            for (int nt = 0; nt < 4; ++nt) acc[mt][nt] = (f32x4){0.f, 0.f, 0.f, 0.f};
        const bf16* ap = Arows + (size_t)ln * lda + 8 * q4; const bf16* bp = Bt + (size_t)(n0 + ln) * K + 8 * q4;
        bf16x8 a[3][2], b[3][4];
#pragma unroll
        for (int i = 0; i < 3; ++i) { const int ks = ks0 + wave + 8 * i; const int k = 32 * (ks < ks1 ? ks : ks0);
#pragma unroll
            for (int mt = 0; mt < 2; ++mt) a[i][mt] = *(const GAS bf16x8*)(ap + (size_t)(16 * mt) * lda + k);
#pragma unroll
            for (int nt = 0; nt < 4; ++nt) b[i][nt] = *(const GAS bf16x8*)(bp + (size_t)(16 * nt) * K + k); }
#pragma unroll
        for (int i = 0; i < 3; ++i) if (ks0 + wave + 8 * i < ks1) {
#pragma unroll
            for (int mt = 0; mt < 2; ++mt)
#pragma unroll
                for (int nt = 0; nt < 4; ++nt) acc[mt][nt] = __builtin_amdgcn_mfma_f32_16x16x32_bf16(a[i][mt], b[i][nt], acc[mt][nt], 0, 0, 0); }
#pragma unroll
        for (int mt = 0; mt < 2; ++mt)
#pragma unroll
            for (int nt = 0; nt < 4; ++nt) *(LAS f32x4*)(lds + ((wave * 8 + mt * 4 + nt) * 64 + lane) * 16) = acc[mt][nt];
        __syncthreads();
        { const int tile = tid >> 6, l = tid & 63; f32x4 sum = (f32x4){0.f, 0.f, 0.f, 0.f};
#pragma unroll
          for (int w = 0; w < 8; ++w) sum += *(const LAS f32x4*)(lds + ((w * 8 + tile) * 64 + l) * 16);
          float* sp = slabs + (size_t)sl * 32 * DM + (size_t)(16 * (tile >> 2) + 4 * (l >> 4)) * DM + n0 + 16 * (tile & 3) + (l & 15);
          __hip_atomic_store(sp, sum.x, __ATOMIC_RELAXED, __HIP_MEMORY_SCOPE_AGENT); __hip_atomic_store(sp + DM, sum.y, __ATOMIC_RELAXED, __HIP_MEMORY_SCOPE_AGENT);
          __hip_atomic_store(sp + 2 * DM, sum.z, __ATOMIC_RELAXED, __HIP_MEMORY_SCOPE_AGENT); __hip_atomic_store(sp + 3 * DM, sum.w, __ATOMIC_RELAXED, __HIP_MEMORY_SCOPE_AGENT); }
        VM_WAIT(); __syncthreads();
        if (tid == 0) { const unsigned t = __hip_atomic_fetch_add(cnt + nb, 1u, __ATOMIC_RELAXED, __HIP_MEMORY_SCOPE_AGENT);
            *(LAS unsigned*)(lds + 65536) = (t == (unsigned)(SK_S - 1)) ? 1u : 0u; }
        __syncthreads();
        const unsigned last = *(const LAS unsigned*)(lds + 65536);
        if (last) {
            const int row = tid >> 4, c4 = (tid & 15) * 4, col = n0 + c4;
            f32x4 a4 = (f32x4){0.f, 0.f, 0.f, 0.f};
#pragma unroll
            for (int s2 = 0; s2 < SK_S; ++s2) { const float* sp2 = slabs + (size_t)s2 * 32 * DM + (size_t)row * DM + col;
                a4.x += __hip_atomic_load(sp2, __ATOMIC_RELAXED, __HIP_MEMORY_SCOPE_AGENT); a4.y += __hip_atomic_load(sp2 + 1, __ATOMIC_RELAXED, __HIP_MEMORY_SCOPE_AGENT);
                a4.z += __hip_atomic_load(sp2 + 2, __ATOMIC_RELAXED, __HIP_MEMORY_SCOPE_AGENT); a4.w += __hip_atomic_load(sp2 + 3, __ATOMIC_RELAXED, __HIP_MEMORY_SCOPE_AGENT); }
            f32x4 x0;
            if (xb_in) { const unsigned long long w = *(const GAS unsigned long long*)(xb_in + (size_t)(MP + row) * DM + col);
                x0 = (f32x4){__builtin_bit_cast(float, (unsigned)w << 16), __builtin_bit_cast(float, (unsigned)w & 0xffff0000u), __builtin_bit_cast(float, (unsigned)(w >> 32) << 16), __builtin_bit_cast(float, (unsigned)(w >> 32) & 0xffff0000u)}; }
            else x0 = *(const f32x4*)(xi_s + (size_t)row * DM + col);
            const f32x4 y = x0 + a4 * alpha;
            if (xo_s) *(f32x4*)(xo_s + (size_t)row * DM + col) = y;
            if (XBd) *(GAS unsigned long long*)(XBd + (size_t)(MP + row) * DM + col) = (unsigned long long)pk2(y.x, y.y) | ((unsigned long long)pk2(y.z, y.w) << 32);
            float sq = (y.x * y.x + y.y * y.y) + (y.z * y.z + y.w * y.w);
            sq += __shfl_xor(sq, 1); sq += __shfl_xor(sq, 2); sq += __shfl_xor(sq, 4); sq += __shfl_xor(sq, 8);
            if ((tid & 15) == 0) atomicAdd(ssq + MP + row, sq);
        }
        __syncthreads();
    }
}
__global__ void __launch_bounds__(NWAVES * 64, 2) hymba_fwd(Args args) {
    extern __shared__ __attribute__((aligned(16))) unsigned char lds_raw[];
    { const int t0_ = threadIdx.x;
      for (int u = t0_; u < (LDS_BYTES - LDSCTL_OFF) / 4; u += NWAVES * 64) ((LAS unsigned*)((LAS unsigned char*)lds_raw + LDSCTL_OFF))[u] = 0u; }
    __syncthreads();
    XcdBarrier bar; bar.bar = (unsigned*)((gu32*)(args.ws + WS_CTL) + CW_BAR); bar.x = 0; bar.st = nullptr;
    if (MK_N_LAUNCHES == 1) bar = xcd_barrier_post((unsigned*)((gu32*)(args.ws + WS_CTL) + CW_BAR), (volatile LAS unsigned*)((LAS unsigned char*)lds_raw + MISC_OFF) + 8);
    const int lo = args.ph_lo, hi = args.ph_hi;
#ifndef PH_MASK
#define PH_MASK 0x7ff
#endif
#define IN(k) (((PH_MASK >> (k)) & 1) && lo <= (k) && (k) < hi)
#define SEAM(k) do { if (IN(k) && IN((k) + 1)) xcd_barrier(bar); } while (0)
#ifndef PROBE_REP
#define PROBE_REP 0
#endif
#define NREP(k) (1 + ((PROBE_REP >> (k)) & 1))
#define PHASE_FRAME() Frame F; { int t_ = threadIdx.x; asm volatile("" : "+v"(t_)); F.lds = (LAS unsigned char*)lds_raw; F.MISC = (volatile LAS unsigned*)(F.lds + MISC_OFF); F.tid = t_; F.lane = t_ & 63; \
        F.wave = __builtin_amdgcn_readfirstlane(t_ >> 6); F.G = gridDim.x; F.out = args.out; F.ws = args.ws; F.ctl = (gu32*)(args.ws + WS_CTL); } \
    unsigned char* ws = F.ws; const int gw = blockIdx.x * NWAVES + F.wave, NGW = F.G * NWAVES; (void)gw; (void)NGW; \
    bf16* XB = (bf16*)(ws + WS_XB); bf16* ACT = (bf16*)(ws + WS_ACT); bf16* X2B = (bf16*)(ws + WS_X2B); bf16* MIXB = (bf16*)(ws + WS_MIX); (void)XB; (void)ACT; (void)X2B; (void)MIXB; \
    float* ssq0 = (float*)(F.ctl + CW_SSQ0); float* ssq1 = (float*)(F.ctl + CW_SSQ1); float* ssq2 = (float*)(F.ctl + CW_SSQ2); float* ssq3 = (float*)(F.ctl + CW_SSQ3); float* ssqd = (float*)(F.ctl + CW_SSQD); (void)ssqd; (void)ssq0; (void)ssq1; (void)ssq2; (void)ssq3; \
    float* yp = args.out + O_YP; float* ys = args.out + O_YS; (void)yp; (void)ys;

    if (IN(0)) for (int rep = 0; rep < NREP(0); ++rep) { PHASE_FRAME(); p0_prologue(F, args); if (rep + 1 < NREP(0)) xcd_barrier(bar); else SEAM(0); }
    if (IN(1)) for (int rep = 0; rep < NREP(1); ++rep) { PHASE_FRAME(); pg8::Gemm g{XB, (const bf16*)(ws + WS_WGU1), MPAD, 2 * DFF, DM}; pg8::StaticOrder S; S.init(MPAD, 2 * DFF, F.G, (int)blockIdx.x);
        pg8::EpiSwiglu E{ACT, ssq0};
        pg8::gemm_phase<pg8::EpiSwiglu, pg8::StaticOrder, true, true>(F.lds + RING_OFF, g, S, E);
#ifndef CV_ALL_IN_P0
        { const int nfull = S.nwg % F.G; if (rep == 0 && nfull != 0 && (int)blockIdx.x >= nfull) convert_items(F, args, CV_G0, CV_G1, (int)blockIdx.x - nfull, F.G - nfull);
          else if (rep == 0 && nfull == 0) convert_items(F, args, CV_G0, CV_G1, blockIdx.x, F.G); }
#endif
        if (rep + 1 < NREP(1)) xcd_barrier(bar); else SEAM(1); }
    if (IN(2)) for (int rep = 0; rep < NREP(2); ++rep) { PHASE_FRAME(); pg8::Gemm g{ACT, (const bf16*)(ws + WS_WD1), MP, DM, DFF}; pg8::StaticOrder S; S.init(MP, DM, F.G, (int)blockIdx.x);
        pg8::EpiResid E{nullptr, nullptr, XB, nullptr, nullptr, XB, rep ? ssqd : ssq1, rep ? 0.0f : 0.5f};
        pg8::gemm_phase<pg8::EpiResid, pg8::StaticOrder, true, true>(F.lds + RING_OFF, g, S, E);
        skinny_units(F, ACT + (size_t)MP * DFF, DFF, (const bf16*)(ws + WS_WD1), DFF, (unsigned*)(F.ctl + CW_SKC + 64 * rep), (float*)(ws + WS_QB), nullptr, XB, nullptr, XB, rep ? ssqd : ssq1, rep ? 0.0f : 0.5f);
        if (rep + 1 < NREP(2)) xcd_barrier(bar); else SEAM(2); }
    if (IN(3)) for (int rep = 0; rep < NREP(3); ++rep) { PHASE_FRAME(); pg8::Gemm g{XB, (const bf16*)(ws + WS_WINB), MPAD, INC, DM}; pg8::StaticOrder S; S.init(MPAD, INC, F.G, (int)blockIdx.x);
        pg8::EpiWin E{ssq1, (bf16*)(ws + WS_QB), (bf16*)(ws + WS_KB), (bf16*)(ws + WS_VB), (bf16*)(ws + WS_ACT), args.out};
        pg8::gemm_phase<pg8::EpiWin, pg8::StaticOrder, true, true>(F.lds + RING_OFF, g, S, E);
#ifndef CV_ALL_IN_P0
        { const int nfull = S.nwg % F.G; if (rep == 0 && nfull != 0 && (int)blockIdx.x >= nfull) convert_items(F, args, CV_G0 + CV_G1, CV_G2, (int)blockIdx.x - nfull, F.G - nfull);
          else if (rep == 0 && nfull == 0) convert_items(F, args, CV_G0 + CV_G1, CV_G2, blockIdx.x, F.G); }
#endif
        if (rep + 1 < NREP(3)) xcd_barrier(bar); else SEAM(3); }
    if (IN(4)) for (int rep = 0; rep < NREP(4); ++rep) { PHASE_FRAME();
        lact_phase(F, args); xcd_barrier(bar);
        for (int r2 = 0; r2 < 1 + ((PROBE_REP >> 12) & 1); ++r2) { __syncthreads(); prep_phase(F, args); }
        if (rep + 1 < NREP(4)) xcd_barrier(bar); else SEAM(4); }
    if (IN(5)) for (int rep = 0; rep < NREP(5); ++rep) { PHASE_FRAME();
        if ((int)blockIdx.x < NB * RWH) scan2_unit(F, blockIdx.x);
        else { const int oc = (int)blockIdx.x - NB * RWH, on = (int)F.G - NB * RWH;
            for (int r2 = 0; r2 < 1 + ((PROBE_REP >> 11) & 1); ++r2)
            for (int u = oc; u < NB * 16 * NKVH; u += on) attn_unit(F, args, u >> 6, (u >> 2) & 15, u & 3);
            __syncthreads();
            for (int u = on - 1 - oc; u < NDEC * NQH / 8; u += on) dec_attn_unit(F, args, u);
            __syncthreads();
            for (int u = on - 1 - oc; u < NDEC * RWH / 8; u += on) dec_rwkv_unit(F, args, u);
            { const int n4 = NDEC * (WIN - 1) * KVW / 4;
              for (int i = oc * (NWAVES * 64) + F.tid; i < 2 * n4; i += on * NWAVES * 64) { const int t = i >= n4, j = t ? i - n4 : i; const int bb = j / ((WIN - 1) * KVW / 4), r = j % ((WIN - 1) * KVW / 4);
                  const f32x4 v = *((const f32x4*)(args.in[2 + t] + (size_t)bb * WIN * KVW + KVW) + r);
                  *((f32x4*)(args.out + (t ? O_VS : O_KS) + (size_t)bb * WIN * KVW) + r) = v; } }
        }
        if (rep + 1 < NREP(5)) xcd_barrier(bar); else { if (IN(5) && IN(7)) xcd_barrier(bar); } }
    if (IN(7)) for (int rep = 0; rep < NREP(7); ++rep) { PHASE_FRAME(); pg8::Gemm g{MIXB, (const bf16*)(ws + WS_WOUT), MP, DM, DM}; pg8::StaticOrder S; S.init(MP, DM, F.G, (int)blockIdx.x);
        pg8::EpiResid E{nullptr, nullptr, XB, nullptr, nullptr, X2B, rep ? ssqd : ssq2, 1.0f};
        pg8::gemm_phase<pg8::EpiResid, pg8::StaticOrder, true, true>(F.lds + RING_OFF, g, S, E);
        skinny_units(F, MIXB + (size_t)MP * DM, DM, (const bf16*)(ws + WS_WOUT), DM, (unsigned*)(F.ctl + CW_SKC + 128 + 64 * rep), (float*)(ws + WS_QB), nullptr, XB, nullptr, X2B, rep ? ssqd : ssq2, 1.0f);
        if (rep + 1 < NREP(7)) xcd_barrier(bar); else SEAM(7); }
    if (IN(8)) for (int rep = 0; rep < NREP(8); ++rep) { PHASE_FRAME(); pg8::Gemm g{X2B, (const bf16*)(ws + WS_WGU2), MPAD, 2 * DFF, DM}; pg8::StaticOrder S; S.init(MPAD, 2 * DFF, F.G, (int)blockIdx.x);
        pg8::EpiSwiglu E{ACT, ssq2};
        pg8::gemm_phase<pg8::EpiSwiglu, pg8::StaticOrder, true, true>(F.lds + RING_OFF, g, S, E);
#ifndef CV_ALL_IN_P0
        { const int nfull = S.nwg % F.G; if (rep == 0 && nfull != 0 && (int)blockIdx.x >= nfull) convert_items(F, args, CV_G0 + CV_G1 + CV_G2, CV_G3, (int)blockIdx.x - nfull, F.G - nfull);
          else if (rep == 0 && nfull == 0) convert_items(F, args, CV_G0 + CV_G1 + CV_G2, CV_G3, blockIdx.x, F.G); }
#endif
        if (rep + 1 < NREP(8)) xcd_barrier(bar); else SEAM(8); }
    if (IN(9)) for (int rep = 0; rep < NREP(9); ++rep) { PHASE_FRAME(); pg8::Gemm g{ACT, (const bf16*)(ws + WS_WD2), MP, DM, DFF}; pg8::StaticOrder S; S.init(MP, DM, F.G, (int)blockIdx.x);
        pg8::EpiResid E{nullptr, nullptr, X2B, yp, ys, nullptr, rep ? ssqd : ssq3, 0.5f};
        pg8::gemm_phase<pg8::EpiResid, pg8::StaticOrder, true, true>(F.lds + RING_OFF, g, S, E);
        skinny_units(F, ACT + (size_t)MP * DFF, DFF, (const bf16*)(ws + WS_WD2), DFF, (unsigned*)(F.ctl + CW_SKC + 256 + 64 * rep), (float*)(ws + WS_QB), nullptr, X2B, ys, nullptr, rep ? ssqd : ssq3, 0.5f);
        if (rep + 1 < NREP(9)) xcd_barrier(bar); else SEAM(9); }
    if (IN(10)) for (int rep = 0; rep < NREP(10); ++rep) { PHASE_FRAME(); const float* fn = args.in[30];
        for (int m = gw; m < MV; m += NGW) { float* xr = m < MP ? yp + (size_t)m * DM : ys + (size_t)(m - MP) * DM;
            const float s = rep ? 1.0f : __builtin_amdgcn_rsqf(ssq3[m] * (1.0f / DM) + RMS_EPS);
            GAS f32x4* x4 = (GAS f32x4*)xr + F.lane; const GAS f32x4* f4 = (const GAS f32x4*)fn + F.lane;
#pragma unroll
            for (int j = 0; j < 8; ++j) x4[64 * j] = rep ? x4[64 * j] * s : x4[64 * j] * s * f4[64 * j]; } if (NREP(10) > 1 && rep == 0) xcd_barrier(bar); }
#undef IN
#undef SEAM
}

extern "C" void kernel_launch(void* const* d_in, const int* in_sizes, int n_in, void* d_out, int out_size, void* d_ws, size_t ws_size, hipStream_t stream) {
    static int grid = 0;
    if (grid == 0) {
        if (n_in != 31 || in_sizes[0] != MP * DM || (size_t)out_size != O_END || ws_size < WS_END2) {
            fprintf(stderr, "kernel_launch: unexpected shapes: n_in %d in0 %d out %d (want %zu) ws %zu (want >= %zu); nothing launched\n", n_in, n_in > 0 ? in_sizes[0] : -1, out_size, (size_t)O_END, ws_size, (size_t)WS_END2);
            grid = -1; return; }
        int dev = 0, cus = 0, per_cu = 0;
        if (hipGetDevice(&dev) != hipSuccess || hipDeviceGetAttribute(&cus, hipDeviceAttributeMultiprocessorCount, dev) != hipSuccess) { fprintf(stderr, "kernel_launch: device query failed\n"); grid = -1; return; }
        if (hipFuncSetAttribute((const void*)hymba_fwd, hipFuncAttributeMaxDynamicSharedMemorySize, LDS_BYTES) != hipSuccess) { fprintf(stderr, "kernel_launch: hipFuncSetAttribute failed\n"); grid = -1; return; }
        if (hipOccupancyMaxActiveBlocksPerMultiprocessor(&per_cu, (const void*)hymba_fwd, NWAVES * 64, LDS_BYTES) != hipSuccess || per_cu < 1)
            fprintf(stderr, "kernel_launch: note: occupancy query reports %d workgroups per CU\n", per_cu);
        (void)hipGetLastError();
        grid = cus;
    }
    if (grid < 0) return;
    if (hipMemsetAsync((char*)d_ws + WS_CTL, 0, CTL_ZERO_BYTES, stream) != hipSuccess) { fprintf(stderr, "kernel_launch: hipMemsetAsync failed\n"); return; }
    Args a{};
    for (int i = 0; i < 31; ++i) a.in[i] = (const float*)d_in[i];
    a.out = (float*)d_out; a.ws = (unsigned char*)d_ws;
    for (int li = 0; li < MK_N_LAUNCHES; ++li) {
        a.ph_lo = (MK_N_LAUNCHES == 1) ? 0 : li; a.ph_hi = (MK_N_LAUNCHES == 1) ? NPHASES : li + 1; a.li = li;
        hipLaunchKernelGGL(hymba_fwd, dim3(grid), dim3(NWAVES * 64), LDS_BYTES, stream, a);
        const hipError_t le = hipPeekAtLastError();
        if (le != hipSuccess) { fprintf(stderr, "kernel_launch: launch %d failed: %s\n", li, hipGetErrorName(le)); break; }
    }
}
```

```cpp
#include <hip/hip_runtime.h>
#include <cstdio>
#include <cstdint>
#define MK_N_LAUNCHES 1
constexpr int DM = 2048, SEQ = 2048, NB = 4, MP = NB * SEQ  , NDEC = 32, MV = MP + NDEC  , MPAD = 8448  ;
constexpr int DFF = 5504, ATTW = 1024, KVW = 256, RWW = 1024, NQH = 16, NKVH = 4, HD = 64, RWH = 16, WIN = 128;
constexpr int ATT_COLS = ATTW + 2 * KVW  , SHC = 3 * RWW + 64 + 64 + 128  , INC = ATT_COLS + SHC  ;
constexpr float RMS_EPS = 1e-5f, GN_EPS = 64e-5f, LOG2E = 1.4426950408889634f;
constexpr float QSCALE = 0.125f * LOG2E;
constexpr size_t O_YP = 0, O_YS = O_YP + (size_t)MP * DM, O_KP = O_YS + (size_t)NDEC * DM, O_VP = O_KP + (size_t)NB * WIN * KVW, O_WP = O_VP + (size_t)NB * WIN * KVW,
                 O_SP = O_WP + (size_t)NB * RWH * HD * HD, O_KS = O_SP + (size_t)NB * SHC, O_VS = O_KS + (size_t)NDEC * WIN * KVW, O_WS = O_VS + (size_t)NDEC * WIN * KVW,
                 O_SS = O_WS + (size_t)NDEC * RWH * HD * HD, O_END = O_SS + (size_t)NDEC * SHC;
namespace pg8 {
#define PG8_LAS __attribute__((address_space(3)))
typedef unsigned short bf16_t;
typedef short bf16x8 __attribute__((ext_vector_type(8)));
typedef float f32x4 __attribute__((ext_vector_type(4)));
typedef unsigned u32x4 __attribute__((ext_vector_type(4)));
constexpr int BM = 256, BK = 64, HALF = 128, HTB = HALF * BK * 2  , STAGE_BYTES = 8 * HTB, NXCD = 8, WGM = 8;

__host__ __device__ __forceinline__ int lds_byte(int r, int c) { const int st = (r >> 4) * 2 + (c >> 5), rr = r & 15, cc = c & 31, ob = rr * 64 + cc * 2; return st * 1024 + (ob ^ (((ob >> 9) & 1) << 5)); }
__host__ __device__ __forceinline__ void stage_rc(int b, int& R, int& C) { const int st = b / 1024, sb = b % 1024, swz = sb ^ (((sb >> 9) & 1) << 5); R = (st >> 1) * 16 + swz / 64; C = (st & 1) * 32 + (swz % 64) / 2; }
__host__ __device__ __forceinline__ int perm32(int rho) { const int n = rho >> 4, i = rho & 15; return 8 * (i >> 2) + 4 * n + (i & 3); }

struct Unit { int pm, pn; };
struct Gemm { const bf16_t* A; const bf16_t* Bt; int M, N, K; };

struct StaticOrder {
    int nM, nN, nwg, G, c;
    __host__ __device__ void init(int M, int N, int G_, int c_) { nM = M / BM; nN = N / BM; nwg = nM * nN; G = G_; c = c_; }
    __host__ __device__ bool next(int i, Unit& u) const {
        const long L = (long)i * G + c; if (L >= nwg) return false;
        int wgid = (int)L; { const int q = nwg / NXCD, r = nwg % NXCD, xcd = wgid % NXCD, off = wgid / NXCD; wgid = (xcd < r ? xcd * (q + 1) : r * (q + 1) + (xcd - r) * q) + off; }
        const int nig = WGM * nN, gid = wgid / nig, fm = gid * WGM, gsz = (nM - fm) < WGM ? (nM - fm) : WGM;
        u.pm = fm + ((wgid % nig) % gsz); u.pn = (wgid % nig) / gsz; return true;
    }
    __device__ __forceinline__ void a_ready(const Unit&) const {}
    __device__ __forceinline__ void done(const Unit&) const {}
};

__device__ __forceinline__ unsigned cvt_pk_bf16(float lo, float hi) { unsigned r; asm volatile("v_cvt_pk_bf16_f32 %0, %1, %2" : "=v"(r) : "v"(lo), "v"(hi)); return r; }
__device__ __forceinline__ float silu_mul(float g, float u) { return g * u * __builtin_amdgcn_rcpf(1.0f + __builtin_amdgcn_exp2f(-g * LOG2E)); }

struct EpiSwiglu {
    static constexpr bool PERM = true, AFTER_DRAIN = false;
    bf16_t* O; const float* ssq;
    __device__ __forceinline__ void operator()(const f32x4 (&acc)[2][2][4][2], const Unit& u, int wr, int wc, int fr, int fq) const {
        const int row0 = u.pm * BM + wr * 64 + fr, col0 = u.pn * HALF + wc * 32 + 8 * fq;
#pragma unroll
        for (int ai = 0; ai < 2; ++ai)
#pragma unroll
            for (int m = 0; m < 4; ++m) { const int row = row0 + ai * HALF + m * 16;
                const float s = __builtin_amdgcn_rsqf(ssq[row] * (1.0f / DM) + RMS_EPS);
                const f32x4 g0 = acc[ai][0][m][0] * s, g1 = acc[ai][0][m][1] * s, u0 = acc[ai][1][m][0] * s, u1 = acc[ai][1][m][1] * s;
                u32x4 w; w.x = cvt_pk_bf16(silu_mul(g0[0], u0[0]), silu_mul(g0[1], u0[1])); w.y = cvt_pk_bf16(silu_mul(g0[2], u0[2]), silu_mul(g0[3], u0[3]));
                w.z = cvt_pk_bf16(silu_mul(g1[0], u1[0]), silu_mul(g1[1], u1[1])); w.w = cvt_pk_bf16(silu_mul(g1[2], u1[2]), silu_mul(g1[3], u1[3]));
                *(u32x4*)(O + (size_t)row * DFF + col0) = w; }
    }
};

struct EpiResid {
    static constexpr bool PERM = true, AFTER_DRAIN = false;
    const float* xi_p; const float* xi_s; const bf16_t* xb_in; float* xo_p; float* xo_s; bf16_t* XB; float* ssq; float alpha;
    __device__ __forceinline__ void operator()(const f32x4 (&acc)[2][2][4][2], const Unit& u, int wr, int wc, int fr, int fq) const {
        const int row0 = u.pm * BM + wr * 64 + fr, col0 = u.pn * BM + wc * 32 + 8 * fq;
#pragma unroll
        for (int ai = 0; ai < 2; ++ai)
#pragma unroll
            for (int m = 0; m < 4; ++m) { const int row = row0 + ai * HALF + m * 16; const bool valid = row < MV;
                const size_t ro = row < MP ? (size_t)row * DM : (size_t)(row - MP) * DM;
                float sq = 0.f;
#pragma unroll
                for (int bj = 0; bj < 2; ++bj) { const int col = col0 + bj * HALF;
                    f32x4 x0 = (f32x4){0.f, 0.f, 0.f, 0.f}, x1 = x0;
                    if (xb_in) { const u32x4 w = *(const u32x4*)(xb_in + (size_t)row * DM + col);
                        x0 = (f32x4){__builtin_bit_cast(float, w.x << 16), __builtin_bit_cast(float, w.x & 0xffff0000u), __builtin_bit_cast(float, w.y << 16), __builtin_bit_cast(float, w.y & 0xffff0000u)};
                        x1 = (f32x4){__builtin_bit_cast(float, w.z << 16), __builtin_bit_cast(float, w.z & 0xffff0000u), __builtin_bit_cast(float, w.w << 16), __builtin_bit_cast(float, w.w & 0xffff0000u)}; }
                    else if (valid) { const float* src = (row < MP ? xi_p : xi_s) + ro; x0 = *(const f32x4*)(src + col); x1 = *(const f32x4*)(src + col + 4); }
                    const f32x4 y0 = x0 + acc[ai][bj][m][0] * alpha, y1 = x1 + acc[ai][bj][m][1] * alpha;
                    if (xo_p && valid) { float* dst = (row < MP ? xo_p : xo_s) + ro; *(f32x4*)(dst + col) = y0; *(f32x4*)(dst + col + 4) = y1; }
                    sq += (y0[0] * y0[0] + y0[1] * y0[1]) + (y0[2] * y0[2] + y0[3] * y0[3]) + (y1[0] * y1[0] + y1[1] * y1[1]) + (y1[2] * y1[2] + y1[3] * y1[3]);
                    if (XB) { u32x4 w; w.x = cvt_pk_bf16(y0[0], y0[1]); w.y = cvt_pk_bf16(y0[2], y0[3]); w.z = cvt_pk_bf16(y1[0], y1[1]); w.w = cvt_pk_bf16(y1[2], y1[3]);
                        *(u32x4*)(XB + (size_t)row * DM + col) = w; } }
                sq += __shfl_xor(sq, 16); sq += __shfl_xor(sq, 32);
                if (fq == 0 && valid) atomicAdd(ssq + row, sq); }
    }
};

struct EpiWin {
    static constexpr bool PERM = true, AFTER_DRAIN = false;
    const float* ssq; bf16_t* QB; bf16_t* KB; bf16_t* VB; bf16_t* PR; float* out;
    __device__ __forceinline__ void operator()(const f32x4 (&acc)[2][2][4][2], const Unit& u, int wr, int wc, int fr, int fq) const {
        const int row0 = u.pm * BM + wr * 64 + fr, cl0 = wc * 32 + 8 * fq;
        const int pn = u.pn;
#pragma unroll
        for (int ai = 0; ai < 2; ++ai)
#pragma unroll
            for (int m = 0; m < 4; ++m) { const int row = row0 + ai * HALF + m * 16; const bool valid = row < MV;
                float s = __builtin_amdgcn_rsqf(ssq[row] * (1.0f / DM) + RMS_EPS);
                if (pn < 4) s *= QSCALE;
#pragma unroll
                for (int bj = 0; bj < 2; ++bj) { const int cl = cl0 + bj * HALF;
                    const f32x4 y0 = acc[ai][bj][m][0] * s, y1 = acc[ai][bj][m][1] * s;
                    if (pn < 6) { u32x4 w; w.x = cvt_pk_bf16(y0[0], y0[1]); w.y = cvt_pk_bf16(y0[2], y0[3]); w.z = cvt_pk_bf16(y1[0], y1[1]); w.w = cvt_pk_bf16(y1[2], y1[3]);
                        if (pn < 4) *(u32x4*)(QB + (size_t)row * ATTW + pn * BM + cl) = w;
                        else { *(u32x4*)((pn == 4 ? KB : VB) + (size_t)row * KVW + cl) = w;
                            if (valid) { float* o = nullptr;
                                if (row >= MP) o = out + (pn == 4 ? O_KS : O_VS) + ((size_t)(row - MP) * WIN + (WIN - 1)) * KVW + cl;
                                else if ((row & (SEQ - 1)) >= SEQ - WIN) o = out + (pn == 4 ? O_KP : O_VP) + ((size_t)(row >> 11) * WIN + ((row & (SEQ - 1)) - (SEQ - WIN))) * KVW + cl;
                                if (o) { *(f32x4*)o = y0; *(f32x4*)(o + 4) = y1; } } }
                    } else { const int cs = (pn - 6) * BM + cl;
                        { u32x4 w; w.x = cvt_pk_bf16(y0[0], y0[1]); w.y = cvt_pk_bf16(y0[2], y0[3]); w.z = cvt_pk_bf16(y1[0], y1[1]); w.w = cvt_pk_bf16(y1[2], y1[3]); *(u32x4*)(PR + (size_t)row * SHC + cs) = w; }
                        if (valid) { float* o = nullptr;
                            if (row >= MP) o = out + O_SS + (size_t)(row - MP) * SHC + cs;
                            else if ((row & (SEQ - 1)) == SEQ - 1) o = out + O_SP + (size_t)(row >> 11) * SHC + cs;
                            if (o) { *(f32x4*)o = y0; *(f32x4*)(o + 4) = y1; } } } }
            }
    }
};
template <class Epi, class Sched, bool ALIGN_EPI = false, bool SP2 = false>
__device__ __forceinline__ void gemm_phase(PG8_LAS unsigned char* lds, const Gemm g, const Sched& S, const Epi& E) {
    int tid_ = threadIdx.x; asm volatile("" : "+v"(tid_)); const int tid = tid_, wid = __builtin_amdgcn_readfirstlane(tid >> 6), lane = tid & 63, wr = wid >> 2, wc = wid & 3, fr = lane & 15, fq = lane >> 4;
    const int K = g.K, nt = K / BK;
    unsigned voffA[2], voffB[2];
#pragma unroll
    for (int i = 0; i < 2; ++i) { int R, C; stage_rc(tid * 16 + i * 8192, R, C); const int Rb = Epi::PERM ? ((R & ~31) + perm32(R & 31)) : R;
        voffA[i] = (unsigned)(R * K + C) * 2u; voffB[i] = (unsigned)(Rb * K + C) * 2u; }
    const size_t kstep = (size_t)(BK * 2);
    const size_t hstep = (size_t)HALF * K * 2;
    const size_t tstep = 2 * hstep;
    const unsigned ldsw = (unsigned)wid * 1024u;
    const int aoff = lds_byte(wr * 64 + fr, fq * 8), boff = lds_byte(wc * 32 + fr, fq * 8);
#define PG8_SA(b, h) (((b) * 2 + (h)) * HTB)
#define PG8_SB(b, h) ((4 + (b) * 2 + (h)) * HTB)
#define PG8_STAGE(bufoff, gbase, voff) do { _Pragma("unroll") for (int _i = 0; _i < 2; ++_i) \
        __builtin_amdgcn_global_load_lds((const unsigned*)((const char*)(gbase) + (voff)[_i]), (PG8_LAS unsigned*)(lds + (bufoff) + ldsw + _i * 8192), 16, 0, 0); } while (0)
#define PG8_LDA(dst, b, h) do { _Pragma("unroll") for (int m = 0; m < 4; ++m) _Pragma("unroll") for (int k = 0; k < 2; ++k) dst[m][k] = *(const PG8_LAS bf16x8*)(lds + PG8_SA(b, h) + aoff + m * 2048 + k * 1024); } while (0)
#define PG8_LDB(dst, b, h) do { _Pragma("unroll") for (int n = 0; n < 2; ++n) _Pragma("unroll") for (int k = 0; k < 2; ++k) dst[n][k] = *(const PG8_LAS bf16x8*)(lds + PG8_SB(b, h) + boff + n * 2048 + k * 1024); } while (0)
#define PG8_MMA(ai, bj, At, Bt) do { __builtin_amdgcn_s_setprio(1); _Pragma("unroll") for (int m = 0; m < 4; ++m) _Pragma("unroll") for (int n = 0; n < 2; ++n) _Pragma("unroll") for (int k = 0; k < 2; ++k) \
        acc[ai][bj][m][n] = __builtin_amdgcn_mfma_f32_16x16x32_bf16(Bt[n][k], At[m][k], acc[ai][bj][m][n], 0, 0, 0); __builtin_amdgcn_s_setprio(0); } while (0)
#define PG8_WAIT_V(n) asm volatile("s_waitcnt vmcnt(" #n ")" ::: "memory")
#define PG8_WAIT_L(n) asm volatile("s_waitcnt lgkmcnt(" #n ")" ::: "memory")
#define PG8_BAR __builtin_amdgcn_s_barrier()
#define PG8_SCHED __builtin_amdgcn_sched_barrier(0)
    Unit cur, nxt; int ui = 0;
    if (!S.next(0, cur)) return;
    f32x4 acc[2][2][4][2];
#pragma unroll
    for (int a = 0; a < 2; ++a)
#pragma unroll
        for (int b = 0; b < 2; ++b)
#pragma unroll
            for (int m = 0; m < 4; ++m)
#pragma unroll
                for (int n = 0; n < 2; ++n) acc[a][b][m][n] = (f32x4){0.f, 0.f, 0.f, 0.f};
    bf16x8 At[4][2], B0[2][2], B1[2][2];
    const char* cA = (const char*)g.A + (size_t)cur.pm * tstep; const char* cB = (const char*)g.Bt + (size_t)cur.pn * tstep;
    S.a_ready(cur);
    if constexpr (SP2) {
        PG8_STAGE(PG8_SB(0, 0), cB, voffB); PG8_STAGE(PG8_SB(0, 1), cB + hstep, voffB); PG8_STAGE(PG8_SA(0, 0), cA, voffA); PG8_STAGE(PG8_SA(0, 1), cA + hstep, voffA);
        if (wr == 1) PG8_BAR;
        PG8_WAIT_V(2); PG8_BAR;
        PG8_STAGE(PG8_SB(1, 0), cB + kstep, voffB); PG8_STAGE(PG8_SA(1, 0), cA + kstep, voffA); PG8_STAGE(PG8_SB(1, 1), cB + hstep + kstep, voffB);
        PG8_WAIT_V(6); PG8_BAR;
    } else {
        PG8_STAGE(PG8_SB(0, 0), cB, voffB); PG8_STAGE(PG8_SA(0, 0), cA, voffA); PG8_STAGE(PG8_SB(0, 1), cB + hstep, voffB); PG8_STAGE(PG8_SA(0, 1), cA + hstep, voffA);
        if (wr == 1) PG8_BAR;
        PG8_WAIT_V(4); PG8_BAR;
        PG8_STAGE(PG8_SB(1, 0), cB + kstep, voffB); PG8_STAGE(PG8_SA(1, 0), cA + kstep, voffA); PG8_STAGE(PG8_SB(1, 1), cB + hstep + kstep, voffB);
        PG8_WAIT_V(6); PG8_BAR;
    }
    for (;;) {
        const bool has_next = S.next(ui + 1, nxt);
        const char* nA = has_next ? (const char*)g.A + (size_t)nxt.pm * tstep : cA; const char* nB = has_next ? (const char*)g.Bt + (size_t)nxt.pn * tstep : cB;
        for (int t = 0; t < nt; t += 2) {
            const bool last = (t == nt - 2);
            const char* a1 = cA + (size_t)(t + 1) * kstep;
            const char* a2 = last ? nA : cA + (size_t)(t + 2) * kstep; const char* b2 = last ? nB : cB + (size_t)(t + 2) * kstep;
            const char* a3 = a2 + kstep; const char* b3 = b2 + kstep;
            if (last && has_next) S.a_ready(nxt);
            if constexpr (SP2) {
            PG8_LDB(B0, 0, 0); PG8_LDB(B1, 0, 1); PG8_SCHED; PG8_LDA(At, 0, 0); PG8_STAGE(PG8_SA(1, 1), a1 + hstep, voffA);
            PG8_WAIT_V(8); PG8_WAIT_L(0); PG8_BAR; PG8_MMA(0, 0, At, B0); PG8_MMA(0, 1, At, B1); PG8_BAR; PG8_SCHED;
            PG8_LDA(At, 0, 1); PG8_STAGE(PG8_SB(0, 0), b2, voffB); PG8_STAGE(PG8_SB(0, 1), b2 + hstep, voffB); PG8_STAGE(PG8_SA(0, 0), a2, voffA);
            PG8_WAIT_V(8); PG8_WAIT_L(0); PG8_BAR; PG8_MMA(1, 0, At, B0); PG8_MMA(1, 1, At, B1); PG8_BAR; PG8_SCHED;
            PG8_LDB(B0, 1, 0); PG8_LDB(B1, 1, 1); PG8_SCHED; PG8_LDA(At, 1, 0); PG8_STAGE(PG8_SA(0, 1), a2 + hstep, voffA);
            PG8_WAIT_V(8); PG8_WAIT_L(0); PG8_BAR; PG8_MMA(0, 0, At, B0); PG8_MMA(0, 1, At, B1); PG8_BAR; PG8_SCHED;
            PG8_LDA(At, 1, 1); PG8_STAGE(PG8_SB(1, 0), b3, voffB); PG8_STAGE(PG8_SB(1, 1), b3 + hstep, voffB); PG8_STAGE(PG8_SA(1, 0), a3, voffA);
            PG8_WAIT_V(8); PG8_WAIT_L(0); PG8_BAR; PG8_MMA(1, 0, At, B0); PG8_MMA(1, 1, At, B1); PG8_BAR; PG8_SCHED;
            } else {
            PG8_LDB(B0, 0, 0); PG8_SCHED; PG8_LDA(At, 0, 0); PG8_STAGE(PG8_SA(1, 1), a1 + hstep, voffA);
            PG8_WAIT_L(8); PG8_BAR; PG8_WAIT_L(0); PG8_MMA(0, 0, At, B0); PG8_BAR; PG8_SCHED;
            PG8_LDB(B1, 0, 1); PG8_STAGE(PG8_SB(0, 0), b2, voffB);
            PG8_BAR; PG8_WAIT_L(0); PG8_MMA(0, 1, At, B1); PG8_BAR;
            PG8_LDA(At, 0, 1); PG8_STAGE(PG8_SA(0, 0), a2, voffA);
            PG8_BAR; PG8_WAIT_L(0); PG8_MMA(1, 0, At, B0); PG8_BAR; PG8_SCHED;
            PG8_STAGE(PG8_SB(0, 1), b2 + hstep, voffB);
            PG8_WAIT_V(6); PG8_BAR; PG8_MMA(1, 1, At, B1); PG8_BAR;
            PG8_LDB(B0, 1, 0); PG8_SCHED; PG8_LDA(At, 1, 0); PG8_STAGE(PG8_SA(0, 1), a2 + hstep, voffA);
            PG8_WAIT_L(8); PG8_BAR; PG8_WAIT_L(0); PG8_MMA(0, 0, At, B0); PG8_BAR; PG8_SCHED;
            PG8_LDB(B1, 1, 1); PG8_STAGE(PG8_SB(1, 0), b3, voffB);
            PG8_BAR; PG8_WAIT_L(0); PG8_MMA(0, 1, At, B1); PG8_BAR;
            PG8_LDA(At, 1, 1); PG8_STAGE(PG8_SA(1, 0), a3, voffA);
            PG8_BAR; PG8_WAIT_L(0); PG8_MMA(1, 0, At, B0); PG8_BAR; PG8_SCHED;
            PG8_STAGE(PG8_SB(1, 1), b3 + hstep, voffB);
            PG8_WAIT_V(6); PG8_BAR; PG8_MMA(1, 1, At, B1); PG8_BAR;
            }
        }
        if constexpr (ALIGN_EPI) { if (wr == 0) PG8_BAR; }
        if constexpr (!Epi::AFTER_DRAIN) { E(acc, cur, wr, wc, fr, fq); S.done(cur); }
        if (!has_next) break;
#pragma unroll
        for (int a = 0; a < 2; ++a)
#pragma unroll
            for (int b = 0; b < 2; ++b)
#pragma unroll
                for (int m = 0; m < 4; ++m)
#pragma unroll
                    for (int n = 0; n < 2; ++n) acc[a][b][m][n] = (f32x4){0.f, 0.f, 0.f, 0.f};
        cur = nxt; cA = nA; cB = nB; ++ui;
        if constexpr (ALIGN_EPI) { if (wr == 1) PG8_BAR; }
    }
    PG8_WAIT_V(0);
    if constexpr (!ALIGN_EPI) { if (wr == 0) PG8_BAR; }
    PG8_BAR;
    if constexpr (Epi::AFTER_DRAIN) { E.fused(acc, cur, wr, wc, fr, fq, lds, wid, lane); S.done(cur); }
#undef PG8_SA
#undef PG8_SB
#undef PG8_STAGE
#undef PG8_LDA
#undef PG8_LDB
#undef PG8_MMA
#undef PG8_WAIT_V
#undef PG8_WAIT_L
#undef PG8_BAR
#undef PG8_SCHED
}
}
#define GAS __attribute__((address_space(1)))
#define LAS __attribute__((address_space(3)))
typedef unsigned short bf16;
typedef unsigned v4u __attribute__((ext_vector_type(4)));
typedef float f32x4 __attribute__((ext_vector_type(4)));
typedef short bf16x8 __attribute__((ext_vector_type(8)));
typedef GAS unsigned gu32;
typedef GAS unsigned long long gu64;
#define RLX_AGENT __ATOMIC_RELAXED, __HIP_MEMORY_SCOPE_AGENT
#define LDS_WAIT() asm volatile("s_waitcnt lgkmcnt(0)" ::: "memory")
#define VM_WAIT() asm volatile("s_waitcnt vmcnt(0)" ::: "memory")
__device__ __forceinline__ unsigned long long rt() { return __builtin_amdgcn_s_memrealtime(); }
__device__ __forceinline__ unsigned f2bf(float f) { unsigned u = __builtin_bit_cast(unsigned, f); return (u + 0x7fffu + ((u >> 16) & 1u)) >> 16; }
__device__ __forceinline__ unsigned pk2(float lo, float hi) { return f2bf(lo) | (f2bf(hi) << 16); }

#define XB_TMO      128
#define XB_XCNT(j)  (256  + 64 * (j))
#define XB_XSUB(j)  (1280 + 64 * (j))
#define XB_XGEN(j)  (2304 + 64 * (j))
#define XB_TOP      3328
#define XB_TOPGEN   3392
#define XCD_BAR_WORDS 3456
#define XB_SPIN_CAP (1u << 18)

__device__ __forceinline__ unsigned xb_ld(unsigned* p)              { return __hip_atomic_load(p, __ATOMIC_RELAXED, __HIP_MEMORY_SCOPE_AGENT); }
__device__ __forceinline__ unsigned xb_add(unsigned* p, unsigned v) { return __hip_atomic_fetch_add(p, v, __ATOMIC_RELAXED, __HIP_MEMORY_SCOPE_AGENT); }
__device__ __forceinline__ unsigned xb_xcc_id() { return (unsigned)__builtin_amdgcn_s_getreg((3 << 11) | 20) & 0xFu; }
#define XB_SPIN(cond, bar) do { unsigned _sp = 0; while (cond) { __builtin_amdgcn_s_sleep(1); \
    if ((++_sp & 255u) == 0u) { if (xb_ld(&(bar)[XB_TMO])) break; if (_sp > XB_SPIN_CAP) { atomicAdd(&(bar)[XB_TMO], 1u); break; } } } } while (0)

struct XcdBarrier {
    unsigned* bar; unsigned x;
    volatile LAS unsigned* st;
};

__device__ __forceinline__ XcdBarrier xcd_barrier_post(unsigned* bar, volatile LAS unsigned* st) {
    XcdBarrier b; b.bar = bar; b.x = xb_xcc_id(); b.st = st;
    if (threadIdx.x == 0) (void)xb_add(&bar[XB_XCNT(b.x)], 1u);
    return b;
}
__device__ __forceinline__ void xcd_barrier_complete(unsigned* bar, unsigned x, unsigned& nloc, unsigned& nx) {
    const unsigned G = gridDim.x * gridDim.y * gridDim.z;
    unsigned sum, cnt, mine, sp = 0u;
    for (;;) {
        sum = 0u; cnt = 0u; mine = 0u;
#pragma unroll
        for (unsigned j = 0; j < 16; ++j) { const unsigned c = xb_ld(&bar[XB_XCNT(j)]); sum += c; cnt += (c > 0u) ? 1u : 0u; mine = (j == x) ? c : mine; }
        if (sum == G) break;
        __builtin_amdgcn_s_sleep(1);
        if ((++sp & 255u) == 0u) { if (xb_ld(&bar[XB_TMO])) break; if (sp > XB_SPIN_CAP) { atomicAdd(&bar[XB_TMO], 1u); break; } }
    }
    nloc = mine > 0u ? mine : 1u; nx = cnt > 0u ? cnt : 1u;
}

__device__ __forceinline__ void xcd_barrier(const XcdBarrier& b) {
    asm volatile("s_waitcnt vmcnt(0)" ::: "memory");
    __syncthreads();
    if (threadIdx.x == 0) {
        unsigned* bar = b.bar;
        __builtin_amdgcn_s_waitcnt(0);
        unsigned nloc = b.st[0], nx = b.st[1];
        if (nloc == 0u) { xcd_barrier_complete(bar, b.x, nloc, nx); b.st[0] = nloc; b.st[1] = nx; }
        const unsigned old = xb_add(&bar[XB_XSUB(b.x)], 1u);
        const unsigned gen = old / nloc;
        if (old + 1u == (gen + 1u) * nloc) {
            __builtin_amdgcn_fence(__ATOMIC_RELEASE, "agent");
            asm volatile("s_waitcnt vmcnt(0)" ::: "memory");
            const unsigned og = xb_add(&bar[XB_TOP], 1u);
            const unsigned tg = og / nx;
            if (og + 1u == (tg + 1u) * nx) xb_add(&bar[XB_TOPGEN], 1u);
            else XB_SPIN(xb_ld(&bar[XB_TOPGEN]) == tg, bar);
            __builtin_amdgcn_fence(__ATOMIC_ACQUIRE, "agent");
            xb_add(&bar[XB_XGEN(b.x)], 1u);
            asm volatile("s_waitcnt vmcnt(0)" ::: "memory");
        } else {
            XB_SPIN(xb_ld(&bar[XB_XGEN(b.x)]) == gen, bar);
            __builtin_amdgcn_fence(__ATOMIC_ACQUIRE, "agent");
            asm volatile("s_waitcnt vmcnt(0)" ::: "memory");
        }
    }
    __syncthreads();
}
constexpr size_t MiB = 1u << 20;
constexpr size_t WS_CTL = 0, CTL_ZERO_BYTES = 1 * MiB;
constexpr size_t WS_BIAS = 1 * MiB, WS_W2T = WS_BIAS + 16384, WS_A2T = WS_W2T + 131072, WS_G2T = WS_A2T + 131072;
constexpr size_t WS_WGU1 = 2 * MiB, WS_WD1 = WS_WGU1 + 43 * MiB, WS_WINB = WS_WD1 + 21 * MiB + MiB / 2;
constexpr size_t WS_WOUT = 86 * MiB, WS_WGU2 = 94 * MiB, WS_WD2 = 137 * MiB;
constexpr size_t WS_XB = 159 * MiB;
constexpr size_t WS_ACT = 192 * MiB;
constexpr size_t WS_MIX = 246 * MiB;
constexpr size_t WS_LACT = 280 * MiB;
constexpr size_t WS_QB = 300 * MiB, WS_KB = WS_QB + 16 * MiB + MiB / 2, WS_VB = WS_KB + 4 * MiB + MiB / 8;
constexpr size_t WS_DD = 325 * MiB, WS_LG = 358 * MiB, WS_EE = WS_LG + 16 * MiB + MiB / 2, WS_END = WS_EE + 16 * MiB + MiB / 2;
constexpr size_t WS_SLAB = WS_END, WS_DEC = WS_SLAB + 1 * MiB, WS_END2 = WS_DEC + 6 * (size_t)NDEC * RWW * 4;
constexpr size_t VEC16 = 16 * MiB + MiB / 2;
constexpr size_t WS_KK = WS_WGU1, WS_BB = WS_KK + VEC16, WS_KP = WS_BB + VEC16, WS_RR = WS_KP + VEC16, WS_VV = WS_RR + VEC16;
constexpr size_t WS_X2B = WS_WGU1;
static_assert(WS_VV + VEC16 <= WS_WOUT && WS_WINB + 19 * MiB <= WS_WOUT && WS_WD2 + 22 * MiB <= WS_XB && WS_XB + 33 * MiB <= WS_ACT && WS_VB + 4 * MiB + MiB / 8 <= WS_DD && WS_DD + 33 * MiB <= WS_LG, "d_ws map");
constexpr int CW_BAR = 4096;
constexpr int CW_SSQ0 = 16384, CW_SSQ1 = CW_SSQ0 + MPAD, CW_SSQ2 = CW_SSQ1 + MPAD, CW_SSQ3 = CW_SSQ2 + MPAD;
constexpr int CW_SKC = 8192;
constexpr int CW_SSQD = CW_SSQ3 + MPAD;
static_assert((CW_SSQD + MPAD) * 4 <= (int)CTL_ZERO_BYTES, "CTL");
constexpr int RING_OFF = 0, RING_BYTES = 131072;
constexpr int LDSCTL_OFF = RING_BYTES, MISC_OFF = LDSCTL_OFF + 320;
constexpr int LDS_BYTES = 147456;
constexpr int NWAVES = 8;
constexpr int NPHASES = 11;
#ifndef PROBE_REP
#define PROBE_REP 0
#endif
#ifndef MK_N_LAUNCHES
#define MK_N_LAUNCHES 1
#endif

__constant__ unsigned char T5B[129] = {0, 1, 2, 3, 4, 5, 6, 7, 8, 9, 10, 11, 12, 13, 14, 15, 16, 16, 16, 17, 17, 18, 18, 18, 19, 19, 19, 20, 20, 20, 20, 21, 21, 21, 21, 22, 22, 22, 22, 22, 23, 23, 23, 23, 23, 23, 24, 24, 24, 24, 24, 24, 25, 25, 25, 25, 25, 25, 25, 26, 26, 26, 26, 26, 26, 26, 26, 27, 27, 27, 27, 27, 27, 27, 27, 27, 27, 28, 28, 28, 28, 28, 28, 28, 28, 28, 28, 29, 29, 29, 29, 29, 29, 29, 29, 29, 29, 29, 29, 30, 30, 30, 30, 30, 30, 30, 30, 30, 30, 30, 30, 30, 30, 31, 31, 31, 31, 31, 31, 31, 31, 31, 31, 31, 31, 31, 31, 31, 31};

struct Args { const float* in[31]; float* out; unsigned char* ws; int ph_lo, ph_hi, li, pad; };

struct Frame {
    LAS unsigned char* lds;
    volatile LAS unsigned* MISC;
    gu32* ctl;
    int tid, lane, wave, G;
    float* out; unsigned char* ws;
};
typedef float f32x2 __attribute__((ext_vector_type(2)));
__device__ __forceinline__ float bf2f(unsigned short u) { return __builtin_bit_cast(float, (unsigned)u << 16); }
__device__ __forceinline__ unsigned short f2bfs(float f) { return (unsigned short)f2bf(f); }
__device__ __forceinline__ float wave_sum(float v) {
#pragma unroll
    for (int o = 1; o < 64; o <<= 1) v += __shfl_xor(v, o);
    return v;
}
__device__ __forceinline__ float wave_max(float v) {
#pragma unroll
    for (int o = 1; o < 64; o <<= 1) v = fmaxf(v, __shfl_xor(v, o));
    return v;
}
template <int CTRL> __device__ __forceinline__ float dpp_f(float x) { return __builtin_bit_cast(float, __builtin_amdgcn_update_dpp(0, __builtin_bit_cast(int, x), CTRL, 0xf, 0xf, true)); }
__device__ __forceinline__ float allsum16(float x) { x += dpp_f<0x128>(x); x += dpp_f<0x124>(x); x += dpp_f<0x122>(x); x += dpp_f<0x121>(x); return x; }
__device__ __forceinline__ float sigmoidf_(float x) { return __builtin_amdgcn_rcpf(1.0f + __builtin_amdgcn_exp2f(-x * LOG2E)); }
__device__ __forceinline__ float tanhf_(float x) { return 1.0f - 2.0f * __builtin_amdgcn_rcpf(1.0f + __builtin_amdgcn_exp2f(2.0f * LOG2E * x)); }

constexpr int TP_PITCH = 136;
__device__ __forceinline__ void p0_transpose_item(const float* W, int K, int N, bf16* WT, int kb, int nb, int drow, const float* kscale, LAS unsigned char* scr, int lane) {
    const int k0 = 64 * kb, n0 = 64 * nb, g = lane >> 4, c = lane & 15;
    f32x4 v[16];
#pragma unroll
    for (int j = 0; j < 4; ++j)
#pragma unroll
        for (int r = 0; r < 4; ++r) v[4 * j + r] = *(const GAS f32x4*)(W + (size_t)(k0 + 16 * j + 4 * g + r) * N + n0 + 4 * c);
    if (kscale) {
#pragma unroll
        for (int j = 0; j < 4; ++j) { const f32x4 s4 = *(const GAS f32x4*)(kscale + k0 + 16 * j + 4 * g);
            v[4 * j + 0] *= s4.x; v[4 * j + 1] *= s4.y; v[4 * j + 2] *= s4.z; v[4 * j + 3] *= s4.w; } }
#pragma unroll
    for (int j = 0; j < 4; ++j)
#pragma unroll
        for (int e = 0; e < 4; ++e)
            *(LAS unsigned long long*)(scr + (4 * c + e) * TP_PITCH + (16 * j + 4 * g) * 2) = (unsigned long long)pk2(v[4 * j + 0][e], v[4 * j + 1][e]) | ((unsigned long long)pk2(v[4 * j + 2][e], v[4 * j + 3][e]) << 32);
    LDS_WAIT(); asm volatile("" ::: "memory");
#pragma unroll
    for (int i = 0; i < 8; ++i) { const int n = 8 * i + (lane >> 3), kc = lane & 7;
        const LAS unsigned char* s = scr + n * TP_PITCH + kc * 16;
        v4u o; o.x = *(const LAS unsigned*)(s); o.y = *(const LAS unsigned*)(s + 4); o.z = *(const LAS unsigned*)(s + 8); o.w = *(const LAS unsigned*)(s + 12);
        *(GAS v4u*)(WT + (size_t)(drow + n) * K + k0 + 8 * kc) = o; }
    LDS_WAIT(); asm volatile("" ::: "memory");
}
__device__ __forceinline__ int gu_row(int n0, int up) { return 256 * (n0 >> 7) + (n0 & 127) + 128 * up; }

constexpr int I_GU = (DM / 64) * (DFF / 64), I_D = (DFF / 64) * (DM / 64), I_IN = (DM / 64) * (INC / 64), I_OUT = (DM / 64) * (DM / 64), I_L64 = RWW / 64, I_L128 = 2 * (RWW / 64);
constexpr int CV_G0 = 2 * I_GU + 2 * I_L64 + I_L128, CV_G1 = I_D + I_IN, CV_G2 = I_OUT + 2 * I_GU, CV_G3 = I_D, CV_ALL = CV_G0 + CV_G1 + CV_G2 + CV_G3;
__device__ __forceinline__ void convert_items(Frame& F, const Args& A, int first, int count, int rank, int nranks) {
    LAS unsigned char* scr = F.lds + RING_OFF + F.wave * 16384;
    const int lane = F.lane; unsigned char* ws = F.ws;
    for (int it = first + rank * NWAVES + F.wave; it < first + count; it += nranks * NWAVES) {
        int r = it;
        if (r < I_GU) { const int kb = r / (DFF / 64), nb = r % (DFF / 64); p0_transpose_item(A.in[8], DM, DFF, (bf16*)(ws + WS_WGU1), kb, nb, gu_row(64 * nb, 0), A.in[7], scr, lane); continue; } r -= I_GU;
        if (r < I_GU) { const int kb = r / (DFF / 64), nb = r % (DFF / 64); p0_transpose_item(A.in[9], DM, DFF, (bf16*)(ws + WS_WGU1), kb, nb, gu_row(64 * nb, 1), A.in[7], scr, lane); continue; } r -= I_GU;
        if (r < I_L64) { p0_transpose_item(A.in[16], 64, RWW, (bf16*)(ws + WS_W2T), 0, r, 64 * r, nullptr, scr, lane); continue; } r -= I_L64;
        if (r < I_L64) { p0_transpose_item(A.in[18], 64, RWW, (bf16*)(ws + WS_A2T), 0, r, 64 * r, nullptr, scr, lane); continue; } r -= I_L64;
        if (r < I_L128) { const int kb = r / (RWW / 64), nb = r % (RWW / 64); p0_transpose_item(A.in[19], 128, RWW, (bf16*)(ws + WS_G2T), kb, nb, 64 * nb, nullptr, scr, lane); continue; } r -= I_L128;
        if (r < I_D)  { const int kb = r / (DM / 64), nb = r % (DM / 64); p0_transpose_item(A.in[10], DFF, DM, (bf16*)(ws + WS_WD1), kb, nb, 64 * nb, nullptr, scr, lane); continue; } r -= I_D;
        if (r < I_IN) { const int kb = r / (INC / 64), nb = r % (INC / 64); p0_transpose_item(A.in[12], DM, INC, (bf16*)(ws + WS_WINB), kb, nb, 64 * nb, A.in[11], scr, lane); continue; } r -= I_IN;
        if (r < I_OUT) { const int kb = r / (DM / 64), nb = r % (DM / 64); p0_transpose_item(A.in[25], DM, DM, (bf16*)(ws + WS_WOUT), kb, nb, 64 * nb, nullptr, scr, lane); continue; } r -= I_OUT;
        if (r < I_GU) { const int kb = r / (DFF / 64), nb = r % (DFF / 64); p0_transpose_item(A.in[27], DM, DFF, (bf16*)(ws + WS_WGU2), kb, nb, gu_row(64 * nb, 0), A.in[26], scr, lane); continue; } r -= I_GU;
        if (r < I_GU) { const int kb = r / (DFF / 64), nb = r % (DFF / 64); p0_transpose_item(A.in[28], DM, DFF, (bf16*)(ws + WS_WGU2), kb, nb, gu_row(64 * nb, 1), A.in[26], scr, lane); continue; } r -= I_GU;
        { const int kb = r / (DM / 64), nb = r % (DM / 64); p0_transpose_item(A.in[29], DFF, DM, (bf16*)(ws + WS_WD2), kb, nb, 64 * nb, nullptr, scr, lane); }
    }
}
__device__ __forceinline__ void p0_prologue(Frame& F, const Args& A) {
    const int gw = blockIdx.x * NWAVES + F.wave, NGW = F.G * NWAVES, lane = F.lane;
    unsigned char* ws = F.ws;
#ifdef CV_ALL_IN_P0
    convert_items(F, A, 0, CV_ALL, blockIdx.x, F.G);
#else
    convert_items(F, A, 0, CV_G0, blockIdx.x, F.G);
#endif
    bf16* XB = (bf16*)(ws + WS_XB); float* ssq0 = (float*)(F.ctl + CW_SSQ0);
    for (int m = gw; m < MPAD; m += NGW) {
        GAS unsigned long long* o8 = (GAS unsigned long long*)(XB + (size_t)m * DM) + lane;
        if (m < MV) {
            const float* xrow = m < MP ? A.in[0] + (size_t)m * DM : A.in[1] + (size_t)(m - MP) * DM;
            const GAS f32x4* xr = (const GAS f32x4*)xrow + lane; f32x4 v[8]; float s = 0.f;
#pragma unroll
            for (int j = 0; j < 8; ++j) { v[j] = xr[64 * j]; s += (v[j].x * v[j].x + v[j].y * v[j].y) + (v[j].z * v[j].z + v[j].w * v[j].w); }
            s = wave_sum(s);
#pragma unroll
            for (int j = 0; j < 8; ++j) o8[64 * j] = (unsigned long long)pk2(v[j].x, v[j].y) | ((unsigned long long)pk2(v[j].z, v[j].w) << 32);
            if (lane == 0) ssq0[m] = s;
        } else {
#pragma unroll
            for (int j = 0; j < 8; ++j) o8[64 * j] = 0ull;
        }
    }
    float* bt = (float*)(ws + WS_BIAS);
    for (int i = blockIdx.x * (NWAVES * 64) + F.tid; i < 129 * NQH; i += F.G * NWAVES * 64) bt[i] = A.in[6][(int)T5B[i >> 4] * NQH + (i & 15)] * LOG2E;
}
constexpr int PREP_TILES = (MV + 63) / 64  , PREP_UNITS = PREP_TILES * RWH;
constexpr int PA_PITCH = 528;
constexpr int PW_LD = 68;
constexpr int PA_OFF = 0, PW_OFF = 64 * PA_PITCH  , PMAT = 64 * PW_LD * 4  , PB_OFF = 86016  , PC_OFF = 120832;
constexpr int CB_FA = 0, CB_FR = 2048, CB_FNK = 4096, CB_FT = 4608, CB_FMB = 5120, CB_FMK = 5632, CB_FBG = 6144, CB_FKG = 8192, CB_FV = 10240, CB_GC = 12288, CB_BYTES = 12544, CB_STRIDE = 13312;
constexpr int NCHUNK = SEQ / 16;
constexpr size_t CH_NA = (WS_WOUT - WS_WGU1) / CB_STRIDE, CH_NB = (WS_LG - WS_DD) / CB_STRIDE;
static_assert(CH_NA + CH_NB >= (size_t)NB * RWH * NCHUNK, "chunk blocks");
__device__ __forceinline__ unsigned char* chunk_block(unsigned char* ws, int g) { return (size_t)g < CH_NA ? ws + WS_WGU1 + (size_t)g * CB_STRIDE : ws + WS_DD + ((size_t)g - CH_NA) * CB_STRIDE; }
constexpr int LW_OFF = 0, CS2_OFF = 16384;
static_assert(PW_OFF + 3 * PMAT <= PB_OFF && CS2_OFF + 4 * 16384 <= PB_OFF && PB_OFF + 32768 <= PC_OFF && PC_OFF + 2560 <= RING_BYTES, "prep LDS");
constexpr int SC_FA = 0, SC_FR = 2048, SC_FBH = 4096, SC_FKH = 6144, SC_FBG = 8192, SC_FKG = 10240, SC_FV = 12288, SC_NB = 14336, SC_TT = 15360;
typedef short s16x4 __attribute__((ext_vector_type(4)));
typedef __bf16 bf16x2_t __attribute__((ext_vector_type(2)));
__device__ __forceinline__ unsigned cvtpk_c(float lo, float hi) { const f32x2 v = {lo, hi}; return __builtin_bit_cast(unsigned, __builtin_convertvector(v, bf16x2_t)); }
__device__ __forceinline__ unsigned long long pack4bf(f32x4 v) { return (unsigned long long)cvtpk_c(v.x, v.y) | ((unsigned long long)cvtpk_c(v.z, v.w) << 32); }
__device__ __forceinline__ void chunk_mm(LAS unsigned char* lds, int c, unsigned char* blk, int lane) {
    asm volatile("" : "+v"(lane));
    LAS unsigned char* sc = lds + CS2_OFF + c * 16384;
    const int x = lane & 15, q = lane >> 4;
    bf16x8 aB[2], aK[2], bA[2], bR[2];
#pragma unroll
    for (int k2 = 0; k2 < 2; ++k2) { aB[k2] = *(const LAS bf16x8*)(sc + SC_FBH + (k2 * 64 + lane) * 16); aK[k2] = *(const LAS bf16x8*)(sc + SC_FKH + (k2 * 64 + lane) * 16);
        bA[k2] = *(const LAS bf16x8*)(sc + SC_FA + (k2 * 64 + lane) * 16); bR[k2] = *(const LAS bf16x8*)(sc + SC_FR + (k2 * 64 + lane) * 16); }
    f32x4 nb = (f32x4){0.f, 0.f, 0.f, 0.f}, nk = nb, mb_ = nb, mk = nb;
#pragma unroll
    for (int k2 = 0; k2 < 2; ++k2) { nb = __builtin_amdgcn_mfma_f32_16x16x32_bf16(aB[k2], bA[k2], nb, 0, 0, 0); nk = __builtin_amdgcn_mfma_f32_16x16x32_bf16(aK[k2], bA[k2], nk, 0, 0, 0);
        mb_ = __builtin_amdgcn_mfma_f32_16x16x32_bf16(aB[k2], bR[k2], mb_, 0, 0, 0); mk = __builtin_amdgcn_mfma_f32_16x16x32_bf16(aK[k2], bR[k2], mk, 0, 0, 0); }
#pragma unroll
    for (int r = 0; r < 4; ++r) { const int s_ = 4 * q + r; if (!(s_ < x)) { nb[r] = 0.f; nk[r] = 0.f; } if (!(s_ <= x)) { mb_[r] = 0.f; mk[r] = 0.f; } }
    *(GAS unsigned long long*)(blk + CB_FNK + lane * 8) = pack4bf(nk); *(GAS unsigned long long*)(blk + CB_FMB + lane * 8) = pack4bf(mb_); *(GAS unsigned long long*)(blk + CB_FMK + lane * 8) = pack4bf(mk);
    LAS float* nbs = (LAS float*)(sc + SC_NB);
#pragma unroll
    for (int r = 0; r < 4; ++r) nbs[(4 * q + r) * 16 + x] = nb[r];
    float Tc[16];
#pragma unroll
    for (int t = 0; t < 16; ++t) { float a_ = (x == t) ? 1.f : 0.f;
#pragma unroll
        for (int s_ = 0; s_ < t; ++s_) a_ -= Tc[s_] * nbs[s_ * 16 + t];
        Tc[t] = a_; if ((t & 3) == 3) asm volatile("" ::: "memory"); }
    LAS float* tts = (LAS float*)(sc + SC_TT);
#pragma unroll
    for (int t = 0; t < 16; ++t) tts[x * 16 + t] = Tc[t];
    { f32x4 tv;
#pragma unroll
      for (int e = 0; e < 4; ++e) tv[e] = -tts[(4 * q + e) * 16 + x];
      *(GAS unsigned long long*)(blk + CB_FT + lane * 8) = pack4bf(tv); }
}
__device__ __forceinline__ void chunk_copy(LAS unsigned char* lds, int c, unsigned char* blk, int lane) {
    const LAS unsigned char* sc = lds + CS2_OFF + c * 16384;
#pragma unroll
    for (int i = 0; i < 4; ++i) *(GAS v4u*)(blk + CB_FA + (i * 64 + lane) * 16) = *(const LAS v4u*)(sc + SC_FA + (i * 64 + lane) * 16);
#pragma unroll
    for (int i = 0; i < 6; ++i) *(GAS v4u*)(blk + CB_FBG + (i * 64 + lane) * 16) = *(const LAS v4u*)(sc + SC_FBG + (i * 64 + lane) * 16);
}
__device__ __forceinline__ float qsum8(float x) {
    x += dpp_f<0xB1>(x); x += dpp_f<0x4E>(x); x += dpp_f<0x141>(x); return x; }
__device__ __forceinline__ void lact_phase(Frame& F, const Args& A) {
    unsigned char* ws = F.ws; const bf16* PR = (const bf16*)(ws + WS_ACT); bf16* LA = (bf16*)(ws + WS_LACT); const float* mu = A.in[14];
    for (int i = blockIdx.x * (NWAVES * 64) + F.tid; i < MV * 32; i += F.G * NWAVES * 64) { const int m = i >> 5, c8 = i & 31, c0 = 3 * RWW + 8 * c8;
        const bf16* p = PR + (size_t)m * SHC + c0;
        const v4u ua = *(const GAS v4u*)p;
        f32x4 a0, a1, b0 = (f32x4){0.f, 0.f, 0.f, 0.f}, b1 = b0;
#define UNP(u, lo, hi) { lo = (f32x4){__builtin_bit_cast(float, u.x << 16), __builtin_bit_cast(float, u.x & 0xffff0000u), __builtin_bit_cast(float, u.y << 16), __builtin_bit_cast(float, u.y & 0xffff0000u)}; \
                         hi = (f32x4){__builtin_bit_cast(float, u.z << 16), __builtin_bit_cast(float, u.z & 0xffff0000u), __builtin_bit_cast(float, u.w << 16), __builtin_bit_cast(float, u.w & 0xffff0000u)}; }
        UNP(ua, a0, a1)
        if (m >= MP) { const float* pv = A.in[5] + (size_t)(m - MP) * SHC + c0; b0 = *(const GAS f32x4*)pv; b1 = *(const GAS f32x4*)(pv + 4); }
        else if ((m & (SEQ - 1)) != 0) { const v4u ub = *(const GAS v4u*)(p - SHC); UNP(ub, b0, b1) }
#undef UNP
        const f32x4 m0_ = *(const GAS f32x4*)(mu + c0), m1_ = *(const GAS f32x4*)(mu + c0 + 4);
        f32x4 x0 = a0 + m0_ * (b0 - a0), x1 = a1 + m1_ * (b1 - a1);
        if (c8 < 8) { x0.x = tanhf_(x0.x); x0.y = tanhf_(x0.y); x0.z = tanhf_(x0.z); x0.w = tanhf_(x0.w); x1.x = tanhf_(x1.x); x1.y = tanhf_(x1.y); x1.z = tanhf_(x1.z); x1.w = tanhf_(x1.w); }
        else if (c8 >= 16) { x0.x = sigmoidf_(x0.x); x0.y = sigmoidf_(x0.y); x0.z = sigmoidf_(x0.z); x0.w = sigmoidf_(x0.w); x1.x = sigmoidf_(x1.x); x1.y = sigmoidf_(x1.y); x1.z = sigmoidf_(x1.z); x1.w = sigmoidf_(x1.w); }
        *(GAS v4u*)(LA + (size_t)m * 256 + 8 * c8) = (v4u){pk2(x0.x, x0.y), pk2(x0.z, x0.w), pk2(x1.x, x1.y), pk2(x1.z, x1.w)}; }
}
__device__ __forceinline__ void prep_phase(Frame& F, const Args& A) {
    const int tid = F.tid, lane = F.lane, wave = F.wave;
    unsigned char* ws = F.ws; LAS unsigned char* lds = F.lds;
    const bf16* PR = (const bf16*)(ws + WS_ACT);
    const float* mu = A.in[14];
    int hcur = -1;
    const int mtile = wave & 3, nh = wave >> 2;
    v4u ua[4], u0, u1, u2, w0_, w1_, w2_;
#define RAW_LOAD1(M0_) do { const int ma_ = (M0_) + row1, mc_ = ma_ < MV ? ma_ : MV - 1; const bf16* p_ = (const bf16*)(ws + WS_LACT) + (size_t)mc_ * 256 + 32 * cc; \
        _Pragma("unroll") for (int q_ = 0; q_ < 4; ++q_) ua[q_] = *(const GAS v4u*)(p_ + 8 * q_); } while (0)
#define RAW_LOAD3(M0_, H_) do { const int mb_ = (M0_) + tok3, md_ = mb_ < MV ? mb_ : MV - 1, me_ = (md_ & (SEQ - 1)) != 0 ? md_ - 1 : md_; \
        const bf16* r_ = PR + (size_t)md_ * SHC + 64 * (H_) + 8 * cq; const bf16* rp_ = PR + (size_t)me_ * SHC + 64 * (H_) + 8 * cq; \
        u0 = *(const GAS v4u*)r_; u1 = *(const GAS v4u*)(r_ + RWW); u2 = *(const GAS v4u*)(r_ + 2 * RWW); \
        w0_ = *(const GAS v4u*)rp_; w1_ = *(const GAS v4u*)(rp_ + RWW); w2_ = *(const GAS v4u*)(rp_ + 2 * RWW); } while (0)
    if ((int)blockIdx.x < PREP_UNITS) { const int row1 = tid >> 3, cc = tid & 7, c01 = 3 * RWW + 32 * cc; RAW_LOAD1(((int)blockIdx.x >> 4) * 64); }
    for (int u = blockIdx.x; u < PREP_UNITS; u += F.G) {
        int tl_ = tid; asm volatile("" : "+v"(tl_));
        const int row1 = tl_ >> 3, cc = tl_ & 7, c01 = 3 * RWW + 32 * cc;
        const int ln_ = tl_ & 63, t3 = ln_ >> 3, cq = ln_ & 7, tok3 = 8 * wave + t3, ln = ln_ & 15, q4 = ln_ >> 4;
        const int mt = u >> 4, h = u & 15, m0 = mt * 64, hc0 = 64 * h + 8 * cq;
        if (h != hcur) {
            __syncthreads();
            hcur = h;
            { LAS float* cst = (LAS float*)(lds + PC_OFF);
              for (int i = tid; i < 10 * 64; i += NWAVES * 64) { const int a = i >> 6, c = i & 63, hc = 64 * h + c; float v;
                  if (a < 3) v = mu[a * RWW + hc]; else v = A.in[a == 3 ? 15 : (a == 4 ? 17 : (a == 5 ? 20 : (a == 6 ? 21 : (a == 7 ? 22 : (a == 8 ? 23 : 24)))))][hc];
                  cst[i] = v; } }
#pragma unroll
            for (int i = 0; i < 4; ++i) { const int p_ = tid + 512 * i, fi = p_ >> 6, l_ = p_ & 63;
                const int mat = fi < 8 ? 0 : (fi < 16 ? 1 : 2), fl = fi - (mat == 0 ? 0 : (mat == 1 ? 8 : 16)), KM = mat == 2 ? 128 : 64, nt = fl / (KM / 32), ks = fl % (KM / 32);
                const bf16* Bt = (const bf16*)(ws + (mat == 0 ? WS_W2T : (mat == 1 ? WS_A2T : WS_G2T)));
                *(LAS v4u*)(lds + PB_OFF + p_ * 16) = *(const GAS v4u*)(Bt + (size_t)(64 * h + 16 * nt + (l_ & 15)) * KM + 32 * ks + 8 * (l_ >> 4)); }
            __syncthreads();
        }
        RAW_LOAD3(m0, h);
        const int m1 = m0 + row1; const bool valid1 = m1 < MV;
#define UNP(u, lo, hi) { lo = (f32x4){__builtin_bit_cast(float, u.x << 16), __builtin_bit_cast(float, u.x & 0xffff0000u), __builtin_bit_cast(float, u.y << 16), __builtin_bit_cast(float, u.y & 0xffff0000u)}; \
                         hi = (f32x4){__builtin_bit_cast(float, u.z << 16), __builtin_bit_cast(float, u.z & 0xffff0000u), __builtin_bit_cast(float, u.w << 16), __builtin_bit_cast(float, u.w & 0xffff0000u)}; }
        const int m3 = m0 + tok3; const bool valid3 = m3 < MV;
        f32x4 cr[2], ck[2], cv[2], pr[2], pk[2], pv3[2];
        { const bool hp = valid3 && m3 < MP && (m3 & (SEQ - 1)) != 0; const v4u z4 = (v4u){0u, 0u, 0u, 0u};
          const v4u a_ = hp ? w0_ : z4, b_ = hp ? w1_ : z4, c_ = hp ? w2_ : z4;
          UNP(a_, pr[0], pr[1]) UNP(b_, pk[0], pk[1]) UNP(c_, pv3[0], pv3[1])
          UNP(u0, cr[0], cr[1]) UNP(u1, ck[0], ck[1]) UNP(u2, cv[0], cv[1])
          if (valid3 && m3 >= MP) { const float* q = A.in[5] + (size_t)(m3 - MP) * SHC + hc0;
#pragma unroll
              for (int e = 0; e < 2; ++e) { pr[e] = *(const GAS f32x4*)(q + 4 * e); pk[e] = *(const GAS f32x4*)(q + RWW + 4 * e); pv3[e] = *(const GAS f32x4*)(q + 2 * RWW + 4 * e); } } }
#undef UNP
        for (int rr1_ = 0; rr1_ < 1 + ((PROBE_REP >> 14) & 1); ++rr1_) {
#pragma unroll
        for (int q = 0; q < 4; ++q) *(LAS v4u*)(lds + PA_OFF + row1 * PA_PITCH + (32 * cc + 8 * q) * 2) = valid1 ? ua[q] : (v4u){0u, 0u, 0u, 0u};
        __syncthreads();
#pragma unroll
        for (int mat = 0; mat < 3; ++mat) { const int kbase = mat == 0 ? 0 : (mat == 1 ? 64 : 128), KM = mat == 2 ? 128 : 64;
#pragma unroll
            for (int n2 = 0; n2 < 2; ++n2) { const int nt = 2 * nh + n2; f32x4 acc = (f32x4){0.f, 0.f, 0.f, 0.f};
#pragma unroll
                for (int ks = 0; ks < KM / 32; ++ks) {
                    const bf16x8 a = *(const LAS bf16x8*)(lds + PA_OFF + (16 * mtile + ln) * PA_PITCH + (kbase + 32 * ks + 8 * q4) * 2);
                    const bf16x8 bq = *(const LAS bf16x8*)(lds + PB_OFF + (((mat == 0 ? 0 : (mat == 1 ? 8 : 16)) + nt * (KM / 32) + ks) * 64 + ln_) * 16);
                    acc = __builtin_amdgcn_mfma_f32_16x16x32_bf16(a, bq, acc, 0, 0, 0); }
                LAS float* o = (LAS float*)(lds + PW_OFF + mat * PMAT);
#pragma unroll
                for (int r = 0; r < 4; ++r) o[(16 * mtile + 4 * q4 + r) * PW_LD + 16 * nt + ln] = acc[r]; } }
        __syncthreads();
        }
        { const LAS float* cst = (const LAS float*)(lds + PC_OFF) + 8 * cq;
          const LAS float* Wp = (const LAS float*)(lds + PW_OFF) + tok3 * PW_LD + 8 * cq; const LAS float* Ap = Wp + PMAT / 4; const LAS float* Gp = Ap + PMAT / 4;
          float xr[8], xk[8], xv[8], kkr[8], kp[8], aa[8], gg[8], dec[8], lw2[8]; float n2 = 0.f, bon = 0.f;
#pragma unroll
          for (int e = 0; e < 2; ++e) {
              const f32x4 mur = *(const LAS f32x4*)(cst + 0 * 64 + 4 * e), muk = *(const LAS f32x4*)(cst + 1 * 64 + 4 * e), muv = *(const LAS f32x4*)(cst + 2 * 64 + 4 * e);
              const f32x4 w0 = *(const LAS f32x4*)(cst + 3 * 64 + 4 * e), a0 = *(const LAS f32x4*)(cst + 4 * 64 + 4 * e), k_k = *(const LAS f32x4*)(cst + 5 * 64 + 4 * e);
              const f32x4 k_a = *(const LAS f32x4*)(cst + 6 * 64 + 4 * e), r_k = *(const LAS f32x4*)(cst + 7 * 64 + 4 * e);
              const f32x4 wl = *(const LAS f32x4*)(Wp + 4 * e), al = *(const LAS f32x4*)(Ap + 4 * e), gl = *(const LAS f32x4*)(Gp + 4 * e);
              const f32x4 r4 = cr[e] + mur * (pr[e] - cr[e]), k4 = ck[e] + muk * (pk[e] - ck[e]), v4 = cv[e] + muv * (pv3[e] - cv[e]);
#pragma unroll
              for (int j = 0; j < 4; ++j) { const int i = 4 * e + j;
                  xr[i] = r4[j]; xk[i] = k4[j]; xv[i] = v4[j];
                  lw2[i] = -0.6065306597126334f * LOG2E * sigmoidf_(w0[j] + wl[j]); dec[i] = __builtin_amdgcn_exp2f(lw2[i]);
                  aa[i] = sigmoidf_(a0[j] + al[j]); gg[i] = gl[j];
                  kkr[i] = xk[i] * k_k[j]; n2 += kkr[i] * kkr[i];
                  kp[i] = xk[i] * (1.0f + (aa[i] - 1.0f) * k_a[j]);
                  bon += xr[i] * kp[i] * r_k[j]; } }
          n2 = qsum8(n2); bon = qsum8(bon);
          const float inv = 1.0f / fmaxf(sqrtf(n2), 1e-12f);
          float lgv[8], eev[8], bbv[8];
          { const f32x4 lw0 = *(const LAS f32x4*)(cst + 8 * 64), lw1 = *(const LAS f32x4*)(cst + 8 * 64 + 4), lb0 = *(const LAS f32x4*)(cst + 9 * 64), lb1 = *(const LAS f32x4*)(cst + 9 * 64 + 4);
#pragma unroll
            for (int i = 0; i < 8; ++i) { kkr[i] *= inv; bbv[i] = kkr[i] * aa[i]; const float lw = i < 4 ? lw0[i & 3] : lw1[i & 3], lb = i < 4 ? lb0[i & 3] : lb1[i & 3]; lgv[i] = lw * gg[i]; eev[i] = (lb + bon * xv[i]) * gg[i]; } }
#define PK8(a) (v4u){pk2(a[0], a[1]), pk2(a[2], a[3]), pk2(a[4], a[5]), pk2(a[6], a[7])}
          if (valid3) { const size_t o = (size_t)m3 * RWW + hc0;
              *(GAS v4u*)((bf16*)(ws + WS_LG) + o) = PK8(lgv); *(GAS v4u*)((bf16*)(ws + WS_EE) + o) = PK8(eev); }
          if (u + (int)F.G < PREP_UNITS) RAW_LOAD1(((u + (int)F.G) >> 4) * 64);
          if (m0 >= MP) {
              if (valid3) { float* dv = (float*)(ws + WS_DEC) + (size_t)(m3 - MP) * RWW + hc0;
#define ST8(arr, a) { *(GAS f32x4*)(dv + (size_t)(arr) * NDEC * RWW) = (f32x4){a[0], a[1], a[2], a[3]}; *(GAS f32x4*)(dv + (size_t)(arr) * NDEC * RWW + 4) = (f32x4){a[4], a[5], a[6], a[7]}; }
                  ST8(0, kkr) ST8(1, dec) ST8(2, bbv) ST8(3, kp) ST8(4, xr) ST8(5, xv)
#undef ST8
              }
          } else for (int rr3_ = 0; rr3_ < 1 + ((PROBE_REP >> 15) & 1); ++rr3_) {
              *(LAS f32x4*)(lds + LW_OFF + (tok3 * 64 + 8 * cq) * 4) = (f32x4){lw2[0], lw2[1], lw2[2], lw2[3]}; *(LAS f32x4*)(lds + LW_OFF + (tok3 * 64 + 8 * cq) * 4 + 16) = (f32x4){lw2[4], lw2[5], lw2[6], lw2[7]};
              __syncthreads();
              const int cch = tok3 >> 4, t_ = tok3 & 15;
              if (wave < 4) { LAS float* col = (LAS float*)(lds + LW_OFF) + (16 * wave) * 64 + ln_; float run = 0.f;
#pragma unroll
                  for (int s_ = 0; s_ < 16; ++s_) { run += col[s_ * 64]; col[s_ * 64] = run; } }
              __syncthreads();
              float Lall[8], Lt[8];
              { const LAS float* rp = (const LAS float*)(lds + LW_OFF + (tok3 * 64 + 8 * cq) * 4); const LAS float* ra = (const LAS float*)(lds + LW_OFF + ((16 * cch + 15) * 64 + 8 * cq) * 4);
                const f32x4 a_ = *(const LAS f32x4*)rp, b_ = *(const LAS f32x4*)(rp + 4), c_ = *(const LAS f32x4*)ra, d_ = *(const LAS f32x4*)(ra + 4);
#pragma unroll
                for (int i = 0; i < 4; ++i) { Lt[i] = a_[i]; Lt[4 + i] = b_[i]; Lall[i] = c_[i]; Lall[4 + i] = d_[i]; } }
              unsigned char* blk = chunk_block(ws, ((m0 >> 11) * RWH + h) * NCHUNK + ((m0 & (SEQ - 1)) >> 4) + cch);
              { LAS unsigned char* sc = lds + CS2_OFF + cch * 16384;
                const int ks_ = cq >> 2, qa = 2 * (cq & 1), e0 = 4 * ((cq & 3) >> 1);
                const int a0_ = ((ks_ * 64 + qa * 16 + t_) * 8 + e0) * 2;
#pragma unroll
                for (int hf = 0; hf < 2; ++hf) {
                    float ah[4], rh[4], bh[4], kh[4], bg[4], kg[4], gcv[4];
#pragma unroll
                    for (int i2 = 0; i2 < 4; ++i2) { const int i = 4 * hf + i2;
                        const float gt = __builtin_amdgcn_exp2f(Lt[i]), gp = __builtin_amdgcn_exp2f(Lt[i] - lw2[i]), ig = __builtin_amdgcn_exp2f(-Lt[i]), gr = __builtin_amdgcn_exp2f(Lall[i] - Lt[i]);
                        ah[i2] = gp * kkr[i]; rh[i2] = gt * xr[i]; bh[i2] = bbv[i] * ig; kh[i2] = kp[i] * ig; bg[i2] = bbv[i] * gr; kg[i2] = kp[i] * gr; gcv[i2] = __builtin_amdgcn_exp2f(Lall[i]); }
                    if (t_ == 15) *(GAS f32x4*)(blk + CB_GC + 32 * cq + 16 * hf) = (f32x4){gcv[0], gcv[1], gcv[2], gcv[3]};
#define W4(off, a) *(LAS unsigned long long*)(sc + (off) + a0_ + 256 * hf) = (unsigned long long)cvtpk_c(a[0], a[1]) | ((unsigned long long)cvtpk_c(a[2], a[3]) << 32);
                    W4(SC_FA, ah) W4(SC_FR, rh) W4(SC_FBH, bh) W4(SC_FKH, kh)
#undef W4
#pragma unroll
                    for (int i2 = 0; i2 < 4; ++i2) { const int j_ = 8 * cq + 4 * hf + i2, off = (((j_ >> 4) * 64 + (t_ >> 2) * 16 + (j_ & 15)) * 4 + (t_ & 3)) * 2;
                        *(LAS unsigned short*)(sc + SC_FBG + off) = (unsigned short)cvtpk_c(bg[i2], 0.f); *(LAS unsigned short*)(sc + SC_FKG + off) = (unsigned short)cvtpk_c(kg[i2], 0.f);
                        *(LAS unsigned short*)(sc + SC_FV + off) = (unsigned short)cvtpk_c(xv[4 * hf + i2], 0.f); }
                    asm volatile("" ::: "memory");
                } }
              __syncthreads();
              { unsigned char* blkw = chunk_block(ws, ((m0 >> 11) * RWH + h) * NCHUNK + ((m0 & (SEQ - 1)) >> 4) + (wave & 3));
                if (wave < 4) chunk_mm(lds, wave, blkw, ln_); else chunk_copy(lds, wave - 4, blkw, ln_); }
              __syncthreads();
          }
#undef PK8
        }
    }
#undef RAW_LOAD1
#undef RAW_LOAD3
}

constexpr int AK_PITCH = 144, AV_PITCH = 592, AP_PITCH = 336;
constexpr int AK_OFF = 0, AV_OFF = 272 * AK_PITCH  , AP_OFF = AV_OFF + 64 * AV_PITCH  , AB_OFF = AP_OFF + 8 * 16 * AP_PITCH  ;
static_assert(AB_OFF + 129 * 4 * 4 <= RING_BYTES, "attention LDS");
__device__ __forceinline__ void attn_unit(Frame& F, const Args& A, int b, int blk, int hk) {
    const int tid = F.tid, lane = F.lane, wave = F.wave;
    unsigned char* ws = F.ws; LAS unsigned char* lds = F.lds;
    const bf16* QB = (const bf16*)(ws + WS_QB); const bf16* KB = (const bf16*)(ws + WS_KB); const bf16* VB = (const bf16*)(ws + WS_VB); bf16* MX = (bf16*)(ws + WS_MIX);
    const int mq0 = b * SEQ + blk * 128, mk0 = mq0 - 128;
    for (int i = tid; i < 16 * AK_PITCH / 4; i += NWAVES * 64) ((LAS unsigned*)(lds + AK_OFF + 256 * AK_PITCH))[i] = 0u;
    for (int i = tid; i < 64 * 16; i += NWAVES * 64) ((LAS unsigned*)(lds + AV_OFF + (i >> 4) * AV_PITCH + 512))[i & 15] = 0u;
#pragma unroll
    for (int it = 0; it < 4; ++it) { const int idx = it * 512 + tid, row = idx >> 3, ch = idx & 7;
        v4u kv = (v4u){0u, 0u, 0u, 0u}, vv = kv;
        if (blk > 0 || row >= 128) { kv = *(const GAS v4u*)(KB + (size_t)(mk0 + row) * KVW + hk * 64 + ch * 8); vv = *(const GAS v4u*)(VB + (size_t)(mk0 + row) * KVW + hk * 64 + ch * 8); }
        *(LAS v4u*)(lds + AK_OFF + row * AK_PITCH + ch * 16) = kv;
        LAS unsigned short* vt = (LAS unsigned short*)(lds + AV_OFF + (8 * ch) * AV_PITCH + row * 2);
        vt[0 * (AV_PITCH / 2)] = (unsigned short)(vv.x & 0xffffu); vt[1 * (AV_PITCH / 2)] = (unsigned short)(vv.x >> 16);
        vt[2 * (AV_PITCH / 2)] = (unsigned short)(vv.y & 0xffffu); vt[3 * (AV_PITCH / 2)] = (unsigned short)(vv.y >> 16);
        vt[4 * (AV_PITCH / 2)] = (unsigned short)(vv.z & 0xffffu); vt[5 * (AV_PITCH / 2)] = (unsigned short)(vv.z >> 16);
        vt[6 * (AV_PITCH / 2)] = (unsigned short)(vv.w & 0xffffu); vt[7 * (AV_PITCH / 2)] = (unsigned short)(vv.w >> 16); }
    { const float* bt = (const float*)(ws + WS_BIAS); LAS float* bl = (LAS float*)(lds + AB_OFF);
      for (int i = tid; i < 129 * 4; i += NWAVES * 64) bl[i] = bt[(i >> 2) * NQH + 4 * hk + (i & 3)]; }
    __syncthreads();
    const int g = wave >> 1, half = wave & 1, head = 4 * hk + g, ln = lane & 15, q4 = lane >> 4;
    const float sink2 = A.in[13][head] * LOG2E;
    const LAS float* bl = (const LAS float*)(lds + AB_OFF);
    LAS unsigned char* Pw = lds + AP_OFF + wave * (16 * AP_PITCH);
    bf16x8 qfa[4][2];
#pragma unroll
    for (int rb = 0; rb < 4; ++rb)
#pragma unroll
        for (int ks = 0; ks < 2; ++ks) qfa[rb][ks] = *(const GAS bf16x8*)(QB + (size_t)(mq0 + 64 * half + 16 * rb + ln) * ATTW + head * 64 + 32 * ks + 8 * q4);
#pragma unroll
    for (int rb = 0; rb < 4; ++rb) {
        const int i0 = 64 * half + 16 * rb, kt0 = i0 >> 4;
        bf16x8 qf[2]; qf[0] = qfa[rb][0]; qf[1] = qfa[rb][1];
        f32x4 s[10];
#pragma unroll
        for (int j = 0; j < 10; ++j) { f32x4 acc = (f32x4){0.f, 0.f, 0.f, 0.f};
#pragma unroll
            for (int ks = 0; ks < 2; ++ks) { const bf16x8 kf = *(const LAS bf16x8*)(lds + AK_OFF + (16 * (kt0 + j) + ln) * AK_PITCH + (32 * ks + 8 * q4) * 2);
                acc = __builtin_amdgcn_mfma_f32_16x16x32_bf16(qf[ks], kf, acc, 0, 0, 0); }
            s[j] = acc; }
        float mx[4] = {-INFINITY, -INFINITY, -INFINITY, -INFINITY};
#pragma unroll
        for (int j = 0; j < 10; ++j) { const int kj = 16 * (kt0 + j) + ln;
#pragma unroll
            for (int r = 0; r < 4; ++r) { const int dist = 128 + i0 + 4 * q4 + r - kj; const bool ok = dist >= 0 && dist <= 128 && (blk > 0 || kj >= 128);
                const int dc = dist < 0 ? 0 : (dist > 128 ? 128 : dist);
                const float v = ok ? s[j][r] + bl[dc * 4 + g] : -INFINITY; s[j][r] = v; mx[r] = fmaxf(mx[r], v); } }
        float l[4];
#pragma unroll
        for (int r = 0; r < 4; ++r) { float m_ = mx[r]; m_ = fmaxf(m_, dpp_f<0x128>(m_)); m_ = fmaxf(m_, dpp_f<0x124>(m_)); m_ = fmaxf(m_, dpp_f<0x122>(m_)); m_ = fmaxf(m_, dpp_f<0x121>(m_));
            mx[r] = fmaxf(m_, sink2); l[r] = 0.f; }
#pragma unroll
        for (int j = 0; j < 10; ++j)
#pragma unroll
            for (int r = 0; r < 4; ++r) { const float p = __builtin_amdgcn_exp2f(s[j][r] - mx[r]); l[r] += p;
                *(LAS unsigned short*)(Pw + (4 * q4 + r) * AP_PITCH + (16 * j + ln) * 2) = (unsigned short)cvtpk_c(p, 0.f); }
#pragma unroll
        for (int r = 0; r < 4; ++r) { const float t = allsum16(l[r]);
            l[r] = __builtin_amdgcn_rcpf(t + __builtin_amdgcn_exp2f(sink2 - mx[r])); }
        f32x4 o[4];
#pragma unroll
        for (int dt = 0; dt < 4; ++dt) o[dt] = (f32x4){0.f, 0.f, 0.f, 0.f};
#pragma unroll
        for (int st = 0; st < 5; ++st) { const bf16x8 pf = *(const LAS bf16x8*)(Pw + ln * AP_PITCH + (32 * st + 8 * q4) * 2);
#pragma unroll
            for (int dt = 0; dt < 4; ++dt) { const bf16x8 vf = *(const LAS bf16x8*)(lds + AV_OFF + (16 * dt + ln) * AV_PITCH + (16 * kt0 + 32 * st + 8 * q4) * 2);
                o[dt] = __builtin_amdgcn_mfma_f32_16x16x32_bf16(pf, vf, o[dt], 0, 0, 0); } }
#pragma unroll
        for (int dt = 0; dt < 4; ++dt)
#pragma unroll
            for (int r = 0; r < 4; ++r) *(LAS unsigned short*)(Pw + (4 * q4 + r) * AP_PITCH + (16 * dt + ln) * 2) = (unsigned short)cvtpk_c(o[dt][r] * l[r], 0.f);
#pragma unroll
        for (int i = 0; i < 2; ++i) { const int qrow = 8 * i + (lane >> 3), ch = lane & 7;
            const v4u ov = *(const LAS v4u*)(Pw + qrow * AP_PITCH + ch * 16);
            *(GAS v4u*)(MX + (size_t)(mq0 + i0 + qrow) * DM + head * 64 + ch * 8) = ov; }
    }
    __syncthreads();
}

__device__ __forceinline__ void dec_attn_unit(Frame& F, const Args& A, int du) {
    const int lane = F.lane, wave = F.wave; unsigned char* ws = F.ws;
    const int idx = du * 8 + wave, b = idx >> 4, head = idx & 15, hk = head >> 2, m = MP + b;
    LAS float* qs = (LAS float*)(F.lds + wave * 1024); LAS float* ps = qs + 64;
    const bf16* QB = (const bf16*)(ws + WS_QB); bf16* MX = (bf16*)(ws + WS_MIX);
    const float* bt = (const float*)(ws + WS_BIAS);
    const float sink2 = A.in[13][head] * LOG2E;
    const float qv = bf2f(QB[(size_t)m * ATTW + head * 64 + lane]);
    qs[lane] = qv;
    LDS_WAIT(); asm volatile("" ::: "memory");
    float sc[2];
#pragma unroll
    for (int pi = 0; pi < 2; ++pi) { const int pos = lane + 64 * pi; const float* kr = A.in[2] + ((size_t)(b * WIN + pos) * NKVH + hk) * HD; float d = 0.f;
#pragma unroll
        for (int j = 0; j < 16; ++j) { const f32x4 k4 = *(const f32x4*)(kr + 4 * j); const f32x4 q4v = *(const LAS f32x4*)(qs + 4 * j); d += (k4.x * q4v.x + k4.y * q4v.y) + (k4.z * q4v.z + k4.w * q4v.w); }
        sc[pi] = d + bt[(WIN - pos) * NQH + head]; }
    const float* kn = F.out + O_KS + ((size_t)b * WIN + (WIN - 1)) * KVW + hk * HD; const float* vn = F.out + O_VS + ((size_t)b * WIN + (WIN - 1)) * KVW + hk * HD;
    const float snew = wave_sum(qv * kn[lane]) + bt[head];
    const float mx = fmaxf(fmaxf(wave_max(fmaxf(sc[0], sc[1])), snew), sink2);
    const float p0 = __builtin_amdgcn_exp2f(sc[0] - mx), p1 = __builtin_amdgcn_exp2f(sc[1] - mx), pn = __builtin_amdgcn_exp2f(snew - mx);
    const float linv = __builtin_amdgcn_rcpf(wave_sum(p0 + p1) + pn + __builtin_amdgcn_exp2f(sink2 - mx));
    ps[lane] = p0; ps[lane + 64] = p1;
    LDS_WAIT(); asm volatile("" ::: "memory");
    const float* vr = A.in[3] + ((size_t)(b * WIN) * NKVH + hk) * HD + lane; float o = pn * vn[lane];
#pragma unroll 8
    for (int pos = 0; pos < WIN; ++pos) o += ps[pos] * vr[(size_t)pos * NKVH * HD];
    MX[(size_t)m * DM + head * 64 + lane] = f2bfs(o * linv);
    LDS_WAIT(); asm volatile("" ::: "memory");
}

constexpr int SC_T = 32, SC_REC = 1344  , SC_BUF = SC_T * SC_REC  ;
struct ScanRegs { v4u kk, bb, kp, rr, vv; f32x4 d0, d1; };
__device__ __forceinline__ void scan_load(ScanRegs& R, const unsigned char* ws, int m, int h, int rq, int part) {
    const size_t o = (size_t)m * RWW + 64 * h + 8 * part;
    R.kk = *(const GAS v4u*)((const bf16*)(ws + WS_KK) + o); R.bb = *(const GAS v4u*)((const bf16*)(ws + WS_BB) + o);
    R.kp = *(const GAS v4u*)((const bf16*)(ws + WS_KP) + o); R.rr = *(const GAS v4u*)((const bf16*)(ws + WS_RR) + o);
    R.d0 = *(const GAS f32x4*)((const float*)(ws + WS_DD) + o); R.d1 = *(const GAS f32x4*)((const float*)(ws + WS_DD) + o + 4);
    R.vv = (v4u){0u, 0u, 0u, 0u};
    if (part < 2) R.vv = *(const GAS v4u*)((const bf16*)(ws + WS_VV) + (size_t)m * RWW + 64 * h + 16 * rq + 8 * part);
}
__device__ __forceinline__ void st8(LAS unsigned char* p, v4u u) {
    *(LAS f32x4*)p = (f32x4){__builtin_bit_cast(float, u.x << 16), __builtin_bit_cast(float, u.x & 0xffff0000u), __builtin_bit_cast(float, u.y << 16), __builtin_bit_cast(float, u.y & 0xffff0000u)};
    *(LAS f32x4*)(p + 16) = (f32x4){__builtin_bit_cast(float, u.z << 16), __builtin_bit_cast(float, u.z & 0xffff0000u), __builtin_bit_cast(float, u.w << 16), __builtin_bit_cast(float, u.w & 0xffff0000u)};
}
__device__ __forceinline__ void scan_store(const ScanRegs& R, LAS unsigned char* rec, int part) {
    st8(rec + 0 + 32 * part, R.kk); *(LAS f32x4*)(rec + 256 + 32 * part) = R.d0; *(LAS f32x4*)(rec + 256 + 32 * part + 16) = R.d1;
    st8(rec + 512 + 32 * part, R.bb); st8(rec + 768 + 32 * part, R.kp); st8(rec + 1024 + 32 * part, R.rr);
    if (part < 2) st8(rec + 1280 + 32 * part, R.vv);
}
constexpr int SC_YOFF = 2 * SC_BUF, SC_YBUF = SC_T * 16 * 4 * 4  ;
static_assert(SC_YOFF + 2 * SC_YBUF <= RING_BYTES, "scan LDS");
struct ScanVec { f32x2 kk0, kk1, d0, d1, b0, b1, k0, k1, r0, r1; float v; };
__device__ __forceinline__ void scan_ld(ScanVec& x, const LAS unsigned char* base, const LAS unsigned char* vb, int t) {
    const f32x4 kk = *(const LAS f32x4*)(base + t * SC_REC), dd = *(const LAS f32x4*)(base + t * SC_REC + 256), bb = *(const LAS f32x4*)(base + t * SC_REC + 512),
                kp = *(const LAS f32x4*)(base + t * SC_REC + 768), rr = *(const LAS f32x4*)(base + t * SC_REC + 1024);
    x.kk0 = (f32x2){kk.x, kk.y}; x.kk1 = (f32x2){kk.z, kk.w}; x.d0 = (f32x2){dd.x, dd.y}; x.d1 = (f32x2){dd.z, dd.w}; x.b0 = (f32x2){bb.x, bb.y}; x.b1 = (f32x2){bb.z, bb.w};
    x.k0 = (f32x2){kp.x, kp.y}; x.k1 = (f32x2){kp.z, kp.w}; x.r0 = (f32x2){rr.x, rr.y}; x.r1 = (f32x2){rr.z, rr.w};
    x.v = *(const LAS float*)(vb + t * SC_REC);
}
__device__ __forceinline__ void scan_yflush(const LAS unsigned char* yb, float* YS, int ptid) {
#pragma unroll
    for (int i = 0; i < 2; ++i) { const int o = ptid + 256 * i, t = o >> 4, r = o & 15; const f32x4 q = *(const LAS f32x4*)(yb + o * 16);
        YS[(size_t)t * RWW + r] = (q.x + q.y) + (q.z + q.w); }
}
__device__ __forceinline__ void scan_unit(Frame& F, int c) {
    const int b = c >> 6, h = (c >> 2) & 15, rq = c & 3, lane = F.lane, wave = F.wave;
    unsigned char* ws = F.ws; LAS unsigned char* lds = F.lds;
    const int mb = b * SEQ; constexpr int NCH = SEQ / SC_T;
    if (wave >= 4) {
        const int ptid = F.tid - 256, tok = ptid >> 3, part = ptid & 7;
        float* YS = (float*)(ws + WS_ACT) + (size_t)mb * RWW + 64 * h + 16 * rq;
        ScanRegs cur, nxt;
        scan_load(cur, ws, mb + tok, h, rq, part);
        scan_load(nxt, ws, mb + SC_T + tok, h, rq, part);
        scan_store(cur, lds + tok * SC_REC, part);
        __syncthreads();
        for (int ch = 0; ch < NCH; ++ch) {
            cur = nxt;
            if (ch + 2 < NCH) scan_load(nxt, ws, mb + (ch + 2) * SC_T + tok, h, rq, part);
            if (ch + 1 < NCH) scan_store(cur, lds + ((ch + 1) & 1) * SC_BUF + tok * SC_REC, part);
            if (ch > 0) scan_yflush(lds + SC_YOFF + ((ch - 1) & 1) * SC_YBUF, YS + (size_t)(ch - 1) * SC_T * RWW, ptid);
            __syncthreads();
        }
        scan_yflush(lds + SC_YOFF + ((NCH - 1) & 1) * SC_YBUF, YS + (size_t)(NCH - 1) * SC_T * RWW, ptid);
    } else {
        const int rl = 4 * wave + (lane >> 4), p = lane & 15, row = 16 * rq + rl;
        f32x2 S0 = (f32x2){0.f, 0.f}, S1 = S0;
        __builtin_amdgcn_s_setprio(2);
        __syncthreads();
        for (int ch = 0; ch < NCH; ++ch) {
            const LAS unsigned char* base = lds + (ch & 1) * SC_BUF + p * 16;
            const LAS unsigned char* vb = lds + (ch & 1) * SC_BUF + 1280 + rl * 4;
            LAS unsigned char* yb = lds + SC_YOFF + (ch & 1) * SC_YBUF + (rl * 4 + (p & 3)) * 4;
            ScanVec cur; scan_ld(cur, base, vb, 0);
#pragma unroll
            for (int t = 0; t < SC_T; ++t) {
                ScanVec nxt; scan_ld(nxt, base, vb, t + 1 < SC_T ? t + 1 : t);
                f32x2 a = S0 * cur.kk0; a = S1 * cur.kk1 + a;
                const float sa = -allsum16(a.x + a.y);
                const f32x2 sa2 = (f32x2){sa, sa}, v2 = (f32x2){cur.v, cur.v};
                f32x2 u0 = cur.b0 * sa2, u1 = cur.b1 * sa2;
                u0 = S0 * cur.d0 + u0; u1 = S1 * cur.d1 + u1;
                S0 = cur.k0 * v2 + u0; S1 = cur.k1 * v2 + u1;
                f32x2 q = S0 * cur.r0; q = S1 * cur.r1 + q;
                float y = q.x + q.y; y += dpp_f<0x128>(y); y += dpp_f<0x124>(y);
                *(LAS float*)(yb + t * 256) = y;
                cur = nxt;
            }
            __syncthreads();
        }
        __builtin_amdgcn_s_setprio(0);
        *(f32x4*)(F.out + O_WP + ((size_t)(b * RWH + h) * HD + row) * HD + 4 * p) = (f32x4){S0.x, S0.y, S1.x, S1.y};
    }
}
__device__ __forceinline__ void dec_rwkv_unit(Frame& F, const Args& A, int du) {
    const int lane = F.lane, wave = F.wave; unsigned char* ws = F.ws;
    const int idx = du * 8 + wave, b = idx >> 4, h = idx & 15, m = MP + b;
    LAS float* vec = (LAS float*)(F.lds + wave * 1280);
    const size_t o = (size_t)m * RWW + 64 * h + lane;
    const float* dv = (const float*)(ws + WS_DEC) + (size_t)b * RWW + 64 * h + lane;
    vec[lane] = dv[0]; vec[64 + lane] = dv[(size_t)1 * NDEC * RWW]; vec[128 + lane] = dv[(size_t)2 * NDEC * RWW];
    vec[192 + lane] = dv[(size_t)3 * NDEC * RWW]; vec[256 + lane] = dv[(size_t)4 * NDEC * RWW];
    const float vi = dv[(size_t)5 * NDEC * RWW];
    const size_t so = ((size_t)(b * RWH + h) * HD + lane) * HD;
    const float* Sp = A.in[4] + so; f32x4 S[16];
#pragma unroll
    for (int j = 0; j < 16; ++j) S[j] = *(const f32x4*)(Sp + 4 * j);
    LDS_WAIT(); asm volatile("" ::: "memory");
    float sa = 0.f;
#pragma unroll
    for (int j = 0; j < 16; ++j) { const f32x4 kk = *(const LAS f32x4*)(vec + 4 * j); sa += (S[j].x * kk.x + S[j].y * kk.y) + (S[j].z * kk.z + S[j].w * kk.w); asm volatile("" ::: "memory"); }
    sa = -sa; float y = 0.f; float* So = F.out + O_WS + so;
#pragma unroll
    for (int j = 0; j < 16; ++j) { const f32x4 dd = *(const LAS f32x4*)(vec + 64 + 4 * j), bb = *(const LAS f32x4*)(vec + 128 + 4 * j), kp = *(const LAS f32x4*)(vec + 192 + 4 * j), rr = *(const LAS f32x4*)(vec + 256 + 4 * j);
        S[j] = S[j] * dd + bb * sa + kp * vi; y += (S[j].x * rr.x + S[j].y * rr.y) + (S[j].z * rr.z + S[j].w * rr.w);
        *(f32x4*)(So + 4 * j) = S[j]; asm volatile("" ::: "memory"); }
    { const float mean = wave_sum(y) * (1.0f / 64.0f), dl = y - mean, var = wave_sum(dl * dl) * (1.0f / 64.0f);
      const float r_ = dl * __builtin_amdgcn_rsqf(var + GN_EPS) * bf2f(((const bf16*)(ws + WS_LG))[o]) + bf2f(((const bf16*)(ws + WS_EE))[o]);
      ((bf16*)(ws + WS_MIX))[(size_t)m * DM + ATTW + 64 * h + lane] = f2bfs(r_); }
    LDS_WAIT(); asm volatile("" ::: "memory");
}


__device__ __forceinline__ void post_rows8(unsigned char* ws, int m, int h, int cq, bool ok) {
    const float* YS = (const float*)(ws + WS_ACT); const bf16* LG = (const bf16*)(ws + WS_LG); const bf16* EE = (const bf16*)(ws + WS_EE); bf16* MIXB = (bf16*)(ws + WS_MIX);
    const size_t o = (size_t)(ok ? m : 0) * RWW + 64 * h + 8 * cq;
    const f32x4 y0 = *(const GAS f32x4*)(YS + o), y1 = *(const GAS f32x4*)(YS + o + 4);
    const v4u lg = *(const GAS v4u*)(LG + o), ee = *(const GAS v4u*)(EE + o);
    const float mean = qsum8((y0.x + y0.y) + (y0.z + y0.w) + (y1.x + y1.y) + (y1.z + y1.w)) * (1.0f / 64.0f);
    const f32x4 d0 = y0 - mean, d1 = y1 - mean;
    const float var = qsum8((d0.x * d0.x + d0.y * d0.y) + (d0.z * d0.z + d0.w * d0.w) + (d1.x * d1.x + d1.y * d1.y) + (d1.z * d1.z + d1.w * d1.w)) * (1.0f / 64.0f);
    const float rs = __builtin_amdgcn_rsqf(var + GN_EPS);
#define BFL(w) __builtin_bit_cast(float, (w) << 16)
#define BFH(w) __builtin_bit_cast(float, (w) & 0xffff0000u)
    v4u r;
    r.x = cvtpk_c(d0.x * rs * BFL(lg.x) + BFL(ee.x), d0.y * rs * BFH(lg.x) + BFH(ee.x)); r.y = cvtpk_c(d0.z * rs * BFL(lg.y) + BFL(ee.y), d0.w * rs * BFH(lg.y) + BFH(ee.y));
    r.z = cvtpk_c(d1.x * rs * BFL(lg.z) + BFL(ee.z), d1.y * rs * BFH(lg.z) + BFH(ee.z)); r.w = cvtpk_c(d1.z * rs * BFL(lg.w) + BFL(ee.w), d1.w * rs * BFH(lg.w) + BFH(ee.w));
#undef BFL
#undef BFH
    if (ok) *(GAS v4u*)(MIXB + (size_t)m * DM + ATTW + 64 * h + 8 * cq) = r;
}
constexpr int SC2_NS = 8, SC2_D = SC2_NS - 1;
static_assert(SC2_NS * CB_STRIDE <= RING_BYTES, "scan ring");
__device__ __forceinline__ void scan2_unit(Frame& F, int c) {
    const int b = c >> 4, h = c & 15, lane = F.lane, wave = F.wave;
    unsigned char* ws = F.ws; LAS unsigned char* lds = F.lds;
    const int mb = b * SEQ, g0 = (b * RWH + h) * NCHUNK;
#define SC2_BAR() do { asm volatile("" ::: "memory"); __builtin_amdgcn_s_barrier(); asm volatile("" ::: "memory"); } while (0)
    if (wave >= 4) {
        const int lw = wave - 4;
#define SC2_ISSUE(cc) do { const unsigned char* blk_ = chunk_block(ws, g0 + (cc)); LAS unsigned char* sl_ = lds + ((cc) & (SC2_NS - 1)) * CB_STRIDE; \
            for (int p_ = lw; p_ < 13; p_ += 4) __builtin_amdgcn_global_load_lds((const unsigned*)(blk_ + p_ * 1024 + lane * 16), (LAS unsigned*)(sl_ + p_ * 1024), 16, 0, 0); } while (0)
#define SC2_WAIT() do { if (lw == 0) asm volatile("s_waitcnt vmcnt(20)" ::: "memory"); else asm volatile("s_waitcnt vmcnt(15)" ::: "memory"); } while (0)
        for (int cc = 0; cc < SC2_D; ++cc) SC2_ISSUE(cc);
        SC2_WAIT(); SC2_BAR();
        for (int cc = 0; cc < NCHUNK; ++cc) {
            if (cc + SC2_D < NCHUNK) { SC2_ISSUE(cc + SC2_D); SC2_WAIT(); } else asm volatile("s_waitcnt vmcnt(0)" ::: "memory");
            SC2_BAR();
        }
#undef SC2_ISSUE
#undef SC2_WAIT
    } else {
        const int it = wave, x = lane & 15, q = lane >> 4;
        f32x4 S[4];
#pragma unroll
        for (int jt = 0; jt < 4; ++jt) S[jt] = (f32x4){0.f, 0.f, 0.f, 0.f};
        float* YS = (float*)(ws + WS_ACT) + (size_t)mb * RWW + 64 * h + 16 * it + x;
        struct CkOps { bf16x8 fa[2], fr[2]; s16x4 fnk, ft, fmb, fmk, fv, fbg[4], fkg[4]; f32x4 gc[4]; };
#define SC2_LOAD(O, cc) do { const LAS unsigned char* sl = lds + ((cc) & (SC2_NS - 1)) * CB_STRIDE; \
            _Pragma("unroll") for (int k2 = 0; k2 < 2; ++k2) { O.fa[k2] = *(const LAS bf16x8*)(sl + CB_FA + (k2 * 64 + lane) * 16); O.fr[k2] = *(const LAS bf16x8*)(sl + CB_FR + (k2 * 64 + lane) * 16); } \
            O.fnk = *(const LAS s16x4*)(sl + CB_FNK + lane * 8); O.ft = *(const LAS s16x4*)(sl + CB_FT + lane * 8); O.fmb = *(const LAS s16x4*)(sl + CB_FMB + lane * 8); O.fmk = *(const LAS s16x4*)(sl + CB_FMK + lane * 8); \
            O.fv = *(const LAS s16x4*)(sl + CB_FV + (it * 64 + lane) * 8); \
            _Pragma("unroll") for (int jt = 0; jt < 4; ++jt) { O.fbg[jt] = *(const LAS s16x4*)(sl + CB_FBG + (jt * 64 + lane) * 8); O.fkg[jt] = *(const LAS s16x4*)(sl + CB_FKG + (jt * 64 + lane) * 8); \
                O.gc[jt] = *(const LAS f32x4*)(sl + CB_GC + (16 * jt + 4 * q) * 4); } } while (0)
#define SC2_STEP(O, N, cc) do { \
            bf16x8 sb[2]; \
            _Pragma("unroll") for (int k2 = 0; k2 < 2; ++k2) { const unsigned long long lo = pack4bf(S[2 * k2]), hi = pack4bf(S[2 * k2 + 1]); \
                v4u w_; w_.x = (unsigned)lo; w_.y = (unsigned)(lo >> 32); w_.z = (unsigned)hi; w_.w = (unsigned)(hi >> 32); sb[k2] = __builtin_bit_cast(bf16x8, w_); } \
            f32x4 X = (f32x4){0.f, 0.f, 0.f, 0.f}; \
            X = __builtin_amdgcn_mfma_f32_16x16x32_bf16(O.fa[0], sb[0], X, 0, 0, 0); X = __builtin_amdgcn_mfma_f32_16x16x32_bf16(O.fa[1], sb[1], X, 0, 0, 0); \
            X = __builtin_amdgcn_mfma_f32_16x16x16bf16_1k(O.fnk, O.fv, X, 0, 0, 0); \
            f32x4 Y = (f32x4){0.f, 0.f, 0.f, 0.f}; \
            Y = __builtin_amdgcn_mfma_f32_16x16x32_bf16(O.fr[0], sb[0], Y, 0, 0, 0); Y = __builtin_amdgcn_mfma_f32_16x16x32_bf16(O.fr[1], sb[1], Y, 0, 0, 0); \
            Y = __builtin_amdgcn_mfma_f32_16x16x16bf16_1k(O.fmk, O.fv, Y, 0, 0, 0); \
            f32x4 Sn[4]; \
            _Pragma("unroll") for (int jt = 0; jt < 4; ++jt) Sn[jt] = __builtin_amdgcn_mfma_f32_16x16x16bf16_1k(O.fkg[jt], O.fv, S[jt] * O.gc[jt], 0, 0, 0); \
            const s16x4 xb = __builtin_bit_cast(s16x4, pack4bf(X)); \
            const f32x4 U = __builtin_amdgcn_mfma_f32_16x16x16bf16_1k(O.ft, xb, (f32x4){0.f, 0.f, 0.f, 0.f}, 0, 0, 0);         \
            const s16x4 ub = __builtin_bit_cast(s16x4, pack4bf(U)); \
            Y = __builtin_amdgcn_mfma_f32_16x16x16bf16_1k(O.fmb, ub, Y, 0, 0, 0); \
            _Pragma("unroll") for (int jt = 0; jt < 4; ++jt) S[jt] = __builtin_amdgcn_mfma_f32_16x16x16bf16_1k(O.fbg[jt], ub, Sn[jt], 0, 0, 0); \
            if ((cc) + 1 < NCHUNK) SC2_LOAD(N, (cc) + 1); \
            _Pragma("unroll") for (int r = 0; r < 4; ++r) YS[(size_t)(16 * (cc) + 4 * q + r) * RWW] = Y[r];                           \
            asm volatile("s_waitcnt lgkmcnt(0)" ::: "memory"); \
            SC2_BAR(); } while (0)
        CkOps Oa, Ob;
        SC2_BAR();
        SC2_LOAD(Oa, 0);
        for (int cc = 0; cc < NCHUNK; cc += 2) { SC2_STEP(Oa, Ob, cc); SC2_STEP(Ob, Oa, cc + 1); }
#undef SC2_STEP
#undef SC2_LOAD
#pragma unroll
        for (int jt = 0; jt < 4; ++jt) *(f32x4*)(F.out + O_WP + ((size_t)(b * RWH + h) * HD + 16 * it + x) * HD + 16 * jt + 4 * q) = S[jt];
    }
    asm volatile("s_waitcnt vmcnt(0)" ::: "memory"); SC2_BAR();
#pragma unroll 4
    for (int t8 = wave; t8 < SEQ / 8; t8 += NWAVES) post_rows8(ws, mb + 8 * t8 + (lane >> 3), h, lane & 7, true);
#undef SC2_BAR
}

constexpr int SK_S = 8;
__device__ __forceinline__ void skinny_units(Frame& F, const bf16* Arows, int lda, const bf16* Bt, int K, unsigned* cnt, float* slabs,
                                             const float* xi_s, const bf16* xb_in, float* xo_s, bf16* XBd, float* ssq, float alpha) {
    const int tid = F.tid, lane = F.lane, wave = F.wave, ln = lane & 15, q4 = lane >> 4, ksteps = K / 32;
    LAS unsigned char* lds = F.lds;
    for (int u = blockIdx.x; u < 32 * SK_S; u += F.G) {
        const int nb = u & 31, sl = u >> 5, n0 = 64 * nb, ks0 = sl * ksteps / SK_S, ks1 = (sl + 1) * ksteps / SK_S;
        f32x4 acc[2][4];
#pragma unroll
        for (int mt = 0; mt < 2; ++mt)
#pragma unroll
            for (int nt = 0; nt < 4; ++nt) acc[mt][nt] = (f32x4){0.f, 0.f, 0.f, 0.f};
        const bf16* ap = Arows + (size_t)ln * lda + 8 * q4; const bf16* bp = Bt + (size_t)(n0 + ln) * K + 8 * q4;
        bf16x8 a[3][2], b[3][4];
#pragma unroll
        for (int i = 0; i < 3; ++i) { const int ks = ks0 + wave + 8 * i; const int k = 32 * (ks < ks1 ? ks : ks0);
#pragma unroll
            for (int mt = 0; mt < 2; ++mt) a[i][mt] = *(const GAS bf16x8*)(ap + (size_t)(16 * mt) * lda + k);
#pragma unroll
            for (int nt = 0; nt < 4; ++nt) b[i][nt] = *(const GAS bf16x8*)(bp + (size_t)(16 * nt) * K + k); }
#pragma unroll
        for (int i = 0; i < 3; ++i) if (ks0 + wave + 8 * i < ks1) {
#pragma unroll
            for (int mt = 0; mt < 2; ++mt)
#pragma unroll
                for (int nt = 0; nt < 4; ++nt) acc[mt][nt] = __builtin_amdgcn_mfma_f32_16x16x32_bf16(a[i][mt], b[i][nt], acc[mt][nt], 0, 0, 0); }
#pragma unroll
        for (int mt = 0; mt < 2; ++mt)
#pragma unroll
            for (int nt = 0; nt < 4; ++nt) *(LAS f32x4*)(lds + ((wave * 8 + mt * 4 + nt) * 64 + lane) * 16) = acc[mt][nt];
        __syncthreads();
        { const int tile = tid >> 6, l = tid & 63; f32x4 sum = (f32x4){0.f, 0.f, 0.f, 0.f};
#pragma unroll
          for (int w = 0; w < 8; ++w) sum += *(const LAS f32x4*)(lds + ((w * 8 + tile) * 64 + l) * 16);
          float* sp = slabs + (size_t)sl * 32 * DM + (size_t)(16 * (tile >> 2) + 4 * (l >> 4)) * DM + n0 + 16 * (tile & 3) + (l & 15);
          __hip_atomic_store(sp, sum.x, __ATOMIC_RELAXED, __HIP_MEMORY_SCOPE_AGENT); __hip_atomic_store(sp + DM, sum.y, __ATOMIC_RELAXED, __HIP_MEMORY_SCOPE_AGENT);
          __hip_atomic_store(sp + 2 * DM, sum.z, __ATOMIC_RELAXED, __HIP_MEMORY_SCOPE_AGENT); __hip_atomic_store(sp + 3 * DM, sum.w, __ATOMIC_RELAXED, __HIP_MEMORY_SCOPE_AGENT); }
        VM_WAIT(); __syncthreads();
        if (tid == 0) { const unsigned t = __hip_atomic_fetch_add(cnt + nb, 1u, __ATOMIC_RELAXED, __HIP_MEMORY_SCOPE_AGENT);
            *(LAS unsigned*)(lds + 65536) = (t == (unsigned)(SK_S - 1)) ? 1u : 0u; }
        __syncthreads();
        const unsigned last = *(const LAS unsigned*)(lds + 65536);
        if (last) {
            const int row = tid >> 4, c4 = (tid & 15) * 4, col = n0 + c4;
            f32x4 a4 = (f32x4){0.f, 0.f, 0.f, 0.f};
#pragma unroll
            for (int s2 = 0; s2 < SK_S; ++s2) { const float* sp2 = slabs + (size_t)s2 * 32 * DM + (size_t)row * DM + col;
                a4.x += __hip_atomic_load(sp2, __ATOMIC_RELAXED, __HIP_MEMORY_SCOPE_AGENT); a4.y += __hip_atomic_load(sp2 + 1, __ATOMIC_RELAXED, __HIP_MEMORY_SCOPE_AGENT);
                a4.z += __hip_atomic_load(sp2 + 2, __ATOMIC_RELAXED, __HIP_MEMORY_SCOPE_AGENT); a4.w += __hip_atomic_load(sp2 + 3, __ATOMIC_RELAXED, __HIP_MEMORY_SCOPE_AGENT); }
            f32x4 x0;
            if (xb_in) { const unsigned long long w = *(const GAS unsigned long long*)(xb_in + (size_t)(MP + row) * DM + col);
                x0 = (f32x4){__builtin_bit_cast(float, (unsigned)w << 16), __builtin_bit_cast(float, (unsigned)w & 0xffff0000u), __builtin_bit_cast(float, (unsigned)(w >> 32) << 16), __builtin_bit_cast(float, (unsigned)(w >> 32) & 0xffff0000u)}; }
            else x0 = *(const f32x4*)(xi_s + (size_t)row * DM + col);
            const f32x4 y = x0 + a4 * alpha;
            if (xo_s) *(f32x4*)(xo_s + (size_t)row * DM + col) = y;
            if (XBd) *(GAS unsigned long long*)(XBd + (size_t)(MP + row) * DM + col) = (unsigned long long)pk2(y.x, y.y) | ((unsigned long long)pk2(y.z, y.w) << 32);
            float sq = (y.x * y.x + y.y * y.y) + (y.z * y.z + y.w * y.w);
            sq += __shfl_xor(sq, 1); sq += __shfl_xor(sq, 2); sq += __shfl_xor(sq, 4); sq += __shfl_xor(sq, 8);
            if ((tid & 15) == 0) atomicAdd(ssq + MP + row, sq);
        }
        __syncthreads();
    }
}
__global__ void __launch_bounds__(NWAVES * 64, 2) hymba_fwd(Args args) {
    extern __shared__ __attribute__((aligned(16))) unsigned char lds_raw[];
    { const int t0_ = threadIdx.x;
      for (int u = t0_; u < (LDS_BYTES - LDSCTL_OFF) / 4; u += NWAVES * 64) ((LAS unsigned*)((LAS unsigned char*)lds_raw + LDSCTL_OFF))[u] = 0u; }
    __syncthreads();
    XcdBarrier bar; bar.bar = (unsigned*)((gu32*)(args.ws + WS_CTL) + CW_BAR); bar.x = 0; bar.st = nullptr;
    if (MK_N_LAUNCHES == 1) bar = xcd_barrier_post((unsigned*)((gu32*)(args.ws + WS_CTL) + CW_BAR), (volatile LAS unsigned*)((LAS unsigned char*)lds_raw + MISC_OFF) + 8);
    const int lo = args.ph_lo, hi = args.ph_hi;
#ifndef PH_MASK
#define PH_MASK 0x7ff
#endif
#define IN(k) (((PH_MASK >> (k)) & 1) && lo <= (k) && (k) < hi)
#define SEAM(k) do { if (IN(k) && IN((k) + 1)) xcd_barrier(bar); } while (0)
#ifndef PROBE_REP
#define PROBE_REP 0
#endif
#define NREP(k) (1 + ((PROBE_REP >> (k)) & 1))
#define PHASE_FRAME() Frame F; { int t_ = threadIdx.x; asm volatile("" : "+v"(t_)); F.lds = (LAS unsigned char*)lds_raw; F.MISC = (volatile LAS unsigned*)(F.lds + MISC_OFF); F.tid = t_; F.lane = t_ & 63; \
        F.wave = __builtin_amdgcn_readfirstlane(t_ >> 6); F.G = gridDim.x; F.out = args.out; F.ws = args.ws; F.ctl = (gu32*)(args.ws + WS_CTL); } \
    unsigned char* ws = F.ws; const int gw = blockIdx.x * NWAVES + F.wave, NGW = F.G * NWAVES; (void)gw; (void)NGW; \
    bf16* XB = (bf16*)(ws + WS_XB); bf16* ACT = (bf16*)(ws + WS_ACT); bf16* X2B = (bf16*)(ws + WS_X2B); bf16* MIXB = (bf16*)(ws + WS_MIX); (void)XB; (void)ACT; (void)X2B; (void)MIXB; \
    float* ssq0 = (float*)(F.ctl + CW_SSQ0); float* ssq1 = (float*)(F.ctl + CW_SSQ1); float* ssq2 = (float*)(F.ctl + CW_SSQ2); float* ssq3 = (float*)(F.ctl + CW_SSQ3); float* ssqd = (float*)(F.ctl + CW_SSQD); (void)ssqd; (void)ssq0; (void)ssq1; (void)ssq2; (void)ssq3; \
    float* yp = args.out + O_YP; float* ys = args.out + O_YS; (void)yp; (void)ys;

    if (IN(0)) for (int rep = 0; rep < NREP(0); ++rep) { PHASE_FRAME(); p0_prologue(F, args); if (rep + 1 < NREP(0)) xcd_barrier(bar); else SEAM(0); }
    if (IN(1)) for (int rep = 0; rep < NREP(1); ++rep) { PHASE_FRAME(); pg8::Gemm g{XB, (const bf16*)(ws + WS_WGU1), MPAD, 2 * DFF, DM}; pg8::StaticOrder S; S.init(MPAD, 2 * DFF, F.G, (int)blockIdx.x);
        pg8::EpiSwiglu E{ACT, ssq0};
        pg8::gemm_phase<pg8::EpiSwiglu, pg8::StaticOrder, true, true>(F.lds + RING_OFF, g, S, E);
#ifndef CV_ALL_IN_P0
        { const int nfull = S.nwg % F.G; if (rep == 0 && nfull != 0 && (int)blockIdx.x >= nfull) convert_items(F, args, CV_G0, CV_G1, (int)blockIdx.x - nfull, F.G - nfull);
          else if (rep == 0 && nfull == 0) convert_items(F, args, CV_G0, CV_G1, blockIdx.x, F.G); }
#endif
        if (rep + 1 < NREP(1)) xcd_barrier(bar); else SEAM(1); }
    if (IN(2)) for (int rep = 0; rep < NREP(2); ++rep) { PHASE_FRAME(); pg8::Gemm g{ACT, (const bf16*)(ws + WS_WD1), MP, DM, DFF}; pg8::StaticOrder S; S.init(MP, DM, F.G, (int)blockIdx.x);
        pg8::EpiResid E{nullptr, nullptr, XB, nullptr, nullptr, XB, rep ? ssqd : ssq1, rep ? 0.0f : 0.5f};
        pg8::gemm_phase<pg8::EpiResid, pg8::StaticOrder, true, true>(F.lds + RING_OFF, g, S, E);
        skinny_units(F, ACT + (size_t)MP * DFF, DFF, (const bf16*)(ws + WS_WD1), DFF, (unsigned*)(F.ctl + CW_SKC + 64 * rep), (float*)(ws + WS_QB), nullptr, XB, nullptr, XB, rep ? ssqd : ssq1, rep ? 0.0f : 0.5f);
        if (rep + 1 < NREP(2)) xcd_barrier(bar); else SEAM(2); }
    if (IN(3)) for (int rep = 0; rep < NREP(3); ++rep) { PHASE_FRAME(); pg8::Gemm g{XB, (const bf16*)(ws + WS_WINB), MPAD, INC, DM}; pg8::StaticOrder S; S.init(MPAD, INC, F.G, (int)blockIdx.x);
        pg8::EpiWin E{ssq1, (bf16*)(ws + WS_QB), (bf16*)(ws + WS_KB), (bf16*)(ws + WS_VB), (bf16*)(ws + WS_ACT), args.out};
        pg8::gemm_phase<pg8::EpiWin, pg8::StaticOrder, true, true>(F.lds + RING_OFF, g, S, E);
#ifndef CV_ALL_IN_P0
        { const int nfull = S.nwg % F.G; if (rep == 0 && nfull != 0 && (int)blockIdx.x >= nfull) convert_items(F, args, CV_G0 + CV_G1, CV_G2, (int)blockIdx.x - nfull, F.G - nfull);
          else if (rep == 0 && nfull == 0) convert_items(F, args, CV_G0 + CV_G1, CV_G2, blockIdx.x, F.G); }
#endif
        if (rep + 1 < NREP(3)) xcd_barrier(bar); else SEAM(3); }
    if (IN(4)) for (int rep = 0; rep < NREP(4); ++rep) { PHASE_FRAME();
        lact_phase(F, args); xcd_barrier(bar);
        for (int r2 = 0; r2 < 1 + ((PROBE_REP >> 12) & 1); ++r2) { __syncthreads(); prep_phase(F, args); }
        if (rep + 1 < NREP(4)) xcd_barrier(bar); else SEAM(4); }
    if (IN(5)) for (int rep = 0; rep < NREP(5); ++rep) { PHASE_FRAME();
        if ((int)blockIdx.x < NB * RWH) scan2_unit(F, blockIdx.x);
        else { const int oc = (int)blockIdx.x - NB * RWH, on = (int)F.G - NB * RWH;
            for (int r2 = 0; r2 < 1 + ((PROBE_REP >> 11) & 1); ++r2)
            for (int u = oc; u < NB * 16 * NKVH; u += on) attn_unit(F, args, u >> 6, (u >> 2) & 15, u & 3);
            __syncthreads();
            for (int u = on - 1 - oc; u < NDEC * NQH / 8; u += on) dec_attn_unit(F, args, u);
            __syncthreads();
            for (int u = on - 1 - oc; u < NDEC * RWH / 8; u += on) dec_rwkv_unit(F, args, u);
            { const int n4 = NDEC * (WIN - 1) * KVW / 4;
              for (int i = oc * (NWAVES * 64) + F.tid; i < 2 * n4; i += on * NWAVES * 64) { const int t = i >= n4, j = t ? i - n4 : i; const int bb = j / ((WIN - 1) * KVW / 4), r = j % ((WIN - 1) * KVW / 4);
                  const f32x4 v = *((const f32x4*)(args.in[2 + t] + (size_t)bb * WIN * KVW + KVW) + r);
                  *((f32x4*)(args.out + (t ? O_VS : O_KS) + (size_t)bb * WIN * KVW) + r) = v; } }
        }
        if (rep + 1 < NREP(5)) xcd_barrier(bar); else { if (IN(5) && IN(7)) xcd_barrier(bar); } }
    if (IN(7)) for (int rep = 0; rep < NREP(7); ++rep) { PHASE_FRAME(); pg8::Gemm g{MIXB, (const bf16*)(ws + WS_WOUT), MP, DM, DM}; pg8::StaticOrder S; S.init(MP, DM, F.G, (int)blockIdx.x);
        pg8::EpiResid E{nullptr, nullptr, XB, nullptr, nullptr, X2B, rep ? ssqd : ssq2, 1.0f};
        pg8::gemm_phase<pg8::EpiResid, pg8::StaticOrder, true, true>(F.lds + RING_OFF, g, S, E);
        skinny_units(F, MIXB + (size_t)MP * DM, DM, (const bf16*)(ws + WS_WOUT), DM, (unsigned*)(F.ctl + CW_SKC + 128 + 64 * rep), (float*)(ws + WS_QB), nullptr, XB, nullptr, X2B, rep ? ssqd : ssq2, 1.0f);
        if (rep + 1 < NREP(7)) xcd_barrier(bar); else SEAM(7); }
    if (IN(8)) for (int rep = 0; rep < NREP(8); ++rep) { PHASE_FRAME(); pg8::Gemm g{X2B, (const bf16*)(ws + WS_WGU2), MPAD, 2 * DFF, DM}; pg8::StaticOrder S; S.init(MPAD, 2 * DFF, F.G, (int)blockIdx.x);
        pg8::EpiSwiglu E{ACT, ssq2};
        pg8::gemm_phase<pg8::EpiSwiglu, pg8::StaticOrder, true, true>(F.lds + RING_OFF, g, S, E);
#ifndef CV_ALL_IN_P0
        { const int nfull = S.nwg % F.G; if (rep == 0 && nfull != 0 && (int)blockIdx.x >= nfull) convert_items(F, args, CV_G0 + CV_G1 + CV_G2, CV_G3, (int)blockIdx.x - nfull, F.G - nfull);
          else if (rep == 0 && nfull == 0) convert_items(F, args, CV_G0 + CV_G1 + CV_G2, CV_G3, blockIdx.x, F.G); }
#endif
        if (rep + 1 < NREP(8)) xcd_barrier(bar); else SEAM(8); }
    if (IN(9)) for (int rep = 0; rep < NREP(9); ++rep) { PHASE_FRAME(); pg8::Gemm g{ACT, (const bf16*)(ws + WS_WD2), MP, DM, DFF}; pg8::StaticOrder S; S.init(MP, DM, F.G, (int)blockIdx.x);
        pg8::EpiResid E{nullptr, nullptr, X2B, yp, ys, nullptr, rep ? ssqd : ssq3, 0.5f};
        pg8::gemm_phase<pg8::EpiResid, pg8::StaticOrder, true, true>(F.lds + RING_OFF, g, S, E);
        skinny_units(F, ACT + (size_t)MP * DFF, DFF, (const bf16*)(ws + WS_WD2), DFF, (unsigned*)(F.ctl + CW_SKC + 256 + 64 * rep), (float*)(ws + WS_QB), nullptr, X2B, ys, nullptr, rep ? ssqd : ssq3, 0.5f);
        if (rep + 1 < NREP(9)) xcd_barrier(bar); else SEAM(9); }
    if (IN(10)) for (int rep = 0; rep < NREP(10); ++rep) { PHASE_FRAME(); const float* fn = args.in[30];
        for (int m = gw; m < MV; m += NGW) { float* xr = m < MP ? yp + (size_t)m * DM : ys + (size_t)(m - MP) * DM;
            const float s = rep ? 1.0f : __builtin_amdgcn_rsqf(ssq3[m] * (1.0f / DM) + RMS_EPS);
            GAS f32x4* x4 = (GAS f32x4*)xr + F.lane; const GAS f32x4* f4 = (const GAS f32x4*)fn + F.lane;
#pragma unroll
            for (int j = 0; j < 8; ++j) x4[64 * j] = rep ? x4[64 * j] * s : x4[64 * j] * s * f4[64 * j]; } if (NREP(10) > 1 && rep == 0) xcd_barrier(bar); }
#undef IN
#undef SEAM
}

extern "C" void kernel_launch(void* const* d_in, const int* in_sizes, int n_in, void* d_out, int out_size, void* d_ws, size_t ws_size, hipStream_t stream) {
    static int grid = 0;
    if (grid == 0) {
        if (n_in != 31 || in_sizes[0] != MP * DM || (size_t)out_size != O_END || ws_size < WS_END2) {
            fprintf(stderr, "kernel_launch: unexpected shapes: n_in %d in0 %d out %d (want %zu) ws %zu (want >= %zu); nothing launched\n", n_in, n_in > 0 ? in_sizes[0] : -1, out_size, (size_t)O_END, ws_size, (size_t)WS_END2);
            grid = -1; return; }
        int dev = 0, cus = 0, per_cu = 0;
        if (hipGetDevice(&dev) != hipSuccess || hipDeviceGetAttribute(&cus, hipDeviceAttributeMultiprocessorCount, dev) != hipSuccess) { fprintf(stderr, "kernel_launch: device query failed\n"); grid = -1; return; }
        if (hipFuncSetAttribute((const void*)hymba_fwd, hipFuncAttributeMaxDynamicSharedMemorySize, LDS_BYTES) != hipSuccess) { fprintf(stderr, "kernel_launch: hipFuncSetAttribute failed\n"); grid = -1; return; }
        if (hipOccupancyMaxActiveBlocksPerMultiprocessor(&per_cu, (const void*)hymba_fwd, NWAVES * 64, LDS_BYTES) != hipSuccess || per_cu < 1)
            fprintf(stderr, "kernel_launch: note: occupancy query reports %d workgroups per CU\n", per_cu);
        (void)hipGetLastError();
        grid = cus;
    }
    if (grid < 0) return;
    if (hipMemsetAsync((char*)d_ws + WS_CTL, 0, CTL_ZERO_BYTES, stream) != hipSuccess) { fprintf(stderr, "kernel_launch: hipMemsetAsync failed\n"); return; }
    Args a{};
    for (int i = 0; i < 31; ++i) a.in[i] = (const float*)d_in[i];
    a.out = (float*)d_out; a.ws = (unsigned char*)d_ws;
    for (int li = 0; li < MK_N_LAUNCHES; ++li) {
        a.ph_lo = (MK_N_LAUNCHES == 1) ? 0 : li; a.ph_hi = (MK_N_LAUNCHES == 1) ? NPHASES : li + 1; a.li = li;
        hipLaunchKernelGGL(hymba_fwd, dim3(grid), dim3(NWAVES * 64), LDS_BYTES, stream, a);
        const hipError_t le = hipPeekAtLastError();
        if (le != hipSuccess) { fprintf(stderr, "kernel_launch: launch %d failed: %s\n", li, hipGetErrorName(le)); break; }
    }
}
```
